# Optimizing an MI355X kernel written in HIP

```python
import math
import jax, jax.numpy as jnp
from jax import lax
import numpy as np

D_MODEL = 1024
BATCH = 4
SEQ = 4096
DEPTH = 2

BRANCH_W = D_MODEL // 2
H_A = 4
DV_A = BRANCH_W // H_A
DK_A = DV_A // 2
C_CONV = BRANCH_W
CONV_WIDTH = 31
H_R = 4
DK_R = BRANCH_W // H_R
DV_R = BRANCH_W // H_R
RET_CHUNK = 128
QBLK = 128
N_BRANCH = 3
D_FF = -(-8 * D_MODEL // (3 * 256)) * 256

COL_SIZES = (
    H_A * 2 * DK_A,
    H_A * 2 * DK_A,
    H_A * DV_A,
    2 * C_CONV,
    H_R * DK_R,
    H_R * DK_R,
    H_R * DV_R,
    H_R * DV_R,
    N_BRANCH * D_MODEL,
)
D_IN = sum(COL_SIZES)

kernel_name = "hybrid_diffattn_conformer_retention_gated"


def _rms(x, g, eps=1e-6):
    xf = x.astype(jnp.float32)
    y = xf * lax.rsqrt(jnp.mean(xf * xf, axis=-1, keepdims=True) + eps)
    return (y * g.astype(jnp.float32)).astype(x.dtype)


def _layer_norm(x, g, b, eps=1e-5):
    xf = x.astype(jnp.float32)
    mu = jnp.mean(xf, axis=-1, keepdims=True)
    xc = xf - mu
    y = xc * lax.rsqrt(jnp.mean(xc * xc, axis=-1, keepdims=True) + eps)
    return (y * g.astype(jnp.float32) + b.astype(jnp.float32)).astype(x.dtype)


def _diff_attention(q, k, v, lam):
    B, S = q.shape[0], q.shape[1]
    nblk = S // QBLK
    scale = DK_A ** -0.5
    slopes = 2.0 ** (-8.0 * (jnp.arange(H_A, dtype=jnp.float32) + 1.0) / H_A)
    kpos = jnp.arange(S)
    qb = q.reshape(B, nblk, QBLK, H_A, 2, DK_A).transpose(1, 0, 2, 3, 4, 5)

    def one_block(args):
        qi, i = args
        qpos = i * QBLK + jnp.arange(QBLK)
        dist = qpos[:, None] - kpos[None, :]
        s = jnp.einsum('bqhmd,bkhmd->bhmqk', qi, k,
                       preferred_element_type=jnp.float32) * scale
        s = s - slopes[:, None, None, None] * dist.astype(jnp.float32)
        s = jnp.where(dist >= 0, s, -jnp.inf)
        p = jax.nn.softmax(s, axis=-1)
        a = p[:, :, 0] - lam * p[:, :, 1]
        return jnp.einsum('bhqk,bkhv->bqhv', a.astype(v.dtype), v)

    o = lax.map(one_block, (qb, jnp.arange(nblk)))
    return o.transpose(1, 0, 2, 3, 4).reshape(B, S, H_A, DV_A)


def _conformer_conv(u, w_dw, b_dw, ln_g, ln_b):
    a, gt = jnp.split(u, 2, axis=-1)
    z = a * jax.nn.sigmoid(gt)
    z = lax.conv_general_dilated(
        z, w_dw[:, None, :], window_strides=(1,),
        padding=[(CONV_WIDTH - 1, 0)],
        dimension_numbers=('NWC', 'WIO', 'NWC'),
        feature_group_count=C_CONV) + b_dw
    z = _layer_norm(z, ln_g, ln_b)
    return jax.nn.silu(z)


def _retention(q, k, v):
    B, S = q.shape[0], q.shape[1]
    C = RET_CHUNK
    N = S // C
    log_g = jnp.log(1.0 - 2.0 ** (-5.0 - jnp.arange(H_R, dtype=jnp.float32)))
    k = k * (DK_R ** -0.5)
    qc = q.reshape(B, N, C, H_R, DK_R)
    kc = k.reshape(B, N, C, H_R, DK_R)
    vc = v.reshape(B, N, C, H_R, DV_R)
    idx = jnp.arange(C)
    diff = idx[:, None] - idx[None, :]
    inner_decay = jnp.where(diff >= 0,
                            jnp.exp(jnp.maximum(diff, 0).astype(jnp.float32)[None] * log_g[:, None, None]),
                            0.0)
    s = jnp.einsum('bnqhd,bnkhd->bnhqk', qc, kc,
                   preferred_element_type=jnp.float32) * inner_decay
    o_inner = jnp.einsum('bnhqk,bnkhv->bnqhv', s, vc.astype(jnp.float32))
    to_end = jnp.exp((C - 1 - idx).astype(jnp.float32)[:, None] * log_g[None, :])
    kv = jnp.einsum('bnkhd,bnkhv->bnhdv', kc.astype(jnp.float32) * to_end[:, :, None],
                    vc.astype(jnp.float32))
    chunk_decay = jnp.exp(C * log_g)[:, None, None]

    def step(R, kv_i):
        return chunk_decay * R + kv_i, R

    R0 = jnp.zeros((B, H_R, DK_R, DV_R), jnp.float32)
    _, R_prev = lax.scan(step, R0, kv.transpose(1, 0, 2, 3, 4))
    R_prev = R_prev.transpose(1, 0, 2, 3, 4)
    from_start = jnp.exp((idx + 1).astype(jnp.float32)[:, None] * log_g[None, :])
    o_cross = jnp.einsum('bnqhd,bnhdv->bnqhv',
                         qc.astype(jnp.float32) * from_start[:, :, None], R_prev)
    o = (o_inner + o_cross).reshape(B, S, H_R, DV_R)
    return o.astype(v.dtype)


def setup_inputs(seed: int = 0) -> dict:
    key = jax.random.key(seed)
    ks = jax.random.split(key, 20)
    f32 = jnp.float32
    n = lambda k, shape, s: (jax.random.normal(k, shape, f32) * s)
    return {
        "x": jax.random.normal(ks[0], (BATCH, SEQ, D_MODEL), f32),
        "norm1_g": 1.0 + n(ks[1], (DEPTH, D_MODEL), 0.02),
        "w_in": n(ks[2], (DEPTH, D_MODEL, D_IN), D_MODEL ** -0.5),
        "q_norm_g": 1.0 + n(ks[3], (DEPTH, DK_A), 0.02),
        "k_norm_g": 1.0 + n(ks[4], (DEPTH, DK_A), 0.02),
        "diff_lambda": n(ks[5], (DEPTH, 4, DK_A), 0.1),
        "attn_sub_g": 1.0 + n(ks[6], (DEPTH, DV_A), 0.02),
        "conv_w": n(ks[7], (DEPTH, CONV_WIDTH, C_CONV), CONV_WIDTH ** -0.5),
        "conv_b": n(ks[8], (DEPTH, C_CONV), 0.01),
        "conv_ln_g": 1.0 + n(ks[9], (DEPTH, C_CONV), 0.02),
        "conv_ln_b": n(ks[10], (DEPTH, C_CONV), 0.01),
        "ret_gn_g": 1.0 + n(ks[11], (DEPTH, DV_R), 0.02),
        "b_gate": n(ks[12], (DEPTH, N_BRANCH * D_MODEL), 0.01),
        "w_branch": n(ks[13], (DEPTH, N_BRANCH, BRANCH_W, D_MODEL), BRANCH_W ** -0.5),
        "w_out": n(ks[14], (DEPTH, D_MODEL, D_MODEL), D_MODEL ** -0.5),
        "norm2_g": 1.0 + n(ks[15], (DEPTH, D_MODEL), 0.02),
        "w_ffn_in": n(ks[16], (DEPTH, D_MODEL, 2 * D_FF), D_MODEL ** -0.5),
        "w_ffn_out": n(ks[17], (DEPTH, D_FF, D_MODEL), D_FF ** -0.5),
    }


def reference(x, norm1_g, w_in, q_norm_g, k_norm_g, diff_lambda, attn_sub_g,
              conv_w, conv_b, conv_ln_g, conv_ln_b, ret_gn_g, b_gate, w_branch,
              w_out, norm2_g, w_ffn_in, w_ffn_out):
    B, S = x.shape[0], x.shape[1]
    split_pts = list(np.cumsum(COL_SIZES)[:-1])
    for l in range(DEPTH):
        lam_init = 0.8 - 0.6 * math.exp(-0.3 * l)
        h = _rms(x, norm1_g[l])
        u = h @ w_in[l]
        aq, ak, av, cu, rq, rk, rv, rg, gl = jnp.split(u, split_pts, axis=-1)

        aq = _rms(aq.reshape(B, S, H_A, 2, DK_A), q_norm_g[l])
        ak = _rms(ak.reshape(B, S, H_A, 2, DK_A), k_norm_g[l])
        av = av.reshape(B, S, H_A, DV_A)
        lq1, lk1, lq2, lk2 = diff_lambda[l, 0], diff_lambda[l, 1], diff_lambda[l, 2], diff_lambda[l, 3]
        lam = (jnp.exp(jnp.sum(lq1.astype(jnp.float32) * lk1.astype(jnp.float32)))
               - jnp.exp(jnp.sum(lq2.astype(jnp.float32) * lk2.astype(jnp.float32)))
               + lam_init)
        ya = _diff_attention(aq, ak, av, lam)
        ya = (_rms(ya, attn_sub_g[l]) * (1.0 - lam_init)).reshape(B, S, BRANCH_W)

        yb = _conformer_conv(cu, conv_w[l], conv_b[l], conv_ln_g[l], conv_ln_b[l])

        yc = _retention(rq.reshape(B, S, H_R, DK_R), rk.reshape(B, S, H_R, DK_R),
                        rv.reshape(B, S, H_R, DV_R))
        yc = _rms(yc, ret_gn_g[l]).reshape(B, S, BRANCH_W) * jax.nn.silu(rg)

        br = jnp.stack([ya, yb, yc], axis=2)
        yproj = jnp.einsum('bsnc,ncd->bsnd', br, w_branch[l])
        gates = jax.nn.sigmoid(gl + b_gate[l]).reshape(B, S, N_BRANCH, D_MODEL)
        y = jnp.sum(gates * yproj, axis=2)
        x = x + y @ w_out[l]

        h2 = _rms(x, norm2_g[l])
        g, up = jnp.split(h2 @ w_ffn_in[l], 2, axis=-1)
        x = x + (jax.nn.silu(g) * up) @ w_ffn_out[l]
    return x
```

```cpp
#include <hip/hip_runtime.h>
#include <cstdio>
#include <cstdint>

#define GAS __attribute__((address_space(1)))
#define LAS __attribute__((address_space(3)))
typedef unsigned short bf16_t;
typedef GAS unsigned gu32;
#define RLX_AGENT __ATOMIC_RELAXED, __HIP_MEMORY_SCOPE_AGENT

constexpr int BATCH = 4, SEQ = 4096, DM = 1024, M = BATCH * SEQ, DEPTH = 2;
constexpr int DIN = 7680, NU = 4608, NGATE = 3072, DFF = 2816, BW = 512;
constexpr float RMS_EPS = 1e-6f, LN_EPS = 1e-5f;
constexpr float LOG2E = 1.4426950408889634f;
constexpr float QSCALE = 0.125f * LOG2E;
constexpr int NTHREADS = 512, NWAVES = 8;

enum { I_X = 0, I_N1G, I_WIN, I_QG, I_KG, I_DLAM, I_ASG, I_CW, I_CB, I_CLG, I_CLB, I_RGN, I_BGATE, I_WBR, I_WOUT, I_N2G, I_WF1, I_WF2, N_IN };

constexpr size_t MiB = 1u << 20;
constexpr size_t WS_CTL = 0, CTL_ZERO_BYTES = 1 * MiB;
constexpr size_t WS_ROWSS = 256 * 1024;
constexpr size_t WS_LAM = 512 * 1024;
constexpr size_t WS_XB = 78 * MiB;
constexpr size_t WS_AQ = 110 * MiB, WS_AK = 126 * MiB, WS_AV = 142 * MiB, WS_Z = 158 * MiB, WS_RQ = 174 * MiB, WS_RK = 190 * MiB, WS_RV = 206 * MiB, WS_RG = 222 * MiB, WS_YB = 238 * MiB;
constexpr size_t WS_YA = WS_AQ, WS_YC = WS_RQ;
constexpr size_t WS_Y = 126 * MiB;
constexpr size_t WS_MID = 110 * MiB;
constexpr size_t WS_END = 256 * MiB;
constexpr int CW_BAR = 4096;

struct Args { const float* in[N_IN]; float* out; unsigned char* ws; int ph_lo, ph_hi; };

__device__ __forceinline__ float bf2f(unsigned v) { return __uint_as_float(v << 16); }
__device__ __forceinline__ unsigned f2bf(float f) { unsigned u = __float_as_uint(f); return (u + 0x7fffu + ((u >> 16) & 1u)) >> 16; }
__device__ __forceinline__ unsigned pk2(float lo, float hi) { return f2bf(lo) | (f2bf(hi) << 16); }
__device__ __forceinline__ float wave_sum(float v) {
#pragma unroll
    for (int o = 1; o < 64; o <<= 1) v += __shfl_xor(v, o);
    return v;
}
__device__ __forceinline__ float wave_max(float v) {
#pragma unroll
    for (int o = 1; o < 64; o <<= 1) v = fmaxf(v, __shfl_xor(v, o));
    return v;
}
__device__ __forceinline__ float sigmoidf_(float x) { return 1.0f / (1.0f + __expf(-x)); }
__device__ __forceinline__ float siluf_(float x) { return x / (1.0f + __expf(-x)); }
__device__ __forceinline__ float lam_init_of(int l) { return l == 0 ? 0.2f : (0.8f - 0.6f * 0.74081822068171788f); }
__device__ __forceinline__ float log2_gamma(int h) { return log2f(1.0f - exp2f(-5.0f - (float)h)); }

#define XB_TMO      128
#define XB_XCNT(j)  (256  + 64 * (j))
#define XB_XSUB(j)  (1280 + 64 * (j))
#define XB_XGEN(j)  (2304 + 64 * (j))
#define XB_TOP      3328
#define XB_TOPGEN   3392
#define XCD_BAR_WORDS 3456
#define XB_SPIN_CAP (1u << 22)
__device__ __forceinline__ unsigned xb_ld(unsigned* p)              { return __hip_atomic_load(p, __ATOMIC_RELAXED, __HIP_MEMORY_SCOPE_AGENT); }
__device__ __forceinline__ unsigned xb_add(unsigned* p, unsigned v) { return __hip_atomic_fetch_add(p, v, __ATOMIC_RELAXED, __HIP_MEMORY_SCOPE_AGENT); }
__device__ __forceinline__ unsigned xb_xcc_id() { return (unsigned)__builtin_amdgcn_s_getreg((3 << 11) | 20) & 0xFu; }
#define XB_SPIN(cond, bar) do { unsigned _sp = 0; while (cond) { __builtin_amdgcn_s_sleep(1); \
    if ((++_sp & 255u) == 0u) { if (xb_ld(&(bar)[XB_TMO])) break; if (_sp > XB_SPIN_CAP) { atomicAdd(&(bar)[XB_TMO], 1u); break; } } } } while (0)
struct XcdBarrier { unsigned* bar; unsigned x; volatile LAS unsigned* st; };
__device__ __forceinline__ XcdBarrier xcd_barrier_post(unsigned* bar, volatile LAS unsigned* st) {
    XcdBarrier b; b.bar = bar; b.x = xb_xcc_id(); b.st = st;
    if (threadIdx.x == 0) (void)xb_add(&bar[XB_XCNT(b.x)], 1u);
    return b;
}
__device__ __forceinline__ void xcd_barrier_complete(unsigned* bar, unsigned x, unsigned& nloc, unsigned& nx) {
    const unsigned G = gridDim.x * gridDim.y * gridDim.z;
    unsigned sum, cnt, mine, sp = 0u;
    for (;;) {
        sum = 0u; cnt = 0u; mine = 0u;
#pragma unroll
        for (unsigned j = 0; j < 16; ++j) { const unsigned c = xb_ld(&bar[XB_XCNT(j)]); sum += c; cnt += (c > 0u) ? 1u : 0u; mine = (j == x) ? c : mine; }
        if (sum == G) break;
        __builtin_amdgcn_s_sleep(1);
        if ((++sp & 255u) == 0u) { if (xb_ld(&bar[XB_TMO])) break; if (sp > XB_SPIN_CAP) { atomicAdd(&bar[XB_TMO], 1u); break; } }
    }
    nloc = mine > 0u ? mine : 1u; nx = cnt > 0u ? cnt : 1u;
}
__device__ __forceinline__ void xcd_barrier(const XcdBarrier& b) {
    asm volatile("s_waitcnt vmcnt(0)" ::: "memory");
    __syncthreads();
    if (threadIdx.x == 0) {
        unsigned* bar = b.bar;
        __builtin_amdgcn_s_waitcnt(0);
        unsigned nloc = b.st[0], nx = b.st[1];
        if (nloc == 0u) { xcd_barrier_complete(bar, b.x, nloc, nx); b.st[0] = nloc; b.st[1] = nx; }
        const unsigned old = xb_add(&bar[XB_XSUB(b.x)], 1u);
        const unsigned gen = old / nloc;
        if (old + 1u == (gen + 1u) * nloc) {
            __builtin_amdgcn_fence(__ATOMIC_RELEASE, "agent");
            asm volatile("s_waitcnt vmcnt(0)" ::: "memory");
            const unsigned og = xb_add(&bar[XB_TOP], 1u);
            const unsigned tg = og / nx;
            if (og + 1u == (tg + 1u) * nx) xb_add(&bar[XB_TOPGEN], 1u);
            else XB_SPIN(xb_ld(&bar[XB_TOPGEN]) == tg, bar);
            __builtin_amdgcn_fence(__ATOMIC_ACQUIRE, "agent");
            xb_add(&bar[XB_XGEN(b.x)], 1u);
            asm volatile("s_waitcnt vmcnt(0)" ::: "memory");
        } else {
            XB_SPIN(xb_ld(&bar[XB_XGEN(b.x)]) == gen, bar);
            __builtin_amdgcn_fence(__ATOMIC_ACQUIRE, "agent");
            asm volatile("s_waitcnt vmcnt(0)" ::: "memory");
        }
    }
    __syncthreads();
}


__device__ __forceinline__ void nv_p0(const Args& A, int wg, int nwg) {
    const int tid = threadIdx.x, lane = tid & 63, wave = tid >> 6;
    const float* x = A.in[I_X];
    bf16_t* XB = (bf16_t*)(A.ws + WS_XB);
    float* rowss = (float*)(A.ws + WS_ROWSS);
    for (int m = wg * NWAVES + wave; m < M; m += nwg * NWAVES) {
        const float4* xr = (const float4*)(x + (size_t)m * DM) + lane;
        uint2* o = (uint2*)(XB + (size_t)m * DM) + lane;
        float s = 0.f;
#pragma unroll
        for (int j = 0; j < 4; ++j) { const float4 v = xr[64 * j]; s += v.x * v.x + v.y * v.y + v.z * v.z + v.w * v.w; o[64 * j] = make_uint2(pk2(v.x, v.y), pk2(v.z, v.w)); }
        s = wave_sum(s);
        if (lane == 0) rowss[m] = s;
    }
    if (wg == 0 && wave < DEPTH) {
        const float* dl = A.in[I_DLAM] + wave * 4 * 64;
        float a = dl[lane] * dl[64 + lane], b = dl[128 + lane] * dl[192 + lane];
        a = wave_sum(a); b = wave_sum(b);
        if (lane == 0) ((float*)(A.ws + WS_LAM))[wave] = __expf(a) - __expf(b) + lam_init_of(wave);
    }
}

template <class AL, class WL>
__device__ __forceinline__ void nv_core(float (&acc)[4][4], int K, const AL& aload, const WL& wload, float* sA, float* sB, int tid) {
    const int tx = tid & 15, ty = tid >> 4;
#pragma unroll
    for (int i = 0; i < 4; ++i)
#pragma unroll
        for (int j = 0; j < 4; ++j) acc[i][j] = 0.f;
    const int ar = tid & 127, akq = tid >> 7;
    const int wk = tid >> 5, wc = (tid & 31) * 2;
#pragma unroll 1
    for (int k0 = 0; k0 < K; k0 += 16) {
        float a0, a1, a2, a3; aload(ar, k0 + 4 * akq, a0, a1, a2, a3);
        const float w0 = wload(k0 + wk, wc), w1 = wload(k0 + wk, wc + 1);
        __syncthreads();
        sA[(4 * akq + 0) * 128 + ar] = a0; sA[(4 * akq + 1) * 128 + ar] = a1; sA[(4 * akq + 2) * 128 + ar] = a2; sA[(4 * akq + 3) * 128 + ar] = a3;
        sB[wk * 64 + wc] = w0; sB[wk * 64 + wc + 1] = w1;
        __syncthreads();
#pragma unroll 2
        for (int kk = 0; kk < 16; ++kk) {
            const float4 a = *(const float4*)&sA[kk * 128 + ty * 4];
            const float4 b = *(const float4*)&sB[kk * 64 + tx * 4];
            const float av[4] = {a.x, a.y, a.z, a.w}, bv[4] = {b.x, b.y, b.z, b.w};
#pragma unroll
            for (int i = 0; i < 4; ++i)
#pragma unroll
                for (int j = 0; j < 4; ++j) acc[i][j] += av[i] * bv[j];
        }
    }
    __syncthreads();
}
struct ALbf {
    const bf16_t* A; int lda; int row0;
    __device__ __forceinline__ void operator()(int r, int k, float& a0, float& a1, float& a2, float& a3) const {
        const uint2 v = *(const uint2*)(A + (size_t)(row0 + r) * lda + k);
        a0 = __uint_as_float(v.x << 16); a1 = __uint_as_float(v.x & 0xffff0000u); a2 = __uint_as_float(v.y << 16); a3 = __uint_as_float(v.y & 0xffff0000u);
    }
};
struct WLf32 {
    const float* W; int ldw; int c0, c1; const float* g;
    __device__ __forceinline__ float operator()(int k, int j) const {
        const float w = W[(size_t)k * ldw + (j < 32 ? c0 + j : c1 + j - 32)];
        return g ? w * g[k] : w;
    }
};

__device__ __forceinline__ void nv_p1(const Args& A, int l, int wg, int nwg, float* sm) {
    float* sA = sm; float* sB = sm + 16 * 128; float* sC = sB + 16 * 64;
    const int tid = threadIdx.x, tx = tid & 15, ty = tid >> 4;
    const float* Win = A.in[I_WIN] + (size_t)l * DM * DIN;
    const float* g1 = A.in[I_N1G] + l * DM;
    const bf16_t* XB = (const bf16_t*)(A.ws + WS_XB);
    const float* rowss = (const float*)(A.ws + WS_ROWSS) + (size_t)(l == 0 ? 0 : 2) * M;
    const float* qg = A.in[I_QG] + l * 64; const float* kg = A.in[I_KG] + l * 64;
    for (int it = wg; it < 128 * 72; it += nwg) {
        const int rt = it / 72, cg = it % 72, row0 = rt * 128;
        int c0 = 64 * cg, c1 = 64 * cg + 32;
        if (cg >= 24 && cg < 40) { c0 = 1536 + 32 * (cg - 24); c1 = 2048 + 32 * (cg - 24); }
        float acc[4][4];
        nv_core(acc, DM, ALbf{XB, DM, row0}, WLf32{Win, DIN, c0, c1, g1}, sA, sB, tid);
#pragma unroll
        for (int i = 0; i < 4; ++i) {
            const int r = ty * 4 + i; const float rstd = rsqrtf(rowss[row0 + r] * (1.0f / DM) + RMS_EPS);
#pragma unroll
            for (int j = 0; j < 4; ++j) sC[r * 65 + tx * 4 + j] = acc[i][j] * rstd;
        }
        __syncthreads();
        const int r = tid >> 2, q4 = tid & 3, m = row0 + r, t = m & (SEQ - 1);
        const float* cr = sC + r * 65;
        if (cg < 16) {
            float ss = 0.f;
#pragma unroll
            for (int j = 0; j < 16; ++j) { const float v = cr[q4 * 16 + j]; ss += v * v; }
            ss += __shfl_xor(ss, 1); ss += __shfl_xor(ss, 2);
            const float rn = rsqrtf(ss * (1.0f / 64.0f) + RMS_EPS);
            const bool isq = cg < 8; const float* gg = isq ? qg : kg; const float sc = isq ? QSCALE : 1.0f;
            bf16_t* o = (bf16_t*)(A.ws + (isq ? WS_AQ : WS_AK)) + (size_t)m * BW + (cg & 7) * 64 + q4 * 16;
#pragma unroll
            for (int j = 0; j < 16; ++j) o[j] = (bf16_t)f2bf(cr[q4 * 16 + j] * rn * gg[q4 * 16 + j] * sc);
        } else if (cg >= 24 && cg < 40) {
            bf16_t* o = (bf16_t*)(A.ws + WS_Z) + (size_t)m * BW + (cg - 24) * 32 + q4 * 8;
#pragma unroll
            for (int j = 0; j < 8; ++j) o[j] = (bf16_t)f2bf(cr[q4 * 8 + j] * sigmoidf_(cr[32 + q4 * 8 + j]));
        } else {
            size_t base; int cb; int kind;
            if (cg < 24)      { base = WS_AV; cb = cg - 16; kind = 0; }
            else if (cg < 48) { base = WS_RQ; cb = cg - 40; kind = 1; }
            else if (cg < 56) { base = WS_RK; cb = cg - 48; kind = 2; }
            else if (cg < 64) { base = WS_RV; cb = cg - 56; kind = 0; }
            else              { base = WS_RG; cb = cg - 64; kind = 3; }
            const int h = cb >> 1; const float l2g = log2_gamma(h); const float tp = (float)(t & 127);
            float f = 1.0f;
            if (kind == 1) f = exp2f(tp * l2g);
            if (kind == 2) f = 0.08838834764831845f * exp2f(-tp * l2g);
            bf16_t* o = (bf16_t*)(A.ws + base) + (size_t)m * BW + cb * 64 + q4 * 16;
#pragma unroll
            for (int j = 0; j < 16; ++j) { float v = cr[q4 * 16 + j]; v = (kind == 3) ? siluf_(v) : v * f; o[j] = (bf16_t)f2bf(v); }
        }
        __syncthreads();
    }
}

__device__ __forceinline__ void nv_attn(const Args& A, int l, int wg, int nwg, float* sm) {
    const int tid = threadIdx.x, lane = tid & 63, wave = tid >> 6;
    float* sq = sm + wave * 256;
    const bf16_t* AQ = (const bf16_t*)(A.ws + WS_AQ); const bf16_t* AK = (const bf16_t*)(A.ws + WS_AK); const bf16_t* AV = (const bf16_t*)(A.ws + WS_AV);
    bf16_t* YA = (bf16_t*)(A.ws + WS_YA);
    const float lam = ((const float*)(A.ws + WS_LAM))[l];
    const float* asg = A.in[I_ASG] + l * 128;
    const float osc = 1.0f - lam_init_of(l);
    for (int it = wg * NWAVES + wave; it < BATCH * 4 * SEQ; it += nwg * NWAVES) {
        const int t = it & (SEQ - 1), h = (it >> 12) & 3, b = it >> 14;
        const size_t mq = (size_t)b * SEQ + t;
        const float slope2 = exp2f(-2.0f * (float)(h + 1)) * LOG2E;
        sq[lane] = bf2f(AQ[mq * BW + h * 128 + lane]); sq[64 + lane] = bf2f(AQ[mq * BW + h * 128 + 64 + lane]);
        float m1 = -INFINITY, m2 = -INFINITY, l1 = 0.f, l2 = 0.f, o1a = 0.f, o1b = 0.f, o2a = 0.f, o2b = 0.f;
        for (int s0 = 0; s0 <= t; s0 += 64) {
            const int s = s0 + lane; const bool valid = s <= t;
            float d1 = 0.f, d2 = 0.f;
            if (valid) {
                const uint4* kr = (const uint4*)(AK + ((size_t)b * SEQ + s) * BW + h * 128);
#pragma unroll 2
                for (int c = 0; c < 8; ++c) {
                    const uint4 v = kr[c]; const unsigned w[4] = {v.x, v.y, v.z, v.w};
#pragma unroll
                    for (int e = 0; e < 4; ++e) { d1 += sq[c * 8 + 2 * e] * __uint_as_float(w[e] << 16) + sq[c * 8 + 2 * e + 1] * __uint_as_float(w[e] & 0xffff0000u); }
                }
#pragma unroll 2
                for (int c = 0; c < 8; ++c) {
                    const uint4 v = kr[8 + c]; const unsigned w[4] = {v.x, v.y, v.z, v.w};
#pragma unroll
                    for (int e = 0; e < 4; ++e) { d2 += sq[64 + c * 8 + 2 * e] * __uint_as_float(w[e] << 16) + sq[64 + c * 8 + 2 * e + 1] * __uint_as_float(w[e] & 0xffff0000u); }
                }
            }
            const float bias = slope2 * (float)(s - t);
            const float s1 = valid ? d1 + bias : -INFINITY, s2 = valid ? d2 + bias : -INFINITY;
            const float n1 = fmaxf(m1, wave_max(s1)), n2 = fmaxf(m2, wave_max(s2));
            const float a1 = exp2f(m1 - n1), a2 = exp2f(m2 - n2);
            const float p1 = exp2f(s1 - n1), p2 = exp2f(s2 - n2);
            l1 = l1 * a1 + wave_sum(p1); l2 = l2 * a2 + wave_sum(p2);
            o1a *= a1; o1b *= a1; o2a *= a2; o2b *= a2; m1 = n1; m2 = n2;
            sq[128 + lane] = p1; sq[192 + lane] = p2;
            const int nk = min(64, t - s0 + 1);
            const unsigned* vr = (const unsigned*)(AV + ((size_t)b * SEQ + s0) * BW + h * 128) + lane;
            for (int j = 0; j < nk; ++j) {
                const unsigned v = vr[(size_t)j * (BW / 2)];
                const float va = __uint_as_float(v << 16), vb = __uint_as_float(v & 0xffff0000u);
                const float q1 = sq[128 + j], q2 = sq[192 + j];
                o1a += q1 * va; o1b += q1 * vb; o2a += q2 * va; o2b += q2 * vb;
            }
        }
        const float i1 = 1.0f / l1, i2 = lam / l2;
        const float ya = o1a * i1 - o2a * i2, yb = o1b * i1 - o2b * i2;
        const float ss = wave_sum(ya * ya + yb * yb);
        const float rn = rsqrtf(ss * (1.0f / 128.0f) + RMS_EPS) * osc;
        ((unsigned*)(YA + mq * BW + h * 128))[lane] = pk2(ya * rn * asg[2 * lane], yb * rn * asg[2 * lane + 1]);
    }
}

__device__ __forceinline__ void nv_conv(const Args& A, int l, int wg, int nwg) {
    const int tid = threadIdx.x, lane = tid & 63, wave = tid >> 6;
    const bf16_t* Z = (const bf16_t*)(A.ws + WS_Z); bf16_t* YB = (bf16_t*)(A.ws + WS_YB);
    const float* cw = A.in[I_CW] + (size_t)l * 31 * BW; const float* cb = A.in[I_CB] + l * BW;
    const float* lg = A.in[I_CLG] + l * BW; const float* lb = A.in[I_CLB] + l * BW;
    const int c0 = lane * 8;
    for (int m = wg * NWAVES + wave; m < M; m += nwg * NWAVES) {
        const int t = m & (SEQ - 1);
        float acc[8];
#pragma unroll
        for (int e = 0; e < 8; ++e) acc[e] = cb[c0 + e];
        const int j0 = max(0, 30 - t);
        for (int j = j0; j < 31; ++j) {
            const uint4 v = *(const uint4*)(Z + (size_t)(m - 30 + j) * BW + c0);
            const float4 wa = *(const float4*)(cw + j * BW + c0), wb = *(const float4*)(cw + j * BW + c0 + 4);
            acc[0] += wa.x * __uint_as_float(v.x << 16); acc[1] += wa.y * __uint_as_float(v.x & 0xffff0000u);
            acc[2] += wa.z * __uint_as_float(v.y << 16); acc[3] += wa.w * __uint_as_float(v.y & 0xffff0000u);
            acc[4] += wb.x * __uint_as_float(v.z << 16); acc[5] += wb.y * __uint_as_float(v.z & 0xffff0000u);
            acc[6] += wb.z * __uint_as_float(v.w << 16); acc[7] += wb.w * __uint_as_float(v.w & 0xffff0000u);
        }
        float s = 0.f;
#pragma unroll
        for (int e = 0; e < 8; ++e) s += acc[e];
        const float mu = wave_sum(s) * (1.0f / BW);
        float q = 0.f;
#pragma unroll
        for (int e = 0; e < 8; ++e) { acc[e] -= mu; q += acc[e] * acc[e]; }
        const float rstd = rsqrtf(wave_sum(q) * (1.0f / BW) + LN_EPS);
        float o[8];
#pragma unroll
        for (int e = 0; e < 8; ++e) o[e] = siluf_(acc[e] * rstd * lg[c0 + e] + lb[c0 + e]);
        *(uint4*)(YB + (size_t)m * BW + c0) = make_uint4(pk2(o[0], o[1]), pk2(o[2], o[3]), pk2(o[4], o[5]), pk2(o[6], o[7]));
    }
}

__device__ __forceinline__ void nv_ret(const Args& A, int l, int wg, int nwg, float* sm) {
    const int tid = threadIdx.x, lane = tid & 63, wave = tid >> 6;
    float* sq = sm + wave * 256;
    const bf16_t* RQ = (const bf16_t*)(A.ws + WS_RQ); const bf16_t* RK = (const bf16_t*)(A.ws + WS_RK); const bf16_t* RV = (const bf16_t*)(A.ws + WS_RV);
    const bf16_t* RG = (const bf16_t*)(A.ws + WS_RG); bf16_t* YC = (bf16_t*)(A.ws + WS_YC);
    const float* gn = A.in[I_RGN] + l * 128;
    for (int it = wg * NWAVES + wave; it < BATCH * 4 * SEQ; it += nwg * NWAVES) {
        const int t = it & (SEQ - 1), h = (it >> 12) & 3, b = it >> 14;
        const size_t mq = (size_t)b * SEQ + t;
        const float l2g128 = 128.0f * log2_gamma(h);
        { const unsigned v = ((const unsigned*)(RQ + mq * BW + h * 128))[lane]; sq[2 * lane] = __uint_as_float(v << 16); sq[2 * lane + 1] = __uint_as_float(v & 0xffff0000u); }
        float oa = 0.f, ob = 0.f;
        const int ct = t >> 7;
        for (int s0 = 0; s0 <= t; s0 += 64) {
            const int s = s0 + lane; const bool valid = s <= t;
            float d = 0.f;
            if (valid) {
                const uint4* kr = (const uint4*)(RK + ((size_t)b * SEQ + s) * BW + h * 128);
#pragma unroll 2
                for (int c = 0; c < 16; ++c) {
                    const uint4 v = kr[c]; const unsigned w[4] = {v.x, v.y, v.z, v.w};
#pragma unroll
                    for (int e = 0; e < 4; ++e) { d += sq[c * 8 + 2 * e] * __uint_as_float(w[e] << 16) + sq[c * 8 + 2 * e + 1] * __uint_as_float(w[e] & 0xffff0000u); }
                }
                d *= exp2f(l2g128 * (float)(ct - (s >> 7)));
            }
            sq[128 + lane] = d;
            const int nk = min(64, t - s0 + 1);
            const unsigned* vr = (const unsigned*)(RV + ((size_t)b * SEQ + s0) * BW + h * 128) + lane;
            for (int j = 0; j < nk; ++j) {
                const unsigned v = vr[(size_t)j * (BW / 2)];
                const float a = sq[128 + j];
                oa += a * __uint_as_float(v << 16); ob += a * __uint_as_float(v & 0xffff0000u);
            }
        }
        const float ss = wave_sum(oa * oa + ob * ob);
        const float rn = rsqrtf(ss * (1.0f / 128.0f) + RMS_EPS);
        const unsigned gv = ((const unsigned*)(RG + mq * BW + h * 128))[lane];
        ((unsigned*)(YC + mq * BW + h * 128))[lane] = pk2(oa * rn * gn[2 * lane] * __uint_as_float(gv << 16), ob * rn * gn[2 * lane + 1] * __uint_as_float(gv & 0xffff0000u));
    }
}

__device__ __forceinline__ void nv_p3(const Args& A, int l, int wg, int nwg, float* sm) {
    float* sA = sm; float* sB = sm + 16 * 128;
    const int tid = threadIdx.x, tx = tid & 15, ty = tid >> 4;
    const float* Win = A.in[I_WIN] + (size_t)l * DM * DIN;
    const float* g1 = A.in[I_N1G] + l * DM;
    const float* bg = A.in[I_BGATE] + l * NGATE;
    const float* Wbr = A.in[I_WBR] + (size_t)l * 3 * BW * DM;
    const bf16_t* XB = (const bf16_t*)(A.ws + WS_XB);
    const float* rowss = (const float*)(A.ws + WS_ROWSS) + (size_t)(l == 0 ? 0 : 2) * M;
    bf16_t* Y = (bf16_t*)(A.ws + WS_Y);
    for (int it = wg; it < 128 * 16; it += nwg) {
        const int rt = it / 16, cg = it % 16, row0 = rt * 128;
        float y[4][4];
#pragma unroll
        for (int i = 0; i < 4; ++i)
#pragma unroll
            for (int j = 0; j < 4; ++j) y[i][j] = 0.f;
#pragma unroll 1
        for (int n = 0; n < 3; ++n) {
            float ga[4][4], pa[4][4];
            nv_core(ga, DM, ALbf{XB, DM, row0}, WLf32{Win, DIN, NU + n * DM + 64 * cg, NU + n * DM + 64 * cg + 32, g1}, sA, sB, tid);
            const bf16_t* br = (const bf16_t*)(A.ws + (n == 0 ? WS_YA : n == 1 ? WS_YB : WS_YC));
            nv_core(pa, BW, ALbf{br, BW, row0}, WLf32{Wbr + (size_t)n * BW * DM, DM, 64 * cg, 64 * cg + 32, nullptr}, sA, sB, tid);
#pragma unroll
            for (int i = 0; i < 4; ++i) {
                const float rstd = rsqrtf(rowss[row0 + ty * 4 + i] * (1.0f / DM) + RMS_EPS);
#pragma unroll
                for (int j = 0; j < 4; ++j) y[i][j] += sigmoidf_(ga[i][j] * rstd + bg[n * DM + 64 * cg + tx * 4 + j]) * pa[i][j];
            }
        }
#pragma unroll
        for (int i = 0; i < 4; ++i)
            *(uint2*)(Y + (size_t)(row0 + ty * 4 + i) * DM + 64 * cg + tx * 4) = make_uint2(pk2(y[i][0], y[i][1]), pk2(y[i][2], y[i][3]));
    }
}

__device__ __forceinline__ void nv_resid_gemm(const Args& A, const bf16_t* Am, int lda, int K, const float* W, const float* xold, float* rowss_next, int wg, int nwg, float* sm) {
    float* sA = sm; float* sB = sm + 16 * 128;
    const int tid = threadIdx.x, tx = tid & 15, ty = tid >> 4;
    bf16_t* XB = (bf16_t*)(A.ws + WS_XB);
    for (int it = wg; it < 128 * 16; it += nwg) {
        const int rt = it / 16, cg = it % 16, row0 = rt * 128;
        float acc[4][4];
        nv_core(acc, K, ALbf{Am, lda, row0}, WLf32{W, DM, 64 * cg, 64 * cg + 32, nullptr}, sA, sB, tid);
#pragma unroll
        for (int i = 0; i < 4; ++i) {
            const size_t off = (size_t)(row0 + ty * 4 + i) * DM + 64 * cg + tx * 4;
            const float4 xo = *(const float4*)(xold + off);
            const float4 xn = make_float4(xo.x + acc[i][0], xo.y + acc[i][1], xo.z + acc[i][2], xo.w + acc[i][3]);
            *(float4*)(A.out + off) = xn;
            *(uint2*)(XB + off) = make_uint2(pk2(xn.x, xn.y), pk2(xn.z, xn.w));
            float s = xn.x * xn.x + xn.y * xn.y + xn.z * xn.z + xn.w * xn.w;
            s += __shfl_xor(s, 1); s += __shfl_xor(s, 2); s += __shfl_xor(s, 4); s += __shfl_xor(s, 8);
            if (tx == 0 && rowss_next) atomicAdd(rowss_next + row0 + ty * 4 + i, s);
        }
    }
}

__device__ __forceinline__ void nv_p5(const Args& A, int l, int wg, int nwg, float* sm) {
    float* sA = sm; float* sB = sm + 16 * 128; float* sC = sB + 16 * 64;
    const int tid = threadIdx.x, tx = tid & 15, ty = tid >> 4;
    const float* W = A.in[I_WF1] + (size_t)l * DM * 2 * DFF;
    const float* g2 = A.in[I_N2G] + l * DM;
    const bf16_t* XB = (const bf16_t*)(A.ws + WS_XB);
    const float* rowss = (const float*)(A.ws + WS_ROWSS) + (size_t)(l == 0 ? 1 : 3) * M;
    bf16_t* MID = (bf16_t*)(A.ws + WS_MID);
    for (int it = wg; it < 128 * 88; it += nwg) {
        const int rt = it / 88, jj = it % 88, row0 = rt * 128;
        float acc[4][4];
        nv_core(acc, DM, ALbf{XB, DM, row0}, WLf32{W, 2 * DFF, 32 * jj, DFF + 32 * jj, g2}, sA, sB, tid);
#pragma unroll
        for (int i = 0; i < 4; ++i) {
            const int r = ty * 4 + i; const float rstd = rsqrtf(rowss[row0 + r] * (1.0f / DM) + RMS_EPS);
#pragma unroll
            for (int j = 0; j < 4; ++j) sC[r * 65 + tx * 4 + j] = acc[i][j] * rstd;
        }
        __syncthreads();
        const int r = tid >> 2, q4 = tid & 3;
        const float* cr = sC + r * 65;
        bf16_t* o = MID + (size_t)(row0 + r) * DFF + 32 * jj + q4 * 8;
#pragma unroll
        for (int j = 0; j < 8; ++j) o[j] = (bf16_t)f2bf(siluf_(cr[q4 * 8 + j]) * cr[32 + q4 * 8 + j]);
        __syncthreads();
    }
}

constexpr int N_PHASES = 1 + 6 * DEPTH;
__global__ void __launch_bounds__(NTHREADS) fwd_kernel(Args A) {
    extern __shared__ __attribute__((aligned(16))) unsigned char lds[];
    float* sm = (float*)lds;
    volatile LAS unsigned* MISC = (volatile LAS unsigned*)((LAS unsigned char*)lds + 47 * 1024);
    const int wg = blockIdx.x, nwg = gridDim.x;
    const bool multi = (A.ph_hi - A.ph_lo) > 1;
    XcdBarrier bar; bar.bar = nullptr; bar.x = 0; bar.st = nullptr;
    if (multi) {
        if (threadIdx.x < 2) MISC[threadIdx.x] = 0u;
        __syncthreads();
        bar = xcd_barrier_post((unsigned*)(A.ws + WS_CTL) + CW_BAR, MISC);
    }
    for (int ph = A.ph_lo; ph < A.ph_hi; ++ph) {
        if (ph == 0) nv_p0(A, wg, nwg);
        else {
            const int l = (ph - 1) / 6, k = (ph - 1) % 6;
            if (k == 0) nv_p1(A, l, wg, nwg, sm);
            else if (k == 1) { nv_attn(A, l, wg, nwg, sm); nv_conv(A, l, wg, nwg); nv_ret(A, l, wg, nwg, sm); }
            else if (k == 2) nv_p3(A, l, wg, nwg, sm);
            else if (k == 3) nv_resid_gemm(A, (const bf16_t*)(A.ws + WS_Y), DM, DM, A.in[I_WOUT] + (size_t)l * DM * DM, l == 0 ? A.in[I_X] : A.out,
                                           (float*)(A.ws + WS_ROWSS) + (size_t)(l == 0 ? 1 : 3) * M, wg, nwg, sm);
            else if (k == 4) nv_p5(A, l, wg, nwg, sm);
            else nv_resid_gemm(A, (const bf16_t*)(A.ws + WS_MID), DFF, DFF, A.in[I_WF2] + (size_t)l * DFF * DM, A.out,
                               l + 1 < DEPTH ? (float*)(A.ws + WS_ROWSS) + (size_t)2 * M : nullptr, wg, nwg, sm);
        }
        if (ph + 1 < A.ph_hi) xcd_barrier(bar);
    }
}

#ifndef ONE_LAUNCH
#define ONE_LAUNCH 0
#endif
constexpr int LDS_BYTES = 48 * 1024;
extern "C" void kernel_launch(void* const* d_in, const int* in_sizes, int n_in, void* d_out, int out_size, void* d_ws, size_t ws_size, hipStream_t stream) {
    static int grid = 0;
    if (grid == 0) {
        if (n_in != N_IN || out_size != M * DM || ws_size < WS_END) { fprintf(stderr, "kernel_launch: unexpected shapes (n_in %d out %d ws %zu)\n", n_in, out_size, ws_size); grid = -1; return; }
        int dev = 0, cus = 0, per_cu = 0;
        hipGetDevice(&dev); hipDeviceGetAttribute(&cus, hipDeviceAttributeMultiprocessorCount, dev);
        hipFuncSetAttribute((const void*)fwd_kernel, hipFuncAttributeMaxDynamicSharedMemorySize, LDS_BYTES);
        hipOccupancyMaxActiveBlocksPerMultiprocessor(&per_cu, (const void*)fwd_kernel, NTHREADS, LDS_BYTES);
        (void)hipGetLastError();
        if (per_cu < 1) per_cu = 1;
        if (per_cu > 2) per_cu = 2;
        grid = cus * per_cu;
        fprintf(stderr, "kernel_launch: cus %d per_cu %d grid %d\n", cus, per_cu, grid);
    }
    if (grid < 0) return;
    hipMemsetAsync((char*)d_ws + WS_CTL, 0, CTL_ZERO_BYTES, stream);
    Args a{};
    for (int i = 0; i < N_IN; ++i) a.in[i] = (const float*)d_in[i];
    a.out = (float*)d_out; a.ws = (unsigned char*)d_ws;
#if ONE_LAUNCH
    a.ph_lo = 0; a.ph_hi = N_PHASES;
    void* args[] = {&a};
    hipError_t e = hipLaunchCooperativeKernel((const void*)fwd_kernel, dim3(grid), dim3(NTHREADS), args, LDS_BYTES, stream);
    if (e != hipSuccess) fprintf(stderr, "cooperative launch failed: %s (grid %d)\n", hipGetErrorString(e), grid);
#else
    for (int ph = 0; ph < N_PHASES; ++ph) {
        a.ph_lo = ph; a.ph_hi = ph + 1;
        hipLaunchKernelGGL(fwd_kernel, dim3(2048), dim3(NTHREADS), LDS_BYTES, stream, a);
    }
#endif
}
```

```cpp
#include <hip/hip_runtime.h>
#include <cstdio>
#include <cstdint>

#define GAS __attribute__((address_space(1)))
#define LAS __attribute__((address_space(3)))
typedef unsigned short bf16_t;
typedef GAS unsigned gu32;
#define RLX_AGENT __ATOMIC_RELAXED, __HIP_MEMORY_SCOPE_AGENT

constexpr int BATCH = 4, SEQ = 4096, DM = 1024, M = BATCH * SEQ, DEPTH = 2;
constexpr int DIN = 7680, NU = 4608, NGATE = 3072, DFF = 2816, BW = 512;
constexpr float RMS_EPS = 1e-6f, LN_EPS = 1e-5f;
constexpr float LOG2E = 1.4426950408889634f;
constexpr float QSCALE = 0.125f * LOG2E;
constexpr int NTHREADS = 512, NWAVES = 8;

enum { I_X = 0, I_N1G, I_WIN, I_QG, I_KG, I_DLAM, I_ASG, I_CW, I_CB, I_CLG, I_CLB, I_RGN, I_BGATE, I_WBR, I_WOUT, I_N2G, I_WF1, I_WF2, N_IN };

constexpr size_t MiB = 1u << 20;
constexpr size_t WS_CTL = 0, CTL_ZERO_BYTES = 1 * MiB;
constexpr size_t WS_ROWSS = 256 * 1024;
constexpr size_t WS_LAM = 512 * 1024;
constexpr size_t WS_XB = 78 * MiB;
constexpr size_t WS_AQ = 110 * MiB, WS_AK = 126 * MiB, WS_AV = 142 * MiB, WS_Z = 158 * MiB, WS_RQ = 174 * MiB, WS_RK = 190 * MiB, WS_RV = 206 * MiB, WS_RG = 222 * MiB, WS_YB = 238 * MiB;
constexpr size_t WS_YA = WS_AQ, WS_YC = WS_RQ;
constexpr size_t WS_Y = 126 * MiB;
constexpr size_t WS_MID = 110 * MiB;
constexpr size_t WS_END = 256 * MiB;
constexpr int CW_BAR = 4096;

struct Args { const float* in[N_IN]; float* out; unsigned char* ws; int ph_lo, ph_hi; };

__device__ __forceinline__ float bf2f(unsigned v) { return __uint_as_float(v << 16); }
__device__ __forceinline__ unsigned f2bf(float f) { unsigned u = __float_as_uint(f); return (u + 0x7fffu + ((u >> 16) & 1u)) >> 16; }
__device__ __forceinline__ unsigned pk2(float lo, float hi) { return f2bf(lo) | (f2bf(hi) << 16); }
__device__ __forceinline__ float wave_sum(float v) {
#pragma unroll
    for (int o = 1; o < 64; o <<= 1) v += __shfl_xor(v, o);
    return v;
}
__device__ __forceinline__ float wave_max(float v) {
#pragma unroll
    for (int o = 1; o < 64; o <<= 1) v = fmaxf(v, __shfl_xor(v, o));
    return v;
}
__device__ __forceinline__ float sigmoidf_(float x) { return 1.0f / (1.0f + __expf(-x)); }
__device__ __forceinline__ float siluf_(float x) { return x / (1.0f + __expf(-x)); }
__device__ __forceinline__ float lam_init_of(int l) { return l == 0 ? 0.2f : (0.8f - 0.6f * 0.74081822068171788f); }
__device__ __forceinline__ float log2_gamma(int h) { return log2f(1.0f - exp2f(-5.0f - (float)h)); }

#define XB_TMO      128
#define XB_XCNT(j)  (256  + 64 * (j))
#define XB_XSUB(j)  (1280 + 64 * (j))
#define XB_XGEN(j)  (2304 + 64 * (j))
#define XB_TOP      3328
#define XB_TOPGEN   3392
#define XCD_BAR_WORDS 3456
#define XB_SPIN_CAP (1u << 22)
__device__ __forceinline__ unsigned xb_ld(unsigned* p)              { return __hip_atomic_load(p, __ATOMIC_RELAXED, __HIP_MEMORY_SCOPE_AGENT); }
__device__ __forceinline__ unsigned xb_add(unsigned* p, unsigned v) { return __hip_atomic_fetch_add(p, v, __ATOMIC_RELAXED, __HIP_MEMORY_SCOPE_AGENT); }
__device__ __forceinline__ unsigned xb_xcc_id() { return (unsigned)__builtin_amdgcn_s_getreg((3 << 11) | 20) & 0xFu; }
#define XB_SPIN(cond, bar) do { unsigned _sp = 0; while (cond) { __builtin_amdgcn_s_sleep(1); \
    if ((++_sp & 255u) == 0u) { if (xb_ld(&(bar)[XB_TMO])) break; if (_sp > XB_SPIN_CAP) { atomicAdd(&(bar)[XB_TMO], 1u); break; } } } } while (0)
struct XcdBarrier { unsigned* bar; unsigned x; volatile LAS unsigned* st; };
__device__ __forceinline__ XcdBarrier xcd_barrier_post(unsigned* bar, volatile LAS unsigned* st) {
    XcdBarrier b; b.bar = bar; b.x = xb_xcc_id(); b.st = st;
    if (threadIdx.x == 0) (void)xb_add(&bar[XB_XCNT(b.x)], 1u);
    return b;
}
__device__ __forceinline__ void xcd_barrier_complete(unsigned* bar, unsigned x, unsigned& nloc, unsigned& nx) {
    const unsigned G = gridDim.x * gridDim.y * gridDim.z;
    unsigned sum, cnt, mine, sp = 0u;
    for (;;) {
        sum = 0u; cnt = 0u; mine = 0u;
#pragma unroll
        for (unsigned j = 0; j < 16; ++j) { const unsigned c = xb_ld(&bar[XB_XCNT(j)]); sum += c; cnt += (c > 0u) ? 1u : 0u; mine = (j == x) ? c : mine; }
        if (sum == G) break;
        __builtin_amdgcn_s_sleep(1);
        if ((++sp & 255u) == 0u) { if (xb_ld(&bar[XB_TMO])) break; if (sp > XB_SPIN_CAP) { atomicAdd(&bar[XB_TMO], 1u); break; } }
    }
    nloc = mine > 0u ? mine : 1u; nx = cnt > 0u ? cnt : 1u;
}
__device__ __forceinline__ void xcd_barrier(const XcdBarrier& b) {
    asm volatile("s_waitcnt vmcnt(0)" ::: "memory");
    __syncthreads();
    if (threadIdx.x == 0) {
        unsigned* bar = b.bar;
        __builtin_amdgcn_s_waitcnt(0);
        unsigned nloc = b.st[0], nx = b.st[1];
        if (nloc == 0u) { xcd_barrier_complete(bar, b.x, nloc, nx); b.st[0] = nloc; b.st[1] = nx; }
        const unsigned old = xb_add(&bar[XB_XSUB(b.x)], 1u);
        const unsigned gen = old / nloc;
        if (old + 1u == (gen + 1u) * nloc) {
            __builtin_amdgcn_fence(__ATOMIC_RELEASE, "agent");
            asm volatile("s_waitcnt vmcnt(0)" ::: "memory");
            const unsigned og = xb_add(&bar[XB_TOP], 1u);
            const unsigned tg = og / nx;
            if (og + 1u == (tg + 1u) * nx) xb_add(&bar[XB_TOPGEN], 1u);
            else XB_SPIN(xb_ld(&bar[XB_TOPGEN]) == tg, bar);
            __builtin_amdgcn_fence(__ATOMIC_ACQUIRE, "agent");
            xb_add(&bar[XB_XGEN(b.x)], 1u);
            asm volatile("s_waitcnt vmcnt(0)" ::: "memory");
        } else {
            XB_SPIN(xb_ld(&bar[XB_XGEN(b.x)]) == gen, bar);
            __builtin_amdgcn_fence(__ATOMIC_ACQUIRE, "agent");
            asm volatile("s_waitcnt vmcnt(0)" ::: "memory");
        }
    }
    __syncthreads();
}


__device__ __forceinline__ void nv_p0(const Args& A, int wg, int nwg) {
    const int tid = threadIdx.x, lane = tid & 63, wave = tid >> 6;
    const float* x = A.in[I_X];
    bf16_t* XB = (bf16_t*)(A.ws + WS_XB);
    float* rowss = (float*)(A.ws + WS_ROWSS);
    for (int m = wg * NWAVES + wave; m < M; m += nwg * NWAVES) {
        const float4* xr = (const float4*)(x + (size_t)m * DM) + lane;
        uint2* o = (uint2*)(XB + (size_t)m * DM) + lane;
        float s = 0.f;
#pragma unroll
        for (int j = 0; j < 4; ++j) { const float4 v = xr[64 * j]; s += v.x * v.x + v.y * v.y + v.z * v.z + v.w * v.w; o[64 * j] = make_uint2(pk2(v.x, v.y), pk2(v.z, v.w)); }
        s = wave_sum(s);
        if (lane == 0) rowss[m] = s;
    }
    if (wg == 0 && wave < DEPTH) {
        const float* dl = A.in[I_DLAM] + wave * 4 * 64;
        float a = dl[lane] * dl[64 + lane], b = dl[128 + lane] * dl[192 + lane];
        a = wave_sum(a); b = wave_sum(b);
        if (lane == 0) ((float*)(A.ws + WS_LAM))[wave] = __expf(a) - __expf(b) + lam_init_of(wave);
    }
}

template <class AL, class WL>
__device__ __forceinline__ void nv_core(float (&acc)[4][4], int K, const AL& aload, const WL& wload, float* sA, float* sB, int tid) {
    const int tx = tid & 15, ty = tid >> 4;
#pragma unroll
    for (int i = 0; i < 4; ++i)
#pragma unroll
        for (int j = 0; j < 4; ++j) acc[i][j] = 0.f;
    const int ar = tid & 127, akq = tid >> 7;
    const int wk = tid >> 5, wc = (tid & 31) * 2;
#pragma unroll 1
    for (int k0 = 0; k0 < K; k0 += 16) {
        float a0, a1, a2, a3; aload(ar, k0 + 4 * akq, a0, a1, a2, a3);
        const float w0 = wload(k0 + wk, wc), w1 = wload(k0 + wk, wc + 1);
        __syncthreads();
        sA[(4 * akq + 0) * 128 + ar] = a0; sA[(4 * akq + 1) * 128 + ar] = a1; sA[(4 * akq + 2) * 128 + ar] = a2; sA[(4 * akq + 3) * 128 + ar] = a3;
        sB[wk * 64 + wc] = w0; sB[wk * 64 + wc + 1] = w1;
        __syncthreads();
#pragma unroll 2
        for (int kk = 0; kk < 16; ++kk) {
            const float4 a = *(const float4*)&sA[kk * 128 + ty * 4];
            const float4 b = *(const float4*)&sB[kk * 64 + tx * 4];
            const float av[4] = {a.x, a.y, a.z, a.w}, bv[4] = {b.x, b.y, b.z, b.w};
#pragma unroll
            for (int i = 0; i < 4; ++i)
#pragma unroll
                for (int j = 0; j < 4; ++j) acc[i][j] += av[i] * bv[j];
        }
    }
    __syncthreads();
}
struct ALbf {
    const bf16_t* A; int lda; int row0;
    __device__ __forceinline__ void operator()(int r, int k, float& a0, float& a1, float& a2, float& a3) const {
        const uint2 v = *(const uint2*)(A + (size_t)(row0 + r) * lda + k);
        a0 = __uint_as_float(v.x << 16); a1 = __uint_as_float(v.x & 0xffff0000u); a2 = __uint_as_float(v.y << 16); a3 = __uint_as_float(v.y & 0xffff0000u);
    }
};
struct WLf32 {
    const float* W; int ldw; int c0, c1; const float* g;
    __device__ __forceinline__ float operator()(int k, int j) const {
        const float w = W[(size_t)k * ldw + (j < 32 ? c0 + j : c1 + j - 32)];
        return g ? w * g[k] : w;
    }
};

__device__ __forceinline__ void nv_p1(const Args& A, int l, int wg, int nwg, float* sm) {
    float* sA = sm; float* sB = sm + 16 * 128; float* sC = sB + 16 * 64;
    const int tid = threadIdx.x, tx = tid & 15, ty = tid >> 4;
    const float* Win = A.in[I_WIN] + (size_t)l * DM * DIN;
    const float* g1 = A.in[I_N1G] + l * DM;
    const bf16_t* XB = (const bf16_t*)(A.ws + WS_XB);
    const float* rowss = (const float*)(A.ws + WS_ROWSS) + (size_t)(l == 0 ? 0 : 2) * M;
    const float* qg = A.in[I_QG] + l * 64; const float* kg = A.in[I_KG] + l * 64;
    for (int it = wg; it < 128 * 72; it += nwg) {
        const int rt = it / 72, cg = it % 72, row0 = rt * 128;
        int c0 = 64 * cg, c1 = 64 * cg + 32;
        if (cg >= 24 && cg < 40) { c0 = 1536 + 32 * (cg - 24); c1 = 2048 + 32 * (cg - 24); }
        float acc[4][4];
        nv_core(acc, DM, ALbf{XB, DM, row0}, WLf32{Win, DIN, c0, c1, g1}, sA, sB, tid);
#pragma unroll
        for (int i = 0; i < 4; ++i) {
            const int r = ty * 4 + i; const float rstd = rsqrtf(rowss[row0 + r] * (1.0f / DM) + RMS_EPS);
#pragma unroll
            for (int j = 0; j < 4; ++j) sC[r * 65 + tx * 4 + j] = acc[i][j] * rstd;
        }
        __syncthreads();
        const int r = tid >> 2, q4 = tid & 3, m = row0 + r, t = m & (SEQ - 1);
        const float* cr = sC + r * 65;
        if (cg < 16) {
            float ss = 0.f;
#pragma unroll
            for (int j = 0; j < 16; ++j) { const float v = cr[q4 * 16 + j]; ss += v * v; }
            ss += __shfl_xor(ss, 1); ss += __shfl_xor(ss, 2);
            const float rn = rsqrtf(ss * (1.0f / 64.0f) + RMS_EPS);
            const bool isq = cg < 8; const float* gg = isq ? qg : kg; const float sc = isq ? QSCALE : 1.0f;
            bf16_t* o = (bf16_t*)(A.ws + (isq ? WS_AQ : WS_AK)) + (size_t)m * BW + (cg & 7) * 64 + q4 * 16;
#pragma unroll
            for (int j = 0; j < 16; ++j) o[j] = (bf16_t)f2bf(cr[q4 * 16 + j] * rn * gg[q4 * 16 + j] * sc);
        } else if (cg >= 24 && cg < 40) {
            bf16_t* o = (bf16_t*)(A.ws + WS_Z) + (size_t)m * BW + (cg - 24) * 32 + q4 * 8;
#pragma unroll
            for (int j = 0; j < 8; ++j) o[j] = (bf16_t)f2bf(cr[q4 * 8 + j] * sigmoidf_(cr[32 + q4 * 8 + j]));
        } else {
            size_t base; int cb; int kind;
            if (cg < 24)      { base = WS_AV; cb = cg - 16; kind = 0; }
            else if (cg < 48) { base = WS_RQ; cb = cg - 40; kind = 1; }
            else if (cg < 56) { base = WS_RK; cb = cg - 48; kind = 2; }
            else if (cg < 64) { base = WS_RV; cb = cg - 56; kind = 0; }
            else              { base = WS_RG; cb = cg - 64; kind = 3; }
            const int h = cb >> 1; const float l2g = log2_gamma(h); const float tp = (float)(t & 127);
            float f = 1.0f;
            if (kind == 1) f = exp2f(tp * l2g);
            if (kind == 2) f = 0.08838834764831845f * exp2f(-tp * l2g);
            bf16_t* o = (bf16_t*)(A.ws + base) + (size_t)m * BW + cb * 64 + q4 * 16;
#pragma unroll
            for (int j = 0; j < 16; ++j) { float v = cr[q4 * 16 + j]; v = (kind == 3) ? siluf_(v) : v * f; o[j] = (bf16_t)f2bf(v); }
        }
        __syncthreads();
    }
}

__device__ __forceinline__ void nv_attn(const Args& A, int l, int wg, int nwg, float* sm) {
    const int tid = threadIdx.x, lane = tid & 63, wave = tid >> 6;
    float* sq = sm + wave * 256;
    const bf16_t* AQ = (const bf16_t*)(A.ws + WS_AQ); const bf16_t* AK = (const bf16_t*)(A.ws + WS_AK); const bf16_t* AV = (const bf16_t*)(A.ws + WS_AV);
    bf16_t* YA = (bf16_t*)(A.ws + WS_YA);
    const float lam = ((const float*)(A.ws + WS_LAM))[l];
    const float* asg = A.in[I_ASG] + l * 128;
    const float osc = 1.0f - lam_init_of(l);
    for (int it = wg * NWAVES + wave; it < BATCH * 4 * SEQ; it += nwg * NWAVES) {
        const int t = it & (SEQ - 1), h = (it >> 12) & 3, b = it >> 14;
        const size_t mq = (size_t)b * SEQ + t;
        const float slope2 = exp2f(-2.0f * (float)(h + 1)) * LOG2E;
        sq[lane] = bf2f(AQ[mq * BW + h * 128 + lane]); sq[64 + lane] = bf2f(AQ[mq * BW + h * 128 + 64 + lane]);
        float m1 = -INFINITY, m2 = -INFINITY, l1 = 0.f, l2 = 0.f, o1a = 0.f, o1b = 0.f, o2a = 0.f, o2b = 0.f;
        for (int s0 = 0; s0 <= t; s0 += 64) {
            const int s = s0 + lane; const bool valid = s <= t;
            float d1 = 0.f, d2 = 0.f;
            if (valid) {
                const uint4* kr = (const uint4*)(AK + ((size_t)b * SEQ + s) * BW + h * 128);
#pragma unroll 2
                for (int c = 0; c < 8; ++c) {
                    const uint4 v = kr[c]; const unsigned w[4] = {v.x, v.y, v.z, v.w};
#pragma unroll
                    for (int e = 0; e < 4; ++e) { d1 += sq[c * 8 + 2 * e] * __uint_as_float(w[e] << 16) + sq[c * 8 + 2 * e + 1] * __uint_as_float(w[e] & 0xffff0000u); }
                }
#pragma unroll 2
                for (int c = 0; c < 8; ++c) {
                    const uint4 v = kr[8 + c]; const unsigned w[4] = {v.x, v.y, v.z, v.w};
#pragma unroll
                    for (int e = 0; e < 4; ++e) { d2 += sq[64 + c * 8 + 2 * e] * __uint_as_float(w[e] << 16) + sq[64 + c * 8 + 2 * e + 1] * __uint_as_float(w[e] & 0xffff0000u); }
                }
            }
            const float bias = slope2 * (float)(s - t);
            const float s1 = valid ? d1 + bias : -INFINITY, s2 = valid ? d2 + bias : -INFINITY;
            const float n1 = fmaxf(m1, wave_max(s1)), n2 = fmaxf(m2, wave_max(s2));
            const float a1 = exp2f(m1 - n1), a2 = exp2f(m2 - n2);
            const float p1 = exp2f(s1 - n1), p2 = exp2f(s2 - n2);
            l1 = l1 * a1 + wave_sum(p1); l2 = l2 * a2 + wave_sum(p2);
            o1a *= a1; o1b *= a1; o2a *= a2; o2b *= a2; m1 = n1; m2 = n2;
            sq[128 + lane] = p1; sq[192 + lane] = p2;
            const int nk = min(64, t - s0 + 1);
            const unsigned* vr = (const unsigned*)(AV + ((size_t)b * SEQ + s0) * BW + h * 128) + lane;
            for (int j = 0; j < nk; ++j) {
                const unsigned v = vr[(size_t)j * (BW / 2)];
                const float va = __uint_as_float(v << 16), vb = __uint_as_float(v & 0xffff0000u);
                const float q1 = sq[128 + j], q2 = sq[192 + j];
                o1a += q1 * va; o1b += q1 * vb; o2a += q2 * va; o2b += q2 * vb;
            }
        }
        const float i1 = 1.0f / l1, i2 = lam / l2;
        const float ya = o1a * i1 - o2a * i2, yb = o1b * i1 - o2b * i2;
        const float ss = wave_sum(ya * ya + yb * yb);
        const float rn = rsqrtf(ss * (1.0f / 128.0f) + RMS_EPS) * osc;
        ((unsigned*)(YA + mq * BW + h * 128))[lane] = pk2(ya * rn * asg[2 * lane], yb * rn * asg[2 * lane + 1]);
    }
}

__device__ __forceinline__ void nv_conv(const Args& A, int l, int wg, int nwg) {
    const int tid = threadIdx.x, lane = tid & 63, wave = tid >> 6;
    const bf16_t* Z = (const bf16_t*)(A.ws + WS_Z); bf16_t* YB = (bf16_t*)(A.ws + WS_YB);
    const float* cw = A.in[I_CW] + (size_t)l * 31 * BW; const float* cb = A.in[I_CB] + l * BW;
    const float* lg = A.in[I_CLG] + l * BW; const float* lb = A.in[I_CLB] + l * BW;
    const int c0 = lane * 8;
    for (int m = wg * NWAVES + wave; m < M; m += nwg * NWAVES) {
        const int t = m & (SEQ - 1);
        float acc[8];
#pragma unroll
        for (int e = 0; e < 8; ++e) acc[e] = cb[c0 + e];
        const int j0 = max(0, 30 - t);
        for (int j = j0; j < 31; ++j) {
            const uint4 v = *(const uint4*)(Z + (size_t)(m - 30 + j) * BW + c0);
            const float4 wa = *(const float4*)(cw + j * BW + c0), wb = *(const float4*)(cw + j * BW + c0 + 4);
            acc[0] += wa.x * __uint_as_float(v.x << 16); acc[1] += wa.y * __uint_as_float(v.x & 0xffff0000u);
            acc[2] += wa.z * __uint_as_float(v.y << 16); acc[3] += wa.w * __uint_as_float(v.y & 0xffff0000u);
            acc[4] += wb.x * __uint_as_float(v.z << 16); acc[5] += wb.y * __uint_as_float(v.z & 0xffff0000u);
            acc[6] += wb.z * __uint_as_float(v.w << 16); acc[7] += wb.w * __uint_as_float(v.w & 0xffff0000u);
        }
        float s = 0.f;
#pragma unroll
        for (int e = 0; e < 8; ++e) s += acc[e];
        const float mu = wave_sum(s) * (1.0f / BW);
        float q = 0.f;
#pragma unroll
        for (int e = 0; e < 8; ++e) { acc[e] -= mu; q += acc[e] * acc[e]; }
        const float rstd = rsqrtf(wave_sum(q) * (1.0f / BW) + LN_EPS);
        float o[8];
#pragma unroll
        for (int e = 0; e < 8; ++e) o[e] = siluf_(acc[e] * rstd * lg[c0 + e] + lb[c0 + e]);
        *(uint4*)(YB + (size_t)m * BW + c0) = make_uint4(pk2(o[0], o[1]), pk2(o[2], o[3]), pk2(o[4], o[5]), pk2(o[6], o[7]));
    }
}

__device__ __forceinline__ void nv_ret(const Args& A, int l, int wg, int nwg, float* sm) {
    const int tid = threadIdx.x, lane = tid & 63, wave = tid >> 6;
    float* sq = sm + wave * 256;
    const bf16_t* RQ = (const bf16_t*)(A.ws + WS_RQ); const bf16_t* RK = (const bf16_t*)(A.ws + WS_RK); const bf16_t* RV = (const bf16_t*)(A.ws + WS_RV);
    const bf16_t* RG = (const bf16_t*)(A.ws + WS_RG); bf16_t* YC = (bf16_t*)(A.ws + WS_YC);
    const float* gn = A.in[I_RGN] + l * 128;
    for (int it = wg * NWAVES + wave; it < BATCH * 4 * SEQ; it += nwg * NWAVES) {
        const int t = it & (SEQ - 1), h = (it >> 12) & 3, b = it >> 14;
        const size_t mq = (size_t)b * SEQ + t;
        const float l2g128 = 128.0f * log2_gamma(h);
        { const unsigned v = ((const unsigned*)(RQ + mq * BW + h * 128))[lane]; sq[2 * lane] = __uint_as_float(v << 16); sq[2 * lane + 1] = __uint_as_float(v & 0xffff0000u); }
        float oa = 0.f, ob = 0.f;
        const int ct = t >> 7;
        for (int s0 = 0; s0 <= t; s0 += 64) {
            const int s = s0 + lane; const bool valid = s <= t;
            float d = 0.f;
            if (valid) {
                const uint4* kr = (const uint4*)(RK + ((size_t)b * SEQ + s) * BW + h * 128);
#pragma unroll 2
                for (int c = 0; c < 16; ++c) {
                    const uint4 v = kr[c]; const unsigned w[4] = {v.x, v.y, v.z, v.w};
#pragma unroll
                    for (int e = 0; e < 4; ++e) { d += sq[c * 8 + 2 * e] * __uint_as_float(w[e] << 16) + sq[c * 8 + 2 * e + 1] * __uint_as_float(w[e] & 0xffff0000u); }
                }
                d *= exp2f(l2g128 * (float)(ct - (s >> 7)));
            }
            sq[128 + lane] = d;
            const int nk = min(64, t - s0 + 1);
            const unsigned* vr = (const unsigned*)(RV + ((size_t)b * SEQ + s0) * BW + h * 128) + lane;
            for (int j = 0; j < nk; ++j) {
                const unsigned v = vr[(size_t)j * (BW / 2)];
                const float a = sq[128 + j];
                oa += a * __uint_as_float(v << 16); ob += a * __uint_as_float(v & 0xffff0000u);
            }
        }
        const float ss = wave_sum(oa * oa + ob * ob);
        const float rn = rsqrtf(ss * (1.0f / 128.0f) + RMS_EPS);
        const unsigned gv = ((const unsigned*)(RG + mq * BW + h * 128))[lane];
        ((unsigned*)(YC + mq * BW + h * 128))[lane] = pk2(oa * rn * gn[2 * lane] * __uint_as_float(gv << 16), ob * rn * gn[2 * lane + 1] * __uint_as_float(gv & 0xffff0000u));
    }
}

__device__ __forceinline__ void nv_p3(const Args& A, int l, int wg, int nwg, float* sm) {
    float* sA = sm; float* sB = sm + 16 * 128;
    const int tid = threadIdx.x, tx = tid & 15, ty = tid >> 4;
    const float* Win = A.in[I_WIN] + (size_t)l * DM * DIN;
    const float* g1 = A.in[I_N1G] + l * DM;
    const float* bg = A.in[I_BGATE] + l * NGATE;
    const float* Wbr = A.in[I_WBR] + (size_t)l * 3 * BW * DM;
    const bf16_t* XB = (const bf16_t*)(A.ws + WS_XB);
    const float* rowss = (const float*)(A.ws + WS_ROWSS) + (size_t)(l == 0 ? 0 : 2) * M;
    bf16_t* Y = (bf16_t*)(A.ws + WS_Y);
    for (int it = wg; it < 128 * 16; it += nwg) {
        const int rt = it / 16, cg = it % 16, row0 = rt * 128;
        float y[4][4];
#pragma unroll
        for (int i = 0; i < 4; ++i)
#pragma unroll
            for (int j = 0; j < 4; ++j) y[i][j] = 0.f;
#pragma unroll 1
        for (int n = 0; n < 3; ++n) {
            float ga[4][4], pa[4][4];
            nv_core(ga, DM, ALbf{XB, DM, row0}, WLf32{Win, DIN, NU + n * DM + 64 * cg, NU + n * DM + 64 * cg + 32, g1}, sA, sB, tid);
            const bf16_t* br = (const bf16_t*)(A.ws + (n == 0 ? WS_YA : n == 1 ? WS_YB : WS_YC));
            nv_core(pa, BW, ALbf{br, BW, row0}, WLf32{Wbr + (size_t)n * BW * DM, DM, 64 * cg, 64 * cg + 32, nullptr}, sA, sB, tid);
#pragma unroll
            for (int i = 0; i < 4; ++i) {
                const float rstd = rsqrtf(rowss[row0 + ty * 4 + i] * (1.0f / DM) + RMS_EPS);
#pragma unroll
                for (int j = 0; j < 4; ++j) y[i][j] += sigmoidf_(ga[i][j] * rstd + bg[n * DM + 64 * cg + tx * 4 + j]) * pa[i][j];
            }
        }
#pragma unroll
        for (int i = 0; i < 4; ++i)
            *(uint2*)(Y + (size_t)(row0 + ty * 4 + i) * DM + 64 * cg + tx * 4) = make_uint2(pk2(y[i][0], y[i][1]), pk2(y[i][2], y[i][3]));
    }
}

__device__ __forceinline__ void nv_resid_gemm(const Args& A, const bf16_t* Am, int lda, int K, const float* W, const float* xold, float* rowss_next, int wg, int nwg, float* sm) {
    float* sA = sm; float* sB = sm + 16 * 128;
    const int tid = threadIdx.x, tx = tid & 15, ty = tid >> 4;
    bf16_t* XB = (bf16_t*)(A.ws + WS_XB);
    for (int it = wg; it < 128 * 16; it += nwg) {
        const int rt = it / 16, cg = it % 16, row0 = rt * 128;
        float acc[4][4];
        nv_core(acc, K, ALbf{Am, lda, row0}, WLf32{W, DM, 64 * cg, 64 * cg + 32, nullptr}, sA, sB, tid);
#pragma unroll
        for (int i = 0; i < 4; ++i) {
            const size_t off = (size_t)(row0 + ty * 4 + i) * DM + 64 * cg + tx * 4;
            const float4 xo = *(const float4*)(xold + off);
            const float4 xn = make_float4(xo.x + acc[i][0], xo.y + acc[i][1], xo.z + acc[i][2], xo.w + acc[i][3]);
            *(float4*)(A.out + off) = xn;
            *(uint2*)(XB + off) = make_uint2(pk2(xn.x, xn.y), pk2(xn.z, xn.w));
            float s = xn.x * xn.x + xn.y * xn.y + xn.z * xn.z + xn.w * xn.w;
            s += __shfl_xor(s, 1); s += __shfl_xor(s, 2); s += __shfl_xor(s, 4); s += __shfl_xor(s, 8);
            if (tx == 0 && rowss_next) atomicAdd(rowss_next + row0 + ty * 4 + i, s);
        }
    }
}

__device__ __forceinline__ void nv_p5(const Args& A, int l, int wg, int nwg, float* sm) {
    float* sA = sm; float* sB = sm + 16 * 128; float* sC = sB + 16 * 64;
    const int tid = threadIdx.x, tx = tid & 15, ty = tid >> 4;
    const float* W = A.in[I_WF1] + (size_t)l * DM * 2 * DFF;
    const float* g2 = A.in[I_N2G] + l * DM;
    const bf16_t* XB = (const bf16_t*)(A.ws + WS_XB);
    const float* rowss = (const float*)(A.ws + WS_ROWSS) + (size_t)(l == 0 ? 1 : 3) * M;
    bf16_t* MID = (bf16_t*)(A.ws + WS_MID);
    for (int it = wg; it < 128 * 88; it += nwg) {
        const int rt = it / 88, jj = it % 88, row0 = rt * 128;
        float acc[4][4];
        nv_core(acc, DM, ALbf{XB, DM, row0}, WLf32{W, 2 * DFF, 32 * jj, DFF + 32 * jj, g2}, sA, sB, tid);
#pragma unroll
        for (int i = 0; i < 4; ++i) {
            const int r = ty * 4 + i; const float rstd = rsqrtf(rowss[row0 + r] * (1.0f / DM) + RMS_EPS);
#pragma unroll
            for (int j = 0; j < 4; ++j) sC[r * 65 + tx * 4 + j] = acc[i][j] * rstd;
        }
        __syncthreads();
        const int r = tid >> 2, q4 = tid & 3;
        const float* cr = sC + r * 65;
        bf16_t* o = MID + (size_t)(row0 + r) * DFF + 32 * jj + q4 * 8;
#pragma unroll
        for (int j = 0; j < 8; ++j) o[j] = (bf16_t)f2bf(siluf_(cr[q4 * 8 + j]) * cr[32 + q4 * 8 + j]);
        __syncthreads();
    }
}

constexpr int N_PHASES = 1 + 6 * DEPTH;
__global__ void __launch_bounds__(NTHREADS) fwd_kernel(Args A) {
    extern __shared__ __attribute__((aligned(16))) unsigned char lds[];
    float* sm = (float*)lds;
    volatile LAS unsigned* MISC = (volatile LAS unsigned*)((LAS unsigned char*)lds + 47 * 1024);
    const int wg = blockIdx.x, nwg = gridDim.x;
    const bool multi = (A.ph_hi - A.ph_lo) > 1;
    XcdBarrier bar; bar.bar = nullptr; bar.x = 0; bar.st = nullptr;
    if (multi) {
        if (threadIdx.x < 2) MISC[threadIdx.x] = 0u;
        __syncthreads();
        bar = xcd_barrier_post((unsigned*)(A.ws + WS_CTL) + CW_BAR, MISC);
    }
    for (int ph = A.ph_lo; ph < A.ph_hi; ++ph) {
        if (ph == 0) nv_p0(A, wg, nwg);
        else {
            const int l = (ph - 1) / 6, k = (ph - 1) % 6;
            if (k == 0) nv_p1(A, l, wg, nwg, sm);
            else if (k == 1) { nv_attn(A, l, wg, nwg, sm); nv_conv(A, l, wg, nwg); nv_ret(A, l, wg, nwg, sm); }
            else if (k == 2) nv_p3(A, l, wg, nwg, sm);
            else if (k == 3) nv_resid_gemm(A, (const bf16_t*)(A.ws + WS_Y), DM, DM, A.in[I_WOUT] + (size_t)l * DM * DM, l == 0 ? A.in[I_X] : A.out,
                                           (float*)(A.ws + WS_ROWSS) + (size_t)(l == 0 ? 1 : 3) * M, wg, nwg, sm);
            else if (k == 4) nv_p5(A, l, wg, nwg, sm);
            else nv_resid_gemm(A, (const bf16_t*)(A.ws + WS_MID), DFF, DFF, A.in[I_WF2] + (size_t)l * DFF * DM, A.out,
                               l + 1 < DEPTH ? (float*)(A.ws + WS_ROWSS) + (size_t)2 * M : nullptr, wg, nwg, sm);
        }
        if (ph + 1 < A.ph_hi) xcd_barrier(bar);
    }
}

#ifndef ONE_LAUNCH
#define ONE_LAUNCH 1
#endif
constexpr int LDS_BYTES = 48 * 1024;
extern "C" void kernel_launch(void* const* d_in, const int* in_sizes, int n_in, void* d_out, int out_size, void* d_ws, size_t ws_size, hipStream_t stream) {
    static int grid = 0;
    if (grid == 0) {
        if (n_in != N_IN || out_size != M * DM || ws_size < WS_END) { fprintf(stderr, "kernel_launch: unexpected shapes (n_in %d out %d ws %zu)\n", n_in, out_size, ws_size); grid = -1; return; }
        int dev = 0, cus = 0, per_cu = 0;
        hipGetDevice(&dev); hipDeviceGetAttribute(&cus, hipDeviceAttributeMultiprocessorCount, dev);
        hipFuncSetAttribute((const void*)fwd_kernel, hipFuncAttributeMaxDynamicSharedMemorySize, LDS_BYTES);
        hipOccupancyMaxActiveBlocksPerMultiprocessor(&per_cu, (const void*)fwd_kernel, NTHREADS, LDS_BYTES);
        (void)hipGetLastError();
        if (per_cu < 1) per_cu = 1;
        if (per_cu > 2) per_cu = 2;
        grid = cus * per_cu;
        fprintf(stderr, "kernel_launch: cus %d per_cu %d grid %d\n", cus, per_cu, grid);
    }
    if (grid < 0) return;
    hipMemsetAsync((char*)d_ws + WS_CTL, 0, CTL_ZERO_BYTES, stream);
    Args a{};
    for (int i = 0; i < N_IN; ++i) a.in[i] = (const float*)d_in[i];
    a.out = (float*)d_out; a.ws = (unsigned char*)d_ws;
#if ONE_LAUNCH
    a.ph_lo = 0; a.ph_hi = N_PHASES;
    void* args[] = {&a};
    hipError_t e = hipLaunchCooperativeKernel((const void*)fwd_kernel, dim3(grid), dim3(NTHREADS), args, LDS_BYTES, stream);
    if (e != hipSuccess) fprintf(stderr, "cooperative launch failed: %s (grid %d)\n", hipGetErrorString(e), grid);
#else
    for (int ph = 0; ph < N_PHASES; ++ph) {
        a.ph_lo = ph; a.ph_hi = ph + 1;
        hipLaunchKernelGGL(fwd_kernel, dim3(2048), dim3(NTHREADS), LDS_BYTES, stream, a);
    }
#endif
}
```

```cpp
#include <hip/hip_runtime.h>
#include <cstdio>
#include <cstdint>

#define GAS __attribute__((address_space(1)))
#define LAS __attribute__((address_space(3)))
typedef unsigned short bf16_t;
typedef GAS unsigned gu32;
#define RLX_AGENT __ATOMIC_RELAXED, __HIP_MEMORY_SCOPE_AGENT

constexpr int BATCH = 4, SEQ = 4096, DM = 1024, M = BATCH * SEQ, DEPTH = 2;
constexpr int DIN = 7680, NU = 4608, NGATE = 3072, DFF = 2816, BW = 512;
constexpr float RMS_EPS = 1e-6f, LN_EPS = 1e-5f;
constexpr float LOG2E = 1.4426950408889634f;
constexpr float QSCALE = 0.125f * LOG2E;
constexpr int NTHREADS = 512, NWAVES = 8;

enum { I_X = 0, I_N1G, I_WIN, I_QG, I_KG, I_DLAM, I_ASG, I_CW, I_CB, I_CLG, I_CLB, I_RGN, I_BGATE, I_WBR, I_WOUT, I_N2G, I_WF1, I_WF2, N_IN };

constexpr size_t MiB = 1u << 20;
constexpr size_t WS_CTL = 0, CTL_ZERO_BYTES = 1 * MiB;
constexpr size_t WS_ROWSS = 256 * 1024;
constexpr size_t WS_LAM = 512 * 1024;
constexpr size_t WS_XB = 78 * MiB;
constexpr size_t WS_AQ = 110 * MiB, WS_AK = 126 * MiB, WS_AV = 142 * MiB, WS_Z = 158 * MiB, WS_RQ = 174 * MiB, WS_RK = 190 * MiB, WS_RV = 206 * MiB, WS_RG = 222 * MiB, WS_YB = 238 * MiB;
constexpr size_t WS_YA = WS_AQ, WS_YC = WS_RQ;
constexpr size_t WS_Y = 126 * MiB;
constexpr size_t WS_MID = 110 * MiB;
constexpr size_t WS_END = 256 * MiB;
constexpr int CW_BAR = 4096;

struct Args { const float* in[N_IN]; float* out; unsigned char* ws; int ph_lo, ph_hi; };

__device__ __forceinline__ float bf2f(unsigned v) { return __uint_as_float(v << 16); }
__device__ __forceinline__ unsigned f2bf(float f) { unsigned u = __float_as_uint(f); return (u + 0x7fffu + ((u >> 16) & 1u)) >> 16; }
__device__ __forceinline__ unsigned pk2(float lo, float hi) { return f2bf(lo) | (f2bf(hi) << 16); }
__device__ __forceinline__ float wave_sum(float v) {
#pragma unroll
    for (int o = 1; o < 64; o <<= 1) v += __shfl_xor(v, o);
    return v;
}
__device__ __forceinline__ float wave_max(float v) {
#pragma unroll
    for (int o = 1; o < 64; o <<= 1) v = fmaxf(v, __shfl_xor(v, o));
    return v;
}
__device__ __forceinline__ int opaque_tid() { int t = threadIdx.x; asm volatile("" : "+v"(t)); return t; }
__device__ __forceinline__ float sigmoidf_(float x) { return 1.0f / (1.0f + __expf(-x)); }
__device__ __forceinline__ float siluf_(float x) { return x / (1.0f + __expf(-x)); }
__device__ __forceinline__ float lam_init_of(int l) { return l == 0 ? 0.2f : (0.8f - 0.6f * 0.74081822068171788f); }
__device__ __forceinline__ float log2_gamma(int h) { return log2f(1.0f - exp2f(-5.0f - (float)h)); }

#define XB_TMO      128
#define XB_XCNT(j)  (256  + 64 * (j))
#define XB_XSUB(j)  (1280 + 64 * (j))
#define XB_XGEN(j)  (2304 + 64 * (j))
#define XB_TOP      3328
#define XB_TOPGEN   3392
#define XCD_BAR_WORDS 3456
#define XB_SPIN_CAP (1u << 22)
__device__ __forceinline__ unsigned xb_ld(unsigned* p)              { return __hip_atomic_load(p, __ATOMIC_RELAXED, __HIP_MEMORY_SCOPE_AGENT); }
__device__ __forceinline__ unsigned xb_add(unsigned* p, unsigned v) { return __hip_atomic_fetch_add(p, v, __ATOMIC_RELAXED, __HIP_MEMORY_SCOPE_AGENT); }
__device__ __forceinline__ unsigned xb_xcc_id() { return (unsigned)__builtin_amdgcn_s_getreg((3 << 11) | 20) & 0xFu; }
#define XB_SPIN(cond, bar) do { unsigned _sp = 0; while (cond) { __builtin_amdgcn_s_sleep(1); \
    if ((++_sp & 255u) == 0u) { if (xb_ld(&(bar)[XB_TMO])) break; if (_sp > XB_SPIN_CAP) { atomicAdd(&(bar)[XB_TMO], 1u); break; } } } } while (0)
struct XcdBarrier { unsigned* bar; unsigned x; volatile LAS unsigned* st; };
__device__ __forceinline__ XcdBarrier xcd_barrier_post(unsigned* bar, volatile LAS unsigned* st) {
    XcdBarrier b; b.bar = bar; b.x = xb_xcc_id(); b.st = st;
    if (threadIdx.x == 0) (void)xb_add(&bar[XB_XCNT(b.x)], 1u);
    return b;
}
__device__ __forceinline__ void xcd_barrier_complete(unsigned* bar, unsigned x, unsigned& nloc, unsigned& nx) {
    const unsigned G = gridDim.x * gridDim.y * gridDim.z;
    unsigned sum, cnt, mine, sp = 0u;
    for (;;) {
        sum = 0u; cnt = 0u; mine = 0u;
#pragma unroll
        for (unsigned j = 0; j < 16; ++j) { const unsigned c = xb_ld(&bar[XB_XCNT(j)]); sum += c; cnt += (c > 0u) ? 1u : 0u; mine = (j == x) ? c : mine; }
        if (sum == G) break;
        __builtin_amdgcn_s_sleep(1);
        if ((++sp & 255u) == 0u) { if (xb_ld(&bar[XB_TMO])) break; if (sp > XB_SPIN_CAP) { atomicAdd(&bar[XB_TMO], 1u); break; } }
    }
    nloc = mine > 0u ? mine : 1u; nx = cnt > 0u ? cnt : 1u;
}
__device__ __forceinline__ void xcd_barrier(const XcdBarrier& b) {
    asm volatile("s_waitcnt vmcnt(0)" ::: "memory");
    __syncthreads();
    if (threadIdx.x == 0) {
        unsigned* bar = b.bar;
        __builtin_amdgcn_s_waitcnt(0);
        unsigned nloc = b.st[0], nx = b.st[1];
        if (nloc == 0u) { xcd_barrier_complete(bar, b.x, nloc, nx); b.st[0] = nloc; b.st[1] = nx; }
        const unsigned old = xb_add(&bar[XB_XSUB(b.x)], 1u);
        const unsigned gen = old / nloc;
        if (old + 1u == (gen + 1u) * nloc) {
            __builtin_amdgcn_fence(__ATOMIC_RELEASE, "agent");
            asm volatile("s_waitcnt vmcnt(0)" ::: "memory");
            const unsigned og = xb_add(&bar[XB_TOP], 1u);
            const unsigned tg = og / nx;
            if (og + 1u == (tg + 1u) * nx) xb_add(&bar[XB_TOPGEN], 1u);
            else XB_SPIN(xb_ld(&bar[XB_TOPGEN]) == tg, bar);
            __builtin_amdgcn_fence(__ATOMIC_ACQUIRE, "agent");
            xb_add(&bar[XB_XGEN(b.x)], 1u);
            asm volatile("s_waitcnt vmcnt(0)" ::: "memory");
        } else {
            XB_SPIN(xb_ld(&bar[XB_XGEN(b.x)]) == gen, bar);
            __builtin_amdgcn_fence(__ATOMIC_ACQUIRE, "agent");
            asm volatile("s_waitcnt vmcnt(0)" ::: "memory");
        }
    }
    __syncthreads();
}


__device__ __forceinline__ void nv_p0(const Args& A, int wg, int nwg) {
    const int tid = opaque_tid(), lane = tid & 63, wave = tid >> 6;
    const float* x = A.in[I_X];
    bf16_t* XB = (bf16_t*)(A.ws + WS_XB);
    float* rowss = (float*)(A.ws + WS_ROWSS);
    for (int m = wg * NWAVES + wave; m < M; m += nwg * NWAVES) {
        const float4* xr = (const float4*)(x + (size_t)m * DM) + lane;
        uint2* o = (uint2*)(XB + (size_t)m * DM) + lane;
        float s = 0.f;
#pragma unroll
        for (int j = 0; j < 4; ++j) { const float4 v = xr[64 * j]; s += v.x * v.x + v.y * v.y + v.z * v.z + v.w * v.w; o[64 * j] = make_uint2(pk2(v.x, v.y), pk2(v.z, v.w)); }
        s = wave_sum(s);
        if (lane == 0) rowss[m] = s;
    }
    if (wg == 0 && wave < DEPTH) {
        const float* dl = A.in[I_DLAM] + wave * 4 * 64;
        float a = dl[lane] * dl[64 + lane], b = dl[128 + lane] * dl[192 + lane];
        a = wave_sum(a); b = wave_sum(b);
        if (lane == 0) ((float*)(A.ws + WS_LAM))[wave] = __expf(a) - __expf(b) + lam_init_of(wave);
    }
}

template <class AL, class WL>
__device__ __forceinline__ void nv_core(float (&acc)[4][4], int K, const AL& aload, const WL& wload, float* sA, float* sB, int tid) {
    const int tx = tid & 15, ty = tid >> 4;
#pragma unroll
    for (int i = 0; i < 4; ++i)
#pragma unroll
        for (int j = 0; j < 4; ++j) acc[i][j] = 0.f;
    const int ar = tid & 127, akq = tid >> 7;
    const int wk = tid >> 5, wc = (tid & 31) * 2;
#pragma unroll 1
    for (int k0 = 0; k0 < K; k0 += 16) {
        float a0, a1, a2, a3; aload(ar, k0 + 4 * akq, a0, a1, a2, a3);
        const float w0 = wload(k0 + wk, wc), w1 = wload(k0 + wk, wc + 1);
        __syncthreads();
        sA[(4 * akq + 0) * 128 + ar] = a0; sA[(4 * akq + 1) * 128 + ar] = a1; sA[(4 * akq + 2) * 128 + ar] = a2; sA[(4 * akq + 3) * 128 + ar] = a3;
        sB[wk * 64 + wc] = w0; sB[wk * 64 + wc + 1] = w1;
        __syncthreads();
#pragma unroll 2
        for (int kk = 0; kk < 16; ++kk) {
            const float4 a = *(const float4*)&sA[kk * 128 + ty * 4];
            const float4 b = *(const float4*)&sB[kk * 64 + tx * 4];
            const float av[4] = {a.x, a.y, a.z, a.w}, bv[4] = {b.x, b.y, b.z, b.w};
#pragma unroll
            for (int i = 0; i < 4; ++i)
#pragma unroll
                for (int j = 0; j < 4; ++j) acc[i][j] += av[i] * bv[j];
        }
    }
    __syncthreads();
}
struct ALbf {
    const bf16_t* A; int lda; int row0;
    __device__ __forceinline__ void operator()(int r, int k, float& a0, float& a1, float& a2, float& a3) const {
        const uint2 v = *(const uint2*)(A + (size_t)(row0 + r) * lda + k);
        a0 = __uint_as_float(v.x << 16); a1 = __uint_as_float(v.x & 0xffff0000u); a2 = __uint_as_float(v.y << 16); a3 = __uint_as_float(v.y & 0xffff0000u);
    }
};
struct WLf32 {
    const float* W; int ldw; int c0, c1; const float* g;
    __device__ __forceinline__ float operator()(int k, int j) const {
        const float w = W[(size_t)k * ldw + (j < 32 ? c0 + j : c1 + j - 32)];
        return g ? w * g[k] : w;
    }
};

__device__ __forceinline__ void nv_p1(const Args& A, int l, int wg, int nwg, float* sm) {
    float* sA = sm; float* sB = sm + 16 * 128; float* sC = sB + 16 * 64;
    const int tid = opaque_tid(), tx = tid & 15, ty = tid >> 4;
    const float* Win = A.in[I_WIN] + (size_t)l * DM * DIN;
    const float* g1 = A.in[I_N1G] + l * DM;
    const bf16_t* XB = (const bf16_t*)(A.ws + WS_XB);
    const float* rowss = (const float*)(A.ws + WS_ROWSS) + (size_t)(l == 0 ? 0 : 2) * M;
    const float* qg = A.in[I_QG] + l * 64; const float* kg = A.in[I_KG] + l * 64;
    for (int it = wg; it < 128 * 72; it += nwg) {
        const int rt = it / 72, cg = it % 72, row0 = rt * 128;
        int c0 = 64 * cg, c1 = 64 * cg + 32;
        if (cg >= 24 && cg < 40) { c0 = 1536 + 32 * (cg - 24); c1 = 2048 + 32 * (cg - 24); }
        float acc[4][4];
        nv_core(acc, DM, ALbf{XB, DM, row0}, WLf32{Win, DIN, c0, c1, g1}, sA, sB, tid);
#pragma unroll
        for (int i = 0; i < 4; ++i) {
            const int r = ty * 4 + i; const float rstd = rsqrtf(rowss[row0 + r] * (1.0f / DM) + RMS_EPS);
#pragma unroll
            for (int j = 0; j < 4; ++j) sC[r * 65 + tx * 4 + j] = acc[i][j] * rstd;
        }
        __syncthreads();
        const int r = tid >> 2, q4 = tid & 3, m = row0 + r, t = m & (SEQ - 1);
        const float* cr = sC + r * 65;
        if (cg < 16) {
            float ss = 0.f;
#pragma unroll
            for (int j = 0; j < 16; ++j) { const float v = cr[q4 * 16 + j]; ss += v * v; }
            ss += __shfl_xor(ss, 1); ss += __shfl_xor(ss, 2);
            const float rn = rsqrtf(ss * (1.0f / 64.0f) + RMS_EPS);
            const bool isq = cg < 8; const float* gg = isq ? qg : kg; const float sc = isq ? QSCALE : 1.0f;
            bf16_t* o = (bf16_t*)(A.ws + (isq ? WS_AQ : WS_AK)) + (size_t)m * BW + (cg & 7) * 64 + q4 * 16;
#pragma unroll
            for (int j = 0; j < 16; ++j) o[j] = (bf16_t)f2bf(cr[q4 * 16 + j] * rn * gg[q4 * 16 + j] * sc);
        } else if (cg >= 24 && cg < 40) {
            bf16_t* o = (bf16_t*)(A.ws + WS_Z) + (size_t)m * BW + (cg - 24) * 32 + q4 * 8;
#pragma unroll
            for (int j = 0; j < 8; ++j) o[j] = (bf16_t)f2bf(cr[q4 * 8 + j] * sigmoidf_(cr[32 + q4 * 8 + j]));
        } else {
            size_t base; int cb; int kind;
            if (cg < 24)      { base = WS_AV; cb = cg - 16; kind = 0; }
            else if (cg < 48) { base = WS_RQ; cb = cg - 40; kind = 1; }
            else if (cg < 56) { base = WS_RK; cb = cg - 48; kind = 2; }
            else if (cg < 64) { base = WS_RV; cb = cg - 56; kind = 0; }
            else              { base = WS_RG; cb = cg - 64; kind = 3; }
            const int h = cb >> 1; const float l2g = log2_gamma(h); const float tp = (float)(t & 127);
            float f = 1.0f;
            if (kind == 1) f = exp2f(tp * l2g);
            if (kind == 2) f = 0.08838834764831845f * exp2f(-tp * l2g);
            bf16_t* o = (bf16_t*)(A.ws + base) + (size_t)m * BW + cb * 64 + q4 * 16;
#pragma unroll
            for (int j = 0; j < 16; ++j) { float v = cr[q4 * 16 + j]; v = (kind == 3) ? siluf_(v) : v * f; o[j] = (bf16_t)f2bf(v); }
        }
        __syncthreads();
    }
}

__device__ __forceinline__ void nv_attn(const Args& A, int l, int wg, int nwg, float* sm) {
    const int tid = opaque_tid(), lane = tid & 63, wave = tid >> 6;
    float* sq = sm + wave * 256;
    const bf16_t* AQ = (const bf16_t*)(A.ws + WS_AQ); const bf16_t* AK = (const bf16_t*)(A.ws + WS_AK); const bf16_t* AV = (const bf16_t*)(A.ws + WS_AV);
    bf16_t* YA = (bf16_t*)(A.ws + WS_YA);
    const float lam = ((const float*)(A.ws + WS_LAM))[l];
    const float* asg = A.in[I_ASG] + l * 128;
    const float osc = 1.0f - lam_init_of(l);
    for (int it = wg * NWAVES + wave; it < BATCH * 4 * SEQ; it += nwg * NWAVES) {
        const int t = it & (SEQ - 1), h = (it >> 12) & 3, b = it >> 14;
        const size_t mq = (size_t)b * SEQ + t;
        const float slope2 = exp2f(-2.0f * (float)(h + 1)) * LOG2E;
        sq[lane] = bf2f(AQ[mq * BW + h * 128 + lane]); sq[64 + lane] = bf2f(AQ[mq * BW + h * 128 + 64 + lane]);
        float m1 = -INFINITY, m2 = -INFINITY, l1 = 0.f, l2 = 0.f, o1a = 0.f, o1b = 0.f, o2a = 0.f, o2b = 0.f;
        for (int s0 = 0; s0 <= t; s0 += 64) {
            const int s = s0 + lane; const bool valid = s <= t;
            float d1 = 0.f, d2 = 0.f;
            if (valid) {
                const uint4* kr = (const uint4*)(AK + ((size_t)b * SEQ + s) * BW + h * 128);
#pragma unroll 2
                for (int c = 0; c < 8; ++c) {
                    const uint4 v = kr[c]; const unsigned w[4] = {v.x, v.y, v.z, v.w};
#pragma unroll
                    for (int e = 0; e < 4; ++e) { d1 += sq[c * 8 + 2 * e] * __uint_as_float(w[e] << 16) + sq[c * 8 + 2 * e + 1] * __uint_as_float(w[e] & 0xffff0000u); }
                }
#pragma unroll 2
                for (int c = 0; c < 8; ++c) {
                    const uint4 v = kr[8 + c]; const unsigned w[4] = {v.x, v.y, v.z, v.w};
#pragma unroll
                    for (int e = 0; e < 4; ++e) { d2 += sq[64 + c * 8 + 2 * e] * __uint_as_float(w[e] << 16) + sq[64 + c * 8 + 2 * e + 1] * __uint_as_float(w[e] & 0xffff0000u); }
                }
            }
            const float bias = slope2 * (float)(s - t);
            const float s1 = valid ? d1 + bias : -INFINITY, s2 = valid ? d2 + bias : -INFINITY;
            const float n1 = fmaxf(m1, wave_max(s1)), n2 = fmaxf(m2, wave_max(s2));
            const float a1 = exp2f(m1 - n1), a2 = exp2f(m2 - n2);
            const float p1 = exp2f(s1 - n1), p2 = exp2f(s2 - n2);
            l1 = l1 * a1 + wave_sum(p1); l2 = l2 * a2 + wave_sum(p2);
            o1a *= a1; o1b *= a1; o2a *= a2; o2b *= a2; m1 = n1; m2 = n2;
            sq[128 + lane] = p1; sq[192 + lane] = p2;
            const int nk = min(64, t - s0 + 1);
            const unsigned* vr = (const unsigned*)(AV + ((size_t)b * SEQ + s0) * BW + h * 128) + lane;
            for (int j = 0; j < nk; ++j) {
                const unsigned v = vr[(size_t)j * (BW / 2)];
                const float va = __uint_as_float(v << 16), vb = __uint_as_float(v & 0xffff0000u);
                const float q1 = sq[128 + j], q2 = sq[192 + j];
                o1a += q1 * va; o1b += q1 * vb; o2a += q2 * va; o2b += q2 * vb;
            }
        }
        const float i1 = 1.0f / l1, i2 = lam / l2;
        const float ya = o1a * i1 - o2a * i2, yb = o1b * i1 - o2b * i2;
        const float ss = wave_sum(ya * ya + yb * yb);
        const float rn = rsqrtf(ss * (1.0f / 128.0f) + RMS_EPS) * osc;
        ((unsigned*)(YA + mq * BW + h * 128))[lane] = pk2(ya * rn * asg[2 * lane], yb * rn * asg[2 * lane + 1]);
    }
}

__device__ __forceinline__ void nv_conv(const Args& A, int l, int wg, int nwg) {
    const int tid = opaque_tid(), lane = tid & 63, wave = tid >> 6;
    const bf16_t* Z = (const bf16_t*)(A.ws + WS_Z); bf16_t* YB = (bf16_t*)(A.ws + WS_YB);
    const float* cw = A.in[I_CW] + (size_t)l * 31 * BW; const float* cb = A.in[I_CB] + l * BW;
    const float* lg = A.in[I_CLG] + l * BW; const float* lb = A.in[I_CLB] + l * BW;
    const int c0 = lane * 8;
    for (int m = wg * NWAVES + wave; m < M; m += nwg * NWAVES) {
        const int t = m & (SEQ - 1);
        float acc[8];
#pragma unroll
        for (int e = 0; e < 8; ++e) acc[e] = cb[c0 + e];
        const int j0 = max(0, 30 - t);
        for (int j = j0; j < 31; ++j) {
            const uint4 v = *(const uint4*)(Z + (size_t)(m - 30 + j) * BW + c0);
            const float4 wa = *(const float4*)(cw + j * BW + c0), wb = *(const float4*)(cw + j * BW + c0 + 4);
            acc[0] += wa.x * __uint_as_float(v.x << 16); acc[1] += wa.y * __uint_as_float(v.x & 0xffff0000u);
            acc[2] += wa.z * __uint_as_float(v.y << 16); acc[3] += wa.w * __uint_as_float(v.y & 0xffff0000u);
            acc[4] += wb.x * __uint_as_float(v.z << 16); acc[5] += wb.y * __uint_as_float(v.z & 0xffff0000u);
            acc[6] += wb.z * __uint_as_float(v.w << 16); acc[7] += wb.w * __uint_as_float(v.w & 0xffff0000u);
        }
        float s = 0.f;
#pragma unroll
        for (int e = 0; e < 8; ++e) s += acc[e];
        const float mu = wave_sum(s) * (1.0f / BW);
        float q = 0.f;
#pragma unroll
        for (int e = 0; e < 8; ++e) { acc[e] -= mu; q += acc[e] * acc[e]; }
        const float rstd = rsqrtf(wave_sum(q) * (1.0f / BW) + LN_EPS);
        float o[8];
#pragma unroll
        for (int e = 0; e < 8; ++e) o[e] = siluf_(acc[e] * rstd * lg[c0 + e] + lb[c0 + e]);
        *(uint4*)(YB + (size_t)m * BW + c0) = make_uint4(pk2(o[0], o[1]), pk2(o[2], o[3]), pk2(o[4], o[5]), pk2(o[6], o[7]));
    }
}

__device__ __forceinline__ void nv_ret(const Args& A, int l, int wg, int nwg, float* sm) {
    const int tid = opaque_tid(), lane = tid & 63, wave = tid >> 6;
    float* sq = sm + wave * 256;
    const bf16_t* RQ = (const bf16_t*)(A.ws + WS_RQ); const bf16_t* RK = (const bf16_t*)(A.ws + WS_RK); const bf16_t* RV = (const bf16_t*)(A.ws + WS_RV);
    const bf16_t* RG = (const bf16_t*)(A.ws + WS_RG); bf16_t* YC = (bf16_t*)(A.ws + WS_YC);
    const float* gn = A.in[I_RGN] + l * 128;
    for (int it = wg * NWAVES + wave; it < BATCH * 4 * SEQ; it += nwg * NWAVES) {
        const int t = it & (SEQ - 1), h = (it >> 12) & 3, b = it >> 14;
        const size_t mq = (size_t)b * SEQ + t;
        const float l2g128 = 128.0f * log2_gamma(h);
        { const unsigned v = ((const unsigned*)(RQ + mq * BW + h * 128))[lane]; sq[2 * lane] = __uint_as_float(v << 16); sq[2 * lane + 1] = __uint_as_float(v & 0xffff0000u); }
        float oa = 0.f, ob = 0.f;
        const int ct = t >> 7;
        for (int s0 = 0; s0 <= t; s0 += 64) {
            const int s = s0 + lane; const bool valid = s <= t;
            float d = 0.f;
            if (valid) {
                const uint4* kr = (const uint4*)(RK + ((size_t)b * SEQ + s) * BW + h * 128);
#pragma unroll 2
                for (int c = 0; c < 16; ++c) {
                    const uint4 v = kr[c]; const unsigned w[4] = {v.x, v.y, v.z, v.w};
#pragma unroll
                    for (int e = 0; e < 4; ++e) { d += sq[c * 8 + 2 * e] * __uint_as_float(w[e] << 16) + sq[c * 8 + 2 * e + 1] * __uint_as_float(w[e] & 0xffff0000u); }
                }
                d *= exp2f(l2g128 * (float)(ct - (s >> 7)));
            }
            sq[128 + lane] = d;
            const int nk = min(64, t - s0 + 1);
            const unsigned* vr = (const unsigned*)(RV + ((size_t)b * SEQ + s0) * BW + h * 128) + lane;
            for (int j = 0; j < nk; ++j) {
                const unsigned v = vr[(size_t)j * (BW / 2)];
                const float a = sq[128 + j];
                oa += a * __uint_as_float(v << 16); ob += a * __uint_as_float(v & 0xffff0000u);
            }
        }
        const float ss = wave_sum(oa * oa + ob * ob);
        const float rn = rsqrtf(ss * (1.0f / 128.0f) + RMS_EPS);
        const unsigned gv = ((const unsigned*)(RG + mq * BW + h * 128))[lane];
        ((unsigned*)(YC + mq * BW + h * 128))[lane] = pk2(oa * rn * gn[2 * lane] * __uint_as_float(gv << 16), ob * rn * gn[2 * lane + 1] * __uint_as_float(gv & 0xffff0000u));
    }
}

__device__ __forceinline__ void nv_p3(const Args& A, int l, int wg, int nwg, float* sm) {
    float* sA = sm; float* sB = sm + 16 * 128;
    const int tid = opaque_tid(), tx = tid & 15, ty = tid >> 4;
    const float* Win = A.in[I_WIN] + (size_t)l * DM * DIN;
    const float* g1 = A.in[I_N1G] + l * DM;
    const float* bg = A.in[I_BGATE] + l * NGATE;
    const float* Wbr = A.in[I_WBR] + (size_t)l * 3 * BW * DM;
    const bf16_t* XB = (const bf16_t*)(A.ws + WS_XB);
    const float* rowss = (const float*)(A.ws + WS_ROWSS) + (size_t)(l == 0 ? 0 : 2) * M;
    bf16_t* Y = (bf16_t*)(A.ws + WS_Y);
    for (int it = wg; it < 128 * 16; it += nwg) {
        const int rt = it / 16, cg = it % 16, row0 = rt * 128;
        float y[4][4];
#pragma unroll
        for (int i = 0; i < 4; ++i)
#pragma unroll
            for (int j = 0; j < 4; ++j) y[i][j] = 0.f;
#pragma unroll 1
        for (int n = 0; n < 3; ++n) {
            float ga[4][4], pa[4][4];
            nv_core(ga, DM, ALbf{XB, DM, row0}, WLf32{Win, DIN, NU + n * DM + 64 * cg, NU + n * DM + 64 * cg + 32, g1}, sA, sB, tid);
            const bf16_t* br = (const bf16_t*)(A.ws + (n == 0 ? WS_YA : n == 1 ? WS_YB : WS_YC));
            nv_core(pa, BW, ALbf{br, BW, row0}, WLf32{Wbr + (size_t)n * BW * DM, DM, 64 * cg, 64 * cg + 32, nullptr}, sA, sB, tid);
#pragma unroll
            for (int i = 0; i < 4; ++i) {
                const float rstd = rsqrtf(rowss[row0 + ty * 4 + i] * (1.0f / DM) + RMS_EPS);
#pragma unroll
                for (int j = 0; j < 4; ++j) y[i][j] += sigmoidf_(ga[i][j] * rstd + bg[n * DM + 64 * cg + tx * 4 + j]) * pa[i][j];
            }
        }
#pragma unroll
        for (int i = 0; i < 4; ++i)
            *(uint2*)(Y + (size_t)(row0 + ty * 4 + i) * DM + 64 * cg + tx * 4) = make_uint2(pk2(y[i][0], y[i][1]), pk2(y[i][2], y[i][3]));
    }
}

__device__ __forceinline__ void nv_resid_gemm(const Args& A, const bf16_t* Am, int lda, int K, const float* W, const float* xold, float* rowss_next, int wg, int nwg, float* sm) {
    float* sA = sm; float* sB = sm + 16 * 128;
    const int tid = opaque_tid(), tx = tid & 15, ty = tid >> 4;
    bf16_t* XB = (bf16_t*)(A.ws + WS_XB);
    for (int it = wg; it < 128 * 16; it += nwg) {
        const int rt = it / 16, cg = it % 16, row0 = rt * 128;
        float acc[4][4];
        nv_core(acc, K, ALbf{Am, lda, row0}, WLf32{W, DM, 64 * cg, 64 * cg + 32, nullptr}, sA, sB, tid);
#pragma unroll
        for (int i = 0; i < 4; ++i) {
            const size_t off = (size_t)(row0 + ty * 4 + i) * DM + 64 * cg + tx * 4;
            const float4 xo = *(const float4*)(xold + off);
            const float4 xn = make_float4(xo.x + acc[i][0], xo.y + acc[i][1], xo.z + acc[i][2], xo.w + acc[i][3]);
            *(float4*)(A.out + off) = xn;
            *(uint2*)(XB + off) = make_uint2(pk2(xn.x, xn.y), pk2(xn.z, xn.w));
            float s = xn.x * xn.x + xn.y * xn.y + xn.z * xn.z + xn.w * xn.w;
            s += __shfl_xor(s, 1); s += __shfl_xor(s, 2); s += __shfl_xor(s, 4); s += __shfl_xor(s, 8);
            if (tx == 0 && rowss_next) atomicAdd(rowss_next + row0 + ty * 4 + i, s);
        }
    }
}

__device__ __forceinline__ void nv_p5(const Args& A, int l, int wg, int nwg, float* sm) {
    float* sA = sm; float* sB = sm + 16 * 128; float* sC = sB + 16 * 64;
    const int tid = opaque_tid(), tx = tid & 15, ty = tid >> 4;
    const float* W = A.in[I_WF1] + (size_t)l * DM * 2 * DFF;
    const float* g2 = A.in[I_N2G] + l * DM;
    const bf16_t* XB = (const bf16_t*)(A.ws + WS_XB);
    const float* rowss = (const float*)(A.ws + WS_ROWSS) + (size_t)(l == 0 ? 1 : 3) * M;
    bf16_t* MID = (bf16_t*)(A.ws + WS_MID);
    for (int it = wg; it < 128 * 88; it += nwg) {
        const int rt = it / 88, jj = it % 88, row0 = rt * 128;
        float acc[4][4];
        nv_core(acc, DM, ALbf{XB, DM, row0}, WLf32{W, 2 * DFF, 32 * jj, DFF + 32 * jj, g2}, sA, sB, tid);
#pragma unroll
        for (int i = 0; i < 4; ++i) {
            const int r = ty * 4 + i; const float rstd = rsqrtf(rowss[row0 + r] * (1.0f / DM) + RMS_EPS);
#pragma unroll
            for (int j = 0; j < 4; ++j) sC[r * 65 + tx * 4 + j] = acc[i][j] * rstd;
        }
        __syncthreads();
        const int r = tid >> 2, q4 = tid & 3;
        const float* cr = sC + r * 65;
        bf16_t* o = MID + (size_t)(row0 + r) * DFF + 32 * jj + q4 * 8;
#pragma unroll
        for (int j = 0; j < 8; ++j) o[j] = (bf16_t)f2bf(siluf_(cr[q4 * 8 + j]) * cr[32 + q4 * 8 + j]);
        __syncthreads();
    }
}


namespace pg8 {
typedef short bf16x8 __attribute__((ext_vector_type(8)));
typedef float f32x4 __attribute__((ext_vector_type(4)));
typedef unsigned u32x4 __attribute__((ext_vector_type(4)));
constexpr int BM = 256, BK = 64, HALF = 128, HTB = HALF * BK * 2, STAGE_BYTES = 8 * HTB, NXCD = 8, WGM = 8;
__host__ __device__ __forceinline__ int lds_byte(int r, int c) { const int st = (r >> 4) * 2 + (c >> 5), rr = r & 15, cc = c & 31, ob = rr * 64 + cc * 2; return st * 1024 + (ob ^ (((ob >> 9) & 1) << 5)); }
__host__ __device__ __forceinline__ void stage_rc(int b, int& R, int& C) { const int st = b / 1024, sb = b % 1024, swz = sb ^ (((sb >> 9) & 1) << 5); R = (st >> 1) * 16 + swz / 64; C = (st & 1) * 32 + (swz % 64) / 2; }
__host__ __device__ __forceinline__ int perm32(int rho) { const int n = rho >> 4, i = rho & 15; return 8 * (i >> 2) + 4 * n + (i & 3); }

struct GUnit { const char* A; const char* B; int lda2, ldb2, nt, pm, pn, kind; };

struct TileOrder {
    int nM, nN, nwg, G, c;
    __device__ __forceinline__ void init(int nM_, int nN_, int G_, int c_) { nM = nM_; nN = nN_; nwg = nM * nN; G = G_; c = c_; }
    __device__ __forceinline__ bool tile(int i, int& pm, int& pn) const {
        const long L = (long)i * G + c; if (L >= nwg) return false;
        int wgid = (int)L; { const int q = nwg / NXCD, r = nwg % NXCD, xcd = wgid % NXCD, off = wgid / NXCD; wgid = (xcd < r ? xcd * (q + 1) : r * (q + 1) + (xcd - r) * q) + off; }
        const int nig = WGM * nN, gid = wgid / nig, fm = gid * WGM, gsz = (nM - fm) < WGM ? (nM - fm) : WGM;
        pm = fm + ((wgid % nig) % gsz); pn = (wgid % nig) / gsz; return true;
    }
};

typedef float f32x2_t __attribute__((ext_vector_type(2))); typedef __bf16 bf16x2_t __attribute__((ext_vector_type(2)));
__device__ __forceinline__ unsigned cvt_pk_bf16(float lo, float hi) { f32x2_t v = {lo, hi}; bf16x2_t b = __builtin_convertvector(v, bf16x2_t); return __builtin_bit_cast(unsigned, b); }
__device__ __forceinline__ u32x4 pack8(const f32x4& a, const f32x4& b) { u32x4 w; w.x = cvt_pk_bf16(a[0], a[1]); w.y = cvt_pk_bf16(a[2], a[3]); w.z = cvt_pk_bf16(b[0], b[1]); w.w = cvt_pk_bf16(b[2], b[3]); return w; }

template <class Epi, class Sched>
__device__ __forceinline__ void gemm_phase(LAS unsigned char* lds, const Sched& S, const Epi& E) {
    const int tid = opaque_tid(), wid = __builtin_amdgcn_readfirstlane(tid >> 6), lane = tid & 63, wr = wid >> 2, wc = wid & 3, fr = lane & 15, fq = lane >> 4;
    const size_t kstep = (size_t)(BK * 2);
    const unsigned ldsw = (unsigned)wid * 1024u;
    const int aoff = lds_byte(wr * 64 + fr, fq * 8), boff = lds_byte(wc * 32 + fr, fq * 8);
#define PG8_SA(b, h) (((b) * 2 + (h)) * HTB)
#define PG8_SB(b, h) ((4 + (b) * 2 + (h)) * HTB)
#define PG8_STAGE(bufoff, gbase, voff) do { _Pragma("unroll") for (int _i = 0; _i < 2; ++_i) \
        __builtin_amdgcn_global_load_lds((const unsigned*)((const char*)(gbase) + (voff)[_i]), (LAS unsigned*)(lds + (bufoff) + ldsw + _i * 8192), 16, 0, 0); } while (0)
#define PG8_LDA(dst, b, h) do { _Pragma("unroll") for (int m = 0; m < 4; ++m) _Pragma("unroll") for (int k = 0; k < 2; ++k) dst[m][k] = *(const LAS bf16x8*)(lds + PG8_SA(b, h) + aoff + m * 2048 + k * 1024); } while (0)
#define PG8_LDB(dst, b, h) do { _Pragma("unroll") for (int n = 0; n < 2; ++n) _Pragma("unroll") for (int k = 0; k < 2; ++k) dst[n][k] = *(const LAS bf16x8*)(lds + PG8_SB(b, h) + boff + n * 2048 + k * 1024); } while (0)
#define PG8_MMA(ai, bj, At, Bt) do { __builtin_amdgcn_s_setprio(1); _Pragma("unroll") for (int m = 0; m < 4; ++m) _Pragma("unroll") for (int n = 0; n < 2; ++n) _Pragma("unroll") for (int k = 0; k < 2; ++k) \
        acc[ai][bj][m][n] = __builtin_amdgcn_mfma_f32_16x16x32_bf16(Bt[n][k], At[m][k], acc[ai][bj][m][n], 0, 0, 0); __builtin_amdgcn_s_setprio(0); } while (0)
#define PG8_WAIT_V(n) asm volatile("s_waitcnt vmcnt(" #n ")" ::: "memory")
#define PG8_WAIT_L(n) asm volatile("s_waitcnt lgkmcnt(" #n ")" ::: "memory")
#define PG8_BAR __builtin_amdgcn_s_barrier()
#define PG8_SCHED __builtin_amdgcn_sched_barrier(0)
    GUnit cur, nxt; int ui = 0;
    if (!S.next(0, cur)) return;
    f32x4 acc[2][2][4][2];
#pragma unroll
    for (int a = 0; a < 2; ++a)
#pragma unroll
        for (int b = 0; b < 2; ++b)
#pragma unroll
            for (int m = 0; m < 4; ++m)
#pragma unroll
                for (int n = 0; n < 2; ++n) acc[a][b][m][n] = (f32x4){0.f, 0.f, 0.f, 0.f};
    bf16x8 At[4][2], B0[2][2], B1[2][2];
#define PG8_VOFF(vA_, vB_, lda2_, ldb2_) do { int tt_ = tid; asm volatile("" : "+v"(tt_)); _Pragma("unroll") for (int i_ = 0; i_ < 2; ++i_) { int R_, C_; stage_rc(tt_ * 16 + i_ * 8192, R_, C_); \
        vA_[i_] = (unsigned)(R_ * (lda2_) + C_ * 2); vB_[i_] = (unsigned)(((R_ & ~31) + perm32(R_ & 31)) * (ldb2_) + C_ * 2); } } while (0)
    const char* cA = cur.A; const char* cB = cur.B; size_t hA = (size_t)HALF * cur.lda2, hB = (size_t)HALF * cur.ldb2;
    { unsigned vA[2], vB[2]; PG8_VOFF(vA, vB, cur.lda2, cur.ldb2);
    PG8_STAGE(PG8_SB(0, 0), cB, vB); PG8_STAGE(PG8_SB(0, 1), cB + hB, vB); PG8_STAGE(PG8_SA(0, 0), cA, vA); PG8_STAGE(PG8_SA(0, 1), cA + hA, vA);
    if (wr == 1) PG8_BAR;
    PG8_WAIT_V(2); PG8_BAR;
    PG8_STAGE(PG8_SB(1, 0), cB + kstep, vB); PG8_STAGE(PG8_SA(1, 0), cA + kstep, vA); PG8_STAGE(PG8_SB(1, 1), cB + hB + kstep, vB);
    PG8_WAIT_V(6); PG8_BAR; }
    for (;;) {
        const bool has_next = S.next(ui + 1, nxt);
        if (!has_next) nxt = cur;
        const size_t nhA = (size_t)HALF * nxt.lda2, nhB = (size_t)HALF * nxt.ldb2;
        const int nt = cur.nt;
        for (int t = 0; t < nt; t += 2) {
            const bool last = (t == nt - 2);
            const char* a1 = cA + (size_t)(t + 1) * kstep;
            const char* a2 = last ? nxt.A : cA + (size_t)(t + 2) * kstep; const char* b2 = last ? nxt.B : cB + (size_t)(t + 2) * kstep;
            const char* a3 = a2 + kstep; const char* b3 = b2 + kstep;
            unsigned wA[2], wB[2];
            const size_t whA = last ? nhA : hA, whB = last ? nhB : hB;
            PG8_LDB(B0, 0, 0); PG8_LDB(B1, 0, 1); PG8_SCHED; PG8_LDA(At, 0, 0);
            { unsigned vA[2], vB[2]; PG8_VOFF(vA, vB, cur.lda2, cur.ldb2); (void)vB; PG8_STAGE(PG8_SA(1, 1), a1 + hA, vA); }
            PG8_VOFF(wA, wB, last ? nxt.lda2 : cur.lda2, last ? nxt.ldb2 : cur.ldb2);
            PG8_WAIT_V(8); PG8_WAIT_L(0); PG8_BAR; PG8_MMA(0, 0, At, B0); PG8_MMA(0, 1, At, B1); PG8_BAR; PG8_SCHED;
            PG8_LDA(At, 0, 1); PG8_STAGE(PG8_SB(0, 0), b2, wB); PG8_STAGE(PG8_SB(0, 1), b2 + whB, wB); PG8_STAGE(PG8_SA(0, 0), a2, wA);
            PG8_WAIT_V(8); PG8_WAIT_L(0); PG8_BAR; PG8_MMA(1, 0, At, B0); PG8_MMA(1, 1, At, B1); PG8_BAR; PG8_SCHED;
            PG8_LDB(B0, 1, 0); PG8_LDB(B1, 1, 1); PG8_SCHED; PG8_LDA(At, 1, 0); PG8_STAGE(PG8_SA(0, 1), a2 + whA, wA);
            PG8_WAIT_V(8); PG8_WAIT_L(0); PG8_BAR; PG8_MMA(0, 0, At, B0); PG8_MMA(0, 1, At, B1); PG8_BAR; PG8_SCHED;
            PG8_LDA(At, 1, 1); PG8_STAGE(PG8_SB(1, 0), b3, wB); PG8_STAGE(PG8_SB(1, 1), b3 + whB, wB); PG8_STAGE(PG8_SA(1, 0), a3, wA);
            PG8_WAIT_V(8); PG8_WAIT_L(0); PG8_BAR; PG8_MMA(1, 0, At, B0); PG8_MMA(1, 1, At, B1); PG8_BAR; PG8_SCHED;
        }
        if (wr == 0) PG8_BAR;
        { int fr_ = fr, fq_ = fq; asm volatile("" : "+v"(fr_), "+v"(fq_));
          E(acc, cur, wr, wc, fr_, fq_); }
        if (!has_next) break;
#pragma unroll
        for (int a = 0; a < 2; ++a)
#pragma unroll
            for (int b = 0; b < 2; ++b)
#pragma unroll
                for (int m = 0; m < 4; ++m)
#pragma unroll
                    for (int n = 0; n < 2; ++n) acc[a][b][m][n] = (f32x4){0.f, 0.f, 0.f, 0.f};
        cur = nxt; cA = cur.A; cB = cur.B; hA = nhA; hB = nhB;
        ++ui;
        if (wr == 1) PG8_BAR;
    }
    PG8_WAIT_V(0);
    PG8_BAR;
#undef PG8_VOFF
#undef PG8_SA
#undef PG8_SB
#undef PG8_STAGE
#undef PG8_LDA
#undef PG8_LDB
#undef PG8_MMA
#undef PG8_WAIT_V
#undef PG8_WAIT_L
#undef PG8_BAR
#undef PG8_SCHED
}
}
using pg8::f32x4; using pg8::u32x4; using pg8::GUnit;

constexpr size_t WS_WB = 2 * MiB, WB_LAYER = 37 * MiB;
constexpr size_t WB_W1 = 0, WB_WG = 9 * MiB, WB_WBR = 15 * MiB, WB_WO = 18 * MiB, WB_WF1 = 20 * MiB, WB_WF2 = 31 * MiB;
constexpr size_t WS_GSCR = 190 * MiB;
static_assert(WS_WB + 2 * WB_LAYER <= WS_XB, "weights vs XB");

__device__ __forceinline__ int p1_src_col(int tile, int p) {
    if (tile < 4) return (tile >> 1) * 512 + (tile & 1) * 256 + 64 * ((p >> 5) & 3) + 32 * (p >> 7);
    if (tile < 6) return 1024 + (tile - 4) * 256 + p;
    if (tile < 10) return (p < 128) ? 1536 + 128 * (tile - 6) + p : 2048 + 128 * (tile - 6) + (p - 128);
    return 2560 + (tile - 10) * 256 + p;
}
__device__ __forceinline__ void p0_titem(const float* W, int ldw, int src0, const float* g, bf16_t* WT, int K, int prow0, int k0, float* scr, int lane) {
#pragma unroll 8
    for (int i = 0; i < 32; ++i) { const int kk = 2 * i + (lane >> 5); float v = W[(size_t)(k0 + kk) * ldw + src0 + (lane & 31)]; if (g) v *= g[k0 + kk]; scr[kk * 33 + (lane & 31)] = v; }
    asm volatile("s_waitcnt lgkmcnt(0)" ::: "memory");
    const int c = lane & 7;
#pragma unroll
    for (int j = 0; j < 4; ++j) { const int n = (lane >> 3) + 8 * j; const float* s = scr + (8 * c) * 33 + n;
        uint4 o; o.x = pk2(s[0 * 33], s[1 * 33]); o.y = pk2(s[2 * 33], s[3 * 33]); o.z = pk2(s[4 * 33], s[5 * 33]); o.w = pk2(s[6 * 33], s[7 * 33]);
        *(uint4*)(WT + (size_t)(prow0 + n) * K + k0 + 8 * c) = o; }
    asm volatile("s_waitcnt lgkmcnt(0)" ::: "memory");
}
__device__ __forceinline__ void fast_p0_weights(const Args& A, int wg, int nwg, float* sm) {
    const int tid = opaque_tid(), lane = tid & 63, wave = tid >> 6;
    float* scr = sm + wave * (64 * 33);
    constexpr int NI_W1 = 144 * 16, NI_WG = 96 * 16, NI_WBR = 3 * 32 * 8, NI_WO = 32 * 16, NI_F1 = 176 * 16, NI_F2 = 32 * 44;
    constexpr int PER_LAYER = NI_W1 + NI_WG + NI_WBR + NI_WO + NI_F1 + NI_F2;
    for (int it = wg * NWAVES + wave; it < DEPTH * PER_LAYER; it += nwg * NWAVES) {
        const int l = it / PER_LAYER; int r = it % PER_LAYER;
        unsigned char* wb = A.ws + WS_WB + (size_t)l * WB_LAYER;
        const float* Win = A.in[I_WIN] + (size_t)l * DM * DIN; const float* g1 = A.in[I_N1G] + l * DM;
        if (r < NI_W1) { const int rb = r / 16, kb = r % 16; p0_titem(Win, DIN, p1_src_col(rb >> 3, (rb & 7) * 32), g1, (bf16_t*)(wb + WB_W1), DM, 32 * rb, 64 * kb, scr, lane); continue; } r -= NI_W1;
        if (r < NI_WG) { const int rb = r / 16, kb = r % 16; p0_titem(Win, DIN, NU + 32 * rb, g1, (bf16_t*)(wb + WB_WG), DM, 32 * rb, 64 * kb, scr, lane); continue; } r -= NI_WG;
        if (r < NI_WBR) { const int n = r / 256, rr = r % 256, rb = rr / 8, kb = rr % 8;
            p0_titem(A.in[I_WBR] + ((size_t)l * 3 + n) * BW * DM, DM, 32 * rb, nullptr, (bf16_t*)(wb + WB_WBR) + (size_t)n * DM * BW, BW, 32 * rb, 64 * kb, scr, lane); continue; } r -= NI_WBR;
        if (r < NI_WO) { const int rb = r / 16, kb = r % 16; p0_titem(A.in[I_WOUT] + (size_t)l * DM * DM, DM, 32 * rb, nullptr, (bf16_t*)(wb + WB_WO), DM, 32 * rb, 64 * kb, scr, lane); continue; } r -= NI_WO;
        if (r < NI_F1) { const int rb = r / 16, kb = r % 16, tile = rb >> 3, p = (rb & 7) * 32; const int src = (p < 128) ? 128 * tile + p : DFF + 128 * tile + (p - 128);
            p0_titem(A.in[I_WF1] + (size_t)l * DM * 2 * DFF, 2 * DFF, src, A.in[I_N2G] + l * DM, (bf16_t*)(wb + WB_WF1), DM, 32 * rb, 64 * kb, scr, lane); continue; } r -= NI_F1;
        { const int rb = r / 44, kb = r % 44; p0_titem(A.in[I_WF2] + (size_t)l * DFF * DM, DM, 32 * rb, nullptr, (bf16_t*)(wb + WB_WF2), DFF, 32 * rb, 64 * kb, scr, lane); }
    }
}

struct SchedPlain {
    pg8::TileOrder o; const char* A; const char* B; int lda2, ldb2, nt;
    __device__ __forceinline__ bool next(int i, GUnit& u) const {
        int pm, pn; if (!o.tile(i, pm, pn)) return false;
        u.A = A + (size_t)pm * 256 * lda2; u.B = B + (size_t)pn * 256 * ldb2; u.lda2 = lda2; u.ldb2 = ldb2; u.nt = nt; u.pm = pm; u.pn = pn; u.kind = 0; return true;
    }
};
struct SchedP3 {
    pg8::TileOrder o; const char* ws; const char* wb;
    __device__ __forceinline__ bool next(int i, GUnit& u) const {
        int pm, pn; if (!o.tile(i / 6, pm, pn)) return false;
        const int sub = i % 6, n = sub >> 1; const bool proj = (sub & 1) != 0;
        u.pm = pm; u.pn = pn; u.kind = sub;
        const size_t aoff = !proj ? WS_XB : (n == 0 ? WS_YA : (n == 1 ? WS_YB : WS_YC));
        const int ld2 = proj ? BW * 2 : DM * 2;
        u.A = ws + aoff + (size_t)pm * 256 * ld2; u.lda2 = ld2;
        u.B = wb + (proj ? WB_WBR : WB_WG) + (size_t)(n * DM + pn * 256) * ld2; u.ldb2 = ld2; u.nt = ld2 >> 7;
        return true;
    }
};

__device__ __forceinline__ float fast_sigmoid(float x) { return __builtin_amdgcn_rcpf(1.0f + __builtin_amdgcn_exp2f(-LOG2E * x)); }
__device__ __forceinline__ f32x4 sig4(const f32x4& v) { return (f32x4){fast_sigmoid(v[0]), fast_sigmoid(v[1]), fast_sigmoid(v[2]), fast_sigmoid(v[3])}; }
__device__ __forceinline__ float dot4(const f32x4& a) { return (a[0] * a[0] + a[1] * a[1]) + (a[2] * a[2] + a[3] * a[3]); }

struct EpiP1 {
    unsigned char* ws; const float* rowss; const float* qg; const float* kg;
    __device__ __forceinline__ void operator()(const f32x4 (&acc)[2][2][4][2], const GUnit& u, int wr, int wc, int fr, int fq) const {
        const int pn = u.pn;
        if (pn < 4) {
            const bool isq = pn < 2; const float* gg = isq ? qg : kg; const float sc = isq ? QSCALE : 1.0f;
            const f32x4 ga0 = *(const f32x4*)(gg + 8 * fq), ga1 = *(const f32x4*)(gg + 8 * fq + 4), gb0 = *(const f32x4*)(gg + 32 + 8 * fq), gb1 = *(const f32x4*)(gg + 32 + 8 * fq + 4);
            bf16_t* base = (bf16_t*)(ws + (isq ? WS_AQ : WS_AK)) + (pn & 1) * 256 + 64 * wc + 8 * fq;
#pragma unroll
            for (int ai = 0; ai < 2; ++ai)
#pragma unroll
                for (int m = 0; m < 4; ++m) {
                    const int row = u.pm * 256 + ai * 128 + wr * 64 + m * 16 + fr;
                    const float rstd = rsqrtf(rowss[row] * (1.0f / DM) + RMS_EPS);
                    const f32x4 a0 = acc[ai][0][m][0] * rstd, a1 = acc[ai][0][m][1] * rstd, b0 = acc[ai][1][m][0] * rstd, b1 = acc[ai][1][m][1] * rstd;
                    float ss = (dot4(a0) + dot4(a1)) + (dot4(b0) + dot4(b1));
                    ss += __shfl_xor(ss, 16); ss += __shfl_xor(ss, 32);
                    const float rn = rsqrtf(ss * (1.0f / 64.0f) + RMS_EPS) * sc;
                    bf16_t* o = base + (size_t)row * BW;
                    *(u32x4*)o = pg8::pack8(a0 * ga0 * rn, a1 * ga1 * rn);
                    *(u32x4*)(o + 32) = pg8::pack8(b0 * gb0 * rn, b1 * gb1 * rn);
                }
        } else if (pn >= 6 && pn < 10) {
            bf16_t* base = (bf16_t*)(ws + WS_Z) + 128 * (pn - 6) + 32 * wc + 8 * fq;
#pragma unroll
            for (int ai = 0; ai < 2; ++ai)
#pragma unroll
                for (int m = 0; m < 4; ++m) {
                    const int row = u.pm * 256 + ai * 128 + wr * 64 + m * 16 + fr;
                    const float rstd = rsqrtf(rowss[row] * (1.0f / DM) + RMS_EPS);
                    const f32x4 z0 = acc[ai][0][m][0] * rstd * sig4(acc[ai][1][m][0] * rstd), z1 = acc[ai][0][m][1] * rstd * sig4(acc[ai][1][m][1] * rstd);
                    *(u32x4*)(base + (size_t)row * BW) = pg8::pack8(z0, z1);
                }
        } else {
            size_t wsoff; int kind;
            if (pn < 6) { wsoff = WS_AV; kind = 0; } else if (pn < 12) { wsoff = WS_RQ; kind = 1; } else if (pn < 14) { wsoff = WS_RK; kind = 2; } else if (pn < 16) { wsoff = WS_RV; kind = 0; } else { wsoff = WS_RG; kind = 3; }
            bf16_t* base = (bf16_t*)(ws + wsoff) + (pn & 1) * 256 + 32 * wc + 8 * fq;
            const float l2g0 = log2_gamma((pn & 1) * 2), l2g1 = log2_gamma((pn & 1) * 2 + 1);
#pragma unroll
            for (int ai = 0; ai < 2; ++ai)
#pragma unroll
                for (int m = 0; m < 4; ++m) {
                    const int row = u.pm * 256 + ai * 128 + wr * 64 + m * 16 + fr;
                    const float rstd = rsqrtf(rowss[row] * (1.0f / DM) + RMS_EPS);
                    const float tp = (float)(row & 127);
                    float f0 = rstd, f1 = rstd;
                    if (kind == 1) { f0 *= exp2f(tp * l2g0); f1 *= exp2f(tp * l2g1); }
                    if (kind == 2) { f0 *= 0.08838834764831845f * exp2f(-tp * l2g0); f1 *= 0.08838834764831845f * exp2f(-tp * l2g1); }
                    f32x4 a0 = acc[ai][0][m][0] * f0, a1 = acc[ai][0][m][1] * f0, b0 = acc[ai][1][m][0] * f1, b1 = acc[ai][1][m][1] * f1;
                    if (kind == 3) { a0 = a0 * sig4(a0); a1 = a1 * sig4(a1); b0 = b0 * sig4(b0); b1 = b1 * sig4(b1); }
                    bf16_t* o = base + (size_t)row * BW;
                    *(u32x4*)o = pg8::pack8(a0, a1);
                    *(u32x4*)(o + 128) = pg8::pack8(b0, b1);
                }
        }
    }
};
struct EpiP3 {
    const float* rowss; const float* bg; unsigned char* gscr; bf16_t* Y;
    __device__ __forceinline__ void operator()(const f32x4 (&acc)[2][2][4][2], const GUnit& u, int wr, int wc, int fr, int fq) const {
        const int n = u.kind >> 1;
        u32x4* gs = (u32x4*)gscr + ((wr * 4 + wc) * 64 + fq * 16 + fr);
        if (!(u.kind & 1)) {
            const float* bp = bg + n * DM + u.pn * 256 + 32 * wc + 8 * fq;
            const f32x4 ba0 = *(const f32x4*)bp, ba1 = *(const f32x4*)(bp + 4), bb0 = *(const f32x4*)(bp + 128), bb1 = *(const f32x4*)(bp + 132);
#pragma unroll
            for (int ai = 0; ai < 2; ++ai)
#pragma unroll
                for (int m = 0; m < 4; ++m) {
                    const int row = u.pm * 256 + ai * 128 + wr * 64 + m * 16 + fr;
                    const float rstd = rsqrtf(rowss[row] * (1.0f / DM) + RMS_EPS);
                    gs[((ai * 4 + m) * 2 + 0) * NTHREADS] = pg8::pack8(sig4(acc[ai][0][m][0] * rstd + ba0), sig4(acc[ai][0][m][1] * rstd + ba1));
                    gs[((ai * 4 + m) * 2 + 1) * NTHREADS] = pg8::pack8(sig4(acc[ai][1][m][0] * rstd + bb0), sig4(acc[ai][1][m][1] * rstd + bb1));
                }
        } else {
#pragma unroll
            for (int ai = 0; ai < 2; ++ai)
#pragma unroll
                for (int m = 0; m < 4; ++m) {
                    const int row = u.pm * 256 + ai * 128 + wr * 64 + m * 16 + fr;
#pragma unroll
                    for (int bj = 0; bj < 2; ++bj) {
                        const u32x4 g = __builtin_nontemporal_load(&gs[((ai * 4 + m) * 2 + bj) * NTHREADS]);
                        bf16_t* yp = Y + (size_t)row * DM + u.pn * 256 + 128 * bj + 32 * wc + 8 * fq;
                        f32x4 y0 = acc[ai][bj][m][0], y1 = acc[ai][bj][m][1];
                        y0[0] *= __uint_as_float(g.x << 16); y0[1] *= __uint_as_float(g.x & 0xffff0000u); y0[2] *= __uint_as_float(g.y << 16); y0[3] *= __uint_as_float(g.y & 0xffff0000u);
                        y1[0] *= __uint_as_float(g.z << 16); y1[1] *= __uint_as_float(g.z & 0xffff0000u); y1[2] *= __uint_as_float(g.w << 16); y1[3] *= __uint_as_float(g.w & 0xffff0000u);
                        if (n > 0) { const u32x4 p = __builtin_nontemporal_load((const u32x4*)yp);
                            y0[0] += __uint_as_float(p.x << 16); y0[1] += __uint_as_float(p.x & 0xffff0000u); y0[2] += __uint_as_float(p.y << 16); y0[3] += __uint_as_float(p.y & 0xffff0000u);
                            y1[0] += __uint_as_float(p.z << 16); y1[1] += __uint_as_float(p.z & 0xffff0000u); y1[2] += __uint_as_float(p.w << 16); y1[3] += __uint_as_float(p.w & 0xffff0000u); }
                        *(u32x4*)yp = pg8::pack8(y0, y1);
                    }
                    asm volatile("" ::: "memory");
                }
        }
    }
};
struct EpiResid {
    const float* xold; float* out; bf16_t* XB; float* rowss_next;
    __device__ __forceinline__ void operator()(const f32x4 (&acc)[2][2][4][2], const GUnit& u, int wr, int wc, int fr, int fq) const {
#pragma unroll
        for (int ai = 0; ai < 2; ++ai)
#pragma unroll
            for (int m = 0; m < 4; ++m) {
                const int row = u.pm * 256 + ai * 128 + wr * 64 + m * 16 + fr;
                float ss = 0.f;
#pragma unroll
                for (int bj = 0; bj < 2; ++bj) {
                    const size_t off = (size_t)row * DM + u.pn * 256 + 128 * bj + 32 * wc + 8 * fq;
                    const f32x4 x0 = *(const f32x4*)(xold + off) + acc[ai][bj][m][0], x1 = *(const f32x4*)(xold + off + 4) + acc[ai][bj][m][1];
                    *(f32x4*)(out + off) = x0; *(f32x4*)(out + off + 4) = x1;
                    *(u32x4*)(XB + off) = pg8::pack8(x0, x1);
                    ss += dot4(x0) + dot4(x1);
                }
                ss += __shfl_xor(ss, 16); ss += __shfl_xor(ss, 32);
                if (fq == 0 && rowss_next) atomicAdd(rowss_next + row, ss);
                if (m & 1) asm volatile("" ::: "memory");
            }
    }
};
struct EpiSwiglu {
    const float* rowss; bf16_t* MID;
    __device__ __forceinline__ void operator()(const f32x4 (&acc)[2][2][4][2], const GUnit& u, int wr, int wc, int fr, int fq) const {
        bf16_t* base = MID + 128 * u.pn + 32 * wc + 8 * fq;
#pragma unroll
        for (int ai = 0; ai < 2; ++ai)
#pragma unroll
            for (int m = 0; m < 4; ++m) {
                const int row = u.pm * 256 + ai * 128 + wr * 64 + m * 16 + fr;
                const float rstd = rsqrtf(rowss[row] * (1.0f / DM) + RMS_EPS);
                const f32x4 g0 = acc[ai][0][m][0] * rstd, g1 = acc[ai][0][m][1] * rstd, u0 = acc[ai][1][m][0] * rstd, u1 = acc[ai][1][m][1] * rstd;
                *(u32x4*)(base + (size_t)row * DFF) = pg8::pack8(g0 * sig4(g0) * u0, g1 * sig4(g1) * u1);
            }
    }
};

__device__ __forceinline__ void fast_gemm(const Args& A, int l, int k, LAS unsigned char* lds) {
    const int G = gridDim.x, c = blockIdx.x;
    const char* wb = (const char*)(A.ws + WS_WB + (size_t)l * WB_LAYER);
    const char* XB = (const char*)(A.ws + WS_XB);
    float* rowss = (float*)(A.ws + WS_ROWSS);
    if (k == 0) {
        SchedPlain S; S.o.init(M / 256, NU / 256, G, c); S.A = XB; S.lda2 = DM * 2; S.B = wb + WB_W1; S.ldb2 = DM * 2; S.nt = DM / 64;
        EpiP1 E{A.ws, rowss + (size_t)(l == 0 ? 0 : 2) * M, A.in[I_QG] + l * 64, A.in[I_KG] + l * 64};
        pg8::gemm_phase(lds, S, E);
    } else if (k == 2) {
        SchedP3 S; S.o.init(M / 256, DM / 256, G, c); S.ws = (const char*)A.ws; S.wb = wb;
        EpiP3 E{rowss + (size_t)(l == 0 ? 0 : 2) * M, A.in[I_BGATE] + l * NGATE, A.ws + WS_GSCR + (size_t)blockIdx.x * (128 * 1024), (bf16_t*)(A.ws + WS_Y)};
        pg8::gemm_phase(lds, S, E);
    } else if (k == 3) {
        SchedPlain S; S.o.init(M / 256, DM / 256, G, c); S.A = (const char*)(A.ws + WS_Y); S.lda2 = DM * 2; S.B = wb + WB_WO; S.ldb2 = DM * 2; S.nt = DM / 64;
        EpiResid E{l == 0 ? A.in[I_X] : A.out, A.out, (bf16_t*)(A.ws + WS_XB), rowss + (size_t)(l == 0 ? 1 : 3) * M};
        pg8::gemm_phase(lds, S, E);
    } else if (k == 4) {
        SchedPlain S; S.o.init(M / 256, 2 * DFF / 256, G, c); S.A = XB; S.lda2 = DM * 2; S.B = wb + WB_WF1; S.ldb2 = DM * 2; S.nt = DM / 64;
        EpiSwiglu E{rowss + (size_t)(l == 0 ? 1 : 3) * M, (bf16_t*)(A.ws + WS_MID)};
        pg8::gemm_phase(lds, S, E);
    } else {
        SchedPlain S; S.o.init(M / 256, DM / 256, G, c); S.A = (const char*)(A.ws + WS_MID); S.lda2 = DFF * 2; S.B = wb + WB_WF2; S.ldb2 = DFF * 2; S.nt = DFF / 64;
        EpiResid E{A.out, A.out, (bf16_t*)(A.ws + WS_XB), l + 1 < DEPTH ? rowss + (size_t)2 * M : nullptr};
        pg8::gemm_phase(lds, S, E);
    }
}

constexpr int N_PHASES = 1 + 6 * DEPTH;
constexpr int RING_BYTES = 131072, MISC_OFF = RING_BYTES + 320, LDS_BYTES = 147456;
#ifndef FAST_GEMM
#define FAST_GEMM 1
#endif
#ifndef FAST_MASK
#define FAST_MASK 0x3f
#endif
__global__ void __launch_bounds__(NTHREADS, 2) fwd_kernel(Args A) {
    extern __shared__ __attribute__((aligned(16))) unsigned char lds[];
    float* sm = (float*)lds;
    LAS unsigned char* ldsl = (LAS unsigned char*)lds;
    volatile LAS unsigned* MISC = (volatile LAS unsigned*)(ldsl + MISC_OFF);
    const int wg = blockIdx.x, nwg = gridDim.x;
    const bool multi = (A.ph_hi - A.ph_lo) > 1;
    XcdBarrier bar; bar.bar = nullptr; bar.x = 0; bar.st = nullptr;
    if (multi) {
        if (threadIdx.x < 2) MISC[threadIdx.x] = 0u;
        __syncthreads();
        bar = xcd_barrier_post((unsigned*)(A.ws + WS_CTL) + CW_BAR, MISC);
    }
    const Args& A0 = A;
    for (int ph = A0.ph_lo; ph < A0.ph_hi; ++ph) {
        Args A = A0;
#pragma unroll
        for (int i = 0; i < N_IN; ++i) asm volatile("" : "+s"(A.in[i]));
        asm volatile("" : "+s"(A.out), "+s"(A.ws));
        if (ph == 0) { nv_p0(A, wg, nwg); if (FAST_GEMM) fast_p0_weights(A, wg, nwg, sm); }
        else {
            const int l = (ph - 1) / 6, k = (ph - 1) % 6;
            if (k == 1) { nv_attn(A, l, wg, nwg, sm); nv_conv(A, l, wg, nwg); nv_ret(A, l, wg, nwg, sm); }
            else if (FAST_GEMM && ((FAST_MASK >> k) & 1)) fast_gemm(A, l, k, ldsl);
            else if (k == 0) nv_p1(A, l, wg, nwg, sm);
            else if (k == 2) nv_p3(A, l, wg, nwg, sm);
            else if (k == 3) nv_resid_gemm(A, (const bf16_t*)(A.ws + WS_Y), DM, DM, A.in[I_WOUT] + (size_t)l * DM * DM, l == 0 ? A.in[I_X] : A.out,
                                           (float*)(A.ws + WS_ROWSS) + (size_t)(l == 0 ? 1 : 3) * M, wg, nwg, sm);
            else if (k == 4) nv_p5(A, l, wg, nwg, sm);
            else nv_resid_gemm(A, (const bf16_t*)(A.ws + WS_MID), DFF, DFF, A.in[I_WF2] + (size_t)l * DFF * DM, A.out,
                               l + 1 < DEPTH ? (float*)(A.ws + WS_ROWSS) + (size_t)2 * M : nullptr, wg, nwg, sm);
        }
        if (ph + 1 < A0.ph_hi) xcd_barrier(bar);
    }
}

extern "C" void kernel_launch(void* const* d_in, const int* in_sizes, int n_in, void* d_out, int out_size, void* d_ws, size_t ws_size, hipStream_t stream) {
    static int grid = 0;
    if (grid == 0) {
        if (n_in != N_IN || out_size != M * DM || ws_size < WS_END) { fprintf(stderr, "kernel_launch: unexpected shapes (n_in %d out %d ws %zu)\n", n_in, out_size, ws_size); grid = -1; return; }
        int dev = 0, cus = 0, per_cu = 0;
        (void)hipGetDevice(&dev); (void)hipDeviceGetAttribute(&cus, hipDeviceAttributeMultiprocessorCount, dev);
        (void)hipFuncSetAttribute((const void*)fwd_kernel, hipFuncAttributeMaxDynamicSharedMemorySize, LDS_BYTES);
        (void)hipOccupancyMaxActiveBlocksPerMultiprocessor(&per_cu, (const void*)fwd_kernel, NTHREADS, LDS_BYTES);
        (void)hipGetLastError();
        if (per_cu < 1) fprintf(stderr, "kernel_launch: occupancy query says %d blocks per CU\n", per_cu);
        grid = cus;
    }
    if (grid < 0) return;
    (void)hipMemsetAsync((char*)d_ws + WS_CTL, 0, CTL_ZERO_BYTES, stream);
    Args a{};
    for (int i = 0; i < N_IN; ++i) a.in[i] = (const float*)d_in[i];
    a.out = (float*)d_out; a.ws = (unsigned char*)d_ws;
    a.ph_lo = 0; a.ph_hi = N_PHASES;
    void* args[] = {&a};
    hipError_t e = hipLaunchCooperativeKernel((const void*)fwd_kernel, dim3(grid), dim3(NTHREADS), args, LDS_BYTES, stream);
    if (e != hipSuccess) fprintf(stderr, "cooperative launch failed: %s (grid %d)\n", hipGetErrorString(e), grid);
}
```

```cpp
#include <hip/hip_runtime.h>
#include <cstdio>
#include <cstdint>

#define GAS __attribute__((address_space(1)))
#define LAS __attribute__((address_space(3)))
typedef unsigned short bf16_t;
typedef GAS unsigned gu32;
#define RLX_AGENT __ATOMIC_RELAXED, __HIP_MEMORY_SCOPE_AGENT

constexpr int BATCH = 4, SEQ = 4096, DM = 1024, M = BATCH * SEQ, DEPTH = 2;
constexpr int DIN = 7680, NU = 4608, NGATE = 3072, DFF = 2816, BW = 512;
constexpr float RMS_EPS = 1e-6f, LN_EPS = 1e-5f;
constexpr float LOG2E = 1.4426950408889634f;
constexpr float QSCALE = 0.125f * LOG2E;
constexpr int NTHREADS = 512, NWAVES = 8;

enum { I_X = 0, I_N1G, I_WIN, I_QG, I_KG, I_DLAM, I_ASG, I_CW, I_CB, I_CLG, I_CLB, I_RGN, I_BGATE, I_WBR, I_WOUT, I_N2G, I_WF1, I_WF2, N_IN };

constexpr size_t MiB = 1u << 20;
constexpr size_t WS_CTL = 0, CTL_ZERO_BYTES = 1 * MiB;
constexpr size_t WS_ROWSS = 256 * 1024;
constexpr size_t WS_LAM = 512 * 1024;
constexpr size_t WS_XB = 78 * MiB;
constexpr size_t WS_AQ = 110 * MiB, WS_AK = 126 * MiB, WS_AV = 142 * MiB, WS_Z = 158 * MiB, WS_RQ = 174 * MiB, WS_RK = 190 * MiB, WS_RV = 206 * MiB, WS_RG = 222 * MiB, WS_YB = 238 * MiB;
constexpr size_t WS_YA = WS_AQ, WS_YC = WS_RQ;
constexpr size_t WS_Y = 126 * MiB;
constexpr size_t WS_MID = 110 * MiB;
constexpr size_t WS_END = 256 * MiB;
constexpr int CW_BAR = 4096;

struct Args { const float* in[N_IN]; float* out; unsigned char* ws; int ph_lo, ph_hi; };

__device__ __forceinline__ float bf2f(unsigned v) { return __uint_as_float(v << 16); }
__device__ __forceinline__ unsigned f2bf(float f) { unsigned u = __float_as_uint(f); return (u + 0x7fffu + ((u >> 16) & 1u)) >> 16; }
__device__ __forceinline__ unsigned pk2(float lo, float hi) { return f2bf(lo) | (f2bf(hi) << 16); }
__device__ __forceinline__ float wave_sum(float v) {
#pragma unroll
    for (int o = 1; o < 64; o <<= 1) v += __shfl_xor(v, o);
    return v;
}
__device__ __forceinline__ float wave_max(float v) {
#pragma unroll
    for (int o = 1; o < 64; o <<= 1) v = fmaxf(v, __shfl_xor(v, o));
    return v;
}
__device__ __forceinline__ int opaque_tid() { int t = threadIdx.x; asm volatile("" : "+v"(t)); return t; }
__device__ __forceinline__ float sigmoidf_(float x) { return 1.0f / (1.0f + __expf(-x)); }
__device__ __forceinline__ float siluf_(float x) { return x / (1.0f + __expf(-x)); }
__device__ __forceinline__ float lam_init_of(int l) { return l == 0 ? 0.2f : (0.8f - 0.6f * 0.74081822068171788f); }
__device__ __forceinline__ float log2_gamma(int h) { return log2f(1.0f - exp2f(-5.0f - (float)h)); }

#define XB_TMO      128
#define XB_XCNT(j)  (256  + 64 * (j))
#define XB_XSUB(j)  (1280 + 64 * (j))
#define XB_XGEN(j)  (2304 + 64 * (j))
#define XB_TOP      3328
#define XB_TOPGEN   3392
#define XCD_BAR_WORDS 3456
#define XB_SPIN_CAP (1u << 22)
__device__ __forceinline__ unsigned xb_ld(unsigned* p)              { return __hip_atomic_load(p, __ATOMIC_RELAXED, __HIP_MEMORY_SCOPE_AGENT); }
__device__ __forceinline__ unsigned xb_add(unsigned* p, unsigned v) { return __hip_atomic_fetch_add(p, v, __ATOMIC_RELAXED, __HIP_MEMORY_SCOPE_AGENT); }
__device__ __forceinline__ unsigned xb_xcc_id() { return (unsigned)__builtin_amdgcn_s_getreg((3 << 11) | 20) & 0xFu; }
#define XB_SPIN(cond, bar) do { unsigned _sp = 0; while (cond) { __builtin_amdgcn_s_sleep(1); \
    if ((++_sp & 255u) == 0u) { if (xb_ld(&(bar)[XB_TMO])) break; if (_sp > XB_SPIN_CAP) { atomicAdd(&(bar)[XB_TMO], 1u); break; } } } } while (0)
struct XcdBarrier { unsigned* bar; unsigned x; volatile LAS unsigned* st; };
__device__ __forceinline__ XcdBarrier xcd_barrier_post(unsigned* bar, volatile LAS unsigned* st) {
    XcdBarrier b; b.bar = bar; b.x = xb_xcc_id(); b.st = st;
    if (threadIdx.x == 0) (void)xb_add(&bar[XB_XCNT(b.x)], 1u);
    return b;
}
__device__ __forceinline__ void xcd_barrier_complete(unsigned* bar, unsigned x, unsigned& nloc, unsigned& nx) {
    const unsigned G = gridDim.x * gridDim.y * gridDim.z;
    unsigned sum, cnt, mine, sp = 0u;
    for (;;) {
        sum = 0u; cnt = 0u; mine = 0u;
#pragma unroll
        for (unsigned j = 0; j < 16; ++j) { const unsigned c = xb_ld(&bar[XB_XCNT(j)]); sum += c; cnt += (c > 0u) ? 1u : 0u; mine = (j == x) ? c : mine; }
        if (sum == G) break;
        __builtin_amdgcn_s_sleep(1);
        if ((++sp & 255u) == 0u) { if (xb_ld(&bar[XB_TMO])) break; if (sp > XB_SPIN_CAP) { atomicAdd(&bar[XB_TMO], 1u); break; } }
    }
    nloc = mine > 0u ? mine : 1u; nx = cnt > 0u ? cnt : 1u;
}
__device__ __forceinline__ void xcd_barrier(const XcdBarrier& b) {
    asm volatile("s_waitcnt vmcnt(0)" ::: "memory");
    __syncthreads();
    if (threadIdx.x == 0) {
        unsigned* bar = b.bar;
        __builtin_amdgcn_s_waitcnt(0);
        unsigned nloc = b.st[0], nx = b.st[1];
        if (nloc == 0u) { xcd_barrier_complete(bar, b.x, nloc, nx); b.st[0] = nloc; b.st[1] = nx; }
        const unsigned old = xb_add(&bar[XB_XSUB(b.x)], 1u);
        const unsigned gen = old / nloc;
        if (old + 1u == (gen + 1u) * nloc) {
            __builtin_amdgcn_fence(__ATOMIC_RELEASE, "agent");
            asm volatile("s_waitcnt vmcnt(0)" ::: "memory");
            const unsigned og = xb_add(&bar[XB_TOP], 1u);
            const unsigned tg = og / nx;
            if (og + 1u == (tg + 1u) * nx) xb_add(&bar[XB_TOPGEN], 1u);
            else XB_SPIN(xb_ld(&bar[XB_TOPGEN]) == tg, bar);
            __builtin_amdgcn_fence(__ATOMIC_ACQUIRE, "agent");
            xb_add(&bar[XB_XGEN(b.x)], 1u);
            asm volatile("s_waitcnt vmcnt(0)" ::: "memory");
        } else {
            XB_SPIN(xb_ld(&bar[XB_XGEN(b.x)]) == gen, bar);
            __builtin_amdgcn_fence(__ATOMIC_ACQUIRE, "agent");
            asm volatile("s_waitcnt vmcnt(0)" ::: "memory");
        }
    }
    __syncthreads();
}


__device__ __forceinline__ void nv_p0(const Args& A, int wg, int nwg) {
    const int tid = opaque_tid(), lane = tid & 63, wave = tid >> 6;
    const float* x = A.in[I_X];
    bf16_t* XB = (bf16_t*)(A.ws + WS_XB);
    float* rowss = (float*)(A.ws + WS_ROWSS);
    for (int m = wg * NWAVES + wave; m < M; m += nwg * NWAVES) {
        const float4* xr = (const float4*)(x + (size_t)m * DM) + lane;
        uint2* o = (uint2*)(XB + (size_t)m * DM) + lane;
        float s = 0.f;
#pragma unroll
        for (int j = 0; j < 4; ++j) { const float4 v = xr[64 * j]; s += v.x * v.x + v.y * v.y + v.z * v.z + v.w * v.w; o[64 * j] = make_uint2(pk2(v.x, v.y), pk2(v.z, v.w)); }
        s = wave_sum(s);
        if (lane == 0) rowss[m] = s;
    }
    if (wg == 0 && wave < DEPTH) {
        const float* dl = A.in[I_DLAM] + wave * 4 * 64;
        float a = dl[lane] * dl[64 + lane], b = dl[128 + lane] * dl[192 + lane];
        a = wave_sum(a); b = wave_sum(b);
        if (lane == 0) ((float*)(A.ws + WS_LAM))[wave] = __expf(a) - __expf(b) + lam_init_of(wave);
    }
}

template <class AL, class WL>
__device__ __forceinline__ void nv_core(float (&acc)[4][4], int K, const AL& aload, const WL& wload, float* sA, float* sB, int tid) {
    const int tx = tid & 15, ty = tid >> 4;
#pragma unroll
    for (int i = 0; i < 4; ++i)
#pragma unroll
        for (int j = 0; j < 4; ++j) acc[i][j] = 0.f;
    const int ar = tid & 127, akq = tid >> 7;
    const int wk = tid >> 5, wc = (tid & 31) * 2;
#pragma unroll 1
    for (int k0 = 0; k0 < K; k0 += 16) {
        float a0, a1, a2, a3; aload(ar, k0 + 4 * akq, a0, a1, a2, a3);
        const float w0 = wload(k0 + wk, wc), w1 = wload(k0 + wk, wc + 1);
        __syncthreads();
        sA[(4 * akq + 0) * 128 + ar] = a0; sA[(4 * akq + 1) * 128 + ar] = a1; sA[(4 * akq + 2) * 128 + ar] = a2; sA[(4 * akq + 3) * 128 + ar] = a3;
        sB[wk * 64 + wc] = w0; sB[wk * 64 + wc + 1] = w1;
        __syncthreads();
#pragma unroll 2
        for (int kk = 0; kk < 16; ++kk) {
            const float4 a = *(const float4*)&sA[kk * 128 + ty * 4];
            const float4 b = *(const float4*)&sB[kk * 64 + tx * 4];
            const float av[4] = {a.x, a.y, a.z, a.w}, bv[4] = {b.x, b.y, b.z, b.w};
#pragma unroll
            for (int i = 0; i < 4; ++i)
#pragma unroll
                for (int j = 0; j < 4; ++j) acc[i][j] += av[i] * bv[j];
        }
    }
    __syncthreads();
}
struct ALbf {
    const bf16_t* A; int lda; int row0;
    __device__ __forceinline__ void operator()(int r, int k, float& a0, float& a1, float& a2, float& a3) const {
        const uint2 v = *(const uint2*)(A + (size_t)(row0 + r) * lda + k);
        a0 = __uint_as_float(v.x << 16); a1 = __uint_as_float(v.x & 0xffff0000u); a2 = __uint_as_float(v.y << 16); a3 = __uint_as_float(v.y & 0xffff0000u);
    }
};
struct WLf32 {
    const float* W; int ldw; int c0, c1; const float* g;
    __device__ __forceinline__ float operator()(int k, int j) const {
        const float w = W[(size_t)k * ldw + (j < 32 ? c0 + j : c1 + j - 32)];
        return g ? w * g[k] : w;
    }
};

__device__ __forceinline__ void nv_p1(const Args& A, int l, int wg, int nwg, float* sm) {
    float* sA = sm; float* sB = sm + 16 * 128; float* sC = sB + 16 * 64;
    const int tid = opaque_tid(), tx = tid & 15, ty = tid >> 4;
    const float* Win = A.in[I_WIN] + (size_t)l * DM * DIN;
    const float* g1 = A.in[I_N1G] + l * DM;
    const bf16_t* XB = (const bf16_t*)(A.ws + WS_XB);
    const float* rowss = (const float*)(A.ws + WS_ROWSS) + (size_t)(l == 0 ? 0 : 2) * M;
    const float* qg = A.in[I_QG] + l * 64; const float* kg = A.in[I_KG] + l * 64;
    for (int it = wg; it < 128 * 72; it += nwg) {
        const int rt = it / 72, cg = it % 72, row0 = rt * 128;
        int c0 = 64 * cg, c1 = 64 * cg + 32;
        if (cg >= 24 && cg < 40) { c0 = 1536 + 32 * (cg - 24); c1 = 2048 + 32 * (cg - 24); }
        float acc[4][4];
        nv_core(acc, DM, ALbf{XB, DM, row0}, WLf32{Win, DIN, c0, c1, g1}, sA, sB, tid);
#pragma unroll
        for (int i = 0; i < 4; ++i) {
            const int r = ty * 4 + i; const float rstd = rsqrtf(rowss[row0 + r] * (1.0f / DM) + RMS_EPS);
#pragma unroll
            for (int j = 0; j < 4; ++j) sC[r * 65 + tx * 4 + j] = acc[i][j] * rstd;
        }
        __syncthreads();
        const int r = tid >> 2, q4 = tid & 3, m = row0 + r, t = m & (SEQ - 1);
        const float* cr = sC + r * 65;
        if (cg < 16) {
            float ss = 0.f;
#pragma unroll
            for (int j = 0; j < 16; ++j) { const float v = cr[q4 * 16 + j]; ss += v * v; }
            ss += __shfl_xor(ss, 1); ss += __shfl_xor(ss, 2);
            const float rn = rsqrtf(ss * (1.0f / 64.0f) + RMS_EPS);
            const bool isq = cg < 8; const float* gg = isq ? qg : kg; const float sc = isq ? QSCALE : 1.0f;
            bf16_t* o = (bf16_t*)(A.ws + (isq ? WS_AQ : WS_AK)) + (size_t)m * BW + (cg & 7) * 64 + q4 * 16;
#pragma unroll
            for (int j = 0; j < 16; ++j) o[j] = (bf16_t)f2bf(cr[q4 * 16 + j] * rn * gg[q4 * 16 + j] * sc);
        } else if (cg >= 24 && cg < 40) {
            bf16_t* o = (bf16_t*)(A.ws + WS_Z) + (size_t)m * BW + (cg - 24) * 32 + q4 * 8;
#pragma unroll
            for (int j = 0; j < 8; ++j) o[j] = (bf16_t)f2bf(cr[q4 * 8 + j] * sigmoidf_(cr[32 + q4 * 8 + j]));
        } else {
            size_t base; int cb; int kind;
            if (cg < 24)      { base = WS_AV; cb = cg - 16; kind = 0; }
            else if (cg < 48) { base = WS_RQ; cb = cg - 40; kind = 1; }
            else if (cg < 56) { base = WS_RK; cb = cg - 48; kind = 2; }
            else if (cg < 64) { base = WS_RV; cb = cg - 56; kind = 0; }
            else              { base = WS_RG; cb = cg - 64; kind = 3; }
            const int h = cb >> 1; const float l2g = log2_gamma(h); const float tp = (float)(t & 127);
            float f = 1.0f;
            if (kind == 1) f = exp2f(tp * l2g);
            if (kind == 2) f = 0.08838834764831845f * exp2f(-tp * l2g);
            bf16_t* o = (bf16_t*)(A.ws + base) + (size_t)m * BW + cb * 64 + q4 * 16;
#pragma unroll
            for (int j = 0; j < 16; ++j) { float v = cr[q4 * 16 + j]; v = (kind == 3) ? siluf_(v) : v * f; o[j] = (bf16_t)f2bf(v); }
        }
        __syncthreads();
    }
}

__device__ __forceinline__ void nv_attn(const Args& A, int l, int wg, int nwg, float* sm) {
    const int tid = opaque_tid(), lane = tid & 63, wave = tid >> 6;
    float* sq = sm + wave * 256;
    const bf16_t* AQ = (const bf16_t*)(A.ws + WS_AQ); const bf16_t* AK = (const bf16_t*)(A.ws + WS_AK); const bf16_t* AV = (const bf16_t*)(A.ws + WS_AV);
    bf16_t* YA = (bf16_t*)(A.ws + WS_YA);
    const float lam = ((const float*)(A.ws + WS_LAM))[l];
    const float* asg = A.in[I_ASG] + l * 128;
    const float osc = 1.0f - lam_init_of(l);
    for (int it = wg * NWAVES + wave; it < BATCH * 4 * SEQ; it += nwg * NWAVES) {
        const int t = it & (SEQ - 1), h = (it >> 12) & 3, b = it >> 14;
        const size_t mq = (size_t)b * SEQ + t;
        const float slope2 = exp2f(-2.0f * (float)(h + 1)) * LOG2E;
        sq[lane] = bf2f(AQ[mq * BW + h * 128 + lane]); sq[64 + lane] = bf2f(AQ[mq * BW + h * 128 + 64 + lane]);
        float m1 = -INFINITY, m2 = -INFINITY, l1 = 0.f, l2 = 0.f, o1a = 0.f, o1b = 0.f, o2a = 0.f, o2b = 0.f;
        for (int s0 = 0; s0 <= t; s0 += 64) {
            const int s = s0 + lane; const bool valid = s <= t;
            float d1 = 0.f, d2 = 0.f;
            if (valid) {
                const uint4* kr = (const uint4*)(AK + ((size_t)b * SEQ + s) * BW + h * 128);
#pragma unroll 2
                for (int c = 0; c < 8; ++c) {
                    const uint4 v = kr[c]; const unsigned w[4] = {v.x, v.y, v.z, v.w};
#pragma unroll
                    for (int e = 0; e < 4; ++e) { d1 += sq[c * 8 + 2 * e] * __uint_as_float(w[e] << 16) + sq[c * 8 + 2 * e + 1] * __uint_as_float(w[e] & 0xffff0000u); }
                }
#pragma unroll 2
                for (int c = 0; c < 8; ++c) {
                    const uint4 v = kr[8 + c]; const unsigned w[4] = {v.x, v.y, v.z, v.w};
#pragma unroll
                    for (int e = 0; e < 4; ++e) { d2 += sq[64 + c * 8 + 2 * e] * __uint_as_float(w[e] << 16) + sq[64 + c * 8 + 2 * e + 1] * __uint_as_float(w[e] & 0xffff0000u); }
                }
            }
            const float bias = slope2 * (float)(s - t);
            const float s1 = valid ? d1 + bias : -INFINITY, s2 = valid ? d2 + bias : -INFINITY;
            const float n1 = fmaxf(m1, wave_max(s1)), n2 = fmaxf(m2, wave_max(s2));
            const float a1 = exp2f(m1 - n1), a2 = exp2f(m2 - n2);
            const float p1 = exp2f(s1 - n1), p2 = exp2f(s2 - n2);
            l1 = l1 * a1 + wave_sum(p1); l2 = l2 * a2 + wave_sum(p2);
            o1a *= a1; o1b *= a1; o2a *= a2; o2b *= a2; m1 = n1; m2 = n2;
            sq[128 + lane] = p1; sq[192 + lane] = p2;
            const int nk = min(64, t - s0 + 1);
            const unsigned* vr = (const unsigned*)(AV + ((size_t)b * SEQ + s0) * BW + h * 128) + lane;
            for (int j = 0; j < nk; ++j) {
                const unsigned v = vr[(size_t)j * (BW / 2)];
                const float va = __uint_as_float(v << 16), vb = __uint_as_float(v & 0xffff0000u);
                const float q1 = sq[128 + j], q2 = sq[192 + j];
                o1a += q1 * va; o1b += q1 * vb; o2a += q2 * va; o2b += q2 * vb;
            }
        }
        const float i1 = 1.0f / l1, i2 = lam / l2;
        const float ya = o1a * i1 - o2a * i2, yb = o1b * i1 - o2b * i2;
        const float ss = wave_sum(ya * ya + yb * yb);
        const float rn = rsqrtf(ss * (1.0f / 128.0f) + RMS_EPS) * osc;
        ((unsigned*)(YA + mq * BW + h * 128))[lane] = pk2(ya * rn * asg[2 * lane], yb * rn * asg[2 * lane + 1]);
    }
}

__device__ __forceinline__ void nv_conv(const Args& A, int l, int wg, int nwg) {
    const int tid = opaque_tid(), lane = tid & 63, wave = tid >> 6;
    const bf16_t* Z = (const bf16_t*)(A.ws + WS_Z); bf16_t* YB = (bf16_t*)(A.ws + WS_YB);
    const float* cw = A.in[I_CW] + (size_t)l * 31 * BW; const float* cb = A.in[I_CB] + l * BW;
    const float* lg = A.in[I_CLG] + l * BW; const float* lb = A.in[I_CLB] + l * BW;
    const int c0 = lane * 8;
    for (int m = wg * NWAVES + wave; m < M; m += nwg * NWAVES) {
        const int t = m & (SEQ - 1);
        float acc[8];
#pragma unroll
        for (int e = 0; e < 8; ++e) acc[e] = cb[c0 + e];
        const int j0 = max(0, 30 - t);
        for (int j = j0; j < 31; ++j) {
            const uint4 v = *(const uint4*)(Z + (size_t)(m - 30 + j) * BW + c0);
            const float4 wa = *(const float4*)(cw + j * BW + c0), wb = *(const float4*)(cw + j * BW + c0 + 4);
            acc[0] += wa.x * __uint_as_float(v.x << 16); acc[1] += wa.y * __uint_as_float(v.x & 0xffff0000u);
            acc[2] += wa.z * __uint_as_float(v.y << 16); acc[3] += wa.w * __uint_as_float(v.y & 0xffff0000u);
            acc[4] += wb.x * __uint_as_float(v.z << 16); acc[5] += wb.y * __uint_as_float(v.z & 0xffff0000u);
            acc[6] += wb.z * __uint_as_float(v.w << 16); acc[7] += wb.w * __uint_as_float(v.w & 0xffff0000u);
        }
        float s = 0.f;
#pragma unroll
        for (int e = 0; e < 8; ++e) s += acc[e];
        const float mu = wave_sum(s) * (1.0f / BW);
        float q = 0.f;
#pragma unroll
        for (int e = 0; e < 8; ++e) { acc[e] -= mu; q += acc[e] * acc[e]; }
        const float rstd = rsqrtf(wave_sum(q) * (1.0f / BW) + LN_EPS);
        float o[8];
#pragma unroll
        for (int e = 0; e < 8; ++e) o[e] = siluf_(acc[e] * rstd * lg[c0 + e] + lb[c0 + e]);
        *(uint4*)(YB + (size_t)m * BW + c0) = make_uint4(pk2(o[0], o[1]), pk2(o[2], o[3]), pk2(o[4], o[5]), pk2(o[6], o[7]));
    }
}

__device__ __forceinline__ void nv_ret(const Args& A, int l, int wg, int nwg, float* sm) {
    const int tid = opaque_tid(), lane = tid & 63, wave = tid >> 6;
    float* sq = sm + wave * 256;
    const bf16_t* RQ = (const bf16_t*)(A.ws + WS_RQ); const bf16_t* RK = (const bf16_t*)(A.ws + WS_RK); const bf16_t* RV = (const bf16_t*)(A.ws + WS_RV);
    const bf16_t* RG = (const bf16_t*)(A.ws + WS_RG); bf16_t* YC = (bf16_t*)(A.ws + WS_YC);
    const float* gn = A.in[I_RGN] + l * 128;
    for (int it = wg * NWAVES + wave; it < BATCH * 4 * SEQ; it += nwg * NWAVES) {
        const int t = it & (SEQ - 1), h = (it >> 12) & 3, b = it >> 14;
        const size_t mq = (size_t)b * SEQ + t;
        const float l2g128 = 128.0f * log2_gamma(h);
        { const unsigned v = ((const unsigned*)(RQ + mq * BW + h * 128))[lane]; sq[2 * lane] = __uint_as_float(v << 16); sq[2 * lane + 1] = __uint_as_float(v & 0xffff0000u); }
        float oa = 0.f, ob = 0.f;
        const int ct = t >> 7;
        for (int s0 = 0; s0 <= t; s0 += 64) {
            const int s = s0 + lane; const bool valid = s <= t;
            float d = 0.f;
            if (valid) {
                const uint4* kr = (const uint4*)(RK + ((size_t)b * SEQ + s) * BW + h * 128);
#pragma unroll 2
                for (int c = 0; c < 16; ++c) {
                    const uint4 v = kr[c]; const unsigned w[4] = {v.x, v.y, v.z, v.w};
#pragma unroll
                    for (int e = 0; e < 4; ++e) { d += sq[c * 8 + 2 * e] * __uint_as_float(w[e] << 16) + sq[c * 8 + 2 * e + 1] * __uint_as_float(w[e] & 0xffff0000u); }
                }
                d *= exp2f(l2g128 * (float)(ct - (s >> 7)));
            }
            sq[128 + lane] = d;
            const int nk = min(64, t - s0 + 1);
            const unsigned* vr = (const unsigned*)(RV + ((size_t)b * SEQ + s0) * BW + h * 128) + lane;
            for (int j = 0; j < nk; ++j) {
                const unsigned v = vr[(size_t)j * (BW / 2)];
                const float a = sq[128 + j];
                oa += a * __uint_as_float(v << 16); ob += a * __uint_as_float(v & 0xffff0000u);
            }
        }
        const float ss = wave_sum(oa * oa + ob * ob);
        const float rn = rsqrtf(ss * (1.0f / 128.0f) + RMS_EPS);
        const unsigned gv = ((const unsigned*)(RG + mq * BW + h * 128))[lane];
        ((unsigned*)(YC + mq * BW + h * 128))[lane] = pk2(oa * rn * gn[2 * lane] * __uint_as_float(gv << 16), ob * rn * gn[2 * lane + 1] * __uint_as_float(gv & 0xffff0000u));
    }
}

__device__ __forceinline__ void nv_p3(const Args& A, int l, int wg, int nwg, float* sm) {
    float* sA = sm; float* sB = sm + 16 * 128;
    const int tid = opaque_tid(), tx = tid & 15, ty = tid >> 4;
    const float* Win = A.in[I_WIN] + (size_t)l * DM * DIN;
    const float* g1 = A.in[I_N1G] + l * DM;
    const float* bg = A.in[I_BGATE] + l * NGATE;
    const float* Wbr = A.in[I_WBR] + (size_t)l * 3 * BW * DM;
    const bf16_t* XB = (const bf16_t*)(A.ws + WS_XB);
    const float* rowss = (const float*)(A.ws + WS_ROWSS) + (size_t)(l == 0 ? 0 : 2) * M;
    bf16_t* Y = (bf16_t*)(A.ws + WS_Y);
    for (int it = wg; it < 128 * 16; it += nwg) {
        const int rt = it / 16, cg = it % 16, row0 = rt * 128;
        float y[4][4];
#pragma unroll
        for (int i = 0; i < 4; ++i)
#pragma unroll
            for (int j = 0; j < 4; ++j) y[i][j] = 0.f;
#pragma unroll 1
        for (int n = 0; n < 3; ++n) {
            float ga[4][4], pa[4][4];
            nv_core(ga, DM, ALbf{XB, DM, row0}, WLf32{Win, DIN, NU + n * DM + 64 * cg, NU + n * DM + 64 * cg + 32, g1}, sA, sB, tid);
            const bf16_t* br = (const bf16_t*)(A.ws + (n == 0 ? WS_YA : n == 1 ? WS_YB : WS_YC));
            nv_core(pa, BW, ALbf{br, BW, row0}, WLf32{Wbr + (size_t)n * BW * DM, DM, 64 * cg, 64 * cg + 32, nullptr}, sA, sB, tid);
#pragma unroll
            for (int i = 0; i < 4; ++i) {
                const float rstd = rsqrtf(rowss[row0 + ty * 4 + i] * (1.0f / DM) + RMS_EPS);
#pragma unroll
                for (int j = 0; j < 4; ++j) y[i][j] += sigmoidf_(ga[i][j] * rstd + bg[n * DM + 64 * cg + tx * 4 + j]) * pa[i][j];
            }
        }
#pragma unroll
        for (int i = 0; i < 4; ++i)
            *(uint2*)(Y + (size_t)(row0 + ty * 4 + i) * DM + 64 * cg + tx * 4) = make_uint2(pk2(y[i][0], y[i][1]), pk2(y[i][2], y[i][3]));
    }
}

__device__ __forceinline__ void nv_resid_gemm(const Args& A, const bf16_t* Am, int lda, int K, const float* W, const float* xold, float* rowss_next, int wg, int nwg, float* sm) {
    float* sA = sm; float* sB = sm + 16 * 128;
    const int tid = opaque_tid(), tx = tid & 15, ty = tid >> 4;
    bf16_t* XB = (bf16_t*)(A.ws + WS_XB);
    for (int it = wg; it < 128 * 16; it += nwg) {
        const int rt = it / 16, cg = it % 16, row0 = rt * 128;
        float acc[4][4];
        nv_core(acc, K, ALbf{Am, lda, row0}, WLf32{W, DM, 64 * cg, 64 * cg + 32, nullptr}, sA, sB, tid);
#pragma unroll
        for (int i = 0; i < 4; ++i) {
            const size_t off = (size_t)(row0 + ty * 4 + i) * DM + 64 * cg + tx * 4;
            const float4 xo = *(const float4*)(xold + off);
            const float4 xn = make_float4(xo.x + acc[i][0], xo.y + acc[i][1], xo.z + acc[i][2], xo.w + acc[i][3]);
            *(float4*)(A.out + off) = xn;
            *(uint2*)(XB + off) = make_uint2(pk2(xn.x, xn.y), pk2(xn.z, xn.w));
            float s = xn.x * xn.x + xn.y * xn.y + xn.z * xn.z + xn.w * xn.w;
            s += __shfl_xor(s, 1); s += __shfl_xor(s, 2); s += __shfl_xor(s, 4); s += __shfl_xor(s, 8);
            if (tx == 0 && rowss_next) atomicAdd(rowss_next + row0 + ty * 4 + i, s);
        }
    }
}

__device__ __forceinline__ void nv_p5(const Args& A, int l, int wg, int nwg, float* sm) {
    float* sA = sm; float* sB = sm + 16 * 128; float* sC = sB + 16 * 64;
    const int tid = opaque_tid(), tx = tid & 15, ty = tid >> 4;
    const float* W = A.in[I_WF1] + (size_t)l * DM * 2 * DFF;
    const float* g2 = A.in[I_N2G] + l * DM;
    const bf16_t* XB = (const bf16_t*)(A.ws + WS_XB);
    const float* rowss = (const float*)(A.ws + WS_ROWSS) + (size_t)(l == 0 ? 1 : 3) * M;
    bf16_t* MID = (bf16_t*)(A.ws + WS_MID);
    for (int it = wg; it < 128 * 88; it += nwg) {
        const int rt = it / 88, jj = it % 88, row0 = rt * 128;
        float acc[4][4];
        nv_core(acc, DM, ALbf{XB, DM, row0}, WLf32{W, 2 * DFF, 32 * jj, DFF + 32 * jj, g2}, sA, sB, tid);
#pragma unroll
        for (int i = 0; i < 4; ++i) {
            const int r = ty * 4 + i; const float rstd = rsqrtf(rowss[row0 + r] * (1.0f / DM) + RMS_EPS);
#pragma unroll
            for (int j = 0; j < 4; ++j) sC[r * 65 + tx * 4 + j] = acc[i][j] * rstd;
        }
        __syncthreads();
        const int r = tid >> 2, q4 = tid & 3;
        const float* cr = sC + r * 65;
        bf16_t* o = MID + (size_t)(row0 + r) * DFF + 32 * jj + q4 * 8;
#pragma unroll
        for (int j = 0; j < 8; ++j) o[j] = (bf16_t)f2bf(siluf_(cr[q4 * 8 + j]) * cr[32 + q4 * 8 + j]);
        __syncthreads();
    }
}


namespace pg8 {
typedef short bf16x8 __attribute__((ext_vector_type(8)));
typedef float f32x4 __attribute__((ext_vector_type(4)));
typedef unsigned u32x4 __attribute__((ext_vector_type(4)));
constexpr int BM = 256, BK = 64, HALF = 128, HTB = HALF * BK * 2, STAGE_BYTES = 8 * HTB, NXCD = 8, WGM = 8;
__host__ __device__ __forceinline__ int lds_byte(int r, int c) { const int st = (r >> 4) * 2 + (c >> 5), rr = r & 15, cc = c & 31, ob = rr * 64 + cc * 2; return st * 1024 + (ob ^ (((ob >> 9) & 1) << 5)); }
__host__ __device__ __forceinline__ void stage_rc(int b, int& R, int& C) { const int st = b / 1024, sb = b % 1024, swz = sb ^ (((sb >> 9) & 1) << 5); R = (st >> 1) * 16 + swz / 64; C = (st & 1) * 32 + (swz % 64) / 2; }
__host__ __device__ __forceinline__ int perm32(int rho) { const int n = rho >> 4, i = rho & 15; return 8 * (i >> 2) + 4 * n + (i & 3); }

struct GUnit { const char* A; const char* B; int lda2, ldb2, nt, pm, pn, kind; };

struct TileOrder {
    int nM, nN, nwg, G, c;
    __device__ __forceinline__ void init(int nM_, int nN_, int G_, int c_) { nM = nM_; nN = nN_; nwg = nM * nN; G = G_; c = c_; }
    __device__ __forceinline__ bool tile(int i, int& pm, int& pn) const {
        const long L = (long)i * G + c; if (L >= nwg) return false;
        int wgid = (int)L; { const int q = nwg / NXCD, r = nwg % NXCD, xcd = wgid % NXCD, off = wgid / NXCD; wgid = (xcd < r ? xcd * (q + 1) : r * (q + 1) + (xcd - r) * q) + off; }
        const int nig = WGM * nN, gid = wgid / nig, fm = gid * WGM, gsz = (nM - fm) < WGM ? (nM - fm) : WGM;
        pm = fm + ((wgid % nig) % gsz); pn = (wgid % nig) / gsz; return true;
    }
};

typedef float f32x2_t __attribute__((ext_vector_type(2))); typedef __bf16 bf16x2_t __attribute__((ext_vector_type(2)));
__device__ __forceinline__ unsigned cvt_pk_bf16(float lo, float hi) { f32x2_t v = {lo, hi}; bf16x2_t b = __builtin_convertvector(v, bf16x2_t); return __builtin_bit_cast(unsigned, b); }
__device__ __forceinline__ u32x4 pack8(const f32x4& a, const f32x4& b) { u32x4 w; w.x = cvt_pk_bf16(a[0], a[1]); w.y = cvt_pk_bf16(a[2], a[3]); w.z = cvt_pk_bf16(b[0], b[1]); w.w = cvt_pk_bf16(b[2], b[3]); return w; }

template <class Epi, class Sched>
__device__ __forceinline__ void gemm_phase(LAS unsigned char* lds, const Sched& S, const Epi& E) {
    const int tid = opaque_tid(), wid = __builtin_amdgcn_readfirstlane(tid >> 6), lane = tid & 63, wr = wid >> 2, wc = wid & 3, fr = lane & 15, fq = lane >> 4;
    const size_t kstep = (size_t)(BK * 2);
    const unsigned ldsw = (unsigned)wid * 1024u;
    const int aoff = lds_byte(wr * 64 + fr, fq * 8), boff = lds_byte(wc * 32 + fr, fq * 8);
#define PG8_SA(b, h) (((b) * 2 + (h)) * HTB)
#define PG8_SB(b, h) ((4 + (b) * 2 + (h)) * HTB)
#define PG8_STAGE(bufoff, gbase, voff) do { _Pragma("unroll") for (int _i = 0; _i < 2; ++_i) \
        __builtin_amdgcn_global_load_lds((const unsigned*)((const char*)(gbase) + (voff)[_i]), (LAS unsigned*)(lds + (bufoff) + ldsw + _i * 8192), 16, 0, 0); } while (0)
#define PG8_LDA(dst, b, h) do { _Pragma("unroll") for (int m = 0; m < 4; ++m) _Pragma("unroll") for (int k = 0; k < 2; ++k) dst[m][k] = *(const LAS bf16x8*)(lds + PG8_SA(b, h) + aoff + m * 2048 + k * 1024); } while (0)
#define PG8_LDB(dst, b, h) do { _Pragma("unroll") for (int n = 0; n < 2; ++n) _Pragma("unroll") for (int k = 0; k < 2; ++k) dst[n][k] = *(const LAS bf16x8*)(lds + PG8_SB(b, h) + boff + n * 2048 + k * 1024); } while (0)
#define PG8_MMA(ai, bj, At, Bt) do { __builtin_amdgcn_s_setprio(1); _Pragma("unroll") for (int m = 0; m < 4; ++m) _Pragma("unroll") for (int n = 0; n < 2; ++n) _Pragma("unroll") for (int k = 0; k < 2; ++k) \
        acc[ai][bj][m][n] = __builtin_amdgcn_mfma_f32_16x16x32_bf16(Bt[n][k], At[m][k], acc[ai][bj][m][n], 0, 0, 0); __builtin_amdgcn_s_setprio(0); } while (0)
#define PG8_WAIT_V(n) asm volatile("s_waitcnt vmcnt(" #n ")" ::: "memory")
#define PG8_WAIT_L(n) asm volatile("s_waitcnt lgkmcnt(" #n ")" ::: "memory")
#define PG8_BAR __builtin_amdgcn_s_barrier()
#define PG8_SCHED __builtin_amdgcn_sched_barrier(0)
    GUnit cur, nxt; int ui = 0;
    if (!S.next(0, cur)) return;
    f32x4 acc[2][2][4][2];
#pragma unroll
    for (int a = 0; a < 2; ++a)
#pragma unroll
        for (int b = 0; b < 2; ++b)
#pragma unroll
            for (int m = 0; m < 4; ++m)
#pragma unroll
                for (int n = 0; n < 2; ++n) acc[a][b][m][n] = (f32x4){0.f, 0.f, 0.f, 0.f};
    bf16x8 At[4][2], B0[2][2], B1[2][2];
#define PG8_VOFF(vA_, vB_, lda2_, ldb2_) do { int tt_ = tid; asm volatile("" : "+v"(tt_)); _Pragma("unroll") for (int i_ = 0; i_ < 2; ++i_) { int R_, C_; stage_rc(tt_ * 16 + i_ * 8192, R_, C_); \
        vA_[i_] = (unsigned)(R_ * (lda2_) + C_ * 2); vB_[i_] = (unsigned)(((R_ & ~31) + perm32(R_ & 31)) * (ldb2_) + C_ * 2); } } while (0)
    const char* cA = cur.A; const char* cB = cur.B; size_t hA = (size_t)HALF * cur.lda2, hB = (size_t)HALF * cur.ldb2;
    { unsigned vA[2], vB[2]; PG8_VOFF(vA, vB, cur.lda2, cur.ldb2);
    PG8_STAGE(PG8_SB(0, 0), cB, vB); PG8_STAGE(PG8_SB(0, 1), cB + hB, vB); PG8_STAGE(PG8_SA(0, 0), cA, vA); PG8_STAGE(PG8_SA(0, 1), cA + hA, vA);
    if (wr == 1) PG8_BAR;
    PG8_WAIT_V(2); PG8_BAR;
    PG8_STAGE(PG8_SB(1, 0), cB + kstep, vB); PG8_STAGE(PG8_SA(1, 0), cA + kstep, vA); PG8_STAGE(PG8_SB(1, 1), cB + hB + kstep, vB);
    PG8_WAIT_V(6); PG8_BAR; }
    for (;;) {
        const bool has_next = S.next(ui + 1, nxt);
        if (!has_next) nxt = cur;
        const size_t nhA = (size_t)HALF * nxt.lda2, nhB = (size_t)HALF * nxt.ldb2;
        const int nt = cur.nt;
        for (int t = 0; t < nt; t += 2) {
            const bool last = (t == nt - 2);
            const char* a1 = cA + (size_t)(t + 1) * kstep;
            const char* a2 = last ? nxt.A : cA + (size_t)(t + 2) * kstep; const char* b2 = last ? nxt.B : cB + (size_t)(t + 2) * kstep;
            const char* a3 = a2 + kstep; const char* b3 = b2 + kstep;
            unsigned wA[2], wB[2];
            const size_t whA = last ? nhA : hA, whB = last ? nhB : hB;
            PG8_LDB(B0, 0, 0); PG8_LDB(B1, 0, 1); PG8_SCHED; PG8_LDA(At, 0, 0);
            { unsigned vA[2], vB[2]; PG8_VOFF(vA, vB, cur.lda2, cur.ldb2); (void)vB; PG8_STAGE(PG8_SA(1, 1), a1 + hA, vA); }
            PG8_VOFF(wA, wB, last ? nxt.lda2 : cur.lda2, last ? nxt.ldb2 : cur.ldb2);
            PG8_WAIT_V(8); PG8_WAIT_L(0); PG8_BAR; PG8_MMA(0, 0, At, B0); PG8_MMA(0, 1, At, B1); PG8_BAR; PG8_SCHED;
            PG8_LDA(At, 0, 1); PG8_STAGE(PG8_SB(0, 0), b2, wB); PG8_STAGE(PG8_SB(0, 1), b2 + whB, wB); PG8_STAGE(PG8_SA(0, 0), a2, wA);
            PG8_WAIT_V(8); PG8_WAIT_L(0); PG8_BAR; PG8_MMA(1, 0, At, B0); PG8_MMA(1, 1, At, B1); PG8_BAR; PG8_SCHED;
            PG8_LDB(B0, 1, 0); PG8_LDB(B1, 1, 1); PG8_SCHED; PG8_LDA(At, 1, 0); PG8_STAGE(PG8_SA(0, 1), a2 + whA, wA);
            PG8_WAIT_V(8); PG8_WAIT_L(0); PG8_BAR; PG8_MMA(0, 0, At, B0); PG8_MMA(0, 1, At, B1); PG8_BAR; PG8_SCHED;
            PG8_LDA(At, 1, 1); PG8_STAGE(PG8_SB(1, 0), b3, wB); PG8_STAGE(PG8_SB(1, 1), b3 + whB, wB); PG8_STAGE(PG8_SA(1, 0), a3, wA);
            PG8_WAIT_V(8); PG8_WAIT_L(0); PG8_BAR; PG8_MMA(1, 0, At, B0); PG8_MMA(1, 1, At, B1); PG8_BAR; PG8_SCHED;
        }
        if (wr == 0) PG8_BAR;
        { int fr_ = fr, fq_ = fq; asm volatile("" : "+v"(fr_), "+v"(fq_));
          E(acc, cur, wr, wc, fr_, fq_); }
        if (!has_next) break;
#pragma unroll
        for (int a = 0; a < 2; ++a)
#pragma unroll
            for (int b = 0; b < 2; ++b)
#pragma unroll
                for (int m = 0; m < 4; ++m)
#pragma unroll
                    for (int n = 0; n < 2; ++n) acc[a][b][m][n] = (f32x4){0.f, 0.f, 0.f, 0.f};
        cur = nxt; cA = cur.A; cB = cur.B; hA = nhA; hB = nhB;
        ++ui;
        if (wr == 1) PG8_BAR;
    }
    PG8_WAIT_V(0);
    PG8_BAR;
#undef PG8_VOFF
#undef PG8_SA
#undef PG8_SB
#undef PG8_STAGE
#undef PG8_LDA
#undef PG8_LDB
#undef PG8_MMA
#undef PG8_WAIT_V
#undef PG8_WAIT_L
#undef PG8_BAR
#undef PG8_SCHED
}
}
using pg8::f32x4; using pg8::u32x4; using pg8::GUnit;

constexpr size_t WS_WB = 2 * MiB, WB_LAYER = 37 * MiB;
constexpr size_t WB_W1 = 0, WB_WG = 9 * MiB, WB_WBR = 15 * MiB, WB_WO = 18 * MiB, WB_WF1 = 20 * MiB, WB_WF2 = 31 * MiB;
constexpr size_t WS_GSCR = 190 * MiB;
static_assert(WS_WB + 2 * WB_LAYER <= WS_XB, "weights vs XB");

__device__ __forceinline__ int p1_src_col(int tile, int p) {
    if (tile < 4) return (tile >> 1) * 512 + (tile & 1) * 256 + 64 * ((p >> 5) & 3) + 32 * (p >> 7);
    if (tile < 6) return 1024 + (tile - 4) * 256 + p;
    if (tile < 10) return (p < 128) ? 1536 + 128 * (tile - 6) + p : 2048 + 128 * (tile - 6) + (p - 128);
    return 2560 + (tile - 10) * 256 + p;
}
__device__ __forceinline__ void p0_titem(const float* W, int ldw, int src0, const float* g, bf16_t* WT, int K, int prow0, int k0, float* scr, int lane) {
#pragma unroll 8
    for (int i = 0; i < 32; ++i) { const int kk = 2 * i + (lane >> 5); float v = W[(size_t)(k0 + kk) * ldw + src0 + (lane & 31)]; if (g) v *= g[k0 + kk]; scr[kk * 33 + (lane & 31)] = v; }
    asm volatile("s_waitcnt lgkmcnt(0)" ::: "memory");
    const int c = lane & 7;
#pragma unroll
    for (int j = 0; j < 4; ++j) { const int n = (lane >> 3) + 8 * j; const float* s = scr + (8 * c) * 33 + n;
        uint4 o; o.x = pk2(s[0 * 33], s[1 * 33]); o.y = pk2(s[2 * 33], s[3 * 33]); o.z = pk2(s[4 * 33], s[5 * 33]); o.w = pk2(s[6 * 33], s[7 * 33]);
        *(uint4*)(WT + (size_t)(prow0 + n) * K + k0 + 8 * c) = o; }
    asm volatile("s_waitcnt lgkmcnt(0)" ::: "memory");
}
__device__ __forceinline__ void fast_p0_weights(const Args& A, int wg, int nwg, float* sm) {
    const int tid = opaque_tid(), lane = tid & 63, wave = tid >> 6;
    float* scr = sm + wave * (64 * 33);
    constexpr int NI_W1 = 144 * 16, NI_WG = 96 * 16, NI_WBR = 3 * 32 * 8, NI_WO = 32 * 16, NI_F1 = 176 * 16, NI_F2 = 32 * 44;
    constexpr int PER_LAYER = NI_W1 + NI_WG + NI_WBR + NI_WO + NI_F1 + NI_F2;
    for (int it = wg * NWAVES + wave; it < DEPTH * PER_LAYER; it += nwg * NWAVES) {
        const int l = it / PER_LAYER; int r = it % PER_LAYER;
        unsigned char* wb = A.ws + WS_WB + (size_t)l * WB_LAYER;
        const float* Win = A.in[I_WIN] + (size_t)l * DM * DIN; const float* g1 = A.in[I_N1G] + l * DM;
        if (r < NI_W1) { const int rb = r / 16, kb = r % 16; p0_titem(Win, DIN, p1_src_col(rb >> 3, (rb & 7) * 32), g1, (bf16_t*)(wb + WB_W1), DM, 32 * rb, 64 * kb, scr, lane); continue; } r -= NI_W1;
        if (r < NI_WG) { const int rb = r / 16, kb = r % 16; p0_titem(Win, DIN, NU + 32 * rb, g1, (bf16_t*)(wb + WB_WG), DM, 32 * rb, 64 * kb, scr, lane); continue; } r -= NI_WG;
        if (r < NI_WBR) { const int n = r / 256, rr = r % 256, rb = rr / 8, kb = rr % 8;
            p0_titem(A.in[I_WBR] + ((size_t)l * 3 + n) * BW * DM, DM, 32 * rb, nullptr, (bf16_t*)(wb + WB_WBR) + (size_t)n * DM * BW, BW, 32 * rb, 64 * kb, scr, lane); continue; } r -= NI_WBR;
        if (r < NI_WO) { const int rb = r / 16, kb = r % 16; p0_titem(A.in[I_WOUT] + (size_t)l * DM * DM, DM, 32 * rb, nullptr, (bf16_t*)(wb + WB_WO), DM, 32 * rb, 64 * kb, scr, lane); continue; } r -= NI_WO;
        if (r < NI_F1) { const int rb = r / 16, kb = r % 16, tile = rb >> 3, p = (rb & 7) * 32; const int src = (p < 128) ? 128 * tile + p : DFF + 128 * tile + (p - 128);
            p0_titem(A.in[I_WF1] + (size_t)l * DM * 2 * DFF, 2 * DFF, src, A.in[I_N2G] + l * DM, (bf16_t*)(wb + WB_WF1), DM, 32 * rb, 64 * kb, scr, lane); continue; } r -= NI_F1;
        { const int rb = r / 44, kb = r % 44; p0_titem(A.in[I_WF2] + (size_t)l * DFF * DM, DM, 32 * rb, nullptr, (bf16_t*)(wb + WB_WF2), DFF, 32 * rb, 64 * kb, scr, lane); }
    }
}

struct SchedPlain {
    pg8::TileOrder o; const char* A; const char* B; int lda2, ldb2, nt;
    __device__ __forceinline__ bool next(int i, GUnit& u) const {
        int pm, pn; if (!o.tile(i, pm, pn)) return false;
        u.A = A + (size_t)pm * 256 * lda2; u.B = B + (size_t)pn * 256 * ldb2; u.lda2 = lda2; u.ldb2 = ldb2; u.nt = nt; u.pm = pm; u.pn = pn; u.kind = 0; return true;
    }
};
struct SchedP3 {
    pg8::TileOrder o; const char* ws; const char* wb;
    __device__ __forceinline__ bool next(int i, GUnit& u) const {
        int pm, pn; if (!o.tile(i / 6, pm, pn)) return false;
        const int sub = i % 6, n = sub >> 1; const bool proj = (sub & 1) != 0;
        u.pm = pm; u.pn = pn; u.kind = sub;
        const size_t aoff = !proj ? WS_XB : (n == 0 ? WS_YA : (n == 1 ? WS_YB : WS_YC));
        const int ld2 = proj ? BW * 2 : DM * 2;
        u.A = ws + aoff + (size_t)pm * 256 * ld2; u.lda2 = ld2;
        u.B = wb + (proj ? WB_WBR : WB_WG) + (size_t)(n * DM + pn * 256) * ld2; u.ldb2 = ld2; u.nt = ld2 >> 7;
        return true;
    }
};

__device__ __forceinline__ float fast_sigmoid(float x) { return __builtin_amdgcn_rcpf(1.0f + __builtin_amdgcn_exp2f(-LOG2E * x)); }
__device__ __forceinline__ f32x4 sig4(const f32x4& v) { return (f32x4){fast_sigmoid(v[0]), fast_sigmoid(v[1]), fast_sigmoid(v[2]), fast_sigmoid(v[3])}; }
__device__ __forceinline__ float dot4(const f32x4& a) { return (a[0] * a[0] + a[1] * a[1]) + (a[2] * a[2] + a[3] * a[3]); }

struct EpiP1 {
    unsigned char* ws; const float* rowss; const float* qg; const float* kg;
    __device__ __forceinline__ void operator()(const f32x4 (&acc)[2][2][4][2], const GUnit& u, int wr, int wc, int fr, int fq) const {
        const int pn = u.pn;
        if (pn < 4) {
            const bool isq = pn < 2; const float* gg = isq ? qg : kg; const float sc = isq ? QSCALE : 1.0f;
            const f32x4 ga0 = *(const f32x4*)(gg + 8 * fq), ga1 = *(const f32x4*)(gg + 8 * fq + 4), gb0 = *(const f32x4*)(gg + 32 + 8 * fq), gb1 = *(const f32x4*)(gg + 32 + 8 * fq + 4);
            bf16_t* base = (bf16_t*)(ws + (isq ? WS_AQ : WS_AK)) + (pn & 1) * 256 + 64 * wc + 8 * fq;
#pragma unroll
            for (int ai = 0; ai < 2; ++ai)
#pragma unroll
                for (int m = 0; m < 4; ++m) {
                    const int row = u.pm * 256 + ai * 128 + wr * 64 + m * 16 + fr;
                    const float rstd = rsqrtf(rowss[row] * (1.0f / DM) + RMS_EPS);
                    const f32x4 a0 = acc[ai][0][m][0] * rstd, a1 = acc[ai][0][m][1] * rstd, b0 = acc[ai][1][m][0] * rstd, b1 = acc[ai][1][m][1] * rstd;
                    float ss = (dot4(a0) + dot4(a1)) + (dot4(b0) + dot4(b1));
                    ss += __shfl_xor(ss, 16); ss += __shfl_xor(ss, 32);
                    const float rn = rsqrtf(ss * (1.0f / 64.0f) + RMS_EPS) * sc;
                    bf16_t* o = base + (size_t)row * BW;
                    *(u32x4*)o = pg8::pack8(a0 * ga0 * rn, a1 * ga1 * rn);
                    *(u32x4*)(o + 32) = pg8::pack8(b0 * gb0 * rn, b1 * gb1 * rn);
                }
        } else if (pn >= 6 && pn < 10) {
            bf16_t* base = (bf16_t*)(ws + WS_Z) + 128 * (pn - 6) + 32 * wc + 8 * fq;
#pragma unroll
            for (int ai = 0; ai < 2; ++ai)
#pragma unroll
                for (int m = 0; m < 4; ++m) {
                    const int row = u.pm * 256 + ai * 128 + wr * 64 + m * 16 + fr;
                    const float rstd = rsqrtf(rowss[row] * (1.0f / DM) + RMS_EPS);
                    const f32x4 z0 = acc[ai][0][m][0] * rstd * sig4(acc[ai][1][m][0] * rstd), z1 = acc[ai][0][m][1] * rstd * sig4(acc[ai][1][m][1] * rstd);
                    *(u32x4*)(base + (size_t)row * BW) = pg8::pack8(z0, z1);
                }
        } else {
            size_t wsoff; int kind;
            if (pn < 6) { wsoff = WS_AV; kind = 0; } else if (pn < 12) { wsoff = WS_RQ; kind = 1; } else if (pn < 14) { wsoff = WS_RK; kind = 2; } else if (pn < 16) { wsoff = WS_RV; kind = 0; } else { wsoff = WS_RG; kind = 3; }
            bf16_t* base = (bf16_t*)(ws + wsoff) + (pn & 1) * 256 + 32 * wc + 8 * fq;
            const float l2g0 = log2_gamma((pn & 1) * 2), l2g1 = log2_gamma((pn & 1) * 2 + 1);
#pragma unroll
            for (int ai = 0; ai < 2; ++ai)
#pragma unroll
                for (int m = 0; m < 4; ++m) {
                    const int row = u.pm * 256 + ai * 128 + wr * 64 + m * 16 + fr;
                    const float rstd = rsqrtf(rowss[row] * (1.0f / DM) + RMS_EPS);
                    const float tp = (float)(row & 127);
                    float f0 = rstd, f1 = rstd;
                    if (kind == 1) { f0 *= exp2f(tp * l2g0); f1 *= exp2f(tp * l2g1); }
                    if (kind == 2) { f0 *= 0.08838834764831845f * exp2f(-tp * l2g0); f1 *= 0.08838834764831845f * exp2f(-tp * l2g1); }
                    f32x4 a0 = acc[ai][0][m][0] * f0, a1 = acc[ai][0][m][1] * f0, b0 = acc[ai][1][m][0] * f1, b1 = acc[ai][1][m][1] * f1;
                    if (kind == 3) { a0 = a0 * sig4(a0); a1 = a1 * sig4(a1); b0 = b0 * sig4(b0); b1 = b1 * sig4(b1); }
                    bf16_t* o = base + (size_t)row * BW;
                    *(u32x4*)o = pg8::pack8(a0, a1);
                    *(u32x4*)(o + 128) = pg8::pack8(b0, b1);
                }
        }
    }
};
struct EpiP3 {
    const float* rowss; const float* bg; unsigned char* gscr; bf16_t* Y;
    __device__ __forceinline__ void operator()(const f32x4 (&acc)[2][2][4][2], const GUnit& u, int wr, int wc, int fr, int fq) const {
        const int n = u.kind >> 1;
        u32x4* gs = (u32x4*)gscr + ((wr * 4 + wc) * 64 + fq * 16 + fr);
        if (!(u.kind & 1)) {
            const float* bp = bg + n * DM + u.pn * 256 + 32 * wc + 8 * fq;
            const f32x4 ba0 = *(const f32x4*)bp, ba1 = *(const f32x4*)(bp + 4), bb0 = *(const f32x4*)(bp + 128), bb1 = *(const f32x4*)(bp + 132);
#pragma unroll
            for (int ai = 0; ai < 2; ++ai)
#pragma unroll
                for (int m = 0; m < 4; ++m) {
                    const int row = u.pm * 256 + ai * 128 + wr * 64 + m * 16 + fr;
                    const float rstd = rsqrtf(rowss[row] * (1.0f / DM) + RMS_EPS);
                    gs[((ai * 4 + m) * 2 + 0) * NTHREADS] = pg8::pack8(sig4(acc[ai][0][m][0] * rstd + ba0), sig4(acc[ai][0][m][1] * rstd + ba1));
                    gs[((ai * 4 + m) * 2 + 1) * NTHREADS] = pg8::pack8(sig4(acc[ai][1][m][0] * rstd + bb0), sig4(acc[ai][1][m][1] * rstd + bb1));
                }
        } else {
#pragma unroll
            for (int ai = 0; ai < 2; ++ai)
#pragma unroll
                for (int m = 0; m < 4; ++m) {
                    const int row = u.pm * 256 + ai * 128 + wr * 64 + m * 16 + fr;
#pragma unroll
                    for (int bj = 0; bj < 2; ++bj) {
                        const u32x4 g = __builtin_nontemporal_load(&gs[((ai * 4 + m) * 2 + bj) * NTHREADS]);
                        bf16_t* yp = Y + (size_t)row * DM + u.pn * 256 + 128 * bj + 32 * wc + 8 * fq;
                        f32x4 y0 = acc[ai][bj][m][0], y1 = acc[ai][bj][m][1];
                        y0[0] *= __uint_as_float(g.x << 16); y0[1] *= __uint_as_float(g.x & 0xffff0000u); y0[2] *= __uint_as_float(g.y << 16); y0[3] *= __uint_as_float(g.y & 0xffff0000u);
                        y1[0] *= __uint_as_float(g.z << 16); y1[1] *= __uint_as_float(g.z & 0xffff0000u); y1[2] *= __uint_as_float(g.w << 16); y1[3] *= __uint_as_float(g.w & 0xffff0000u);
                        if (n > 0) { const u32x4 p = __builtin_nontemporal_load((const u32x4*)yp);
                            y0[0] += __uint_as_float(p.x << 16); y0[1] += __uint_as_float(p.x & 0xffff0000u); y0[2] += __uint_as_float(p.y << 16); y0[3] += __uint_as_float(p.y & 0xffff0000u);
                            y1[0] += __uint_as_float(p.z << 16); y1[1] += __uint_as_float(p.z & 0xffff0000u); y1[2] += __uint_as_float(p.w << 16); y1[3] += __uint_as_float(p.w & 0xffff0000u); }
                        *(u32x4*)yp = pg8::pack8(y0, y1);
                    }
                    asm volatile("" ::: "memory");
                }
        }
    }
};
struct EpiResid {
    const float* xold; float* out; bf16_t* XB; float* rowss_next;
    __device__ __forceinline__ void operator()(const f32x4 (&acc)[2][2][4][2], const GUnit& u, int wr, int wc, int fr, int fq) const {
#pragma unroll
        for (int ai = 0; ai < 2; ++ai)
#pragma unroll
            for (int m = 0; m < 4; ++m) {
                const int row = u.pm * 256 + ai * 128 + wr * 64 + m * 16 + fr;
                float ss = 0.f;
#pragma unroll
                for (int bj = 0; bj < 2; ++bj) {
                    const size_t off = (size_t)row * DM + u.pn * 256 + 128 * bj + 32 * wc + 8 * fq;
                    const f32x4 x0 = *(const f32x4*)(xold + off) + acc[ai][bj][m][0], x1 = *(const f32x4*)(xold + off + 4) + acc[ai][bj][m][1];
                    *(f32x4*)(out + off) = x0; *(f32x4*)(out + off + 4) = x1;
                    *(u32x4*)(XB + off) = pg8::pack8(x0, x1);
                    ss += dot4(x0) + dot4(x1);
                }
                ss += __shfl_xor(ss, 16); ss += __shfl_xor(ss, 32);
                if (fq == 0 && rowss_next) atomicAdd(rowss_next + row, ss);
                if (m & 1) asm volatile("" ::: "memory");
            }
    }
};
struct EpiSwiglu {
    const float* rowss; bf16_t* MID;
    __device__ __forceinline__ void operator()(const f32x4 (&acc)[2][2][4][2], const GUnit& u, int wr, int wc, int fr, int fq) const {
        bf16_t* base = MID + 128 * u.pn + 32 * wc + 8 * fq;
#pragma unroll
        for (int ai = 0; ai < 2; ++ai)
#pragma unroll
            for (int m = 0; m < 4; ++m) {
                const int row = u.pm * 256 + ai * 128 + wr * 64 + m * 16 + fr;
                const float rstd = rsqrtf(rowss[row] * (1.0f / DM) + RMS_EPS);
                const f32x4 g0 = acc[ai][0][m][0] * rstd, g1 = acc[ai][0][m][1] * rstd, u0 = acc[ai][1][m][0] * rstd, u1 = acc[ai][1][m][1] * rstd;
                *(u32x4*)(base + (size_t)row * DFF) = pg8::pack8(g0 * sig4(g0) * u0, g1 * sig4(g1) * u1);
            }
    }
};

__device__ __forceinline__ void fast_gemm(const Args& A, int l, int k, LAS unsigned char* lds) {
    const int G = gridDim.x, c = blockIdx.x;
    const char* wb = (const char*)(A.ws + WS_WB + (size_t)l * WB_LAYER);
    const char* XB = (const char*)(A.ws + WS_XB);
    float* rowss = (float*)(A.ws + WS_ROWSS);
    if (k == 0) {
        SchedPlain S; S.o.init(M / 256, NU / 256, G, c); S.A = XB; S.lda2 = DM * 2; S.B = wb + WB_W1; S.ldb2 = DM * 2; S.nt = DM / 64;
        EpiP1 E{A.ws, rowss + (size_t)(l == 0 ? 0 : 2) * M, A.in[I_QG] + l * 64, A.in[I_KG] + l * 64};
        pg8::gemm_phase(lds, S, E);
    } else if (k == 2) {
        SchedP3 S; S.o.init(M / 256, DM / 256, G, c); S.ws = (const char*)A.ws; S.wb = wb;
        EpiP3 E{rowss + (size_t)(l == 0 ? 0 : 2) * M, A.in[I_BGATE] + l * NGATE, A.ws + WS_GSCR + (size_t)blockIdx.x * (128 * 1024), (bf16_t*)(A.ws + WS_Y)};
        pg8::gemm_phase(lds, S, E);
    } else if (k == 3) {
        SchedPlain S; S.o.init(M / 256, DM / 256, G, c); S.A = (const char*)(A.ws + WS_Y); S.lda2 = DM * 2; S.B = wb + WB_WO; S.ldb2 = DM * 2; S.nt = DM / 64;
        EpiResid E{l == 0 ? A.in[I_X] : A.out, A.out, (bf16_t*)(A.ws + WS_XB), rowss + (size_t)(l == 0 ? 1 : 3) * M};
        pg8::gemm_phase(lds, S, E);
    } else if (k == 4) {
        SchedPlain S; S.o.init(M / 256, 2 * DFF / 256, G, c); S.A = XB; S.lda2 = DM * 2; S.B = wb + WB_WF1; S.ldb2 = DM * 2; S.nt = DM / 64;
        EpiSwiglu E{rowss + (size_t)(l == 0 ? 1 : 3) * M, (bf16_t*)(A.ws + WS_MID)};
        pg8::gemm_phase(lds, S, E);
    } else {
        SchedPlain S; S.o.init(M / 256, DM / 256, G, c); S.A = (const char*)(A.ws + WS_MID); S.lda2 = DFF * 2; S.B = wb + WB_WF2; S.ldb2 = DFF * 2; S.nt = DFF / 64;
        EpiResid E{A.out, A.out, (bf16_t*)(A.ws + WS_XB), l + 1 < DEPTH ? rowss + (size_t)2 * M : nullptr};
        pg8::gemm_phase(lds, S, E);
    }
}


namespace mx {
typedef short bf16x8 __attribute__((ext_vector_type(8)));
typedef short s16x4 __attribute__((ext_vector_type(4)));
typedef short v4i16_t __attribute__((ext_vector_type(4)));
typedef float f32x16 __attribute__((ext_vector_type(16)));
typedef LAS unsigned char* lptr;
typedef unsigned u32x2 __attribute__((ext_vector_type(2)));
__device__ __forceinline__ int crow(int r, int hi) { return (r & 3) + 8 * (r >> 2) + 4 * hi; }
__device__ __forceinline__ s16x4 vtr(lptr p) { return __builtin_bit_cast(s16x4, __builtin_amdgcn_ds_read_tr16_b64_v4i16((LAS v4i16_t*)p)); }
__device__ __forceinline__ bf16x8 cat8(s16x4 lo, s16x4 hi) { return (bf16x8){lo[0], lo[1], lo[2], lo[3], hi[0], hi[1], hi[2], hi[3]}; }
__device__ __forceinline__ bf16x8 ld8(lptr p) { return *(const LAS bf16x8*)p; }
__device__ __forceinline__ float swap_max(float v) { auto rr = __builtin_amdgcn_permlane32_swap(__float_as_uint(v), __float_as_uint(v), false, false); return fmaxf(__uint_as_float(rr[0]), __uint_as_float(rr[1])); }
__device__ __forceinline__ float swap_sum(float v) { auto rr = __builtin_amdgcn_permlane32_swap(__float_as_uint(v), __float_as_uint(v), false, false); return __uint_as_float(rr[0]) + __uint_as_float(rr[1]); }
__device__ __forceinline__ bf16x8 pack_p(const f32x16& p, int b) {
    pg8::u32x4 w; w.x = pg8::cvt_pk_bf16(p[b], p[b + 1]); w.y = pg8::cvt_pk_bf16(p[b + 2], p[b + 3]); w.z = pg8::cvt_pk_bf16(p[b + 4], p[b + 5]); w.w = pg8::cvt_pk_bf16(p[b + 6], p[b + 7]);
    return __builtin_bit_cast(bf16x8, w);
}
#define MFMA32(a, b, c) __builtin_amdgcn_mfma_f32_32x32x16_bf16((a), (b), (c), 0, 0, 0)

constexpr int A_KSLOT = 8192, A_TILE = 32768, A_WS = 65536, A_STAGE = 65536 + 2048;
__device__ __forceinline__ void attn_unit(const Args& A, int l, int b, int h, int qb, lptr lds) {
    const int tid = opaque_tid(), lane = tid & 63, r32 = lane & 31, hi = lane >> 5; const int wid = __builtin_amdgcn_readfirstlane(tid >> 6), mp = wid >> 2, qw = wid & 3;
    const bf16_t* AQ = (const bf16_t*)(A.ws + WS_AQ); const bf16_t* AK = (const bf16_t*)(A.ws + WS_AK); const bf16_t* AV = (const bf16_t*)(A.ws + WS_AV);
    const size_t rowbase = (size_t)b * SEQ;
    const int q0 = 128 * qb + 32 * qw;
    const int NT = 2 * (qb + 1);
    LAS float* wsf = (LAS float*)(lds + A_WS) + wid * 64;
    bf16x8 qf[4];
#pragma unroll
    for (int d0 = 0; d0 < 4; ++d0) qf[d0] = *(const bf16x8*)(AQ + (rowbase + q0 + r32) * BW + h * 128 + mp * 64 + d0 * 16 + hi * 8);
    const float slope2 = exp2f(-2.0f * (float)(h + 1)) * LOG2E;
    float m = -1e30f, lsum = 0.f;
    f32x16 o[4];
#pragma unroll
    for (int d0 = 0; d0 < 4; ++d0) o[d0] = f32x16{};
    const int skey = tid >> 4, c16 = tid & 15;
    u32x4 st[4];
    const int kwoff = (c16 >> 3) * A_KSLOT + (((c16 & 7) ^ (skey & 7)) * 16) + skey * 128;
    const int vwoff = 2 * A_KSLOT + (((skey >> 3) * 4 + (c16 >> 2)) * 512) + (skey & 7) * 64 + (c16 & 3) * 16;
#define ATT_LOAD(t) do { const size_t r0_ = (rowbase + 64 * (t) + skey) * BW + h * 128 + c16 * 8; \
        st[0] = *(const u32x4*)(AK + r0_); st[1] = *(const u32x4*)(AK + r0_ + 32 * BW); st[2] = *(const u32x4*)(AV + r0_); st[3] = *(const u32x4*)(AV + r0_ + 32 * BW); } while (0)
#define ATT_WRITE(buf) do { *(LAS u32x4*)((buf) + kwoff) = st[0]; *(LAS u32x4*)((buf) + kwoff + 32 * 128) = st[1]; *(LAS u32x4*)((buf) + vwoff) = st[2]; *(LAS u32x4*)((buf) + vwoff + 8192) = st[3]; } while (0)
    const int kroff = mp * A_KSLOT + r32 * 128;
    const int vroff = 2 * A_KSLOT + (4 * hi + ((lane & 15) >> 2)) * 64 + ((lane >> 4) & 1) * 32 + (lane & 3) * 8;
    __syncthreads();
    ATT_LOAD(NT - 1); ATT_WRITE(lds);
    __syncthreads();
    int cur = 0;
    for (int t = NT - 1; t >= 0; --t) {
        lptr buf = lds + cur * A_TILE;
        if (t > 0) ATT_LOAD(t - 1);
        const bool skip = (t == NT - 1) && (qw < 2);
        if (!skip) {
            f32x16 p0 = f32x16{}, p1 = f32x16{};
#pragma unroll
            for (int d0 = 0; d0 < 4; ++d0) {
                const int ch = ((2 * d0 + hi) ^ (r32 & 7)) * 16;
                const bf16x8 a0 = ld8(buf + kroff + ch), a1 = ld8(buf + kroff + 32 * 128 + ch);
                p0 = MFMA32(a0, qf[d0], p0); p1 = MFMA32(a1, qf[d0], p1);
            }
            const int krel = 64 * t + 4 * hi - (q0 + r32);
            const float sb = slope2 * (float)krel;
#pragma unroll
            for (int r = 0; r < 16; ++r) { const float c = slope2 * (float)((r & 3) + 8 * (r >> 2)); p0[r] += sb + c; p1[r] += sb + c + 32.0f * slope2; }
            if (t >= NT - 2) {
#pragma unroll
                for (int r = 0; r < 16; ++r) { const int d = krel + (r & 3) + 8 * (r >> 2); if (d > 0) p0[r] = -INFINITY; if (d + 32 > 0) p1[r] = -INFINITY; }
            }
            float mx_ = fmaxf(p0[0], p1[0]);
#pragma unroll
            for (int r = 1; r < 16; ++r) mx_ = fmaxf(mx_, fmaxf(p0[r], p1[r]));
            mx_ = swap_max(mx_);
            const float mnew = fmaxf(m, mx_);
            if (__any(mnew > m)) {
                const float alpha = exp2f(m - mnew);
                lsum *= alpha; m = mnew;
                if (hi == 0) wsf[r32] = alpha;
#pragma unroll
                for (int r = 0; r < 16; ++r) { const float a = wsf[crow(r, hi)];
#pragma unroll
                    for (int d0 = 0; d0 < 4; ++d0) o[d0][r] *= a; }
            }
            float ps = 0.f;
#pragma unroll
            for (int r = 0; r < 16; ++r) { p0[r] = exp2f(p0[r] - m); p1[r] = exp2f(p1[r] - m); ps += p0[r] + p1[r]; }
            lsum += ps;
            const bf16x8 pa0 = pack_p(p0, 0), pa1 = pack_p(p0, 8), pa2 = pack_p(p1, 0), pa3 = pack_p(p1, 8);
#pragma unroll
            for (int d0 = 0; d0 < 4; ++d0) {
                lptr vb = buf + vroff + d0 * 512;
                const bf16x8 v0 = cat8(vtr(vb), vtr(vb + 2048)), v1 = cat8(vtr(vb + 4096), vtr(vb + 4096 + 2048));
                const bf16x8 v2 = cat8(vtr(vb + 8192), vtr(vb + 8192 + 2048)), v3 = cat8(vtr(vb + 12288), vtr(vb + 12288 + 2048));
                o[d0] = MFMA32(pa0, v0, o[d0]); o[d0] = MFMA32(pa1, v1, o[d0]); o[d0] = MFMA32(pa2, v2, o[d0]); o[d0] = MFMA32(pa3, v3, o[d0]);
            }
        }
        if (t > 0) ATT_WRITE(lds + (cur ^ 1) * A_TILE);
        __syncthreads();
        cur ^= 1;
    }
#undef ATT_LOAD
#undef ATT_WRITE
    lsum = swap_sum(lsum);
    if (hi == 0) wsf[32 + r32] = 1.0f / lsum;
    const float lam = ((const float*)(A.ws + WS_LAM))[l];
    LAS float* xch = (LAS float*)lds + qw * (4 * 16 * 64) + lane;
    if (mp == 1) {
#pragma unroll
        for (int r = 0; r < 16; ++r) { const float il = wsf[32 + crow(r, hi)] * lam;
#pragma unroll
            for (int d0 = 0; d0 < 4; ++d0) xch[(d0 * 16 + r) * 64] = o[d0][r] * il; }
    }
    __syncthreads();
    if (mp == 0) {
        float ss[16];
#pragma unroll
        for (int r = 0; r < 16; ++r) { const float il = wsf[32 + crow(r, hi)]; float s_ = 0.f;
#pragma unroll
            for (int d0 = 0; d0 < 4; ++d0) { const float y = o[d0][r] * il - xch[(d0 * 16 + r) * 64]; o[d0][r] = y; s_ += y * y; }
            ss[r] = s_; }
#pragma unroll
        for (int r = 0; r < 16; ++r) { float v = ss[r]; v += __shfl_xor(v, 1); v += __shfl_xor(v, 2); v += __shfl_xor(v, 4); v += __shfl_xor(v, 8); v += __shfl_xor(v, 16); ss[r] = v; }
        const float osc = 1.0f - lam_init_of(l);
        const float* asg = A.in[I_ASG] + l * 128;
        float gv[4];
#pragma unroll
        for (int d0 = 0; d0 < 4; ++d0) gv[d0] = asg[32 * d0 + r32] * osc;
        LAS bf16_t* stg = (LAS bf16_t*)(lds + A_STAGE) + qw * (32 * 128);
#pragma unroll
        for (int r = 0; r < 16; ++r) { const float rn = rsqrtf(ss[r] * (1.0f / 128.0f) + RMS_EPS); const int row = crow(r, hi);
#pragma unroll
            for (int d0 = 0; d0 < 4; ++d0) stg[row * 128 + 32 * d0 + r32] = (bf16_t)f2bf(o[d0][r] * rn * gv[d0]); }
        bf16_t* YA = (bf16_t*)(A.ws + WS_YA) + (rowbase + q0) * BW + h * 128;
#pragma unroll
        for (int i = 0; i < 8; ++i) { const int idx = lane + 64 * i, row = idx >> 4, ch = idx & 15;
            *(u32x4*)(YA + (size_t)row * BW + ch * 8) = *(const LAS u32x4*)(stg + row * 128 + ch * 8); }
    }
}

__device__ __forceinline__ int offa(int row, int ch) { return 2048 * (row >> 3) + 512 * (ch >> 2) + 64 * (row & 7) + 16 * ((ch & 3) ^ ((row >> 2) & 3)); }
constexpr int R_K = 0, R_V = 32768, R_RT = 65536, R_SS = 98304;
__device__ __forceinline__ void ret_task(const Args& A, int l, int b, int h, lptr lds) {
    const int tid = opaque_tid(), lane = tid & 63; const int wid = __builtin_amdgcn_readfirstlane(tid >> 6), qb = wid & 3, vh = wid >> 2;
    const bf16_t* RQ = (const bf16_t*)(A.ws + WS_RQ); const bf16_t* RK = (const bf16_t*)(A.ws + WS_RK); const bf16_t* RV = (const bf16_t*)(A.ws + WS_RV);
    const bf16_t* RG = (const bf16_t*)(A.ws + WS_RG); bf16_t* YC = (bf16_t*)(A.ws + WS_YC);
    const float l2g = log2_gamma(h); const float gam = exp2f(l2g), g127 = exp2f(127.0f * l2g), g128 = exp2f(128.0f * l2g);
    const float* gn = A.in[I_RGN] + l * 128;
    f32x16 R0 = f32x16{}, R1 = f32x16{};
    LAS float* ssq = (LAS float*)(lds + R_SS);
    for (int c = 0; c < SEQ / 128; ++c) {
        int ln = lane; asm volatile("" : "+v"(ln));
        const int r32 = ln & 31, hi = ln >> 5, tq = (ln & 15) >> 2, tp = ln & 3, tg = (ln >> 4) & 1, z = 2 * tg + (tp >> 1), w = (r32 >> 2) & 3;
        const int tnb0 = 2048 * hi + 64 * tq + 8 * (tp & 1) + 16 * (z ^ (2 * hi));
        const int tnb1 = 2048 * hi + 64 * (tq + 4) + 8 * (tp & 1) + 16 * (z ^ (2 * hi + 1));
        const int tpb0 = 64 * (4 * hi + tq) + 8 * (tp & 1) + 16 * (z ^ hi);
        const int tpb1 = 2048 + 64 * (4 * hi + tq) + 8 * (tp & 1) + 16 * (z ^ (2 + hi));
        const int rb0 = 2048 * (r32 >> 3) + 64 * (r32 & 7) + 16 * (hi ^ w);
        const int rb1 = 2048 * (r32 >> 3) + 64 * (r32 & 7) + 16 * ((2 + hi) ^ w);
        const size_t crow0 = (size_t)b * SEQ + 128 * c;
        __syncthreads();
        {
            const int srow = tid >> 4, sch = tid & 15;
            const int sb = 2048 * (srow >> 3) + 512 * (sch >> 2) + 64 * (srow & 7) + 16 * ((sch & 3) ^ ((srow >> 2) & 3));
            u32x4 st[4];
#pragma unroll
            for (int j = 0; j < 4; ++j) st[j] = *(const u32x4*)(RK + (crow0 + srow + 32 * j) * BW + h * 128 + sch * 8);
#pragma unroll
            for (int j = 0; j < 4; ++j) *(LAS u32x4*)(lds + R_K + sb + 8192 * j) = st[j];
#pragma unroll
            for (int j = 0; j < 4; ++j) st[j] = *(const u32x4*)(RV + (crow0 + srow + 32 * j) * BW + h * 128 + sch * 8);
#pragma unroll
            for (int j = 0; j < 4; ++j) *(LAS u32x4*)(lds + R_V + sb + 8192 * j) = st[j];
        }
        bf16x8 qf[8];
#pragma unroll
        for (int ds = 0; ds < 8; ++ds) qf[ds] = *(const bf16x8*)(RQ + (crow0 + 32 * qb + r32) * BW + h * 128 + ds * 16 + hi * 8);
        __syncthreads();
        f32x16 o0 = f32x16{}, o1 = f32x16{};
        for (int kb = 0; kb <= qb; ++kb) {
            f32x16 p = f32x16{};
            lptr kr = lds + R_K + 8192 * kb;
#pragma unroll
            for (int ds = 0; ds < 8; ++ds) p = MFMA32(ld8(kr + ((ds & 1) ? rb1 : rb0) + 512 * (ds >> 1)), qf[ds], p);
            if (kb == qb) {
#pragma unroll
                for (int r = 0; r < 16; ++r) if (crow(r, hi) > r32) p[r] = 0.f;
            }
            const bf16x8 pa0 = pack_p(p, 0), pa1 = pack_p(p, 8);
            lptr vr = lds + R_V + 8192 * kb + 512 * (2 * vh);
#pragma unroll
            for (int s2 = 0; s2 < 2; ++s2) {
                const bf16x8 pa = s2 ? pa1 : pa0;
                const bf16x8 vf0 = cat8(vtr(vr + tpb0 + 4096 * s2), vtr(vr + tpb1 + 4096 * s2));
                const bf16x8 vf1 = cat8(vtr(vr + 512 + tpb0 + 4096 * s2), vtr(vr + 512 + tpb1 + 4096 * s2));
                o0 = MFMA32(pa, vf0, o0); o1 = MFMA32(pa, vf1, o1);
            }
        }
        if (c > 0) {
            f32x16 x0 = f32x16{}, x1 = f32x16{};
            lptr rr = lds + R_RT + 256 * (64 * vh);
#pragma unroll
            for (int ds = 0; ds < 8; ++ds) {
                const int ob = ((ds & 1) ? rb1 : rb0) + 512 * (ds >> 1);
                x0 = MFMA32(qf[ds], ld8(rr + ob), x0);
                x1 = MFMA32(qf[ds], ld8(rr + 8192 + ob), x1);
            }
#pragma unroll
            for (int r = 0; r < 16; ++r) { o0[r] += gam * x0[r]; o1[r] += gam * x1[r]; }
        }
#pragma unroll
        for (int r = 0; r < 16; ++r) { float v = o0[r] * o0[r] + o1[r] * o1[r]; v += __shfl_xor(v, 1); v += __shfl_xor(v, 2); v += __shfl_xor(v, 4); v += __shfl_xor(v, 8); v += __shfl_xor(v, 16);
            if (r32 == 0) ssq[vh * 128 + 32 * qb + crow(r, hi)] = v; }
        __syncthreads();
        {
            f32x16 t0 = f32x16{}, t1 = f32x16{};
            lptr ka = lds + R_K + 512 * qb, va = lds + R_V + 512 * (2 * vh);
#pragma unroll
            for (int ks = 0; ks < 8; ++ks) {
                const bf16x8 kf = cat8(vtr(ka + tnb0 + 4096 * ks), vtr(ka + tnb1 + 4096 * ks));
                const bf16x8 v0 = cat8(vtr(va + tnb0 + 4096 * ks), vtr(va + tnb1 + 4096 * ks));
                const bf16x8 v1 = cat8(vtr(va + 512 + tnb0 + 4096 * ks), vtr(va + 512 + tnb1 + 4096 * ks));
                t0 = MFMA32(kf, v0, t0); t1 = MFMA32(kf, v1, t1);
            }
#pragma unroll
            for (int r = 0; r < 16; ++r) { R0[r] = g128 * R0[r] + g127 * t0[r]; R1[r] = g128 * R1[r] + g127 * t1[r]; }
            lptr rw = lds + R_RT + 256 * (64 * vh) + 2048 * (r32 >> 3) + 64 * (r32 & 7) + 512 * qb + 8 * hi;
#pragma unroll
            for (int g = 0; g < 4; ++g) {
                *(LAS u32x2*)(rw + 16 * (g ^ w)) = (u32x2){pg8::cvt_pk_bf16(R0[4 * g], R0[4 * g + 1]), pg8::cvt_pk_bf16(R0[4 * g + 2], R0[4 * g + 3])};
                *(LAS u32x2*)(rw + 8192 + 16 * (g ^ w)) = (u32x2){pg8::cvt_pk_bf16(R1[4 * g], R1[4 * g + 1]), pg8::cvt_pk_bf16(R1[4 * g + 2], R1[4 * g + 3])};
            }
        }
        const float gn0 = gn[64 * vh + r32], gn1 = gn[64 * vh + 32 + r32];
#pragma unroll
        for (int r = 0; r < 16; ++r) {
            const int row = 32 * qb + crow(r, hi);
            const float rn = rsqrtf((ssq[row] + ssq[128 + row]) * (1.0f / 128.0f) + RMS_EPS);
            const size_t off = (crow0 + row) * BW + h * 128 + 64 * vh + r32;
            YC[off] = (bf16_t)f2bf(o0[r] * rn * gn0 * bf2f(RG[off]));
            YC[off + 32] = (bf16_t)f2bf(o1[r] * rn * gn1 * bf2f(RG[off + 32]));
        }
    }
}
#undef MFMA32

__device__ __forceinline__ void conv_token(const Args& A, int l, int m, int lane) {
    const bf16_t* Z = (const bf16_t*)(A.ws + WS_Z); bf16_t* YB = (bf16_t*)(A.ws + WS_YB);
    const float* cw = A.in[I_CW] + (size_t)l * 31 * BW; const float* cb = A.in[I_CB] + l * BW;
    const float* lg = A.in[I_CLG] + l * BW; const float* lb = A.in[I_CLB] + l * BW;
    const int c0 = lane * 8, t = m & (SEQ - 1);
    float acc[8];
#pragma unroll
    for (int e = 0; e < 8; ++e) acc[e] = cb[c0 + e];
    const int j0 = max(0, 30 - t);
#pragma unroll 4
    for (int j = j0; j < 31; ++j) {
        const uint4 v = *(const uint4*)(Z + (size_t)(m - 30 + j) * BW + c0);
        const float4 wa = *(const float4*)(cw + j * BW + c0), wb = *(const float4*)(cw + j * BW + c0 + 4);
        acc[0] += wa.x * __uint_as_float(v.x << 16); acc[1] += wa.y * __uint_as_float(v.x & 0xffff0000u);
        acc[2] += wa.z * __uint_as_float(v.y << 16); acc[3] += wa.w * __uint_as_float(v.y & 0xffff0000u);
        acc[4] += wb.x * __uint_as_float(v.z << 16); acc[5] += wb.y * __uint_as_float(v.z & 0xffff0000u);
        acc[6] += wb.z * __uint_as_float(v.w << 16); acc[7] += wb.w * __uint_as_float(v.w & 0xffff0000u);
    }
    float s_ = 0.f;
#pragma unroll
    for (int e = 0; e < 8; ++e) s_ += acc[e];
    const float mu = wave_sum(s_) * (1.0f / BW);
    float q = 0.f;
#pragma unroll
    for (int e = 0; e < 8; ++e) { acc[e] -= mu; q += acc[e] * acc[e]; }
    const float rstd = rsqrtf(wave_sum(q) * (1.0f / BW) + LN_EPS);
    float o[8];
#pragma unroll
    for (int e = 0; e < 8; ++e) o[e] = siluf_(acc[e] * rstd * lg[c0 + e] + lb[c0 + e]);
    *(uint4*)(YB + (size_t)m * BW + c0) = make_uint4(pk2(o[0], o[1]), pk2(o[2], o[3]), pk2(o[4], o[5]), pk2(o[6], o[7]));
}

constexpr int N_RET = 16, N_ATT = 512, N_CONV = 256, N_TASKS = N_RET + N_ATT + N_CONV;
constexpr int CW_QUEUE = 8192;
__device__ __forceinline__ void mixer_phase(const Args& A, int l, lptr lds, volatile LAS unsigned* slot) {
    unsigned* ctr = (unsigned*)(A.ws + WS_CTL) + CW_QUEUE + 64 * l;
    for (;;) {
        __syncthreads();
        if (threadIdx.x == 0) *slot = __hip_atomic_fetch_add(ctr, 1u, __ATOMIC_RELAXED, __HIP_MEMORY_SCOPE_AGENT);
        __syncthreads();
        const int id = (int)*slot;
        if (id >= N_TASKS) break;
        if (id < N_RET) ret_task(A, l, id >> 2, id & 3, lds);
        else if (id < N_RET + N_ATT) { const int a = id - N_RET; attn_unit(A, l, (a & 15) >> 2, a & 3, 31 - (a >> 4), lds); }
        else { const int tid = opaque_tid(); const int m0 = (id - N_RET - N_ATT) * 64 + (tid >> 6) * 8;
            for (int i = 0; i < 8; ++i) conv_token(A, l, m0 + i, tid & 63); }
    }
}
}

constexpr int N_PHASES = 1 + 6 * DEPTH;
constexpr int RING_BYTES = 131072, MISC_OFF = RING_BYTES + 320, LDS_BYTES = 147456;
#ifndef FAST_GEMM
#define FAST_GEMM 1
#endif
#ifndef FAST_MIX
#define FAST_MIX 1
#endif
#ifndef FAST_MASK
#define FAST_MASK 0x3f
#endif
__global__ void __launch_bounds__(NTHREADS, 2) fwd_kernel(Args A) {
    extern __shared__ __attribute__((aligned(16))) unsigned char lds[];
    float* sm = (float*)lds;
    LAS unsigned char* ldsl = (LAS unsigned char*)lds;
    volatile LAS unsigned* MISC = (volatile LAS unsigned*)(ldsl + MISC_OFF);
    const int wg = blockIdx.x, nwg = gridDim.x;
    const bool multi = (A.ph_hi - A.ph_lo) > 1;
    XcdBarrier bar; bar.bar = nullptr; bar.x = 0; bar.st = nullptr;
    if (multi) {
        if (threadIdx.x < 2) MISC[threadIdx.x] = 0u;
        __syncthreads();
        bar = xcd_barrier_post((unsigned*)(A.ws + WS_CTL) + CW_BAR, MISC);
    }
    const Args& A0 = A;
    for (int ph = A0.ph_lo; ph < A0.ph_hi; ++ph) {
        Args A = A0;
#pragma unroll
        for (int i = 0; i < N_IN; ++i) asm volatile("" : "+s"(A.in[i]));
        asm volatile("" : "+s"(A.out), "+s"(A.ws));
        if (ph == 0) { nv_p0(A, wg, nwg); if (FAST_GEMM) fast_p0_weights(A, wg, nwg, sm); }
        else {
            const int l = (ph - 1) / 6, k = (ph - 1) % 6;
            if (k == 1) {
#if FAST_MIX
                mx::mixer_phase(A, l, ldsl, MISC + 4);
#else
                nv_attn(A, l, wg, nwg, sm); nv_conv(A, l, wg, nwg); nv_ret(A, l, wg, nwg, sm);
#endif
            }
            else if (FAST_GEMM && ((FAST_MASK >> k) & 1)) fast_gemm(A, l, k, ldsl);
            else if (k == 0) nv_p1(A, l, wg, nwg, sm);
            else if (k == 2) nv_p3(A, l, wg, nwg, sm);
            else if (k == 3) nv_resid_gemm(A, (const bf16_t*)(A.ws + WS_Y), DM, DM, A.in[I_WOUT] + (size_t)l * DM * DM, l == 0 ? A.in[I_X] : A.out,
                                           (float*)(A.ws + WS_ROWSS) + (size_t)(l == 0 ? 1 : 3) * M, wg, nwg, sm);
            else if (k == 4) nv_p5(A, l, wg, nwg, sm);
            else nv_resid_gemm(A, (const bf16_t*)(A.ws + WS_MID), DFF, DFF, A.in[I_WF2] + (size_t)l * DFF * DM, A.out,
                               l + 1 < DEPTH ? (float*)(A.ws + WS_ROWSS) + (size_t)2 * M : nullptr, wg, nwg, sm);
        }
        if (ph + 1 < A0.ph_hi) xcd_barrier(bar);
    }
}

extern "C" void kernel_launch(void* const* d_in, const int* in_sizes, int n_in, void* d_out, int out_size, void* d_ws, size_t ws_size, hipStream_t stream) {
    static int grid = 0;
    if (grid == 0) {
        if (n_in != N_IN || out_size != M * DM || ws_size < WS_END) { fprintf(stderr, "kernel_launch: unexpected shapes (n_in %d out %d ws %zu)\n", n_in, out_size, ws_size); grid = -1; return; }
        int dev = 0, cus = 0, per_cu = 0;
        (void)hipGetDevice(&dev); (void)hipDeviceGetAttribute(&cus, hipDeviceAttributeMultiprocessorCount, dev);
        (void)hipFuncSetAttribute((const void*)fwd_kernel, hipFuncAttributeMaxDynamicSharedMemorySize, LDS_BYTES);
        (void)hipOccupancyMaxActiveBlocksPerMultiprocessor(&per_cu, (const void*)fwd_kernel, NTHREADS, LDS_BYTES);
        (void)hipGetLastError();
        if (per_cu < 1) fprintf(stderr, "kernel_launch: occupancy query says %d blocks per CU\n", per_cu);
        grid = cus;
    }
    if (grid < 0) return;
    (void)hipMemsetAsync((char*)d_ws + WS_CTL, 0, CTL_ZERO_BYTES, stream);
    Args a{};
    for (int i = 0; i < N_IN; ++i) a.in[i] = (const float*)d_in[i];
    a.out = (float*)d_out; a.ws = (unsigned char*)d_ws;
    a.ph_lo = 0; a.ph_hi = N_PHASES;
    void* args[] = {&a};
    hipError_t e = hipLaunchCooperativeKernel((const void*)fwd_kernel, dim3(grid), dim3(NTHREADS), args, LDS_BYTES, stream);
    if (e != hipSuccess) fprintf(stderr, "cooperative launch failed: %s (grid %d)\n", hipGetErrorString(e), grid);
}
```

```cpp
#include <hip/hip_runtime.h>
#include <cstdio>
#include <cstdint>
#ifndef ABL_ATTN
#define ABL_ATTN 0
#endif
#ifndef PROBE_PHASE
#define PROBE_PHASE -1
#endif

#define GAS __attribute__((address_space(1)))
#define LAS __attribute__((address_space(3)))
typedef unsigned short bf16_t;
typedef GAS unsigned gu32;
#define RLX_AGENT __ATOMIC_RELAXED, __HIP_MEMORY_SCOPE_AGENT

constexpr int BATCH = 4, SEQ = 4096, DM = 1024, M = BATCH * SEQ, DEPTH = 2;
constexpr int DIN = 7680, NU = 4608, NGATE = 3072, DFF = 2816, BW = 512;
constexpr float RMS_EPS = 1e-6f, LN_EPS = 1e-5f;
constexpr float LOG2E = 1.4426950408889634f;
constexpr float QSCALE = 0.125f * LOG2E;
constexpr int NTHREADS = 512, NWAVES = 8;

enum { I_X = 0, I_N1G, I_WIN, I_QG, I_KG, I_DLAM, I_ASG, I_CW, I_CB, I_CLG, I_CLB, I_RGN, I_BGATE, I_WBR, I_WOUT, I_N2G, I_WF1, I_WF2, N_IN };

constexpr size_t MiB = 1u << 20;
constexpr size_t WS_CTL = 0, CTL_ZERO_BYTES = 1 * MiB;
constexpr size_t WS_ROWSS = 256 * 1024;
constexpr size_t WS_LAM = 512 * 1024;
constexpr size_t WS_XB = 78 * MiB;
constexpr size_t WS_AQ = 110 * MiB, WS_AK = 126 * MiB, WS_AV = 142 * MiB, WS_Z = 158 * MiB, WS_RQ = 174 * MiB, WS_RK = 190 * MiB, WS_RV = 206 * MiB, WS_RG = 222 * MiB, WS_YB = 238 * MiB;
constexpr size_t WS_YA = WS_AQ, WS_YC = WS_RQ;
constexpr size_t WS_Y = 126 * MiB;
constexpr size_t WS_MID = 110 * MiB;
constexpr size_t WS_END = 256 * MiB;
constexpr int CW_BAR = 4096;

struct Args { const float* in[N_IN]; float* out; unsigned char* ws; int ph_lo, ph_hi; };

__device__ __forceinline__ float bf2f(unsigned v) { return __uint_as_float(v << 16); }
__device__ __forceinline__ unsigned f2bf(float f) { unsigned u = __float_as_uint(f); return (u + 0x7fffu + ((u >> 16) & 1u)) >> 16; }
__device__ __forceinline__ unsigned pk2(float lo, float hi) { return f2bf(lo) | (f2bf(hi) << 16); }
__device__ __forceinline__ float wave_sum(float v) {
#pragma unroll
    for (int o = 1; o < 64; o <<= 1) v += __shfl_xor(v, o);
    return v;
}
__device__ __forceinline__ float wave_max(float v) {
#pragma unroll
    for (int o = 1; o < 64; o <<= 1) v = fmaxf(v, __shfl_xor(v, o));
    return v;
}
__device__ __forceinline__ int opaque_tid() { int t = threadIdx.x; asm volatile("" : "+v"(t)); return t; }
__device__ __forceinline__ float sigmoidf_(float x) { return 1.0f / (1.0f + __expf(-x)); }
__device__ __forceinline__ float siluf_(float x) { return x / (1.0f + __expf(-x)); }
__device__ __forceinline__ float lam_init_of(int l) { return l == 0 ? 0.2f : (0.8f - 0.6f * 0.74081822068171788f); }
__device__ __forceinline__ float log2_gamma(int h) { return log2f(1.0f - exp2f(-5.0f - (float)h)); }

#define XB_TMO      128
#define XB_XCNT(j)  (256  + 64 * (j))
#define XB_XSUB(j)  (1280 + 64 * (j))
#define XB_XGEN(j)  (2304 + 64 * (j))
#define XB_TOP      3328
#define XB_TOPGEN   3392
#define XCD_BAR_WORDS 3456
#define XB_SPIN_CAP (1u << 22)
__device__ __forceinline__ unsigned xb_ld(unsigned* p)              { return __hip_atomic_load(p, __ATOMIC_RELAXED, __HIP_MEMORY_SCOPE_AGENT); }
__device__ __forceinline__ unsigned xb_add(unsigned* p, unsigned v) { return __hip_atomic_fetch_add(p, v, __ATOMIC_RELAXED, __HIP_MEMORY_SCOPE_AGENT); }
__device__ __forceinline__ unsigned xb_xcc_id() { return (unsigned)__builtin_amdgcn_s_getreg((3 << 11) | 20) & 0xFu; }
#define XB_SPIN(cond, bar) do { unsigned _sp = 0; while (cond) { __builtin_amdgcn_s_sleep(1); \
    if ((++_sp & 255u) == 0u) { if (xb_ld(&(bar)[XB_TMO])) break; if (_sp > XB_SPIN_CAP) { atomicAdd(&(bar)[XB_TMO], 1u); break; } } } } while (0)
struct XcdBarrier { unsigned* bar; unsigned x; volatile LAS unsigned* st; };
__device__ __forceinline__ XcdBarrier xcd_barrier_post(unsigned* bar, volatile LAS unsigned* st) {
    XcdBarrier b; b.bar = bar; b.x = xb_xcc_id(); b.st = st;
    if (threadIdx.x == 0) (void)xb_add(&bar[XB_XCNT(b.x)], 1u);
    return b;
}
__device__ __forceinline__ void xcd_barrier_complete(unsigned* bar, unsigned x, unsigned& nloc, unsigned& nx) {
    const unsigned G = gridDim.x * gridDim.y * gridDim.z;
    unsigned sum, cnt, mine, sp = 0u;
    for (;;) {
        sum = 0u; cnt = 0u; mine = 0u;
#pragma unroll
        for (unsigned j = 0; j < 16; ++j) { const unsigned c = xb_ld(&bar[XB_XCNT(j)]); sum += c; cnt += (c > 0u) ? 1u : 0u; mine = (j == x) ? c : mine; }
        if (sum == G) break;
        __builtin_amdgcn_s_sleep(1);
        if ((++sp & 255u) == 0u) { if (xb_ld(&bar[XB_TMO])) break; if (sp > XB_SPIN_CAP) { atomicAdd(&bar[XB_TMO], 1u); break; } }
    }
    nloc = mine > 0u ? mine : 1u; nx = cnt > 0u ? cnt : 1u;
}
__device__ __forceinline__ void xcd_barrier(const XcdBarrier& b) {
    asm volatile("s_waitcnt vmcnt(0)" ::: "memory");
    __syncthreads();
    if (threadIdx.x == 0) {
        unsigned* bar = b.bar;
        __builtin_amdgcn_s_waitcnt(0);
        unsigned nloc = b.st[0], nx = b.st[1];
        if (nloc == 0u) { xcd_barrier_complete(bar, b.x, nloc, nx); b.st[0] = nloc; b.st[1] = nx; }
        const unsigned old = xb_add(&bar[XB_XSUB(b.x)], 1u);
        const unsigned gen = old / nloc;
        if (old + 1u == (gen + 1u) * nloc) {
            __builtin_amdgcn_fence(__ATOMIC_RELEASE, "agent");
            asm volatile("s_waitcnt vmcnt(0)" ::: "memory");
            const unsigned og = xb_add(&bar[XB_TOP], 1u);
            const unsigned tg = og / nx;
            if (og + 1u == (tg + 1u) * nx) xb_add(&bar[XB_TOPGEN], 1u);
            else XB_SPIN(xb_ld(&bar[XB_TOPGEN]) == tg, bar);
            __builtin_amdgcn_fence(__ATOMIC_ACQUIRE, "agent");
            xb_add(&bar[XB_XGEN(b.x)], 1u);
            asm volatile("s_waitcnt vmcnt(0)" ::: "memory");
        } else {
            XB_SPIN(xb_ld(&bar[XB_XGEN(b.x)]) == gen, bar);
            __builtin_amdgcn_fence(__ATOMIC_ACQUIRE, "agent");
            asm volatile("s_waitcnt vmcnt(0)" ::: "memory");
        }
    }
    __syncthreads();
}


__device__ __forceinline__ void nv_p0(const Args& A, int wg, int nwg) {
    const int tid = opaque_tid(), lane = tid & 63, wave = tid >> 6;
    const float* x = A.in[I_X];
    bf16_t* XB = (bf16_t*)(A.ws + WS_XB);
    float* rowss = (float*)(A.ws + WS_ROWSS);
    for (int m0 = wg * NWAVES + wave; m0 < M; m0 += 4 * nwg * NWAVES) {
        float4 v[4][4];
#pragma unroll
        for (int r = 0; r < 4; ++r) { const int m = m0 + r * nwg * NWAVES; if (m < M) { const float4* xr = (const float4*)(x + (size_t)m * DM) + lane;
#pragma unroll
            for (int j = 0; j < 4; ++j) v[r][j] = xr[64 * j]; } }
#pragma unroll
        for (int r = 0; r < 4; ++r) { const int m = m0 + r * nwg * NWAVES; if (m < M) { uint2* o = (uint2*)(XB + (size_t)m * DM) + lane; float s = 0.f;
#pragma unroll
            for (int j = 0; j < 4; ++j) { const float4 q = v[r][j]; s += q.x * q.x + q.y * q.y + q.z * q.z + q.w * q.w; o[64 * j] = make_uint2(pk2(q.x, q.y), pk2(q.z, q.w)); }
            s = wave_sum(s);
            if (lane == 0) rowss[m] = s; } }
    }
    if (wg == 0 && wave < DEPTH) {
        const float* dl = A.in[I_DLAM] + wave * 4 * 64;
        float a = dl[lane] * dl[64 + lane], b = dl[128 + lane] * dl[192 + lane];
        a = wave_sum(a); b = wave_sum(b);
        if (lane == 0) ((float*)(A.ws + WS_LAM))[wave] = __expf(a) - __expf(b) + lam_init_of(wave);
    }
}

template <class AL, class WL>
__device__ __forceinline__ void nv_core(float (&acc)[4][4], int K, const AL& aload, const WL& wload, float* sA, float* sB, int tid) {
    const int tx = tid & 15, ty = tid >> 4;
#pragma unroll
    for (int i = 0; i < 4; ++i)
#pragma unroll
        for (int j = 0; j < 4; ++j) acc[i][j] = 0.f;
    const int ar = tid & 127, akq = tid >> 7;
    const int wk = tid >> 5, wc = (tid & 31) * 2;
#pragma unroll 1
    for (int k0 = 0; k0 < K; k0 += 16) {
        float a0, a1, a2, a3; aload(ar, k0 + 4 * akq, a0, a1, a2, a3);
        const float w0 = wload(k0 + wk, wc), w1 = wload(k0 + wk, wc + 1);
        __syncthreads();
        sA[(4 * akq + 0) * 128 + ar] = a0; sA[(4 * akq + 1) * 128 + ar] = a1; sA[(4 * akq + 2) * 128 + ar] = a2; sA[(4 * akq + 3) * 128 + ar] = a3;
        sB[wk * 64 + wc] = w0; sB[wk * 64 + wc + 1] = w1;
        __syncthreads();
#pragma unroll 2
        for (int kk = 0; kk < 16; ++kk) {
            const float4 a = *(const float4*)&sA[kk * 128 + ty * 4];
            const float4 b = *(const float4*)&sB[kk * 64 + tx * 4];
            const float av[4] = {a.x, a.y, a.z, a.w}, bv[4] = {b.x, b.y, b.z, b.w};
#pragma unroll
            for (int i = 0; i < 4; ++i)
#pragma unroll
                for (int j = 0; j < 4; ++j) acc[i][j] += av[i] * bv[j];
        }
    }
    __syncthreads();
}
struct ALbf {
    const bf16_t* A; int lda; int row0;
    __device__ __forceinline__ void operator()(int r, int k, float& a0, float& a1, float& a2, float& a3) const {
        const uint2 v = *(const uint2*)(A + (size_t)(row0 + r) * lda + k);
        a0 = __uint_as_float(v.x << 16); a1 = __uint_as_float(v.x & 0xffff0000u); a2 = __uint_as_float(v.y << 16); a3 = __uint_as_float(v.y & 0xffff0000u);
    }
};
struct WLf32 {
    const float* W; int ldw; int c0, c1; const float* g;
    __device__ __forceinline__ float operator()(int k, int j) const {
        const float w = W[(size_t)k * ldw + (j < 32 ? c0 + j : c1 + j - 32)];
        return g ? w * g[k] : w;
    }
};

__device__ __forceinline__ void nv_p1(const Args& A, int l, int wg, int nwg, float* sm) {
    float* sA = sm; float* sB = sm + 16 * 128; float* sC = sB + 16 * 64;
    const int tid = opaque_tid(), tx = tid & 15, ty = tid >> 4;
    const float* Win = A.in[I_WIN] + (size_t)l * DM * DIN;
    const float* g1 = A.in[I_N1G] + l * DM;
    const bf16_t* XB = (const bf16_t*)(A.ws + WS_XB);
    const float* rowss = (const float*)(A.ws + WS_ROWSS) + (size_t)(l == 0 ? 0 : 2) * M;
    const float* qg = A.in[I_QG] + l * 64; const float* kg = A.in[I_KG] + l * 64;
    for (int it = wg; it < 128 * 72; it += nwg) {
        const int rt = it / 72, cg = it % 72, row0 = rt * 128;
        int c0 = 64 * cg, c1 = 64 * cg + 32;
        if (cg >= 24 && cg < 40) { c0 = 1536 + 32 * (cg - 24); c1 = 2048 + 32 * (cg - 24); }
        float acc[4][4];
        nv_core(acc, DM, ALbf{XB, DM, row0}, WLf32{Win, DIN, c0, c1, g1}, sA, sB, tid);
#pragma unroll
        for (int i = 0; i < 4; ++i) {
            const int r = ty * 4 + i; const float rstd = rsqrtf(rowss[row0 + r] * (1.0f / DM) + RMS_EPS);
#pragma unroll
            for (int j = 0; j < 4; ++j) sC[r * 65 + tx * 4 + j] = acc[i][j] * rstd;
        }
        __syncthreads();
        const int r = tid >> 2, q4 = tid & 3, m = row0 + r, t = m & (SEQ - 1);
        const float* cr = sC + r * 65;
        if (cg < 16) {
            float ss = 0.f;
#pragma unroll
            for (int j = 0; j < 16; ++j) { const float v = cr[q4 * 16 + j]; ss += v * v; }
            ss += __shfl_xor(ss, 1); ss += __shfl_xor(ss, 2);
            const float rn = rsqrtf(ss * (1.0f / 64.0f) + RMS_EPS);
            const bool isq = cg < 8; const float* gg = isq ? qg : kg; const float sc = isq ? QSCALE : 1.0f;
            bf16_t* o = (bf16_t*)(A.ws + (isq ? WS_AQ : WS_AK)) + (size_t)m * BW + (cg & 7) * 64 + q4 * 16;
#pragma unroll
            for (int j = 0; j < 16; ++j) o[j] = (bf16_t)f2bf(cr[q4 * 16 + j] * rn * gg[q4 * 16 + j] * sc);
        } else if (cg >= 24 && cg < 40) {
            bf16_t* o = (bf16_t*)(A.ws + WS_Z) + (size_t)m * BW + (cg - 24) * 32 + q4 * 8;
#pragma unroll
            for (int j = 0; j < 8; ++j) o[j] = (bf16_t)f2bf(cr[q4 * 8 + j] * sigmoidf_(cr[32 + q4 * 8 + j]));
        } else {
            size_t base; int cb; int kind;
            if (cg < 24)      { base = WS_AV; cb = cg - 16; kind = 0; }
            else if (cg < 48) { base = WS_RQ; cb = cg - 40; kind = 1; }
            else if (cg < 56) { base = WS_RK; cb = cg - 48; kind = 2; }
            else if (cg < 64) { base = WS_RV; cb = cg - 56; kind = 0; }
            else              { base = WS_RG; cb = cg - 64; kind = 3; }
            const int h = cb >> 1; const float l2g = log2_gamma(h); const float tp = (float)(t & 127);
            float f = 1.0f;
            if (kind == 1) f = exp2f(tp * l2g);
            if (kind == 2) f = 0.08838834764831845f * exp2f(-tp * l2g);
            bf16_t* o = (bf16_t*)(A.ws + base) + (size_t)m * BW + cb * 64 + q4 * 16;
#pragma unroll
            for (int j = 0; j < 16; ++j) { float v = cr[q4 * 16 + j]; v = (kind == 3) ? siluf_(v) : v * f; o[j] = (bf16_t)f2bf(v); }
        }
        __syncthreads();
    }
}

__device__ __forceinline__ void nv_attn(const Args& A, int l, int wg, int nwg, float* sm) {
    const int tid = opaque_tid(), lane = tid & 63, wave = tid >> 6;
    float* sq = sm + wave * 256;
    const bf16_t* AQ = (const bf16_t*)(A.ws + WS_AQ); const bf16_t* AK = (const bf16_t*)(A.ws + WS_AK); const bf16_t* AV = (const bf16_t*)(A.ws + WS_AV);
    bf16_t* YA = (bf16_t*)(A.ws + WS_YA);
    const float lam = ((const float*)(A.ws + WS_LAM))[l];
    const float* asg = A.in[I_ASG] + l * 128;
    const float osc = 1.0f - lam_init_of(l);
    for (int it = wg * NWAVES + wave; it < BATCH * 4 * SEQ; it += nwg * NWAVES) {
        const int t = it & (SEQ - 1), h = (it >> 12) & 3, b = it >> 14;
        const size_t mq = (size_t)b * SEQ + t;
        const float slope2 = exp2f(-2.0f * (float)(h + 1)) * LOG2E;
        sq[lane] = bf2f(AQ[mq * BW + h * 128 + lane]); sq[64 + lane] = bf2f(AQ[mq * BW + h * 128 + 64 + lane]);
        float m1 = -INFINITY, m2 = -INFINITY, l1 = 0.f, l2 = 0.f, o1a = 0.f, o1b = 0.f, o2a = 0.f, o2b = 0.f;
        for (int s0 = 0; s0 <= t; s0 += 64) {
            const int s = s0 + lane; const bool valid = s <= t;
            float d1 = 0.f, d2 = 0.f;
            if (valid) {
                const uint4* kr = (const uint4*)(AK + ((size_t)b * SEQ + s) * BW + h * 128);
#pragma unroll 2
                for (int c = 0; c < 8; ++c) {
                    const uint4 v = kr[c]; const unsigned w[4] = {v.x, v.y, v.z, v.w};
#pragma unroll
                    for (int e = 0; e < 4; ++e) { d1 += sq[c * 8 + 2 * e] * __uint_as_float(w[e] << 16) + sq[c * 8 + 2 * e + 1] * __uint_as_float(w[e] & 0xffff0000u); }
                }
#pragma unroll 2
                for (int c = 0; c < 8; ++c) {
                    const uint4 v = kr[8 + c]; const unsigned w[4] = {v.x, v.y, v.z, v.w};
#pragma unroll
                    for (int e = 0; e < 4; ++e) { d2 += sq[64 + c * 8 + 2 * e] * __uint_as_float(w[e] << 16) + sq[64 + c * 8 + 2 * e + 1] * __uint_as_float(w[e] & 0xffff0000u); }
                }
            }
            const float bias = slope2 * (float)(s - t);
            const float s1 = valid ? d1 + bias : -INFINITY, s2 = valid ? d2 + bias : -INFINITY;
            const float n1 = fmaxf(m1, wave_max(s1)), n2 = fmaxf(m2, wave_max(s2));
            const float a1 = exp2f(m1 - n1), a2 = exp2f(m2 - n2);
            const float p1 = exp2f(s1 - n1), p2 = exp2f(s2 - n2);
            l1 = l1 * a1 + wave_sum(p1); l2 = l2 * a2 + wave_sum(p2);
            o1a *= a1; o1b *= a1; o2a *= a2; o2b *= a2; m1 = n1; m2 = n2;
            sq[128 + lane] = p1; sq[192 + lane] = p2;
            const int nk = min(64, t - s0 + 1);
            const unsigned* vr = (const unsigned*)(AV + ((size_t)b * SEQ + s0) * BW + h * 128) + lane;
            for (int j = 0; j < nk; ++j) {
                const unsigned v = vr[(size_t)j * (BW / 2)];
                const float va = __uint_as_float(v << 16), vb = __uint_as_float(v & 0xffff0000u);
                const float q1 = sq[128 + j], q2 = sq[192 + j];
                o1a += q1 * va; o1b += q1 * vb; o2a += q2 * va; o2b += q2 * vb;
            }
        }
        const float i1 = 1.0f / l1, i2 = lam / l2;
        const float ya = o1a * i1 - o2a * i2, yb = o1b * i1 - o2b * i2;
        const float ss = wave_sum(ya * ya + yb * yb);
        const float rn = rsqrtf(ss * (1.0f / 128.0f) + RMS_EPS) * osc;
        ((unsigned*)(YA + mq * BW + h * 128))[lane] = pk2(ya * rn * asg[2 * lane], yb * rn * asg[2 * lane + 1]);
    }
}

__device__ __forceinline__ void nv_conv(const Args& A, int l, int wg, int nwg) {
    const int tid = opaque_tid(), lane = tid & 63, wave = tid >> 6;
    const bf16_t* Z = (const bf16_t*)(A.ws + WS_Z); bf16_t* YB = (bf16_t*)(A.ws + WS_YB);
    const float* cw = A.in[I_CW] + (size_t)l * 31 * BW; const float* cb = A.in[I_CB] + l * BW;
    const float* lg = A.in[I_CLG] + l * BW; const float* lb = A.in[I_CLB] + l * BW;
    const int c0 = lane * 8;
    for (int m = wg * NWAVES + wave; m < M; m += nwg * NWAVES) {
        const int t = m & (SEQ - 1);
        float acc[8];
#pragma unroll
        for (int e = 0; e < 8; ++e) acc[e] = cb[c0 + e];
        const int j0 = max(0, 30 - t);
        for (int j = j0; j < 31; ++j) {
            const uint4 v = *(const uint4*)(Z + (size_t)(m - 30 + j) * BW + c0);
            const float4 wa = *(const float4*)(cw + j * BW + c0), wb = *(const float4*)(cw + j * BW + c0 + 4);
            acc[0] += wa.x * __uint_as_float(v.x << 16); acc[1] += wa.y * __uint_as_float(v.x & 0xffff0000u);
            acc[2] += wa.z * __uint_as_float(v.y << 16); acc[3] += wa.w * __uint_as_float(v.y & 0xffff0000u);
            acc[4] += wb.x * __uint_as_float(v.z << 16); acc[5] += wb.y * __uint_as_float(v.z & 0xffff0000u);
            acc[6] += wb.z * __uint_as_float(v.w << 16); acc[7] += wb.w * __uint_as_float(v.w & 0xffff0000u);
        }
        float s = 0.f;
#pragma unroll
        for (int e = 0; e < 8; ++e) s += acc[e];
        const float mu = wave_sum(s) * (1.0f / BW);
        float q = 0.f;
#pragma unroll
        for (int e = 0; e < 8; ++e) { acc[e] -= mu; q += acc[e] * acc[e]; }
        const float rstd = rsqrtf(wave_sum(q) * (1.0f / BW) + LN_EPS);
        float o[8];
#pragma unroll
        for (int e = 0; e < 8; ++e) o[e] = siluf_(acc[e] * rstd * lg[c0 + e] + lb[c0 + e]);
        *(uint4*)(YB + (size_t)m * BW + c0) = make_uint4(pk2(o[0], o[1]), pk2(o[2], o[3]), pk2(o[4], o[5]), pk2(o[6], o[7]));
    }
}

__device__ __forceinline__ void nv_ret(const Args& A, int l, int wg, int nwg, float* sm) {
    const int tid = opaque_tid(), lane = tid & 63, wave = tid >> 6;
    float* sq = sm + wave * 256;
    const bf16_t* RQ = (const bf16_t*)(A.ws + WS_RQ); const bf16_t* RK = (const bf16_t*)(A.ws + WS_RK); const bf16_t* RV = (const bf16_t*)(A.ws + WS_RV);
    const bf16_t* RG = (const bf16_t*)(A.ws + WS_RG); bf16_t* YC = (bf16_t*)(A.ws + WS_YC);
    const float* gn = A.in[I_RGN] + l * 128;
    for (int it = wg * NWAVES + wave; it < BATCH * 4 * SEQ; it += nwg * NWAVES) {
        const int t = it & (SEQ - 1), h = (it >> 12) & 3, b = it >> 14;
        const size_t mq = (size_t)b * SEQ + t;
        const float l2g128 = 128.0f * log2_gamma(h);
        { const unsigned v = ((const unsigned*)(RQ + mq * BW + h * 128))[lane]; sq[2 * lane] = __uint_as_float(v << 16); sq[2 * lane + 1] = __uint_as_float(v & 0xffff0000u); }
        float oa = 0.f, ob = 0.f;
        const int ct = t >> 7;
        for (int s0 = 0; s0 <= t; s0 += 64) {
            const int s = s0 + lane; const bool valid = s <= t;
            float d = 0.f;
            if (valid) {
                const uint4* kr = (const uint4*)(RK + ((size_t)b * SEQ + s) * BW + h * 128);
#pragma unroll 2
                for (int c = 0; c < 16; ++c) {
                    const uint4 v = kr[c]; const unsigned w[4] = {v.x, v.y, v.z, v.w};
#pragma unroll
                    for (int e = 0; e < 4; ++e) { d += sq[c * 8 + 2 * e] * __uint_as_float(w[e] << 16) + sq[c * 8 + 2 * e + 1] * __uint_as_float(w[e] & 0xffff0000u); }
                }
                d *= exp2f(l2g128 * (float)(ct - (s >> 7)));
            }
            sq[128 + lane] = d;
            const int nk = min(64, t - s0 + 1);
            const unsigned* vr = (const unsigned*)(RV + ((size_t)b * SEQ + s0) * BW + h * 128) + lane;
            for (int j = 0; j < nk; ++j) {
                const unsigned v = vr[(size_t)j * (BW / 2)];
                const float a = sq[128 + j];
                oa += a * __uint_as_float(v << 16); ob += a * __uint_as_float(v & 0xffff0000u);
            }
        }
        const float ss = wave_sum(oa * oa + ob * ob);
        const float rn = rsqrtf(ss * (1.0f / 128.0f) + RMS_EPS);
        const unsigned gv = ((const unsigned*)(RG + mq * BW + h * 128))[lane];
        ((unsigned*)(YC + mq * BW + h * 128))[lane] = pk2(oa * rn * gn[2 * lane] * __uint_as_float(gv << 16), ob * rn * gn[2 * lane + 1] * __uint_as_float(gv & 0xffff0000u));
    }
}

__device__ __forceinline__ void nv_p3(const Args& A, int l, int wg, int nwg, float* sm) {
    float* sA = sm; float* sB = sm + 16 * 128;
    const int tid = opaque_tid(), tx = tid & 15, ty = tid >> 4;
    const float* Win = A.in[I_WIN] + (size_t)l * DM * DIN;
    const float* g1 = A.in[I_N1G] + l * DM;
    const float* bg = A.in[I_BGATE] + l * NGATE;
    const float* Wbr = A.in[I_WBR] + (size_t)l * 3 * BW * DM;
    const bf16_t* XB = (const bf16_t*)(A.ws + WS_XB);
    const float* rowss = (const float*)(A.ws + WS_ROWSS) + (size_t)(l == 0 ? 0 : 2) * M;
    bf16_t* Y = (bf16_t*)(A.ws + WS_Y);
    for (int it = wg; it < 128 * 16; it += nwg) {
        const int rt = it / 16, cg = it % 16, row0 = rt * 128;
        float y[4][4];
#pragma unroll
        for (int i = 0; i < 4; ++i)
#pragma unroll
            for (int j = 0; j < 4; ++j) y[i][j] = 0.f;
#pragma unroll 1
        for (int n = 0; n < 3; ++n) {
            float ga[4][4], pa[4][4];
            nv_core(ga, DM, ALbf{XB, DM, row0}, WLf32{Win, DIN, NU + n * DM + 64 * cg, NU + n * DM + 64 * cg + 32, g1}, sA, sB, tid);
            const bf16_t* br = (const bf16_t*)(A.ws + (n == 0 ? WS_YA : n == 1 ? WS_YB : WS_YC));
            nv_core(pa, BW, ALbf{br, BW, row0}, WLf32{Wbr + (size_t)n * BW * DM, DM, 64 * cg, 64 * cg + 32, nullptr}, sA, sB, tid);
#pragma unroll
            for (int i = 0; i < 4; ++i) {
                const float rstd = rsqrtf(rowss[row0 + ty * 4 + i] * (1.0f / DM) + RMS_EPS);
#pragma unroll
                for (int j = 0; j < 4; ++j) y[i][j] += sigmoidf_(ga[i][j] * rstd + bg[n * DM + 64 * cg + tx * 4 + j]) * pa[i][j];
            }
        }
#pragma unroll
        for (int i = 0; i < 4; ++i)
            *(uint2*)(Y + (size_t)(row0 + ty * 4 + i) * DM + 64 * cg + tx * 4) = make_uint2(pk2(y[i][0], y[i][1]), pk2(y[i][2], y[i][3]));
    }
}

__device__ __forceinline__ void nv_resid_gemm(const Args& A, const bf16_t* Am, int lda, int K, const float* W, const float* xold, float* rowss_next, int wg, int nwg, float* sm) {
    float* sA = sm; float* sB = sm + 16 * 128;
    const int tid = opaque_tid(), tx = tid & 15, ty = tid >> 4;
    bf16_t* XB = (bf16_t*)(A.ws + WS_XB);
    for (int it = wg; it < 128 * 16; it += nwg) {
        const int rt = it / 16, cg = it % 16, row0 = rt * 128;
        float acc[4][4];
        nv_core(acc, K, ALbf{Am, lda, row0}, WLf32{W, DM, 64 * cg, 64 * cg + 32, nullptr}, sA, sB, tid);
#pragma unroll
        for (int i = 0; i < 4; ++i) {
            const size_t off = (size_t)(row0 + ty * 4 + i) * DM + 64 * cg + tx * 4;
            const float4 xo = *(const float4*)(xold + off);
            const float4 xn = make_float4(xo.x + acc[i][0], xo.y + acc[i][1], xo.z + acc[i][2], xo.w + acc[i][3]);
            *(float4*)(A.out + off) = xn;
            *(uint2*)(XB + off) = make_uint2(pk2(xn.x, xn.y), pk2(xn.z, xn.w));
            float s = xn.x * xn.x + xn.y * xn.y + xn.z * xn.z + xn.w * xn.w;
            s += __shfl_xor(s, 1); s += __shfl_xor(s, 2); s += __shfl_xor(s, 4); s += __shfl_xor(s, 8);
            if (tx == 0 && rowss_next) atomicAdd(rowss_next + row0 + ty * 4 + i, s);
        }
    }
}

__device__ __forceinline__ void nv_p5(const Args& A, int l, int wg, int nwg, float* sm) {
    float* sA = sm; float* sB = sm + 16 * 128; float* sC = sB + 16 * 64;
    const int tid = opaque_tid(), tx = tid & 15, ty = tid >> 4;
    const float* W = A.in[I_WF1] + (size_t)l * DM * 2 * DFF;
    const float* g2 = A.in[I_N2G] + l * DM;
    const bf16_t* XB = (const bf16_t*)(A.ws + WS_XB);
    const float* rowss = (const float*)(A.ws + WS_ROWSS) + (size_t)(l == 0 ? 1 : 3) * M;
    bf16_t* MID = (bf16_t*)(A.ws + WS_MID);
    for (int it = wg; it < 128 * 88; it += nwg) {
        const int rt = it / 88, jj = it % 88, row0 = rt * 128;
        float acc[4][4];
        nv_core(acc, DM, ALbf{XB, DM, row0}, WLf32{W, 2 * DFF, 32 * jj, DFF + 32 * jj, g2}, sA, sB, tid);
#pragma unroll
        for (int i = 0; i < 4; ++i) {
            const int r = ty * 4 + i; const float rstd = rsqrtf(rowss[row0 + r] * (1.0f / DM) + RMS_EPS);
#pragma unroll
            for (int j = 0; j < 4; ++j) sC[r * 65 + tx * 4 + j] = acc[i][j] * rstd;
        }
        __syncthreads();
        const int r = tid >> 2, q4 = tid & 3;
        const float* cr = sC + r * 65;
        bf16_t* o = MID + (size_t)(row0 + r) * DFF + 32 * jj + q4 * 8;
#pragma unroll
        for (int j = 0; j < 8; ++j) o[j] = (bf16_t)f2bf(siluf_(cr[q4 * 8 + j]) * cr[32 + q4 * 8 + j]);
        __syncthreads();
    }
}


namespace pg8 {
typedef short bf16x8 __attribute__((ext_vector_type(8)));
typedef float f32x4 __attribute__((ext_vector_type(4)));
typedef unsigned u32x4 __attribute__((ext_vector_type(4)));
constexpr int BM = 256, BK = 64, HALF = 128, HTB = HALF * BK * 2, STAGE_BYTES = 8 * HTB, NXCD = 8, WGM = 8;
__host__ __device__ __forceinline__ int lds_byte(int r, int c) { const int st = (r >> 4) * 2 + (c >> 5), rr = r & 15, cc = c & 31, ob = rr * 64 + cc * 2; return st * 1024 + (ob ^ (((ob >> 9) & 1) << 5)); }
__host__ __device__ __forceinline__ void stage_rc(int b, int& R, int& C) { const int st = b / 1024, sb = b % 1024, swz = sb ^ (((sb >> 9) & 1) << 5); R = (st >> 1) * 16 + swz / 64; C = (st & 1) * 32 + (swz % 64) / 2; }
__host__ __device__ __forceinline__ int perm32(int rho) { const int n = rho >> 4, i = rho & 15; return 8 * (i >> 2) + 4 * n + (i & 3); }

struct GUnit { const char* A; const char* B; int lda2, ldb2, nt, pm, pn, kind; };

struct TileOrder {
    int nM, nN, nwg, G, c;
    __device__ __forceinline__ void init(int nM_, int nN_, int G_, int c_) { nM = nM_; nN = nN_; nwg = nM * nN; G = G_; c = c_; }
    __device__ __forceinline__ bool tile(int i, int& pm, int& pn) const {
        const long L = (long)i * G + c; if (L >= nwg) return false;
        int wgid = (int)L; { const int q = nwg / NXCD, r = nwg % NXCD, xcd = wgid % NXCD, off = wgid / NXCD; wgid = (xcd < r ? xcd * (q + 1) : r * (q + 1) + (xcd - r) * q) + off; }
        const int nig = WGM * nN, gid = wgid / nig, fm = gid * WGM, gsz = (nM - fm) < WGM ? (nM - fm) : WGM;
        pm = fm + ((wgid % nig) % gsz); pn = (wgid % nig) / gsz; return true;
    }
};

typedef float f32x2_t __attribute__((ext_vector_type(2))); typedef __bf16 bf16x2_t __attribute__((ext_vector_type(2)));
__device__ __forceinline__ unsigned cvt_pk_bf16(float lo, float hi) { f32x2_t v = {lo, hi}; bf16x2_t b = __builtin_convertvector(v, bf16x2_t); return __builtin_bit_cast(unsigned, b); }
__device__ __forceinline__ u32x4 pack8(const f32x4& a, const f32x4& b) { u32x4 w; w.x = cvt_pk_bf16(a[0], a[1]); w.y = cvt_pk_bf16(a[2], a[3]); w.z = cvt_pk_bf16(b[0], b[1]); w.w = cvt_pk_bf16(b[2], b[3]); return w; }

template <class Epi, class Sched>
__device__ __forceinline__ void gemm_phase(LAS unsigned char* lds, const Sched& S, const Epi& E) {
    const int tid = opaque_tid(), wid = __builtin_amdgcn_readfirstlane(tid >> 6), lane = tid & 63, wr = wid >> 2, wc = wid & 3, fr = lane & 15, fq = lane >> 4;
    const size_t kstep = (size_t)(BK * 2);
    const unsigned ldsw = (unsigned)wid * 1024u;
    const int aoff = lds_byte(wr * 64 + fr, fq * 8), boff = lds_byte(wc * 32 + fr, fq * 8);
#define PG8_SA(b, h) (((b) * 2 + (h)) * HTB)
#define PG8_SB(b, h) ((4 + (b) * 2 + (h)) * HTB)
#define PG8_STAGE(bufoff, gbase, voff) do { _Pragma("unroll") for (int _i = 0; _i < 2; ++_i) \
        __builtin_amdgcn_global_load_lds((const unsigned*)((const char*)(gbase) + (voff)[_i]), (LAS unsigned*)(lds + (bufoff) + ldsw + _i * 8192), 16, 0, 0); } while (0)
#define PG8_LDA(dst, b, h) do { _Pragma("unroll") for (int m = 0; m < 4; ++m) _Pragma("unroll") for (int k = 0; k < 2; ++k) dst[m][k] = *(const LAS bf16x8*)(lds + PG8_SA(b, h) + aoff + m * 2048 + k * 1024); } while (0)
#define PG8_LDB(dst, b, h) do { _Pragma("unroll") for (int n = 0; n < 2; ++n) _Pragma("unroll") for (int k = 0; k < 2; ++k) dst[n][k] = *(const LAS bf16x8*)(lds + PG8_SB(b, h) + boff + n * 2048 + k * 1024); } while (0)
#define PG8_MMA(ai, bj, At, Bt) do { __builtin_amdgcn_s_setprio(1); _Pragma("unroll") for (int m = 0; m < 4; ++m) _Pragma("unroll") for (int n = 0; n < 2; ++n) _Pragma("unroll") for (int k = 0; k < 2; ++k) \
        acc[ai][bj][m][n] = __builtin_amdgcn_mfma_f32_16x16x32_bf16(Bt[n][k], At[m][k], acc[ai][bj][m][n], 0, 0, 0); __builtin_amdgcn_s_setprio(0); } while (0)
#define PG8_WAIT_V(n) asm volatile("s_waitcnt vmcnt(" #n ")" ::: "memory")
#define PG8_WAIT_L(n) asm volatile("s_waitcnt lgkmcnt(" #n ")" ::: "memory")
#define PG8_BAR __builtin_amdgcn_s_barrier()
#define PG8_SCHED __builtin_amdgcn_sched_barrier(0)
    GUnit cur, nxt; int ui = 0;
    if (!S.next(0, cur)) return;
    f32x4 acc[2][2][4][2];
#pragma unroll
    for (int a = 0; a < 2; ++a)
#pragma unroll
        for (int b = 0; b < 2; ++b)
#pragma unroll
            for (int m = 0; m < 4; ++m)
#pragma unroll
                for (int n = 0; n < 2; ++n) acc[a][b][m][n] = (f32x4){0.f, 0.f, 0.f, 0.f};
    bf16x8 At[4][2], B0[2][2], B1[2][2];
#define PG8_VOFF(vA_, vB_, lda2_, ldb2_) do { int tt_ = tid; asm volatile("" : "+v"(tt_)); _Pragma("unroll") for (int i_ = 0; i_ < 2; ++i_) { int R_, C_; stage_rc(tt_ * 16 + i_ * 8192, R_, C_); \
        vA_[i_] = (unsigned)(R_ * (lda2_) + C_ * 2); vB_[i_] = (unsigned)(((R_ & ~31) + perm32(R_ & 31)) * (ldb2_) + C_ * 2); } } while (0)
    const char* cA = cur.A; const char* cB = cur.B; size_t hA = (size_t)HALF * cur.lda2, hB = (size_t)HALF * cur.ldb2;
    unsigned vA[2], vB[2]; PG8_VOFF(vA, vB, cur.lda2, cur.ldb2);
    {
    PG8_STAGE(PG8_SB(0, 0), cB, vB); PG8_STAGE(PG8_SB(0, 1), cB + hB, vB); PG8_STAGE(PG8_SA(0, 0), cA, vA); PG8_STAGE(PG8_SA(0, 1), cA + hA, vA);
    if (wr == 1) PG8_BAR;
    PG8_WAIT_V(2); PG8_BAR;
    PG8_STAGE(PG8_SB(1, 0), cB + kstep, vB); PG8_STAGE(PG8_SA(1, 0), cA + kstep, vA); PG8_STAGE(PG8_SB(1, 1), cB + hB + kstep, vB);
    PG8_WAIT_V(6); PG8_BAR; }
    for (;;) {
        const bool has_next = S.next(ui + 1, nxt);
        if (!has_next) nxt = cur;
        const size_t nhA = (size_t)HALF * nxt.lda2, nhB = (size_t)HALF * nxt.ldb2;
        const int nt = cur.nt;
        unsigned wA[2], wB[2];
        for (int t = 0; t < nt; t += 2) {
            const bool last = (t == nt - 2);
            const char* a1 = cA + (size_t)(t + 1) * kstep;
            const char* a2 = last ? nxt.A : cA + (size_t)(t + 2) * kstep; const char* b2 = last ? nxt.B : cB + (size_t)(t + 2) * kstep;
            const char* a3 = a2 + kstep; const char* b3 = b2 + kstep;
            const size_t whA = last ? nhA : hA, whB = last ? nhB : hB;
            PG8_LDB(B0, 0, 0); PG8_LDB(B1, 0, 1); PG8_SCHED; PG8_LDA(At, 0, 0);
            PG8_STAGE(PG8_SA(1, 1), a1 + hA, vA);
            if (last) PG8_VOFF(wA, wB, nxt.lda2, nxt.ldb2); else { wA[0] = vA[0]; wA[1] = vA[1]; wB[0] = vB[0]; wB[1] = vB[1]; }
            PG8_WAIT_V(8); PG8_WAIT_L(0); PG8_BAR; PG8_MMA(0, 0, At, B0); PG8_MMA(0, 1, At, B1); PG8_BAR; PG8_SCHED;
            PG8_LDA(At, 0, 1); PG8_STAGE(PG8_SB(0, 0), b2, wB); PG8_STAGE(PG8_SB(0, 1), b2 + whB, wB); PG8_STAGE(PG8_SA(0, 0), a2, wA);
            PG8_WAIT_V(8); PG8_WAIT_L(0); PG8_BAR; PG8_MMA(1, 0, At, B0); PG8_MMA(1, 1, At, B1); PG8_BAR; PG8_SCHED;
            PG8_LDB(B0, 1, 0); PG8_LDB(B1, 1, 1); PG8_SCHED; PG8_LDA(At, 1, 0); PG8_STAGE(PG8_SA(0, 1), a2 + whA, wA);
            PG8_WAIT_V(8); PG8_WAIT_L(0); PG8_BAR; PG8_MMA(0, 0, At, B0); PG8_MMA(0, 1, At, B1); PG8_BAR; PG8_SCHED;
            PG8_LDA(At, 1, 1); PG8_STAGE(PG8_SB(1, 0), b3, wB); PG8_STAGE(PG8_SB(1, 1), b3 + whB, wB); PG8_STAGE(PG8_SA(1, 0), a3, wA);
            PG8_WAIT_V(8); PG8_WAIT_L(0); PG8_BAR; PG8_MMA(1, 0, At, B0); PG8_MMA(1, 1, At, B1); PG8_BAR; PG8_SCHED;
        }
        if (wr == 0) PG8_BAR;
        { int fr_ = fr, fq_ = fq; asm volatile("" : "+v"(fr_), "+v"(fq_));
          E(acc, cur, wr, wc, fr_, fq_); }
        if (!has_next) break;
#pragma unroll
        for (int a = 0; a < 2; ++a)
#pragma unroll
            for (int b = 0; b < 2; ++b)
#pragma unroll
                for (int m = 0; m < 4; ++m)
#pragma unroll
                    for (int n = 0; n < 2; ++n) acc[a][b][m][n] = (f32x4){0.f, 0.f, 0.f, 0.f};
        cur = nxt; cA = cur.A; cB = cur.B; hA = nhA; hB = nhB;
        vA[0] = wA[0]; vA[1] = wA[1]; vB[0] = wB[0]; vB[1] = wB[1];
        ++ui;
        if (wr == 1) PG8_BAR;
    }
    PG8_WAIT_V(0);
    PG8_BAR;
#undef PG8_VOFF
#undef PG8_SA
#undef PG8_SB
#undef PG8_STAGE
#undef PG8_LDA
#undef PG8_LDB
#undef PG8_MMA
#undef PG8_WAIT_V
#undef PG8_WAIT_L
#undef PG8_BAR
#undef PG8_SCHED
}
}
using pg8::f32x4; using pg8::u32x4; using pg8::GUnit;

constexpr size_t WS_WB = 2 * MiB, WB_LAYER = 37 * MiB;
constexpr size_t WB_W1 = 0, WB_WG = 9 * MiB, WB_WBR = 15 * MiB, WB_WO = 18 * MiB, WB_WF1 = 20 * MiB, WB_WF2 = 31 * MiB;
constexpr size_t WS_GSCR = 190 * MiB;
static_assert(WS_WB + 2 * WB_LAYER <= WS_XB, "weights vs XB");

__device__ __forceinline__ int p1_src_col(int tile, int p) {
    if (tile < 4) return (tile >> 1) * 512 + (tile & 1) * 256 + 64 * ((p >> 5) & 3) + 32 * (p >> 7);
    if (tile < 6) return 1024 + (tile - 4) * 256 + p;
    if (tile < 10) return (p < 128) ? 1536 + 128 * (tile - 6) + p : 2048 + 128 * (tile - 6) + (p - 128);
    return 2560 + (tile - 10) * 256 + p;
}
__device__ __forceinline__ void p0_titem(const float* W, int ldw, int src0, const float* g, bf16_t* WT, int K, int prow0, int k0, LAS float* scr, int lane) {
    const int kr = lane >> 3, cq = (lane & 7) * 4;
    f32x4 v[8];
#pragma unroll
    for (int i = 0; i < 8; ++i) v[i] = *(const f32x4*)(W + (size_t)(k0 + 8 * i + kr) * ldw + src0 + cq);
    if (g) {
#pragma unroll
        for (int i = 0; i < 8; ++i) v[i] = v[i] * g[k0 + 8 * i + kr];
    }
#pragma unroll
    for (int i = 0; i < 8; ++i) { LAS float* d = scr + (8 * i + kr) * 33 + cq; d[0] = v[i][0]; d[1] = v[i][1]; d[2] = v[i][2]; d[3] = v[i][3]; }
    asm volatile("s_waitcnt lgkmcnt(0)" ::: "memory");
    const int c = lane & 7;
#pragma unroll
    for (int j = 0; j < 4; ++j) { const int n = (lane >> 3) + 8 * j; const LAS float* s_ = scr + (8 * c) * 33 + n;
        u32x4 o; o.x = pg8::cvt_pk_bf16(s_[0 * 33], s_[1 * 33]); o.y = pg8::cvt_pk_bf16(s_[2 * 33], s_[3 * 33]); o.z = pg8::cvt_pk_bf16(s_[4 * 33], s_[5 * 33]); o.w = pg8::cvt_pk_bf16(s_[6 * 33], s_[7 * 33]);
        *(u32x4*)(WT + (size_t)(prow0 + n) * K + k0 + 8 * c) = o; }
    asm volatile("s_waitcnt lgkmcnt(0)" ::: "memory");
}
constexpr int NI_W1 = 144 * 16, NI_WG = 96 * 16, NI_WBR = 3 * 32 * 8, NI_WO = 32 * 16, NI_F1 = 176 * 16, NI_F2 = 32 * 44;
constexpr int PER_LAYER = NI_W1 + NI_WG + NI_WBR + NI_WO + NI_F1 + NI_F2;
__device__ __forceinline__ void fast_p0_weights(const Args& A, int wg, int nwg, LAS float* sm, int item_lo, int item_hi) {
    const int tid = opaque_tid(), lane = tid & 63, wave = tid >> 6;
    LAS float* scr = sm + wave * (64 * 33);
    for (int it = item_lo + wg * NWAVES + wave; it < item_hi; it += nwg * NWAVES) {
        const int l = it / PER_LAYER; int r = it % PER_LAYER;
        unsigned char* wb = A.ws + WS_WB + (size_t)l * WB_LAYER;
        const float* Win = A.in[I_WIN] + (size_t)l * DM * DIN; const float* g1 = A.in[I_N1G] + l * DM;
        if (r < NI_W1) { const int rb = r / 16, kb = r % 16; p0_titem(Win, DIN, p1_src_col(rb >> 3, (rb & 7) * 32), g1, (bf16_t*)(wb + WB_W1), DM, 32 * rb, 64 * kb, scr, lane); continue; } r -= NI_W1;
        if (r < NI_WG) { const int rb = r / 16, kb = r % 16; p0_titem(Win, DIN, NU + 32 * rb, g1, (bf16_t*)(wb + WB_WG), DM, 32 * rb, 64 * kb, scr, lane); continue; } r -= NI_WG;
        if (r < NI_WBR) { const int n = r / 256, rr = r % 256, rb = rr / 8, kb = rr % 8;
            p0_titem(A.in[I_WBR] + ((size_t)l * 3 + n) * BW * DM, DM, 32 * rb, nullptr, (bf16_t*)(wb + WB_WBR) + (size_t)n * DM * BW, BW, 32 * rb, 64 * kb, scr, lane); continue; } r -= NI_WBR;
        if (r < NI_WO) { const int rb = r / 16, kb = r % 16; p0_titem(A.in[I_WOUT] + (size_t)l * DM * DM, DM, 32 * rb, nullptr, (bf16_t*)(wb + WB_WO), DM, 32 * rb, 64 * kb, scr, lane); continue; } r -= NI_WO;
        if (r < NI_F1) { const int rb = r / 16, kb = r % 16, tile = rb >> 3, p = (rb & 7) * 32; const int src = (p < 128) ? 128 * tile + p : DFF + 128 * tile + (p - 128);
            p0_titem(A.in[I_WF1] + (size_t)l * DM * 2 * DFF, 2 * DFF, src, A.in[I_N2G] + l * DM, (bf16_t*)(wb + WB_WF1), DM, 32 * rb, 64 * kb, scr, lane); continue; } r -= NI_F1;
        { const int rb = r / 44, kb = r % 44; p0_titem(A.in[I_WF2] + (size_t)l * DFF * DM, DM, 32 * rb, nullptr, (bf16_t*)(wb + WB_WF2), DFF, 32 * rb, 64 * kb, scr, lane); }
    }
}

struct SchedPlain {
    pg8::TileOrder o; const char* A; const char* B; int lda2, ldb2, nt;
    __device__ __forceinline__ bool next(int i, GUnit& u) const {
        int pm, pn; if (!o.tile(i, pm, pn)) return false;
        u.A = A + (size_t)pm * 256 * lda2; u.B = B + (size_t)pn * 256 * ldb2; u.lda2 = lda2; u.ldb2 = ldb2; u.nt = nt; u.pm = pm; u.pn = pn; u.kind = 0; return true;
    }
};
struct SchedP3 {
    pg8::TileOrder o; const char* ws; const char* wb;
    __device__ __forceinline__ bool next(int i, GUnit& u) const {
        int pm, pn; if (!o.tile(i / 6, pm, pn)) return false;
        const int sub = i % 6, n = sub >> 1; const bool proj = (sub & 1) != 0;
        u.pm = pm; u.pn = pn; u.kind = sub;
        const size_t aoff = !proj ? WS_XB : (n == 0 ? WS_YA : (n == 1 ? WS_YB : WS_YC));
        const int ld2 = proj ? BW * 2 : DM * 2;
        u.A = ws + aoff + (size_t)pm * 256 * ld2; u.lda2 = ld2;
        u.B = wb + (proj ? WB_WBR : WB_WG) + (size_t)(n * DM + pn * 256) * ld2; u.ldb2 = ld2; u.nt = ld2 >> 7;
        return true;
    }
};

__device__ __forceinline__ float fast_sigmoid(float x) { return __builtin_amdgcn_rcpf(1.0f + __builtin_amdgcn_exp2f(-LOG2E * x)); }
__device__ __forceinline__ f32x4 sig4(const f32x4& v) { return (f32x4){fast_sigmoid(v[0]), fast_sigmoid(v[1]), fast_sigmoid(v[2]), fast_sigmoid(v[3])}; }
__device__ __forceinline__ float sigx(float z) { return __builtin_amdgcn_rcpf(1.0f + __builtin_amdgcn_exp2f(z)); }
__device__ __forceinline__ f32x4 sigx4(const f32x4& v) { return (f32x4){sigx(v[0]), sigx(v[1]), sigx(v[2]), sigx(v[3])}; }
__device__ __forceinline__ float dot4(const f32x4& a) { return (a[0] * a[0] + a[1] * a[1]) + (a[2] * a[2] + a[3] * a[3]); }

struct EpiP1 {
    unsigned char* ws; const float* rowss; const float* qg; const float* kg;
    __device__ __forceinline__ void operator()(const f32x4 (&acc)[2][2][4][2], const GUnit& u, int wr, int wc, int fr, int fq) const {
        const int pn = u.pn;
        if (pn < 4) {
            const bool isq = pn < 2; const float* gg = isq ? qg : kg; const float sc = isq ? QSCALE : 1.0f;
            const f32x4 ga0 = *(const f32x4*)(gg + 8 * fq), ga1 = *(const f32x4*)(gg + 8 * fq + 4), gb0 = *(const f32x4*)(gg + 32 + 8 * fq), gb1 = *(const f32x4*)(gg + 32 + 8 * fq + 4);
            bf16_t* base = (bf16_t*)(ws + (isq ? WS_AQ : WS_AK)) + (pn & 1) * 256 + 64 * wc + 8 * fq;
#pragma unroll
            for (int ai = 0; ai < 2; ++ai)
#pragma unroll
                for (int m = 0; m < 4; ++m) {
                    const int row = u.pm * 256 + ai * 128 + wr * 64 + m * 16 + fr;
                    const float rstd = rsqrtf(rowss[row] * (1.0f / DM) + RMS_EPS);
                    const f32x4 a0 = acc[ai][0][m][0] * rstd, a1 = acc[ai][0][m][1] * rstd, b0 = acc[ai][1][m][0] * rstd, b1 = acc[ai][1][m][1] * rstd;
                    float ss = (dot4(a0) + dot4(a1)) + (dot4(b0) + dot4(b1));
                    ss += __shfl_xor(ss, 16); ss += __shfl_xor(ss, 32);
                    const float rn = rsqrtf(ss * (1.0f / 64.0f) + RMS_EPS) * sc;
                    bf16_t* o = base + (size_t)row * BW;
                    *(u32x4*)o = pg8::pack8(a0 * ga0 * rn, a1 * ga1 * rn);
                    *(u32x4*)(o + 32) = pg8::pack8(b0 * gb0 * rn, b1 * gb1 * rn);
                }
        } else if (pn >= 6 && pn < 10) {
            bf16_t* base = (bf16_t*)(ws + WS_Z) + 128 * (pn - 6) + 32 * wc + 8 * fq;
#pragma unroll
            for (int ai = 0; ai < 2; ++ai)
#pragma unroll
                for (int m = 0; m < 4; ++m) {
                    const int row = u.pm * 256 + ai * 128 + wr * 64 + m * 16 + fr;
                    const float rstd = rsqrtf(rowss[row] * (1.0f / DM) + RMS_EPS), nr = -LOG2E * rstd;
                    const f32x4 z0 = acc[ai][0][m][0] * rstd * sigx4(acc[ai][1][m][0] * nr), z1 = acc[ai][0][m][1] * rstd * sigx4(acc[ai][1][m][1] * nr);
                    *(u32x4*)(base + (size_t)row * BW) = pg8::pack8(z0, z1);
                }
        } else {
            size_t wsoff; int kind;
            if (pn < 6) { wsoff = WS_AV; kind = 0; } else if (pn < 12) { wsoff = WS_RQ; kind = 1; } else if (pn < 14) { wsoff = WS_RK; kind = 2; } else if (pn < 16) { wsoff = WS_RV; kind = 0; } else { wsoff = WS_RG; kind = 3; }
            bf16_t* base = (bf16_t*)(ws + wsoff) + (pn & 1) * 256 + 32 * wc + 8 * fq;
            const float l2g0 = log2_gamma((pn & 1) * 2), l2g1 = log2_gamma((pn & 1) * 2 + 1);
#pragma unroll
            for (int ai = 0; ai < 2; ++ai)
#pragma unroll
                for (int m = 0; m < 4; ++m) {
                    const int row = u.pm * 256 + ai * 128 + wr * 64 + m * 16 + fr;
                    const float rstd = rsqrtf(rowss[row] * (1.0f / DM) + RMS_EPS);
                    const float tp = (float)(row & 127);
                    float f0 = rstd, f1 = rstd;
                    if (kind == 1) { f0 *= exp2f(tp * l2g0); f1 *= exp2f(tp * l2g1); }
                    if (kind == 2) { f0 *= 0.08838834764831845f * exp2f(-tp * l2g0); f1 *= 0.08838834764831845f * exp2f(-tp * l2g1); }
                    f32x4 a0 = acc[ai][0][m][0] * f0, a1 = acc[ai][0][m][1] * f0, b0 = acc[ai][1][m][0] * f1, b1 = acc[ai][1][m][1] * f1;
                    if (kind == 3) { a0 = a0 * sigx4(a0 * -LOG2E); a1 = a1 * sigx4(a1 * -LOG2E); b0 = b0 * sigx4(b0 * -LOG2E); b1 = b1 * sigx4(b1 * -LOG2E); }
                    bf16_t* o = base + (size_t)row * BW;
                    *(u32x4*)o = pg8::pack8(a0, a1);
                    *(u32x4*)(o + 128) = pg8::pack8(b0, b1);
                }
        }
    }
};
struct EpiP3 {
    const float* rowss; const float* bg; unsigned char* gscr; bf16_t* Y;
    __device__ __forceinline__ void operator()(const f32x4 (&acc)[2][2][4][2], const GUnit& u, int wr, int wc, int fr, int fq) const {
        const int n = u.kind >> 1;
        u32x4* gs = (u32x4*)gscr + ((wr * 4 + wc) * 64 + fq * 16 + fr);
        if (!(u.kind & 1)) {
            const float* bp = bg + n * DM + u.pn * 256 + 32 * wc + 8 * fq;
            const f32x4 ba0 = *(const f32x4*)bp * -LOG2E, ba1 = *(const f32x4*)(bp + 4) * -LOG2E, bb0 = *(const f32x4*)(bp + 128) * -LOG2E, bb1 = *(const f32x4*)(bp + 132) * -LOG2E;
#pragma unroll
            for (int ai = 0; ai < 2; ++ai)
#pragma unroll
                for (int m = 0; m < 4; ++m) {
                    const int row = u.pm * 256 + ai * 128 + wr * 64 + m * 16 + fr;
                    const float nr = -LOG2E * rsqrtf(rowss[row] * (1.0f / DM) + RMS_EPS);
                    gs[((ai * 4 + m) * 2 + 0) * NTHREADS] = pg8::pack8(sigx4(acc[ai][0][m][0] * nr + ba0), sigx4(acc[ai][0][m][1] * nr + ba1));
                    gs[((ai * 4 + m) * 2 + 1) * NTHREADS] = pg8::pack8(sigx4(acc[ai][1][m][0] * nr + bb0), sigx4(acc[ai][1][m][1] * nr + bb1));
                }
        } else {
#pragma unroll
            for (int ai = 0; ai < 2; ++ai) {
                u32x4 gq[4][2], pq[4][2];
#pragma unroll
                for (int m = 0; m < 4; ++m)
#pragma unroll
                    for (int bj = 0; bj < 2; ++bj) {
                        gq[m][bj] = gs[((ai * 4 + m) * 2 + bj) * NTHREADS];
                        if (n > 0) pq[m][bj] = *(const u32x4*)(Y + (size_t)(u.pm * 256 + ai * 128 + wr * 64 + m * 16 + fr) * DM + u.pn * 256 + 128 * bj + 32 * wc + 8 * fq);
                    }
#pragma unroll
                for (int m = 0; m < 4; ++m) {
                    const int row = u.pm * 256 + ai * 128 + wr * 64 + m * 16 + fr;
#pragma unroll
                    for (int bj = 0; bj < 2; ++bj) {
                        const u32x4 g = gq[m][bj];
                        bf16_t* yp = Y + (size_t)row * DM + u.pn * 256 + 128 * bj + 32 * wc + 8 * fq;
                        f32x4 y0 = acc[ai][bj][m][0], y1 = acc[ai][bj][m][1];
                        y0[0] *= __uint_as_float(g.x << 16); y0[1] *= __uint_as_float(g.x & 0xffff0000u); y0[2] *= __uint_as_float(g.y << 16); y0[3] *= __uint_as_float(g.y & 0xffff0000u);
                        y1[0] *= __uint_as_float(g.z << 16); y1[1] *= __uint_as_float(g.z & 0xffff0000u); y1[2] *= __uint_as_float(g.w << 16); y1[3] *= __uint_as_float(g.w & 0xffff0000u);
                        if (n > 0) { const u32x4 p = pq[m][bj];
                            y0[0] += __uint_as_float(p.x << 16); y0[1] += __uint_as_float(p.x & 0xffff0000u); y0[2] += __uint_as_float(p.y << 16); y0[3] += __uint_as_float(p.y & 0xffff0000u);
                            y1[0] += __uint_as_float(p.z << 16); y1[1] += __uint_as_float(p.z & 0xffff0000u); y1[2] += __uint_as_float(p.w << 16); y1[3] += __uint_as_float(p.w & 0xffff0000u); }
                        *(u32x4*)yp = pg8::pack8(y0, y1);
                    }
                }
                asm volatile("" ::: "memory");
            }
        }
    }
};
struct EpiResid {
    bf16_t* XB; float* out; float* rowss_next;
    __device__ __forceinline__ void operator()(const f32x4 (&acc)[2][2][4][2], const GUnit& u, int wr, int wc, int fr, int fq) const {
#pragma unroll
        for (int ai = 0; ai < 2; ++ai) {
            u32x4 xo[4][2];
#pragma unroll
            for (int m = 0; m < 4; ++m)
#pragma unroll
                for (int bj = 0; bj < 2; ++bj)
                    xo[m][bj] = *(const u32x4*)(XB + (size_t)(u.pm * 256 + ai * 128 + wr * 64 + m * 16 + fr) * DM + u.pn * 256 + 128 * bj + 32 * wc + 8 * fq);
#pragma unroll
            for (int m = 0; m < 4; ++m) {
                const int row = u.pm * 256 + ai * 128 + wr * 64 + m * 16 + fr;
                float ss = 0.f;
#pragma unroll
                for (int bj = 0; bj < 2; ++bj) {
                    const size_t off = (size_t)row * DM + u.pn * 256 + 128 * bj + 32 * wc + 8 * fq;
                    const u32x4 p = xo[m][bj];
                    f32x4 x0 = acc[ai][bj][m][0], x1 = acc[ai][bj][m][1];
                    x0[0] += __uint_as_float(p.x << 16); x0[1] += __uint_as_float(p.x & 0xffff0000u); x0[2] += __uint_as_float(p.y << 16); x0[3] += __uint_as_float(p.y & 0xffff0000u);
                    x1[0] += __uint_as_float(p.z << 16); x1[1] += __uint_as_float(p.z & 0xffff0000u); x1[2] += __uint_as_float(p.w << 16); x1[3] += __uint_as_float(p.w & 0xffff0000u);
                    if (out) { *(f32x4*)(out + off) = x0; *(f32x4*)(out + off + 4) = x1; }
                    else { *(u32x4*)(XB + off) = pg8::pack8(x0, x1); ss += dot4(x0) + dot4(x1); }
                }
                if (!out) { ss += __shfl_xor(ss, 16); ss += __shfl_xor(ss, 32); if (fq == 0) atomicAdd(rowss_next + row, ss); }
            }
            asm volatile("" ::: "memory");
        }
    }
};
struct EpiSwiglu {
    const float* rowss; bf16_t* MID;
    __device__ __forceinline__ void operator()(const f32x4 (&acc)[2][2][4][2], const GUnit& u, int wr, int wc, int fr, int fq) const {
        bf16_t* base = MID + 128 * u.pn + 32 * wc + 8 * fq;
#pragma unroll
        for (int ai = 0; ai < 2; ++ai)
#pragma unroll
            for (int m = 0; m < 4; ++m) {
                const int row = u.pm * 256 + ai * 128 + wr * 64 + m * 16 + fr;
                const float rstd = rsqrtf(rowss[row] * (1.0f / DM) + RMS_EPS); const float nr = -LOG2E * rstd, r2 = rstd * rstd;
                const f32x4 a0 = acc[ai][0][m][0], a1 = acc[ai][0][m][1];
                *(u32x4*)(base + (size_t)row * DFF) = pg8::pack8(a0 * acc[ai][1][m][0] * r2 * sigx4(a0 * nr), a1 * acc[ai][1][m][1] * r2 * sigx4(a1 * nr));
            }
    }
};

__device__ __forceinline__ void fast_gemm(const Args& A, int l, int k, LAS unsigned char* lds) {
    const int G = gridDim.x, c = blockIdx.x;
    const char* wb = (const char*)(A.ws + WS_WB + (size_t)l * WB_LAYER);
    const char* XB = (const char*)(A.ws + WS_XB);
    float* rowss = (float*)(A.ws + WS_ROWSS);
    if (k == 0) {
        SchedPlain S; S.o.init(M / 256, NU / 256, G, c); S.A = XB; S.lda2 = DM * 2; S.B = wb + WB_W1; S.ldb2 = DM * 2; S.nt = DM / 64;
        EpiP1 E{A.ws, rowss + (size_t)(l == 0 ? 0 : 2) * M, A.in[I_QG] + l * 64, A.in[I_KG] + l * 64};
        pg8::gemm_phase(lds, S, E);
        if (l == 0) { const int full = S.o.nwg / G, rem = S.o.nwg - full * G;
            if (rem > 0 && c >= rem) fast_p0_weights(A, c - rem, G - rem, (LAS float*)lds, NI_W1, PER_LAYER);
            else if (rem == 0) fast_p0_weights(A, c, G, (LAS float*)lds, NI_W1, PER_LAYER); }
    } else if (k == 2) {
        SchedP3 S; S.o.init(M / 256, DM / 256, G, c); S.ws = (const char*)A.ws; S.wb = wb;
        EpiP3 E{rowss + (size_t)(l == 0 ? 0 : 2) * M, A.in[I_BGATE] + l * NGATE, A.ws + WS_GSCR + (size_t)blockIdx.x * (128 * 1024), (bf16_t*)(A.ws + WS_Y)};
        pg8::gemm_phase(lds, S, E);
    } else if (k == 3) {
        SchedPlain S; S.o.init(M / 256, DM / 256, G, c); S.A = (const char*)(A.ws + WS_Y); S.lda2 = DM * 2; S.B = wb + WB_WO; S.ldb2 = DM * 2; S.nt = DM / 64;
        EpiResid E{(bf16_t*)(A.ws + WS_XB), nullptr, rowss + (size_t)(l == 0 ? 1 : 3) * M};
        pg8::gemm_phase(lds, S, E);
    } else if (k == 4) {
        SchedPlain S; S.o.init(M / 256, 2 * DFF / 256, G, c); S.A = XB; S.lda2 = DM * 2; S.B = wb + WB_WF1; S.ldb2 = DM * 2; S.nt = DM / 64;
        EpiSwiglu E{rowss + (size_t)(l == 0 ? 1 : 3) * M, (bf16_t*)(A.ws + WS_MID)};
        pg8::gemm_phase(lds, S, E);
        if (l == 0) { const int full = S.o.nwg / G, rem = S.o.nwg - full * G;
            if (rem > 0 && c >= rem) fast_p0_weights(A, c - rem, G - rem, (LAS float*)lds, PER_LAYER, DEPTH * PER_LAYER);
            else if (rem == 0) fast_p0_weights(A, c, G, (LAS float*)lds, PER_LAYER, DEPTH * PER_LAYER); }
    } else {
        SchedPlain S; S.o.init(M / 256, DM / 256, G, c); S.A = (const char*)(A.ws + WS_MID); S.lda2 = DFF * 2; S.B = wb + WB_WF2; S.ldb2 = DFF * 2; S.nt = DFF / 64;
        EpiResid E{(bf16_t*)(A.ws + WS_XB), l + 1 < DEPTH ? nullptr : A.out, rowss + (size_t)2 * M};
        pg8::gemm_phase(lds, S, E);
    }
}


namespace mx {
typedef short bf16x8 __attribute__((ext_vector_type(8)));
typedef short s16x4 __attribute__((ext_vector_type(4)));
typedef short v4i16_t __attribute__((ext_vector_type(4)));
typedef float f32x16 __attribute__((ext_vector_type(16)));
typedef LAS unsigned char* lptr;
typedef unsigned u32x2 __attribute__((ext_vector_type(2)));
__device__ __forceinline__ int crow(int r, int hi) { return (r & 3) + 8 * (r >> 2) + 4 * hi; }
__device__ __forceinline__ s16x4 vtr(lptr p) { return __builtin_bit_cast(s16x4, __builtin_amdgcn_ds_read_tr16_b64_v4i16((LAS v4i16_t*)p)); }
__device__ __forceinline__ bf16x8 cat8(s16x4 lo, s16x4 hi) { return (bf16x8){lo[0], lo[1], lo[2], lo[3], hi[0], hi[1], hi[2], hi[3]}; }
__device__ __forceinline__ bf16x8 ld8(lptr p) { return *(const LAS bf16x8*)p; }
__device__ __forceinline__ float swap_max(float v) { auto rr = __builtin_amdgcn_permlane32_swap(__float_as_uint(v), __float_as_uint(v), false, false); return fmaxf(__uint_as_float(rr[0]), __uint_as_float(rr[1])); }
__device__ __forceinline__ float swap_sum(float v) { auto rr = __builtin_amdgcn_permlane32_swap(__float_as_uint(v), __float_as_uint(v), false, false); return __uint_as_float(rr[0]) + __uint_as_float(rr[1]); }
__device__ __forceinline__ bf16x8 pack_p(const f32x16& p, int b) {
    pg8::u32x4 w; w.x = pg8::cvt_pk_bf16(p[b], p[b + 1]); w.y = pg8::cvt_pk_bf16(p[b + 2], p[b + 3]); w.z = pg8::cvt_pk_bf16(p[b + 4], p[b + 5]); w.w = pg8::cvt_pk_bf16(p[b + 6], p[b + 7]);
    return __builtin_bit_cast(bf16x8, w);
}
#define MFMA32(a, b, c) __builtin_amdgcn_mfma_f32_32x32x16_bf16((a), (b), (c), 0, 0, 0)
#define DPP_ADD(v, ctrl, rmask) ((v) + __builtin_bit_cast(float, __builtin_amdgcn_update_dpp(0, __builtin_bit_cast(int, (v)), (ctrl), (rmask), 0xf, false)))
__device__ __forceinline__ float half_sum32(float v) {
    v = DPP_ADD(v, 0xB1, 0xf);
    v = DPP_ADD(v, 0x4E, 0xf);
    v = DPP_ADD(v, 0x141, 0xf);
    v = DPP_ADD(v, 0x140, 0xf);
    v = DPP_ADD(v, 0x142, 0xa);
    return v;
}

#define LDS_BAR() asm volatile("s_waitcnt lgkmcnt(0)\n\ts_barrier" ::: "memory")

constexpr int A_KSLOT = 8192, A_KBUF = 16384, A_V0 = 32768, A_VBUF = 16384, A_STAGE = 98304, A_WS = 131072 + 4096;
template <int ABL>
__device__ __forceinline__ void attn_unit(const Args& A, int l, int b, int h, int qb, lptr lds) {
    const int tid = opaque_tid(), lane = tid & 63, r32 = lane & 31, hi = lane >> 5; const int wid = __builtin_amdgcn_readfirstlane(tid >> 6), mp = wid >> 2, qw = wid & 3;
    const bf16_t* AQ = (const bf16_t*)(A.ws + WS_AQ); const bf16_t* AK = (const bf16_t*)(A.ws + WS_AK); const bf16_t* AV = (const bf16_t*)(A.ws + WS_AV);
    const size_t rowbase = (size_t)b * SEQ;
    const int q0 = 128 * qb + 32 * qw;
    const int NT = 2 * (qb + 1);
    LAS float* wsf = (LAS float*)(lds + A_WS) + wid * 64;
    const bf16_t* ksrc[2]; const bf16_t* vsrc[2]; int kdst[2], vdst[2];
#pragma unroll
    for (int j = 0; j < 2; ++j) { const int P = 2 * wid + j;
        ksrc[j] = AK + (rowbase + 8 * (P & 7) + (lane >> 3)) * BW + h * 128 + (P >> 3) * 64 + (((lane & 7) ^ (lane >> 3)) * 8);
        vsrc[j] = AV + (rowbase + 8 * (P >> 1) + ((lane >> 2) & 7)) * BW + h * 128 + 32 * (2 * (P & 1) + (lane >> 5)) + 8 * (lane & 3);
        kdst[j] = (P >> 3) * A_KSLOT + (P & 7) * 1024; vdst[j] = (P >> 1) * 2048 + (P & 1) * 1024; }
#define ATT_DMA(t, kb_, vb_) do { _Pragma("unroll") for (int j = 0; j < 2; ++j) { \
        __builtin_amdgcn_global_load_lds((const unsigned*)(ksrc[j] + (size_t)64 * (t) * BW), (LAS unsigned*)((kb_) + kdst[j]), 16, 0, 0); \
        __builtin_amdgcn_global_load_lds((const unsigned*)(vsrc[j] + (size_t)64 * (t) * BW), (LAS unsigned*)((vb_) + vdst[j]), 16, 0, 0); } } while (0)
    bf16x8 qf[4];
#pragma unroll
    for (int d0 = 0; d0 < 4; ++d0) qf[d0] = *(const bf16x8*)(AQ + (rowbase + q0 + r32) * BW + h * 128 + mp * 64 + d0 * 16 + hi * 8);
    const float slope2 = exp2f(-2.0f * (float)(h + 1)) * LOG2E;
    float m = 0.f, lsum = 0.f; bool first = true;
    f32x16 o[4];
#pragma unroll
    for (int d0 = 0; d0 < 4; ++d0) o[d0] = f32x16{};
    bf16x8 pa0 = bf16x8{}, pa1 = bf16x8{}, pa2 = bf16x8{}, pa3 = bf16x8{};
    const int kroff = mp * A_KSLOT + r32 * 128;
    const int vroff = (4 * hi + ((lane & 15) >> 2)) * 64 + ((lane >> 4) & 1) * 32 + (lane & 3) * 8;
#define ATT_A(P0, P1, t, kb_) do { \
        const float sb_ = slope2 * (float)(64 * (t) + 4 * hi - (q0 + r32)) - m; \
        _Pragma("unroll") for (int r = 0; r < 16; ++r) { P0[r] = fmaf(slope2, (float)((r & 3) + 8 * (r >> 2)), sb_); P1[r] = fmaf(slope2, (float)(32 + (r & 3) + 8 * (r >> 2)), sb_); } \
        _Pragma("unroll") for (int d0 = 0; d0 < 4; ++d0) { const int ch_ = ((2 * d0 + hi) ^ (r32 & 7)) * 16; \
            P0 = MFMA32(ld8((kb_) + kroff + ch_), qf[d0], P0); P1 = MFMA32(ld8((kb_) + kroff + 32 * 128 + ch_), qf[d0], P1); } } while (0)
#define ATT_MASK(P0, P1, t) do { const int krel_ = 64 * (t) + 4 * hi - (q0 + r32); \
        _Pragma("unroll") for (int r = 0; r < 16; ++r) { const int d_ = krel_ + (r & 3) + 8 * (r >> 2); if (d_ > 0) P0[r] = -INFINITY; if (d_ + 32 > 0) P1[r] = -INFINITY; } } while (0)
    __syncthreads();
    {
        *(LAS u32x4*)(lds + A_V0 + 3 * A_VBUF + tid * 32) = (u32x4){0u, 0u, 0u, 0u}; *(LAS u32x4*)(lds + A_V0 + 3 * A_VBUF + tid * 32 + 16) = (u32x4){0u, 0u, 0u, 0u}; }
    ATT_DMA(NT - 1, lds, lds + A_V0);
    ATT_DMA(NT - 2, lds + A_KBUF, lds + A_V0 + A_VBUF);
    __syncthreads();
    f32x16 s0, s1;
    ATT_A(s0, s1, NT - 1, lds); ATT_MASK(s0, s1, NT - 1);
    __syncthreads();
    bool resc = false;
#define ATT_RESC() do { if (resc) { _Pragma("unroll") for (int r = 0; r < 16; ++r) { const float a = wsf[crow(r, hi)]; _Pragma("unroll") for (int d0 = 0; d0 < 4; ++d0) o[d0][r] *= a; } resc = false; } } while (0)
#define ATT_TRIP(i, S0, S1, N0, N1, PR0, PR1, PR2, PR3, PW0, PW1, PW2, PW3) do { \
        const int t = NT - 1 - (i); \
        if ((i) == 1) ATT_MASK(S0, S1, t); \
        ATT_RESC(); \
        if (!(ABL & 8) && (i) + 2 < NT) ATT_DMA(t - 2, lds + ((i) & 1) * A_KBUF, lds + A_V0 + (((i) + 2) & 3) * A_VBUF); \
        float mx_; \
        { const int tn = (t > 0) ? t - 1 : 0; lptr kb = lds + (((i) + (t > 0 ? 1 : 0)) & 1) * A_KBUF; \
          __builtin_amdgcn_sched_barrier(0); \
          ATT_A(N0, N1, tn, kb); \
          mx_ = fmaxf(S0[0], S1[0]); \
          _Pragma("unroll") for (int r = 1; r < 16; ++r) mx_ = fmaxf(mx_, fmaxf(S0[r], S1[r])); \
          __builtin_amdgcn_sched_group_barrier(0x2, 34, 0); \
          _Pragma("unroll") for (int k = 0; k < 8; ++k) { __builtin_amdgcn_sched_group_barrier(0x100, 1, 0); __builtin_amdgcn_sched_group_barrier(0x8, 1, 0); __builtin_amdgcn_sched_group_barrier(0x2, 3, 0); } \
          __builtin_amdgcn_sched_barrier(0); } \
        mx_ = swap_max(mx_); \
        const bool live = mx_ > -INFINITY; \
        const float dl = first ? (live ? mx_ : 0.f) : fmaxf(mx_, 0.f); \
        if (__any(first || dl > 0.f)) { \
            m += dl; \
            _Pragma("unroll") for (int r = 0; r < 16; ++r) { S0[r] -= dl; S1[r] -= dl; N0[r] -= dl; N1[r] -= dl; } \
            if (!first) { const float alpha = __builtin_amdgcn_exp2f(-dl); lsum *= alpha; if (hi == 0) wsf[r32] = alpha; resc = true; } \
            if (live) first = false; } \
        { __builtin_amdgcn_sched_barrier(0); \
          lptr vb = lds + A_V0 + (((i) + 3) & 3) * A_VBUF + vroff; \
          bf16x8 vfa = ATT_VF(0), vfb = ATT_VF(1); \
          float ps = 0.f; \
          _Pragma("unroll") for (int k = 0; k < 16; ++k) { \
              bf16x8 vfn = vfb; \
              if (k + 2 < 16) vfn = ATT_VF(k + 2); \
              const bf16x8 cc = (k & 3) == 0 ? PR0 : (k & 3) == 1 ? PR1 : (k & 3) == 2 ? PR2 : PR3; \
              if (!(ABL & 4)) o[k >> 2] = MFMA32(cc, vfa, o[k >> 2]); else { asm volatile("" :: "v"(cc), "v"(vfa)); } \
              if (k < 8) { S0[2 * k] = ATT_EXP(S0[2 * k]); S0[2 * k + 1] = ATT_EXP(S0[2 * k + 1]); ps += S0[2 * k] + S0[2 * k + 1]; } \
              else { S1[2 * k - 16] = ATT_EXP(S1[2 * k - 16]); S1[2 * k - 15] = ATT_EXP(S1[2 * k - 15]); ps += S1[2 * k - 16] + S1[2 * k - 15]; } \
              if (k == 3) PW0 = pack_p(S0, 0); \
              if (k == 7) PW1 = pack_p(S0, 8); \
              if (k == 11) PW2 = pack_p(S1, 0); \
              if (k == 15) PW3 = pack_p(S1, 8); \
              vfa = vfb; vfb = vfn; \
              __builtin_amdgcn_sched_barrier(0); } \
          lsum += ps; } \
        if (!(ABL & 16)) __syncthreads(); } while (0)
#define ATT_EXP(x_) ((ABL & 2) ? (x_) * 0.001f : __builtin_amdgcn_exp2f(x_))
#define ATT_VF(k_) cat8(vtr(vb + ((k_) >> 2) * 512 + ((k_) & 3) * 4096), vtr(vb + ((k_) >> 2) * 512 + ((k_) & 3) * 4096 + 2048))
    f32x16 n0, n1;
    bf16x8 pb0 = bf16x8{}, pb1 = bf16x8{}, pb2 = bf16x8{}, pb3 = bf16x8{};
    for (int i = 0; i < NT; i += 2) {
        ATT_TRIP(i, s0, s1, n0, n1, pa0, pa1, pa2, pa3, pb0, pb1, pb2, pb3);
        ATT_TRIP(i + 1, n0, n1, s0, s1, pb0, pb1, pb2, pb3, pa0, pa1, pa2, pa3);
    }
    ATT_RESC();
#undef ATT_RESC
#undef ATT_TRIP
#undef ATT_VF
#undef ATT_EXP
    { lptr vb = lds + A_V0 + ((NT - 1) & 3) * A_VBUF + vroff;
#pragma unroll
      for (int d0 = 0; d0 < 4; ++d0) { lptr vp_ = vb + d0 * 512;
        const bf16x8 v0 = cat8(vtr(vp_), vtr(vp_ + 2048)), v1 = cat8(vtr(vp_ + 4096), vtr(vp_ + 4096 + 2048));
        const bf16x8 v2 = cat8(vtr(vp_ + 8192), vtr(vp_ + 8192 + 2048)), v3 = cat8(vtr(vp_ + 12288), vtr(vp_ + 12288 + 2048));
        o[d0] = MFMA32(pa0, v0, o[d0]); o[d0] = MFMA32(pa1, v1, o[d0]); o[d0] = MFMA32(pa2, v2, o[d0]); o[d0] = MFMA32(pa3, v3, o[d0]); } }
    __syncthreads();
#undef ATT_DMA
#undef ATT_A
#undef ATT_MASK
    lsum = swap_sum(lsum);
    if (hi == 0) wsf[32 + r32] = 1.0f / lsum;
    const float lam = ((const float*)(A.ws + WS_LAM))[l];
    LAS float* xch = (LAS float*)lds + qw * (4 * 16 * 64) + lane;
    if (mp == 1) {
#pragma unroll
        for (int r = 0; r < 16; ++r) { const float il = wsf[32 + crow(r, hi)] * lam;
#pragma unroll
            for (int d0 = 0; d0 < 4; ++d0) xch[(d0 * 16 + r) * 64] = o[d0][r] * il; }
    }
    __syncthreads();
    if (mp == 0) {
        float ss[16];
#pragma unroll
        for (int r = 0; r < 16; ++r) { const float il = wsf[32 + crow(r, hi)]; float s_ = 0.f;
#pragma unroll
            for (int d0 = 0; d0 < 4; ++d0) { const float y = o[d0][r] * il - xch[(d0 * 16 + r) * 64]; o[d0][r] = y; s_ += y * y; }
            ss[r] = s_; }
#pragma unroll
        for (int r = 0; r < 16; ++r) { float v = ss[r]; v += __shfl_xor(v, 1); v += __shfl_xor(v, 2); v += __shfl_xor(v, 4); v += __shfl_xor(v, 8); v += __shfl_xor(v, 16); ss[r] = v; }
        int l_ = l; asm volatile("" : "+s"(l_));
        const float osc = 1.0f - lam_init_of(l_);
        const float* asg = A.in[I_ASG] + l * 128;
        float gv[4];
#pragma unroll
        for (int d0 = 0; d0 < 4; ++d0) gv[d0] = asg[32 * d0 + r32] * osc;
        LAS bf16_t* stg = (LAS bf16_t*)(lds + A_STAGE) + qw * (32 * 128);
#pragma unroll
        for (int r = 0; r < 16; ++r) { const float rn = rsqrtf(ss[r] * (1.0f / 128.0f) + RMS_EPS); const int row = crow(r, hi);
#pragma unroll
            for (int d0 = 0; d0 < 4; ++d0) stg[row * 128 + 32 * d0 + r32] = (bf16_t)f2bf(o[d0][r] * rn * gv[d0]); }
        bf16_t* YA = ABL ? (bf16_t*)(A.ws + 254 * MiB) + (size_t)(blockIdx.x & 63) * 32 * BW : (bf16_t*)(A.ws + WS_YA) + (rowbase + q0) * BW + h * 128;
#pragma unroll
        for (int i = 0; i < 8; ++i) { const int idx = lane + 64 * i, row = idx >> 4, ch = idx & 15;
            *(u32x4*)(YA + (size_t)row * BW + ch * 8) = *(const LAS u32x4*)(stg + row * 128 + ch * 8); }
    }
}

__device__ __forceinline__ int offa(int row, int ch) { return 2048 * (row >> 3) + 512 * (ch >> 2) + 64 * (row & 7) + 16 * ((ch & 3) ^ ((row >> 2) & 3)); }
constexpr int R_K = 0, R_V = 32768, R_RT = 65536, R_ST = 98304, R_SS = 131072 + 1024;
constexpr size_t WS_RSTATE = 76 * MiB;
constexpr int CW_RFLAG = 12288;
struct RetLane { int r32, hi, tnb0, tnb1, tpb0, tpb1, rb0, rb1, w; };
__device__ __forceinline__ RetLane ret_lane(int lane) {
    int ln = lane; asm volatile("" : "+v"(ln));
    RetLane L; L.r32 = ln & 31; L.hi = ln >> 5; const int tq = (ln & 15) >> 2, tp = ln & 3, tg = (ln >> 4) & 1, z = 2 * tg + (tp >> 1); L.w = (L.r32 >> 2) & 3;
    L.tnb0 = 2048 * L.hi + 64 * tq + 8 * (tp & 1) + 16 * (z ^ (2 * L.hi));
    L.tnb1 = 2048 * L.hi + 64 * (tq + 4) + 8 * (tp & 1) + 16 * (z ^ (2 * L.hi + 1));
    L.tpb0 = 64 * (4 * L.hi + tq) + 8 * (tp & 1) + 16 * (z ^ L.hi);
    L.tpb1 = 2048 + 64 * (4 * L.hi + tq) + 8 * (tp & 1) + 16 * (z ^ (2 + L.hi));
    L.rb0 = 2048 * (L.r32 >> 3) + 64 * (L.r32 & 7) + 16 * (L.hi ^ L.w);
    L.rb1 = 2048 * (L.r32 >> 3) + 64 * (L.r32 & 7) + 16 * ((2 + L.hi) ^ L.w);
    return L;
}
__device__ __forceinline__ void ret_update(f32x16& R0, f32x16& R1, lptr lds, const RetLane& L, int qb, int vh, float g127, float g128) {
    f32x16 t0 = f32x16{}, t1 = f32x16{};
    lptr ka = lds + R_K + 512 * qb, va = lds + R_V + 512 * (2 * vh);
#pragma unroll
    for (int ks = 0; ks < 8; ++ks) {
        const bf16x8 kf = cat8(vtr(ka + L.tnb0 + 4096 * ks), vtr(ka + L.tnb1 + 4096 * ks));
        const bf16x8 v0 = cat8(vtr(va + L.tnb0 + 4096 * ks), vtr(va + L.tnb1 + 4096 * ks));
        const bf16x8 v1 = cat8(vtr(va + 512 + L.tnb0 + 4096 * ks), vtr(va + 512 + L.tnb1 + 4096 * ks));
        t0 = MFMA32(kf, v0, t0); t1 = MFMA32(kf, v1, t1);
    }
#pragma unroll
    for (int r = 0; r < 16; ++r) { R0[r] = g128 * R0[r] + g127 * t0[r]; R1[r] = g128 * R1[r] + g127 * t1[r]; }
}
#define RET_KV_LOAD(stK, stV, c_) do { const size_t r0_ = ((size_t)b * SEQ + 128 * (c_) + srow) * BW + h * 128 + sch * 8; \
    _Pragma("unroll") for (int j = 0; j < 4; ++j) { stK[j] = *(const u32x4*)(RK + r0_ + (size_t)32 * j * BW); stV[j] = *(const u32x4*)(RV + r0_ + (size_t)32 * j * BW); } } while (0)
#define RET_KV_WRITE(stK, stV) do { _Pragma("unroll") for (int j = 0; j < 4; ++j) { *(LAS u32x4*)(lds + R_K + sb + 8192 * j) = stK[j]; *(LAS u32x4*)(lds + R_V + sb + 8192 * j) = stV[j]; } } while (0)

__device__ __forceinline__ void ret_a_task(const Args& A, int l, int b, int h, int seg, lptr lds) {
    const int tid = opaque_tid(), lane = tid & 63; const int wid = __builtin_amdgcn_readfirstlane(tid >> 6), qb = wid & 3, vh = wid >> 2;
    const bf16_t* RK = (const bf16_t*)(A.ws + WS_RK); const bf16_t* RV = (const bf16_t*)(A.ws + WS_RV);
    const float l2g = log2_gamma(h); const float g127 = exp2f(127.0f * l2g), g128 = exp2f(128.0f * l2g);
    const int srow = tid >> 4, sch = tid & 15;
    const int sb = 2048 * (srow >> 3) + 512 * (sch >> 2) + 64 * (srow & 7) + 16 * ((sch & 3) ^ ((srow >> 2) & 3));
    f32x16 R0 = f32x16{}, R1 = f32x16{};
    u32x4 stK[4], stV[4];
    RET_KV_LOAD(stK, stV, 8 * seg);
    for (int cc = 0; cc < 8; ++cc) {
        const RetLane L = ret_lane(lane);
        LDS_BAR();
        RET_KV_WRITE(stK, stV);
        if (cc < 7) RET_KV_LOAD(stK, stV, 8 * seg + cc + 1);
        LDS_BAR();
        ret_update(R0, R1, lds, L, qb, vh, g127, g128);
    }
    unsigned long long* dst = (unsigned long long*)(A.ws + WS_RSTATE) + ((size_t)((b * 4 + h) * 3 + seg) * 8 + wid) * 512 + lane;
#pragma unroll
    for (int g = 0; g < 4; ++g) {
        __hip_atomic_store(dst + (2 * g) * 64, (unsigned long long)pg8::cvt_pk_bf16(R0[4 * g], R0[4 * g + 1]) | ((unsigned long long)pg8::cvt_pk_bf16(R0[4 * g + 2], R0[4 * g + 3]) << 32), RLX_AGENT);
        __hip_atomic_store(dst + (2 * g + 1) * 64, (unsigned long long)pg8::cvt_pk_bf16(R1[4 * g], R1[4 * g + 1]) | ((unsigned long long)pg8::cvt_pk_bf16(R1[4 * g + 2], R1[4 * g + 3]) << 32), RLX_AGENT);
    }
    asm volatile("s_waitcnt vmcnt(0)" ::: "memory");
    __syncthreads();
    if (threadIdx.x == 0) __hip_atomic_store((unsigned*)(A.ws + WS_CTL) + CW_RFLAG + 64 * ((l * 16 + b * 4 + h) * 4 + seg), 1u, RLX_AGENT);
}

__device__ __forceinline__ void ret_b_task(const Args& A, int l, int b, int h, int seg, lptr lds) {
    const int tid = opaque_tid(), lane = tid & 63; const int wid = __builtin_amdgcn_readfirstlane(tid >> 6), qb = wid & 3, vh = wid >> 2;
    const bf16_t* RQ = (const bf16_t*)(A.ws + WS_RQ); const bf16_t* RK = (const bf16_t*)(A.ws + WS_RK); const bf16_t* RV = (const bf16_t*)(A.ws + WS_RV);
    const bf16_t* RG = (const bf16_t*)(A.ws + WS_RG); bf16_t* YC = (bf16_t*)(A.ws + WS_YC);
    const float l2g = log2_gamma(h); const float gam = exp2f(l2g), g127 = exp2f(127.0f * l2g), g128 = exp2f(128.0f * l2g);
    const float* gn = A.in[I_RGN] + l * 128;
    LAS float* ssq = (LAS float*)(lds + R_SS);
    const int srow = tid >> 4, sch = tid & 15;
    const int sb = 2048 * (srow >> 3) + 512 * (sch >> 2) + 64 * (srow & 7) + 16 * ((sch & 3) ^ ((srow >> 2) & 3));
    u32x4 stK[4], stV[4];
    RET_KV_LOAD(stK, stV, 8 * seg);
    f32x16 R0 = f32x16{}, R1 = f32x16{};
    if (seg > 0) {
        if (threadIdx.x < 64) {
            unsigned* fl = (unsigned*)(A.ws + WS_CTL) + CW_RFLAG + 64 * ((l * 16 + b * 4 + h) * 4);
            unsigned spins = 0;
            for (;;) {
                unsigned ok = 1u;
                for (int s2 = 0; s2 < seg; ++s2) ok &= __hip_atomic_load(fl + 64 * s2, RLX_AGENT);
                if (__builtin_amdgcn_readfirstlane(ok)) break;
                __builtin_amdgcn_s_sleep(8);
                if (++spins > (1u << 22)) break;
            }
        }
        __syncthreads();
        const float g1024 = exp2f(1024.0f * l2g);
        for (int s2 = 0; s2 < seg; ++s2) {
            const unsigned long long* src = (const unsigned long long*)(A.ws + WS_RSTATE) + ((size_t)((b * 4 + h) * 3 + s2) * 8 + wid) * 512 + lane;
#pragma unroll
            for (int r = 0; r < 16; ++r) { R0[r] *= g1024; R1[r] *= g1024; }
#pragma unroll
            for (int g = 0; g < 4; ++g) {
                const unsigned long long a0 = __hip_atomic_load(src + (2 * g) * 64, RLX_AGENT), a1 = __hip_atomic_load(src + (2 * g + 1) * 64, RLX_AGENT);
                R0[4 * g] += bf2f((unsigned)a0 & 0xffffu); R0[4 * g + 1] += __uint_as_float((unsigned)a0 & 0xffff0000u); R0[4 * g + 2] += bf2f((unsigned)(a0 >> 32) & 0xffffu); R0[4 * g + 3] += __uint_as_float((unsigned)(a0 >> 32) & 0xffff0000u);
                R1[4 * g] += bf2f((unsigned)a1 & 0xffffu); R1[4 * g + 1] += __uint_as_float((unsigned)a1 & 0xffff0000u); R1[4 * g + 2] += bf2f((unsigned)(a1 >> 32) & 0xffffu); R1[4 * g + 3] += __uint_as_float((unsigned)(a1 >> 32) & 0xffff0000u);
            }
        }
    }
    bf16x8 qf[8];
    u32x4 gst[4];
#define RET_Q_LOAD(c_) do { const size_t r0_ = ((size_t)b * SEQ + 128 * (c_) + 32 * qb + (lane & 31)) * BW + h * 128 + (lane >> 5) * 8; \
    _Pragma("unroll") for (int ds = 0; ds < 8; ++ds) qf[ds] = *(const bf16x8*)(RQ + r0_ + ds * 16); } while (0)
#define RET_G_LOAD(c_) do { _Pragma("unroll") for (int i = 0; i < 4; ++i) { const int idx_ = lane + 64 * i; \
    gst[i] = *(const u32x4*)(RG + ((size_t)b * SEQ + 128 * (c_) + 32 * qb + (idx_ >> 3)) * BW + h * 128 + 64 * vh + (idx_ & 7) * 8); } } while (0)
    RET_Q_LOAD(8 * seg); RET_G_LOAD(8 * seg);
    for (int cc = 0; cc < 8; ++cc) {
        const int c = 8 * seg + cc;
        const RetLane L = ret_lane(lane);
        const int r32 = L.r32, hi = L.hi, w = L.w;
        const size_t crow0 = (size_t)b * SEQ + 128 * c;
        lptr stg = lds + R_ST + 4096 * wid;
        LDS_BAR();
        RET_KV_WRITE(stK, stV);
        if (c > 0) {
            lptr rw = lds + R_RT + 256 * (64 * vh) + 2048 * (r32 >> 3) + 64 * (r32 & 7) + 512 * qb + 8 * hi;
#pragma unroll
            for (int g = 0; g < 4; ++g) {
                *(LAS u32x2*)(rw + 16 * (g ^ w)) = (u32x2){pg8::cvt_pk_bf16(R0[4 * g], R0[4 * g + 1]), pg8::cvt_pk_bf16(R0[4 * g + 2], R0[4 * g + 3])};
                *(LAS u32x2*)(rw + 8192 + 16 * (g ^ w)) = (u32x2){pg8::cvt_pk_bf16(R1[4 * g], R1[4 * g + 1]), pg8::cvt_pk_bf16(R1[4 * g + 2], R1[4 * g + 3])};
            }
        }
#pragma unroll
        for (int i = 0; i < 4; ++i) { const int idx = lane + 64 * i; *(LAS u32x4*)(stg + (idx >> 3) * 128 + (idx & 7) * 16) = gst[i]; }
        LDS_BAR();
        f32x16 o0 = f32x16{}, o1 = f32x16{};
        for (int kb = 0; kb <= qb; ++kb) {
            f32x16 p = f32x16{};
            lptr kr = lds + R_K + 8192 * kb;
#pragma unroll
            for (int ds = 0; ds < 8; ++ds) p = MFMA32(ld8(kr + ((ds & 1) ? L.rb1 : L.rb0) + 512 * (ds >> 1)), qf[ds], p);
            if (kb == qb) {
#pragma unroll
                for (int r = 0; r < 16; ++r) if (crow(r, hi) > r32) p[r] = 0.f;
            }
            const bf16x8 pa0 = pack_p(p, 0), pa1 = pack_p(p, 8);
            lptr vr = lds + R_V + 8192 * kb + 512 * (2 * vh);
#pragma unroll
            for (int s2 = 0; s2 < 2; ++s2) {
                const bf16x8 pa = s2 ? pa1 : pa0;
                const bf16x8 vf0 = cat8(vtr(vr + L.tpb0 + 4096 * s2), vtr(vr + L.tpb1 + 4096 * s2));
                const bf16x8 vf1 = cat8(vtr(vr + 512 + L.tpb0 + 4096 * s2), vtr(vr + 512 + L.tpb1 + 4096 * s2));
                o0 = MFMA32(pa, vf0, o0); o1 = MFMA32(pa, vf1, o1);
            }
        }
        if (c > 0) {
            f32x16 x0 = f32x16{}, x1 = f32x16{};
            lptr rr = lds + R_RT + 256 * (64 * vh);
#pragma unroll
            for (int ds = 0; ds < 8; ++ds) {
                const int ob = ((ds & 1) ? L.rb1 : L.rb0) + 512 * (ds >> 1);
                x0 = MFMA32(qf[ds], ld8(rr + ob), x0);
                x1 = MFMA32(qf[ds], ld8(rr + 8192 + ob), x1);
            }
#pragma unroll
            for (int r = 0; r < 16; ++r) { o0[r] += gam * x0[r]; o1[r] += gam * x1[r]; }
        }
#pragma unroll
        for (int r = 0; r < 16; ++r) { const float v = half_sum32(o0[r] * o0[r] + o1[r] * o1[r]);
            if (r32 == 16) ssq[vh * 128 + 32 * qb + crow(r, hi)] = v; }
        if (cc < 7) RET_KV_LOAD(stK, stV, c + 1);
        LDS_BAR();
        if (c < SEQ / 128 - 1) ret_update(R0, R1, lds, L, qb, vh, g127, g128);
        if (cc < 7) { RET_Q_LOAD(c + 1); RET_G_LOAD(c + 1); }
        const float gn0 = gn[64 * vh + r32], gn1 = gn[64 * vh + 32 + r32];
#pragma unroll
        for (int r = 0; r < 16; ++r) {
            const int row = crow(r, hi);
            const float rn = rsqrtf((ssq[32 * qb + row] + ssq[128 + 32 * qb + row]) * (1.0f / 128.0f) + RMS_EPS);
            LAS bf16_t* sp = (LAS bf16_t*)(stg + row * 128) + r32;
            sp[0] = (bf16_t)f2bf(o0[r] * rn * gn0 * bf2f(sp[0]));
            sp[32] = (bf16_t)f2bf(o1[r] * rn * gn1 * bf2f(sp[32]));
        }
#pragma unroll
        for (int i = 0; i < 4; ++i) { const int idx = lane + 64 * i;
            *(u32x4*)(YC + (crow0 + 32 * qb + (idx >> 3)) * BW + h * 128 + 64 * vh + (idx & 7) * 8) = *(const LAS u32x4*)(stg + (idx >> 3) * 128 + (idx & 7) * 16); }
    }
#undef RET_Q_LOAD
#undef RET_G_LOAD
}
#undef RET_KV_LOAD
#undef RET_KV_WRITE
#undef MFMA32

constexpr int C_Z = 65536;
__device__ __forceinline__ void conv_task(const Args& A, int l, int task, lptr lds) {
    const int tid = opaque_tid(), lane = tid & 63; const int wave = __builtin_amdgcn_readfirstlane(tid >> 6);
    const bf16_t* Z = (const bf16_t*)(A.ws + WS_Z); bf16_t* YB = (bf16_t*)(A.ws + WS_YB);
    const float* cw = A.in[I_CW] + (size_t)l * 31 * BW; const float* cb = A.in[I_CB] + l * BW;
    const float* lg = A.in[I_CLG] + l * BW; const float* lb = A.in[I_CLB] + l * BW;
    const int m0 = task * 32, t0 = m0 & (SEQ - 1);
    __syncthreads();
    for (int pc = wave; pc < 62; pc += NWAVES) {
        const int j = pc >> 1, hf = pc & 1;
        __builtin_amdgcn_global_load_lds((const unsigned*)(cw + (size_t)j * BW + 8 * lane + 4 * hf), (LAS unsigned*)(lds + pc * 1024), 16, 0, 0);
    }
    for (int r = wave; r < 62; r += NWAVES) {
        if (t0 - 30 + r >= 0) __builtin_amdgcn_global_load_lds((const unsigned*)(Z + (size_t)(m0 - 30 + r) * BW + lane * 8), (LAS unsigned*)(lds + C_Z + r * 1024), 16, 0, 0);
        else { unsigned zz = 0u; asm volatile("" : "+v"(zz)); *(LAS u32x4*)(lds + C_Z + r * 1024 + lane * 16) = (u32x4){zz, zz, zz, zz}; }
    }
    __syncthreads();
    const int c0 = lane * 8;
    float acc[4][8];
    { const f32x4 b0 = *(const f32x4*)(cb + c0), b1 = *(const f32x4*)(cb + c0 + 4);
#pragma unroll
      for (int k = 0; k < 4; ++k) { acc[k][0] = b0[0]; acc[k][1] = b0[1]; acc[k][2] = b0[2]; acc[k][3] = b0[3]; acc[k][4] = b1[0]; acc[k][5] = b1[1]; acc[k][6] = b1[2]; acc[k][7] = b1[3]; } }
    float zf[4][8];
    lptr zb = lds + C_Z + (4 * wave) * 1024 + lane * 16;
#define CONV_ZROW(slot, rr) do { const u32x4 v_ = *(const LAS u32x4*)(zb + (rr) * 1024); \
        zf[slot][0] = __uint_as_float(v_.x << 16); zf[slot][1] = __uint_as_float(v_.x & 0xffff0000u); zf[slot][2] = __uint_as_float(v_.y << 16); zf[slot][3] = __uint_as_float(v_.y & 0xffff0000u); \
        zf[slot][4] = __uint_as_float(v_.z << 16); zf[slot][5] = __uint_as_float(v_.z & 0xffff0000u); zf[slot][6] = __uint_as_float(v_.w << 16); zf[slot][7] = __uint_as_float(v_.w & 0xffff0000u); } while (0)
    CONV_ZROW(0, 0); CONV_ZROW(1, 1); CONV_ZROW(2, 2); CONV_ZROW(3, 3);
#pragma unroll
    for (int j = 0; j < 31; ++j) {
        const f32x4 w0 = *(const LAS f32x4*)(lds + ((j * 2 + 0) * 64 + lane) * 16), w1 = *(const LAS f32x4*)(lds + ((j * 2 + 1) * 64 + lane) * 16);
#pragma unroll
        for (int k = 0; k < 4; ++k) {
            const int sl = (j + k) & 3;
            acc[k][0] += w0[0] * zf[sl][0]; acc[k][1] += w0[1] * zf[sl][1]; acc[k][2] += w0[2] * zf[sl][2]; acc[k][3] += w0[3] * zf[sl][3];
            acc[k][4] += w1[0] * zf[sl][4]; acc[k][5] += w1[1] * zf[sl][5]; acc[k][6] += w1[2] * zf[sl][6]; acc[k][7] += w1[3] * zf[sl][7];
        }
        if (j < 30) CONV_ZROW(j & 3, j + 4);
    }
#undef CONV_ZROW
    const f32x4 g0 = *(const f32x4*)(lg + c0), g1 = *(const f32x4*)(lg + c0 + 4), h0 = *(const f32x4*)(lb + c0), h1 = *(const f32x4*)(lb + c0 + 4);
#pragma unroll
    for (int k = 0; k < 4; ++k) {
        float s_ = 0.f;
#pragma unroll
        for (int e = 0; e < 8; ++e) s_ += acc[k][e];
        const float mu = wave_sum(s_) * (1.0f / BW);
        float q = 0.f;
#pragma unroll
        for (int e = 0; e < 8; ++e) { acc[k][e] -= mu; q += acc[k][e] * acc[k][e]; }
        const float rstd = rsqrtf(wave_sum(q) * (1.0f / BW) + LN_EPS);
        float o[8];
#pragma unroll
        for (int e = 0; e < 4; ++e) { o[e] = siluf_(acc[k][e] * rstd * g0[e] + h0[e]); o[4 + e] = siluf_(acc[k][4 + e] * rstd * g1[e] + h1[e]); }
        *(uint4*)(YB + (size_t)(m0 + 4 * wave + k) * BW + c0) = make_uint4(pk2(o[0], o[1]), pk2(o[2], o[3]), pk2(o[4], o[5]), pk2(o[6], o[7]));
    }
}

constexpr int Q_RA = 6, Q_AT = 32, Q_RB = 8, Q_CONV = 64, Q_TASKS = Q_RA + Q_AT + Q_RB + Q_AT + Q_CONV;
constexpr int CW_QUEUE = 8192;
__device__ __forceinline__ void mixer_phase(const Args& A, int l, lptr lds, volatile LAS unsigned* slot) {
    const int x0 = (int)(xb_xcc_id() & 7u);
    int qi = 0;
    for (;;) {
        const int x = (x0 + qi) & 7;
        unsigned* ctr = (unsigned*)(A.ws + WS_CTL) + CW_QUEUE + 64 * (8 * l + x);
        __syncthreads();
        if (threadIdx.x == 0) *slot = __hip_atomic_fetch_add(ctr, 1u, __ATOMIC_RELAXED, __HIP_MEMORY_SCOPE_AGENT);
        __syncthreads();
        int id = (int)*slot;
        if (id >= Q_TASKS) { if (++qi == 8) break; continue; }
#if PROBE_PHASE >= 10
        const unsigned t0_ = (unsigned)__builtin_amdgcn_s_memrealtime(); int kind = 0;
#endif
        if (id < Q_RA) { const int bh = 2 * x + id / 3; ret_a_task(A, l, bh >> 2, bh & 3, id % 3, lds); }
        else if ((id -= Q_RA) < Q_AT) { const int bh = 2 * x + (id & 1); attn_unit<0>(A, l, bh >> 2, bh & 3, 31 - (id >> 1), lds);
#if PROBE_PHASE >= 10
            kind = 1;
#endif
        }
        else if ((id -= Q_AT) < Q_RB) { const int bh = 2 * x + (id >> 2); ret_b_task(A, l, bh >> 2, bh & 3, id & 3, lds); }
        else if ((id -= Q_RB) < Q_AT) { const int bh = 2 * x + (id & 1); attn_unit<0>(A, l, bh >> 2, bh & 3, 15 - (id >> 1), lds);
#if PROBE_PHASE >= 10
            kind = 1;
#endif
        }
        else { id -= Q_AT; conv_task(A, l, 64 * x + id, lds);
#if PROBE_PHASE >= 10
            kind = 2;
#endif
        }
#if PROBE_PHASE >= 10
        __syncthreads();
        if (threadIdx.x == 0 && kind == PROBE_PHASE - 10) atomicAdd((unsigned*)(A.ws + WS_CTL) + CW_QUEUE + 2048, (unsigned)__builtin_amdgcn_s_memrealtime() - t0_);
#endif
    }
#if ABL_ATTN > 0
    if (l == 0) {
        unsigned* ctr2 = (unsigned*)(A.ws + WS_CTL) + CW_QUEUE + 4096;
        for (;;) {
            __syncthreads();
            if (threadIdx.x == 0) *slot = __hip_atomic_fetch_add(ctr2, 1u, __ATOMIC_RELAXED, __HIP_MEMORY_SCOPE_AGENT);
            __syncthreads();
            const int id = (int)*slot;
            if (id >= 512) break;
            attn_unit<ABL_ATTN>(A, l, (id & 15) >> 2, id & 3, 31 - (id >> 4), lds);
        }
    }
#endif
}
}

constexpr int N_PHASES = 1 + 6 * DEPTH;
constexpr int RING_BYTES = 131072, MISC_OFF = RING_BYTES + 320, LDS_BYTES = 147456;
#ifndef FAST_GEMM
#define FAST_GEMM 1
#endif
#ifndef FAST_MIX
#define FAST_MIX 1
#endif
#ifndef FAST_MASK
#define FAST_MASK 0x3f
#endif
__global__ void __launch_bounds__(NTHREADS, 2) fwd_kernel(Args A) {
    extern __shared__ __attribute__((aligned(16))) unsigned char lds[];
    float* sm = (float*)lds;
    LAS unsigned char* ldsl = (LAS unsigned char*)lds;
    volatile LAS unsigned* MISC = (volatile LAS unsigned*)(ldsl + MISC_OFF);
    const int wg = blockIdx.x, nwg = gridDim.x;
    const bool multi = (A.ph_hi - A.ph_lo) > 1;
    XcdBarrier bar; bar.bar = nullptr; bar.x = 0; bar.st = nullptr;
    if (multi) {
        if (threadIdx.x < 2) MISC[threadIdx.x] = 0u;
        __syncthreads();
        bar = xcd_barrier_post((unsigned*)(A.ws + WS_CTL) + CW_BAR, MISC);
    }
    const Args& A0 = A;
#if PROBE_PHASE >= 0
    if (blockIdx.x == 0 && threadIdx.x == 0) { const unsigned now = (unsigned)__builtin_amdgcn_s_memrealtime(); MISC[8] = now; MISC[9] = 0u; MISC[10] = now; }
#endif
    for (int ph = A0.ph_lo; ph < A0.ph_hi; ++ph) {
        Args A = A0;
        asm volatile("" : "+s"(A.out), "+s"(A.ws));
        if (ph == 0) { nv_p0(A, wg, nwg); if (FAST_GEMM) fast_p0_weights(A, wg, nwg, (LAS float*)ldsl, 0, NI_W1); }
        else {
            const int l = (ph - 1) / 6, k = (ph - 1) % 6;
            if (k == 1) {
#if FAST_MIX
                mx::mixer_phase(A, l, ldsl, MISC + 4);
#else
                nv_attn(A, l, wg, nwg, sm); nv_conv(A, l, wg, nwg); nv_ret(A, l, wg, nwg, sm);
#endif
            }
            else if (FAST_GEMM && ((FAST_MASK >> k) & 1)) fast_gemm(A, l, k, ldsl);
            else if (k == 0) nv_p1(A, l, wg, nwg, sm);
            else if (k == 2) nv_p3(A, l, wg, nwg, sm);
            else if (k == 3) nv_resid_gemm(A, (const bf16_t*)(A.ws + WS_Y), DM, DM, A.in[I_WOUT] + (size_t)l * DM * DM, l == 0 ? A.in[I_X] : A.out,
                                           (float*)(A.ws + WS_ROWSS) + (size_t)(l == 0 ? 1 : 3) * M, wg, nwg, sm);
            else if (k == 4) nv_p5(A, l, wg, nwg, sm);
            else nv_resid_gemm(A, (const bf16_t*)(A.ws + WS_MID), DFF, DFF, A.in[I_WF2] + (size_t)l * DFF * DM, A.out,
                               l + 1 < DEPTH ? (float*)(A.ws + WS_ROWSS) + (size_t)2 * M : nullptr, wg, nwg, sm);
        }
        if (ph + 1 < A0.ph_hi) xcd_barrier(bar);
#if PROBE_PHASE >= 0
        if (blockIdx.x == 0 && threadIdx.x == 0) { const unsigned long long now = __builtin_amdgcn_s_memrealtime(); const int k = ph == 0 ? 0 : 1 + (ph - 1) % 6;
            if (k == PROBE_PHASE) MISC[9] += (unsigned)now - MISC[10]; MISC[10] = (unsigned)now; }
#endif
    }
#if PROBE_PHASE >= 0
    xcd_barrier(bar);
    if (blockIdx.x == 0 && threadIdx.x == 0) { const unsigned now = (unsigned)__builtin_amdgcn_s_memrealtime(); float frac = (float)MISC[9] / (float)(now - MISC[8]);
        if (PROBE_PHASE >= 10) frac = (float)__hip_atomic_load((unsigned*)(A0.ws + WS_CTL) + mx::CW_QUEUE + 2048, __ATOMIC_RELAXED, __HIP_MEMORY_SCOPE_AGENT) / ((float)gridDim.x * (float)(now - MISC[8]));
        A0.out[0] += 2.0f + 28.0f * frac; }
#endif
}

extern "C" void kernel_launch(void* const* d_in, const int* in_sizes, int n_in, void* d_out, int out_size, void* d_ws, size_t ws_size, hipStream_t stream) {
    static int grid = 0;
    if (grid == 0) {
        if (n_in != N_IN || out_size != M * DM || ws_size < WS_END) { fprintf(stderr, "kernel_launch: unexpected shapes (n_in %d out %d ws %zu)\n", n_in, out_size, ws_size); grid = -1; return; }
        int dev = 0, cus = 0, per_cu = 0;
        (void)hipGetDevice(&dev); (void)hipDeviceGetAttribute(&cus, hipDeviceAttributeMultiprocessorCount, dev);
        (void)hipFuncSetAttribute((const void*)fwd_kernel, hipFuncAttributeMaxDynamicSharedMemorySize, LDS_BYTES);
        (void)hipOccupancyMaxActiveBlocksPerMultiprocessor(&per_cu, (const void*)fwd_kernel, NTHREADS, LDS_BYTES);
        (void)hipGetLastError();
        if (per_cu < 1) fprintf(stderr, "kernel_launch: occupancy query says %d blocks per CU\n", per_cu);
        grid = cus;
    }
    if (grid < 0) return;
    (void)hipMemsetAsync((char*)d_ws + WS_CTL, 0, CTL_ZERO_BYTES, stream);
    Args a{};
    for (int i = 0; i < N_IN; ++i) a.in[i] = (const float*)d_in[i];
    a.out = (float*)d_out; a.ws = (unsigned char*)d_ws;
    a.ph_lo = 0; a.ph_hi = N_PHASES;
    void* args[] = {&a};
    hipError_t e = hipLaunchCooperativeKernel((const void*)fwd_kernel, dim3(grid), dim3(NTHREADS), args, LDS_BYTES, stream);
    if (e != hipSuccess) fprintf(stderr, "cooperative launch failed: %s (grid %d)\n", hipGetErrorString(e), grid);
}
```

```cpp
#include <hip/hip_runtime.h>
#include <cstdio>
#include <cstdint>
#ifndef ABL_ATTN
#define ABL_ATTN 0
#endif
#ifndef PROBE_PHASE
#define PROBE_PHASE -1
#endif

#define GAS __attribute__((address_space(1)))
#define LAS __attribute__((address_space(3)))
typedef unsigned short bf16_t;
typedef GAS unsigned gu32;
#define RLX_AGENT __ATOMIC_RELAXED, __HIP_MEMORY_SCOPE_AGENT

constexpr int BATCH = 4, SEQ = 4096, DM = 1024, M = BATCH * SEQ, DEPTH = 2;
constexpr int DIN = 7680, NU = 4608, NGATE = 3072, DFF = 2816, BW = 512;
constexpr float RMS_EPS = 1e-6f, LN_EPS = 1e-5f;
constexpr float LOG2E = 1.4426950408889634f;
constexpr float QSCALE = 0.125f * LOG2E;
constexpr int NTHREADS = 512, NWAVES = 8;

enum { I_X = 0, I_N1G, I_WIN, I_QG, I_KG, I_DLAM, I_ASG, I_CW, I_CB, I_CLG, I_CLB, I_RGN, I_BGATE, I_WBR, I_WOUT, I_N2G, I_WF1, I_WF2, N_IN };

constexpr size_t MiB = 1u << 20;
constexpr size_t WS_CTL = 0, CTL_ZERO_BYTES = 1 * MiB;
constexpr size_t WS_ROWSS = 256 * 1024;
constexpr size_t WS_LAM = 512 * 1024;
constexpr size_t WS_XB = 78 * MiB;
constexpr size_t WS_AQ = 110 * MiB, WS_AK = 126 * MiB, WS_AV = 142 * MiB, WS_Z = 158 * MiB, WS_RQ = 174 * MiB, WS_RK = 190 * MiB, WS_RV = 206 * MiB, WS_RG = 222 * MiB, WS_YB = 238 * MiB;
constexpr size_t WS_YA = WS_AQ, WS_YC = WS_RQ;
constexpr size_t WS_Y = 126 * MiB;
constexpr size_t WS_MID = 110 * MiB;
constexpr size_t WS_END = 256 * MiB;
constexpr int CW_BAR = 4096;

struct Args { const float* in[N_IN]; float* out; unsigned char* ws; int ph_lo, ph_hi; };

__device__ __forceinline__ float bf2f(unsigned v) { return __uint_as_float(v << 16); }
__device__ __forceinline__ unsigned f2bf(float f) { unsigned u = __float_as_uint(f); return (u + 0x7fffu + ((u >> 16) & 1u)) >> 16; }
__device__ __forceinline__ unsigned pk2(float lo, float hi) { return f2bf(lo) | (f2bf(hi) << 16); }
__device__ __forceinline__ float wave_sum(float v) {
#pragma unroll
    for (int o = 1; o < 64; o <<= 1) v += __shfl_xor(v, o);
    return v;
}
__device__ __forceinline__ float wave_max(float v) {
#pragma unroll
    for (int o = 1; o < 64; o <<= 1) v = fmaxf(v, __shfl_xor(v, o));
    return v;
}
__device__ __forceinline__ int opaque_tid() { int t = threadIdx.x; asm volatile("" : "+v"(t)); return t; }
__device__ __forceinline__ float sigmoidf_(float x) { return 1.0f / (1.0f + __expf(-x)); }
__device__ __forceinline__ float siluf_(float x) { return x / (1.0f + __expf(-x)); }
__device__ __forceinline__ float lam_init_of(int l) { return l == 0 ? 0.2f : (0.8f - 0.6f * 0.74081822068171788f); }
__device__ __forceinline__ float log2_gamma(int h) { return log2f(1.0f - exp2f(-5.0f - (float)h)); }

#define XB_TMO      128
#define XB_XCNT(j)  (256  + 64 * (j))
#define XB_XSUB(j)  (1280 + 64 * (j))
#define XB_XGEN(j)  (2304 + 64 * (j))
#define XB_TOP      3328
#define XB_TOPGEN   3392
#define XCD_BAR_WORDS 3456
#define XB_SPIN_CAP (1u << 22)
__device__ __forceinline__ unsigned xb_ld(unsigned* p)              { return __hip_atomic_load(p, __ATOMIC_RELAXED, __HIP_MEMORY_SCOPE_AGENT); }
__device__ __forceinline__ unsigned xb_add(unsigned* p, unsigned v) { return __hip_atomic_fetch_add(p, v, __ATOMIC_RELAXED, __HIP_MEMORY_SCOPE_AGENT); }
__device__ __forceinline__ unsigned xb_xcc_id() { return (unsigned)__builtin_amdgcn_s_getreg((3 << 11) | 20) & 0xFu; }
#define XB_SPIN(cond, bar) do { unsigned _sp = 0; while (cond) { __builtin_amdgcn_s_sleep(1); \
    if ((++_sp & 255u) == 0u) { if (xb_ld(&(bar)[XB_TMO])) break; if (_sp > XB_SPIN_CAP) { atomicAdd(&(bar)[XB_TMO], 1u); break; } } } } while (0)
struct XcdBarrier { unsigned* bar; unsigned x; volatile LAS unsigned* st; };
__device__ __forceinline__ XcdBarrier xcd_barrier_post(unsigned* bar, volatile LAS unsigned* st) {
    XcdBarrier b; b.bar = bar; b.x = xb_xcc_id(); b.st = st;
    if (threadIdx.x == 0) (void)xb_add(&bar[XB_XCNT(b.x)], 1u);
    return b;
}
__device__ __forceinline__ void xcd_barrier_complete(unsigned* bar, unsigned x, unsigned& nloc, unsigned& nx) {
    const unsigned G = gridDim.x * gridDim.y * gridDim.z;
    unsigned sum, cnt, mine, sp = 0u;
    for (;;) {
        sum = 0u; cnt = 0u; mine = 0u;
#pragma unroll
        for (unsigned j = 0; j < 16; ++j) { const unsigned c = xb_ld(&bar[XB_XCNT(j)]); sum += c; cnt += (c > 0u) ? 1u : 0u; mine = (j == x) ? c : mine; }
        if (sum == G) break;
        __builtin_amdgcn_s_sleep(1);
        if ((++sp & 255u) == 0u) { if (xb_ld(&bar[XB_TMO])) break; if (sp > XB_SPIN_CAP) { atomicAdd(&bar[XB_TMO], 1u); break; } }
    }
    nloc = mine > 0u ? mine : 1u; nx = cnt > 0u ? cnt : 1u;
}
__device__ __forceinline__ void xcd_barrier(const XcdBarrier& b) {
    asm volatile("s_waitcnt vmcnt(0)" ::: "memory");
    __syncthreads();
    if (threadIdx.x == 0) {
        unsigned* bar = b.bar;
        __builtin_amdgcn_s_waitcnt(0);
        unsigned nloc = b.st[0], nx = b.st[1];
        if (nloc == 0u) { xcd_barrier_complete(bar, b.x, nloc, nx); b.st[0] = nloc; b.st[1] = nx; }
        const unsigned old = xb_add(&bar[XB_XSUB(b.x)], 1u);
        const unsigned gen = old / nloc;
        if (old + 1u == (gen + 1u) * nloc) {
            __builtin_amdgcn_fence(__ATOMIC_RELEASE, "agent");
            asm volatile("s_waitcnt vmcnt(0)" ::: "memory");
            const unsigned og = xb_add(&bar[XB_TOP], 1u);
            const unsigned tg = og / nx;
            if (og + 1u == (tg + 1u) * nx) xb_add(&bar[XB_TOPGEN], 1u);
            else XB_SPIN(xb_ld(&bar[XB_TOPGEN]) == tg, bar);
            __builtin_amdgcn_fence(__ATOMIC_ACQUIRE, "agent");
            xb_add(&bar[XB_XGEN(b.x)], 1u);
            asm volatile("s_waitcnt vmcnt(0)" ::: "memory");
        } else {
            XB_SPIN(xb_ld(&bar[XB_XGEN(b.x)]) == gen, bar);
            __builtin_amdgcn_fence(__ATOMIC_ACQUIRE, "agent");
            asm volatile("s_waitcnt vmcnt(0)" ::: "memory");
        }
    }
    __syncthreads();
}


__device__ __forceinline__ void nv_p0(const Args& A, int wg, int nwg) {
    const int tid = opaque_tid(), lane = tid & 63, wave = tid >> 6;
    const float* x = A.in[I_X];
    bf16_t* XB = (bf16_t*)(A.ws + WS_XB);
    float* rowss = (float*)(A.ws + WS_ROWSS);
    for (int m0 = wg * NWAVES + wave; m0 < M; m0 += 4 * nwg * NWAVES) {
        float4 v[4][4];
#pragma unroll
        for (int r = 0; r < 4; ++r) { const int m = m0 + r * nwg * NWAVES; if (m < M) { const float4* xr = (const float4*)(x + (size_t)m * DM) + lane;
#pragma unroll
            for (int j = 0; j < 4; ++j) v[r][j] = xr[64 * j]; } }
#pragma unroll
        for (int r = 0; r < 4; ++r) { const int m = m0 + r * nwg * NWAVES; if (m < M) { uint2* o = (uint2*)(XB + (size_t)m * DM) + lane; float s = 0.f;
#pragma unroll
            for (int j = 0; j < 4; ++j) { const float4 q = v[r][j]; s += q.x * q.x + q.y * q.y + q.z * q.z + q.w * q.w; o[64 * j] = make_uint2(pk2(q.x, q.y), pk2(q.z, q.w)); }
            s = wave_sum(s);
            if (lane == 0) rowss[m] = s; } }
    }
    if (wg == 0 && wave < DEPTH) {
        const float* dl = A.in[I_DLAM] + wave * 4 * 64;
        float a = dl[lane] * dl[64 + lane], b = dl[128 + lane] * dl[192 + lane];
        a = wave_sum(a); b = wave_sum(b);
        if (lane == 0) ((float*)(A.ws + WS_LAM))[wave] = __expf(a) - __expf(b) + lam_init_of(wave);
    }
}

template <class AL, class WL>
__device__ __forceinline__ void nv_core(float (&acc)[4][4], int K, const AL& aload, const WL& wload, float* sA, float* sB, int tid) {
    const int tx = tid & 15, ty = tid >> 4;
#pragma unroll
    for (int i = 0; i < 4; ++i)
#pragma unroll
        for (int j = 0; j < 4; ++j) acc[i][j] = 0.f;
    const int ar = tid & 127, akq = tid >> 7;
    const int wk = tid >> 5, wc = (tid & 31) * 2;
#pragma unroll 1
    for (int k0 = 0; k0 < K; k0 += 16) {
        float a0, a1, a2, a3; aload(ar, k0 + 4 * akq, a0, a1, a2, a3);
        const float w0 = wload(k0 + wk, wc), w1 = wload(k0 + wk, wc + 1);
        __syncthreads();
        sA[(4 * akq + 0) * 128 + ar] = a0; sA[(4 * akq + 1) * 128 + ar] = a1; sA[(4 * akq + 2) * 128 + ar] = a2; sA[(4 * akq + 3) * 128 + ar] = a3;
        sB[wk * 64 + wc] = w0; sB[wk * 64 + wc + 1] = w1;
        __syncthreads();
#pragma unroll 2
        for (int kk = 0; kk < 16; ++kk) {
            const float4 a = *(const float4*)&sA[kk * 128 + ty * 4];
            const float4 b = *(const float4*)&sB[kk * 64 + tx * 4];
            const float av[4] = {a.x, a.y, a.z, a.w}, bv[4] = {b.x, b.y, b.z, b.w};
#pragma unroll
            for (int i = 0; i < 4; ++i)
#pragma unroll
                for (int j = 0; j < 4; ++j) acc[i][j] += av[i] * bv[j];
        }
    }
    __syncthreads();
}
struct ALbf {
    const bf16_t* A; int lda; int row0;
    __device__ __forceinline__ void operator()(int r, int k, float& a0, float& a1, float& a2, float& a3) const {
        const uint2 v = *(const uint2*)(A + (size_t)(row0 + r) * lda + k);
        a0 = __uint_as_float(v.x << 16); a1 = __uint_as_float(v.x & 0xffff0000u); a2 = __uint_as_float(v.y << 16); a3 = __uint_as_float(v.y & 0xffff0000u);
    }
};
struct WLf32 {
    const float* W; int ldw; int c0, c1; const float* g;
    __device__ __forceinline__ float operator()(int k, int j) const {
        const float w = W[(size_t)k * ldw + (j < 32 ? c0 + j : c1 + j - 32)];
        return g ? w * g[k] : w;
    }
};

__device__ __forceinline__ void nv_p1(const Args& A, int l, int wg, int nwg, float* sm) {
    float* sA = sm; float* sB = sm + 16 * 128; float* sC = sB + 16 * 64;
    const int tid = opaque_tid(), tx = tid & 15, ty = tid >> 4;
    const float* Win = A.in[I_WIN] + (size_t)l * DM * DIN;
    const float* g1 = A.in[I_N1G] + l * DM;
    const bf16_t* XB = (const bf16_t*)(A.ws + WS_XB);
    const float* rowss = (const float*)(A.ws + WS_ROWSS) + (size_t)(l == 0 ? 0 : 2) * M;
    const float* qg = A.in[I_QG] + l * 64; const float* kg = A.in[I_KG] + l * 64;
    for (int it = wg; it < 128 * 72; it += nwg) {
        const int rt = it / 72, cg = it % 72, row0 = rt * 128;
        int c0 = 64 * cg, c1 = 64 * cg + 32;
        if (cg >= 24 && cg < 40) { c0 = 1536 + 32 * (cg - 24); c1 = 2048 + 32 * (cg - 24); }
        float acc[4][4];
        nv_core(acc, DM, ALbf{XB, DM, row0}, WLf32{Win, DIN, c0, c1, g1}, sA, sB, tid);
#pragma unroll
        for (int i = 0; i < 4; ++i) {
            const int r = ty * 4 + i; const float rstd = rsqrtf(rowss[row0 + r] * (1.0f / DM) + RMS_EPS);
#pragma unroll
            for (int j = 0; j < 4; ++j) sC[r * 65 + tx * 4 + j] = acc[i][j] * rstd;
        }
        __syncthreads();
        const int r = tid >> 2, q4 = tid & 3, m = row0 + r, t = m & (SEQ - 1);
        const float* cr = sC + r * 65;
        if (cg < 16) {
            float ss = 0.f;
#pragma unroll
            for (int j = 0; j < 16; ++j) { const float v = cr[q4 * 16 + j]; ss += v * v; }
            ss += __shfl_xor(ss, 1); ss += __shfl_xor(ss, 2);
            const float rn = rsqrtf(ss * (1.0f / 64.0f) + RMS_EPS);
            const bool isq = cg < 8; const float* gg = isq ? qg : kg; const float sc = isq ? QSCALE : 1.0f;
            bf16_t* o = (bf16_t*)(A.ws + (isq ? WS_AQ : WS_AK)) + (size_t)m * BW + (cg & 7) * 64 + q4 * 16;
#pragma unroll
            for (int j = 0; j < 16; ++j) o[j] = (bf16_t)f2bf(cr[q4 * 16 + j] * rn * gg[q4 * 16 + j] * sc);
        } else if (cg >= 24 && cg < 40) {
            bf16_t* o = (bf16_t*)(A.ws + WS_Z) + (size_t)m * BW + (cg - 24) * 32 + q4 * 8;
#pragma unroll
            for (int j = 0; j < 8; ++j) o[j] = (bf16_t)f2bf(cr[q4 * 8 + j] * sigmoidf_(cr[32 + q4 * 8 + j]));
        } else {
            size_t base; int cb; int kind;
            if (cg < 24)      { base = WS_AV; cb = cg - 16; kind = 0; }
            else if (cg < 48) { base = WS_RQ; cb = cg - 40; kind = 1; }
            else if (cg < 56) { base = WS_RK; cb = cg - 48; kind = 2; }
            else if (cg < 64) { base = WS_RV; cb = cg - 56; kind = 0; }
            else              { base = WS_RG; cb = cg - 64; kind = 3; }
            const int h = cb >> 1; const float l2g = log2_gamma(h); const float tp = (float)(t & 127);
            float f = 1.0f;
            if (kind == 1) f = exp2f(tp * l2g);
            if (kind == 2) f = 0.08838834764831845f * exp2f(-tp * l2g);
            bf16_t* o = (bf16_t*)(A.ws + base) + (size_t)m * BW + cb * 64 + q4 * 16;
#pragma unroll
            for (int j = 0; j < 16; ++j) { float v = cr[q4 * 16 + j]; v = (kind == 3) ? siluf_(v) : v * f; o[j] = (bf16_t)f2bf(v); }
        }
        __syncthreads();
    }
}

__device__ __forceinline__ void nv_attn(const Args& A, int l, int wg, int nwg, float* sm) {
    const int tid = opaque_tid(), lane = tid & 63, wave = tid >> 6;
    float* sq = sm + wave * 256;
    const bf16_t* AQ = (const bf16_t*)(A.ws + WS_AQ); const bf16_t* AK = (const bf16_t*)(A.ws + WS_AK); const bf16_t* AV = (const bf16_t*)(A.ws + WS_AV);
    bf16_t* YA = (bf16_t*)(A.ws + WS_YA);
    const float lam = ((const float*)(A.ws + WS_LAM))[l];
    const float* asg = A.in[I_ASG] + l * 128;
    const float osc = 1.0f - lam_init_of(l);
    for (int it = wg * NWAVES + wave; it < BATCH * 4 * SEQ; it += nwg * NWAVES) {
        const int t = it & (SEQ - 1), h = (it >> 12) & 3, b = it >> 14;
        const size_t mq = (size_t)b * SEQ + t;
        const float slope2 = exp2f(-2.0f * (float)(h + 1)) * LOG2E;
        sq[lane] = bf2f(AQ[mq * BW + h * 128 + lane]); sq[64 + lane] = bf2f(AQ[mq * BW + h * 128 + 64 + lane]);
        float m1 = -INFINITY, m2 = -INFINITY, l1 = 0.f, l2 = 0.f, o1a = 0.f, o1b = 0.f, o2a = 0.f, o2b = 0.f;
        for (int s0 = 0; s0 <= t; s0 += 64) {
            const int s = s0 + lane; const bool valid = s <= t;
            float d1 = 0.f, d2 = 0.f;
            if (valid) {
                const uint4* kr = (const uint4*)(AK + ((size_t)b * SEQ + s) * BW + h * 128);
#pragma unroll 2
                for (int c = 0; c < 8; ++c) {
                    const uint4 v = kr[c]; const unsigned w[4] = {v.x, v.y, v.z, v.w};
#pragma unroll
                    for (int e = 0; e < 4; ++e) { d1 += sq[c * 8 + 2 * e] * __uint_as_float(w[e] << 16) + sq[c * 8 + 2 * e + 1] * __uint_as_float(w[e] & 0xffff0000u); }
                }
#pragma unroll 2
                for (int c = 0; c < 8; ++c) {
                    const uint4 v = kr[8 + c]; const unsigned w[4] = {v.x, v.y, v.z, v.w};
#pragma unroll
                    for (int e = 0; e < 4; ++e) { d2 += sq[64 + c * 8 + 2 * e] * __uint_as_float(w[e] << 16) + sq[64 + c * 8 + 2 * e + 1] * __uint_as_float(w[e] & 0xffff0000u); }
                }
            }
            const float bias = slope2 * (float)(s - t);
            const float s1 = valid ? d1 + bias : -INFINITY, s2 = valid ? d2 + bias : -INFINITY;
            const float n1 = fmaxf(m1, wave_max(s1)), n2 = fmaxf(m2, wave_max(s2));
            const float a1 = exp2f(m1 - n1), a2 = exp2f(m2 - n2);
            const float p1 = exp2f(s1 - n1), p2 = exp2f(s2 - n2);
            l1 = l1 * a1 + wave_sum(p1); l2 = l2 * a2 + wave_sum(p2);
            o1a *= a1; o1b *= a1; o2a *= a2; o2b *= a2; m1 = n1; m2 = n2;
            sq[128 + lane] = p1; sq[192 + lane] = p2;
            const int nk = min(64, t - s0 + 1);
            const unsigned* vr = (const unsigned*)(AV + ((size_t)b * SEQ + s0) * BW + h * 128) + lane;
            for (int j = 0; j < nk; ++j) {
                const unsigned v = vr[(size_t)j * (BW / 2)];
                const float va = __uint_as_float(v << 16), vb = __uint_as_float(v & 0xffff0000u);
                const float q1 = sq[128 + j], q2 = sq[192 + j];
                o1a += q1 * va; o1b += q1 * vb; o2a += q2 * va; o2b += q2 * vb;
            }
        }
        const float i1 = 1.0f / l1, i2 = lam / l2;
        const float ya = o1a * i1 - o2a * i2, yb = o1b * i1 - o2b * i2;
        const float ss = wave_sum(ya * ya + yb * yb);
        const float rn = rsqrtf(ss * (1.0f / 128.0f) + RMS_EPS) * osc;
        ((unsigned*)(YA + mq * BW + h * 128))[lane] = pk2(ya * rn * asg[2 * lane], yb * rn * asg[2 * lane + 1]);
    }
}

__device__ __forceinline__ void nv_conv(const Args& A, int l, int wg, int nwg) {
    const int tid = opaque_tid(), lane = tid & 63, wave = tid >> 6;
    const bf16_t* Z = (const bf16_t*)(A.ws + WS_Z); bf16_t* YB = (bf16_t*)(A.ws + WS_YB);
    const float* cw = A.in[I_CW] + (size_t)l * 31 * BW; const float* cb = A.in[I_CB] + l * BW;
    const float* lg = A.in[I_CLG] + l * BW; const float* lb = A.in[I_CLB] + l * BW;
    const int c0 = lane * 8;
    for (int m = wg * NWAVES + wave; m < M; m += nwg * NWAVES) {
        const int t = m & (SEQ - 1);
        float acc[8];
#pragma unroll
        for (int e = 0; e < 8; ++e) acc[e] = cb[c0 + e];
        const int j0 = max(0, 30 - t);
        for (int j = j0; j < 31; ++j) {
            const uint4 v = *(const uint4*)(Z + (size_t)(m - 30 + j) * BW + c0);
            const float4 wa = *(const float4*)(cw + j * BW + c0), wb = *(const float4*)(cw + j * BW + c0 + 4);
            acc[0] += wa.x * __uint_as_float(v.x << 16); acc[1] += wa.y * __uint_as_float(v.x & 0xffff0000u);
            acc[2] += wa.z * __uint_as_float(v.y << 16); acc[3] += wa.w * __uint_as_float(v.y & 0xffff0000u);
            acc[4] += wb.x * __uint_as_float(v.z << 16); acc[5] += wb.y * __uint_as_float(v.z & 0xffff0000u);
            acc[6] += wb.z * __uint_as_float(v.w << 16); acc[7] += wb.w * __uint_as_float(v.w & 0xffff0000u);
        }
        float s = 0.f;
#pragma unroll
        for (int e = 0; e < 8; ++e) s += acc[e];
        const float mu = wave_sum(s) * (1.0f / BW);
        float q = 0.f;
#pragma unroll
        for (int e = 0; e < 8; ++e) { acc[e] -= mu; q += acc[e] * acc[e]; }
        const float rstd = rsqrtf(wave_sum(q) * (1.0f / BW) + LN_EPS);
        float o[8];
#pragma unroll
        for (int e = 0; e < 8; ++e) o[e] = siluf_(acc[e] * rstd * lg[c0 + e] + lb[c0 + e]);
        *(uint4*)(YB + (size_t)m * BW + c0) = make_uint4(pk2(o[0], o[1]), pk2(o[2], o[3]), pk2(o[4], o[5]), pk2(o[6], o[7]));
    }
}

__device__ __forceinline__ void nv_ret(const Args& A, int l, int wg, int nwg, float* sm) {
    const int tid = opaque_tid(), lane = tid & 63, wave = tid >> 6;
    float* sq = sm + wave * 256;
    const bf16_t* RQ = (const bf16_t*)(A.ws + WS_RQ); const bf16_t* RK = (const bf16_t*)(A.ws + WS_RK); const bf16_t* RV = (const bf16_t*)(A.ws + WS_RV);
    const bf16_t* RG = (const bf16_t*)(A.ws + WS_RG); bf16_t* YC = (bf16_t*)(A.ws + WS_YC);
    const float* gn = A.in[I_RGN] + l * 128;
    for (int it = wg * NWAVES + wave; it < BATCH * 4 * SEQ; it += nwg * NWAVES) {
        const int t = it & (SEQ - 1), h = (it >> 12) & 3, b = it >> 14;
        const size_t mq = (size_t)b * SEQ + t;
        const float l2g128 = 128.0f * log2_gamma(h);
        { const unsigned v = ((const unsigned*)(RQ + mq * BW + h * 128))[lane]; sq[2 * lane] = __uint_as_float(v << 16); sq[2 * lane + 1] = __uint_as_float(v & 0xffff0000u); }
        float oa = 0.f, ob = 0.f;
        const int ct = t >> 7;
        for (int s0 = 0; s0 <= t; s0 += 64) {
            const int s = s0 + lane; const bool valid = s <= t;
            float d = 0.f;
            if (valid) {
                const uint4* kr = (const uint4*)(RK + ((size_t)b * SEQ + s) * BW + h * 128);
#pragma unroll 2
                for (int c = 0; c < 16; ++c) {
                    const uint4 v = kr[c]; const unsigned w[4] = {v.x, v.y, v.z, v.w};
#pragma unroll
                    for (int e = 0; e < 4; ++e) { d += sq[c * 8 + 2 * e] * __uint_as_float(w[e] << 16) + sq[c * 8 + 2 * e + 1] * __uint_as_float(w[e] & 0xffff0000u); }
                }
                d *= exp2f(l2g128 * (float)(ct - (s >> 7)));
            }
            sq[128 + lane] = d;
            const int nk = min(64, t - s0 + 1);
            const unsigned* vr = (const unsigned*)(RV + ((size_t)b * SEQ + s0) * BW + h * 128) + lane;
            for (int j = 0; j < nk; ++j) {
                const unsigned v = vr[(size_t)j * (BW / 2)];
                const float a = sq[128 + j];
                oa += a * __uint_as_float(v << 16); ob += a * __uint_as_float(v & 0xffff0000u);
            }
        }
        const float ss = wave_sum(oa * oa + ob * ob);
        const float rn = rsqrtf(ss * (1.0f / 128.0f) + RMS_EPS);
        const unsigned gv = ((const unsigned*)(RG + mq * BW + h * 128))[lane];
        ((unsigned*)(YC + mq * BW + h * 128))[lane] = pk2(oa * rn * gn[2 * lane] * __uint_as_float(gv << 16), ob * rn * gn[2 * lane + 1] * __uint_as_float(gv & 0xffff0000u));
    }
}

__device__ __forceinline__ void nv_p3(const Args& A, int l, int wg, int nwg, float* sm) {
    float* sA = sm; float* sB = sm + 16 * 128;
    const int tid = opaque_tid(), tx = tid & 15, ty = tid >> 4;
    const float* Win = A.in[I_WIN] + (size_t)l * DM * DIN;
    const float* g1 = A.in[I_N1G] + l * DM;
    const float* bg = A.in[I_BGATE] + l * NGATE;
    const float* Wbr = A.in[I_WBR] + (size_t)l * 3 * BW * DM;
    const bf16_t* XB = (const bf16_t*)(A.ws + WS_XB);
    const float* rowss = (const float*)(A.ws + WS_ROWSS) + (size_t)(l == 0 ? 0 : 2) * M;
    bf16_t* Y = (bf16_t*)(A.ws + WS_Y);
    for (int it = wg; it < 128 * 16; it += nwg) {
        const int rt = it / 16, cg = it % 16, row0 = rt * 128;
        float y[4][4];
#pragma unroll
        for (int i = 0; i < 4; ++i)
#pragma unroll
            for (int j = 0; j < 4; ++j) y[i][j] = 0.f;
#pragma unroll 1
        for (int n = 0; n < 3; ++n) {
            float ga[4][4], pa[4][4];
            nv_core(ga, DM, ALbf{XB, DM, row0}, WLf32{Win, DIN, NU + n * DM + 64 * cg, NU + n * DM + 64 * cg + 32, g1}, sA, sB, tid);
            const bf16_t* br = (const bf16_t*)(A.ws + (n == 0 ? WS_YA : n == 1 ? WS_YB : WS_YC));
            nv_core(pa, BW, ALbf{br, BW, row0}, WLf32{Wbr + (size_t)n * BW * DM, DM, 64 * cg, 64 * cg + 32, nullptr}, sA, sB, tid);
#pragma unroll
            for (int i = 0; i < 4; ++i) {
                const float rstd = rsqrtf(rowss[row0 + ty * 4 + i] * (1.0f / DM) + RMS_EPS);
#pragma unroll
                for (int j = 0; j < 4; ++j) y[i][j] += sigmoidf_(ga[i][j] * rstd + bg[n * DM + 64 * cg + tx * 4 + j]) * pa[i][j];
            }
        }
#pragma unroll
        for (int i = 0; i < 4; ++i)
            *(uint2*)(Y + (size_t)(row0 + ty * 4 + i) * DM + 64 * cg + tx * 4) = make_uint2(pk2(y[i][0], y[i][1]), pk2(y[i][2], y[i][3]));
    }
}

__device__ __forceinline__ void nv_resid_gemm(const Args& A, const bf16_t* Am, int lda, int K, const float* W, const float* xold, float* rowss_next, int wg, int nwg, float* sm) {
    float* sA = sm; float* sB = sm + 16 * 128;
    const int tid = opaque_tid(), tx = tid & 15, ty = tid >> 4;
    bf16_t* XB = (bf16_t*)(A.ws + WS_XB);
    for (int it = wg; it < 128 * 16; it += nwg) {
        const int rt = it / 16, cg = it % 16, row0 = rt * 128;
        float acc[4][4];
        nv_core(acc, K, ALbf{Am, lda, row0}, WLf32{W, DM, 64 * cg, 64 * cg + 32, nullptr}, sA, sB, tid);
#pragma unroll
        for (int i = 0; i < 4; ++i) {
            const size_t off = (size_t)(row0 + ty * 4 + i) * DM + 64 * cg + tx * 4;
            const float4 xo = *(const float4*)(xold + off);
            const float4 xn = make_float4(xo.x + acc[i][0], xo.y + acc[i][1], xo.z + acc[i][2], xo.w + acc[i][3]);
            *(float4*)(A.out + off) = xn;
            *(uint2*)(XB + off) = make_uint2(pk2(xn.x, xn.y), pk2(xn.z, xn.w));
            float s = xn.x * xn.x + xn.y * xn.y + xn.z * xn.z + xn.w * xn.w;
            s += __shfl_xor(s, 1); s += __shfl_xor(s, 2); s += __shfl_xor(s, 4); s += __shfl_xor(s, 8);
            if (tx == 0 && rowss_next) atomicAdd(rowss_next + row0 + ty * 4 + i, s);
        }
    }
}

__device__ __forceinline__ void nv_p5(const Args& A, int l, int wg, int nwg, float* sm) {
    float* sA = sm; float* sB = sm + 16 * 128; float* sC = sB + 16 * 64;
    const int tid = opaque_tid(), tx = tid & 15, ty = tid >> 4;
    const float* W = A.in[I_WF1] + (size_t)l * DM * 2 * DFF;
    const float* g2 = A.in[I_N2G] + l * DM;
    const bf16_t* XB = (const bf16_t*)(A.ws + WS_XB);
    const float* rowss = (const float*)(A.ws + WS_ROWSS) + (size_t)(l == 0 ? 1 : 3) * M;
    bf16_t* MID = (bf16_t*)(A.ws + WS_MID);
    for (int it = wg; it < 128 * 88; it += nwg) {
        const int rt = it / 88, jj = it % 88, row0 = rt * 128;
        float acc[4][4];
        nv_core(acc, DM, ALbf{XB, DM, row0}, WLf32{W, 2 * DFF, 32 * jj, DFF + 32 * jj, g2}, sA, sB, tid);
#pragma unroll
        for (int i = 0; i < 4; ++i) {
            const int r = ty * 4 + i; const float rstd = rsqrtf(rowss[row0 + r] * (1.0f / DM) + RMS_EPS);
#pragma unroll
            for (int j = 0; j < 4; ++j) sC[r * 65 + tx * 4 + j] = acc[i][j] * rstd;
        }
        __syncthreads();
        const int r = tid >> 2, q4 = tid & 3;
        const float* cr = sC + r * 65;
        bf16_t* o = MID + (size_t)(row0 + r) * DFF + 32 * jj + q4 * 8;
#pragma unroll
        for (int j = 0; j < 8; ++j) o[j] = (bf16_t)f2bf(siluf_(cr[q4 * 8 + j]) * cr[32 + q4 * 8 + j]);
        __syncthreads();
    }
}


namespace pg8 {
typedef short bf16x8 __attribute__((ext_vector_type(8)));
typedef float f32x4 __attribute__((ext_vector_type(4)));
typedef unsigned u32x4 __attribute__((ext_vector_type(4)));
constexpr int BM = 256, BK = 64, HALF = 128, HTB = HALF * BK * 2, STAGE_BYTES = 8 * HTB, NXCD = 8, WGM = 8;
__host__ __device__ __forceinline__ int lds_byte(int r, int c) { const int st = (r >> 4) * 2 + (c >> 5), rr = r & 15, cc = c & 31, ob = rr * 64 + cc * 2; return st * 1024 + (ob ^ (((ob >> 9) & 1) << 5)); }
__host__ __device__ __forceinline__ void stage_rc(int b, int& R, int& C) { const int st = b / 1024, sb = b % 1024, swz = sb ^ (((sb >> 9) & 1) << 5); R = (st >> 1) * 16 + swz / 64; C = (st & 1) * 32 + (swz % 64) / 2; }
__host__ __device__ __forceinline__ int perm32(int rho) { const int n = rho >> 4, i = rho & 15; return 8 * (i >> 2) + 4 * n + (i & 3); }

struct GUnit { const char* A; const char* B; int lda2, ldb2, nt, pm, pn, kind; };

struct TileOrder {
    int nM, nN, nwg, G, c;
    __device__ __forceinline__ void init(int nM_, int nN_, int G_, int c_) { nM = nM_; nN = nN_; nwg = nM * nN; G = G_; c = c_; }
    __device__ __forceinline__ bool tile(int i, int& pm, int& pn) const {
        const long L = (long)i * G + c; if (L >= nwg) return false;
        int wgid = (int)L; { const int q = nwg / NXCD, r = nwg % NXCD, xcd = wgid % NXCD, off = wgid / NXCD; wgid = (xcd < r ? xcd * (q + 1) : r * (q + 1) + (xcd - r) * q) + off; }
        const int nig = WGM * nN, gid = wgid / nig, fm = gid * WGM, gsz = (nM - fm) < WGM ? (nM - fm) : WGM;
        pm = fm + ((wgid % nig) % gsz); pn = (wgid % nig) / gsz; return true;
    }
};

typedef float f32x2_t __attribute__((ext_vector_type(2))); typedef __bf16 bf16x2_t __attribute__((ext_vector_type(2)));
__device__ __forceinline__ unsigned cvt_pk_bf16(float lo, float hi) { f32x2_t v = {lo, hi}; bf16x2_t b = __builtin_convertvector(v, bf16x2_t); return __builtin_bit_cast(unsigned, b); }
__device__ __forceinline__ u32x4 pack8(const f32x4& a, const f32x4& b) { u32x4 w; w.x = cvt_pk_bf16(a[0], a[1]); w.y = cvt_pk_bf16(a[2], a[3]); w.z = cvt_pk_bf16(b[0], b[1]); w.w = cvt_pk_bf16(b[2], b[3]); return w; }

template <class Epi, class Sched>
__device__ __forceinline__ void gemm_phase(LAS unsigned char* lds, const Sched& S, const Epi& E) {
    const int tid = opaque_tid(), wid = __builtin_amdgcn_readfirstlane(tid >> 6), lane = tid & 63, wr = wid >> 2, wc = wid & 3, fr = lane & 15, fq = lane >> 4;
    const size_t kstep = (size_t)(BK * 2);
    const unsigned ldsw = (unsigned)wid * 1024u;
    const int aoff = lds_byte(wr * 64 + fr, fq * 8), boff = lds_byte(wc * 32 + fr, fq * 8);
#define PG8_SA(b, h) (((b) * 2 + (h)) * HTB)
#define PG8_SB(b, h) ((4 + (b) * 2 + (h)) * HTB)
#define PG8_STAGE(bufoff, gbase, voff) do { _Pragma("unroll") for (int _i = 0; _i < 2; ++_i) \
        __builtin_amdgcn_global_load_lds((const unsigned*)((const char*)(gbase) + (voff)[_i]), (LAS unsigned*)(lds + (bufoff) + ldsw + _i * 8192), 16, 0, 0); } while (0)
#define PG8_LDA(dst, b, h) do { _Pragma("unroll") for (int m = 0; m < 4; ++m) _Pragma("unroll") for (int k = 0; k < 2; ++k) dst[m][k] = *(const LAS bf16x8*)(lds + PG8_SA(b, h) + aoff + m * 2048 + k * 1024); } while (0)
#define PG8_LDB(dst, b, h) do { _Pragma("unroll") for (int n = 0; n < 2; ++n) _Pragma("unroll") for (int k = 0; k < 2; ++k) dst[n][k] = *(const LAS bf16x8*)(lds + PG8_SB(b, h) + boff + n * 2048 + k * 1024); } while (0)
#define PG8_MMA(ai, bj, At, Bt) do { __builtin_amdgcn_s_setprio(1); _Pragma("unroll") for (int m = 0; m < 4; ++m) _Pragma("unroll") for (int n = 0; n < 2; ++n) _Pragma("unroll") for (int k = 0; k < 2; ++k) \
        acc[ai][bj][m][n] = __builtin_amdgcn_mfma_f32_16x16x32_bf16(Bt[n][k], At[m][k], acc[ai][bj][m][n], 0, 0, 0); __builtin_amdgcn_s_setprio(0); } while (0)
#define PG8_WAIT_V(n) asm volatile("s_waitcnt vmcnt(" #n ")" ::: "memory")
#define PG8_WAIT_L(n) asm volatile("s_waitcnt lgkmcnt(" #n ")" ::: "memory")
#define PG8_BAR __builtin_amdgcn_s_barrier()
#define PG8_SCHED __builtin_amdgcn_sched_barrier(0)
    GUnit cur, nxt; int ui = 0;
    if (!S.next(0, cur)) return;
    f32x4 acc[2][2][4][2];
#pragma unroll
    for (int a = 0; a < 2; ++a)
#pragma unroll
        for (int b = 0; b < 2; ++b)
#pragma unroll
            for (int m = 0; m < 4; ++m)
#pragma unroll
                for (int n = 0; n < 2; ++n) acc[a][b][m][n] = (f32x4){0.f, 0.f, 0.f, 0.f};
    bf16x8 At[4][2], B0[2][2], B1[2][2];
#define PG8_VOFF(vA_, vB_, lda2_, ldb2_) do { int tt_ = tid; asm volatile("" : "+v"(tt_)); _Pragma("unroll") for (int i_ = 0; i_ < 2; ++i_) { int R_, C_; stage_rc(tt_ * 16 + i_ * 8192, R_, C_); \
        vA_[i_] = (unsigned)(R_ * (lda2_) + C_ * 2); vB_[i_] = (unsigned)(((R_ & ~31) + perm32(R_ & 31)) * (ldb2_) + C_ * 2); } } while (0)
    const char* cA = cur.A; const char* cB = cur.B; size_t hA = (size_t)HALF * cur.lda2, hB = (size_t)HALF * cur.ldb2;
    unsigned vA[2], vB[2]; PG8_VOFF(vA, vB, cur.lda2, cur.ldb2);
    {
    PG8_STAGE(PG8_SB(0, 0), cB, vB); PG8_STAGE(PG8_SB(0, 1), cB + hB, vB); PG8_STAGE(PG8_SA(0, 0), cA, vA); PG8_STAGE(PG8_SA(0, 1), cA + hA, vA);
    if (wr == 1) PG8_BAR;
    PG8_WAIT_V(2); PG8_BAR;
    PG8_STAGE(PG8_SB(1, 0), cB + kstep, vB); PG8_STAGE(PG8_SA(1, 0), cA + kstep, vA); PG8_STAGE(PG8_SB(1, 1), cB + hB + kstep, vB);
    PG8_WAIT_V(6); PG8_BAR; }
    for (;;) {
        const bool has_next = S.next(ui + 1, nxt);
        if (!has_next) nxt = cur;
        const size_t nhA = (size_t)HALF * nxt.lda2, nhB = (size_t)HALF * nxt.ldb2;
        const int nt = cur.nt;
        unsigned wA[2], wB[2];
        for (int t = 0; t < nt; t += 2) {
            const bool last = (t == nt - 2);
            const char* a1 = cA + (size_t)(t + 1) * kstep;
            const char* a2 = last ? nxt.A : cA + (size_t)(t + 2) * kstep; const char* b2 = last ? nxt.B : cB + (size_t)(t + 2) * kstep;
            const char* a3 = a2 + kstep; const char* b3 = b2 + kstep;
            const size_t whA = last ? nhA : hA, whB = last ? nhB : hB;
            PG8_LDB(B0, 0, 0); PG8_LDB(B1, 0, 1); PG8_SCHED; PG8_LDA(At, 0, 0);
            PG8_STAGE(PG8_SA(1, 1), a1 + hA, vA);
            if (last) PG8_VOFF(wA, wB, nxt.lda2, nxt.ldb2); else { wA[0] = vA[0]; wA[1] = vA[1]; wB[0] = vB[0]; wB[1] = vB[1]; }
            PG8_WAIT_V(8); PG8_WAIT_L(0); PG8_BAR; PG8_MMA(0, 0, At, B0); PG8_MMA(0, 1, At, B1); PG8_BAR; PG8_SCHED;
            PG8_LDA(At, 0, 1); PG8_STAGE(PG8_SB(0, 0), b2, wB); PG8_STAGE(PG8_SB(0, 1), b2 + whB, wB); PG8_STAGE(PG8_SA(0, 0), a2, wA);
            PG8_WAIT_V(8); PG8_WAIT_L(0); PG8_BAR; PG8_MMA(1, 0, At, B0); PG8_MMA(1, 1, At, B1); PG8_BAR; PG8_SCHED;
            PG8_LDB(B0, 1, 0); PG8_LDB(B1, 1, 1); PG8_SCHED; PG8_LDA(At, 1, 0); PG8_STAGE(PG8_SA(0, 1), a2 + whA, wA);
            PG8_WAIT_V(8); PG8_WAIT_L(0); PG8_BAR; PG8_MMA(0, 0, At, B0); PG8_MMA(0, 1, At, B1); PG8_BAR; PG8_SCHED;
            PG8_LDA(At, 1, 1); PG8_STAGE(PG8_SB(1, 0), b3, wB); PG8_STAGE(PG8_SB(1, 1), b3 + whB, wB); PG8_STAGE(PG8_SA(1, 0), a3, wA);
            PG8_WAIT_V(8); PG8_WAIT_L(0); PG8_BAR; PG8_MMA(1, 0, At, B0); PG8_MMA(1, 1, At, B1); PG8_BAR; PG8_SCHED;
        }
        if (wr == 0) PG8_BAR;
        { int fr_ = fr, fq_ = fq; asm volatile("" : "+v"(fr_), "+v"(fq_));
          E(acc, cur, wr, wc, fr_, fq_); }
        if (!has_next) break;
#pragma unroll
        for (int a = 0; a < 2; ++a)
#pragma unroll
            for (int b = 0; b < 2; ++b)
#pragma unroll
                for (int m = 0; m < 4; ++m)
#pragma unroll
                    for (int n = 0; n < 2; ++n) acc[a][b][m][n] = (f32x4){0.f, 0.f, 0.f, 0.f};
        cur = nxt; cA = cur.A; cB = cur.B; hA = nhA; hB = nhB;
        vA[0] = wA[0]; vA[1] = wA[1]; vB[0] = wB[0]; vB[1] = wB[1];
        ++ui;
        if (wr == 1) PG8_BAR;
    }
    PG8_WAIT_V(0);
    PG8_BAR;
#undef PG8_VOFF
#undef PG8_SA
#undef PG8_SB
#undef PG8_STAGE
#undef PG8_LDA
#undef PG8_LDB
#undef PG8_MMA
#undef PG8_WAIT_V
#undef PG8_WAIT_L
#undef PG8_BAR
#undef PG8_SCHED
}
}
using pg8::f32x4; using pg8::u32x4; using pg8::GUnit;

constexpr size_t WS_WB = 2 * MiB, WB_LAYER = 37 * MiB;
constexpr size_t WB_W1 = 0, WB_WG = 9 * MiB, WB_WBR = 15 * MiB, WB_WO = 18 * MiB, WB_WF1 = 20 * MiB, WB_WF2 = 31 * MiB;
constexpr size_t WS_GSCR = 190 * MiB;
static_assert(WS_WB + 2 * WB_LAYER <= WS_XB, "weights vs XB");

__device__ __forceinline__ int p1_src_col(int tile, int p) {
    if (tile < 4) return (tile >> 1) * 512 + (tile & 1) * 256 + 64 * ((p >> 5) & 3) + 32 * (p >> 7);
    if (tile < 6) return 1024 + (tile - 4) * 256 + p;
    if (tile < 10) return (p < 128) ? 1536 + 128 * (tile - 6) + p : 2048 + 128 * (tile - 6) + (p - 128);
    return 2560 + (tile - 10) * 256 + p;
}
__device__ __forceinline__ void p0_titem(const float* W, int ldw, int src0, const float* g, bf16_t* WT, int K, int prow0, int k0, LAS float* scr, int lane) {
    const int kr = lane >> 3, cq = (lane & 7) * 4;
    f32x4 v[8];
#pragma unroll
    for (int i = 0; i < 8; ++i) v[i] = *(const f32x4*)(W + (size_t)(k0 + 8 * i + kr) * ldw + src0 + cq);
    if (g) {
#pragma unroll
        for (int i = 0; i < 8; ++i) v[i] = v[i] * g[k0 + 8 * i + kr];
    }
#pragma unroll
    for (int i = 0; i < 8; ++i) { LAS float* d = scr + (8 * i + kr) * 33 + cq; d[0] = v[i][0]; d[1] = v[i][1]; d[2] = v[i][2]; d[3] = v[i][3]; }
    asm volatile("s_waitcnt lgkmcnt(0)" ::: "memory");
    const int c = lane & 7;
#pragma unroll
    for (int j = 0; j < 4; ++j) { const int n = (lane >> 3) + 8 * j; const LAS float* s_ = scr + (8 * c) * 33 + n;
        u32x4 o; o.x = pg8::cvt_pk_bf16(s_[0 * 33], s_[1 * 33]); o.y = pg8::cvt_pk_bf16(s_[2 * 33], s_[3 * 33]); o.z = pg8::cvt_pk_bf16(s_[4 * 33], s_[5 * 33]); o.w = pg8::cvt_pk_bf16(s_[6 * 33], s_[7 * 33]);
        *(u32x4*)(WT + (size_t)(prow0 + n) * K + k0 + 8 * c) = o; }
    asm volatile("s_waitcnt lgkmcnt(0)" ::: "memory");
}
constexpr int NI_W1 = 144 * 16, NI_WG = 96 * 16, NI_WBR = 3 * 32 * 8, NI_WO = 32 * 16, NI_F1 = 176 * 16, NI_F2 = 32 * 44;
constexpr int PER_LAYER = NI_W1 + NI_WG + NI_WBR + NI_WO + NI_F1 + NI_F2;
__device__ __forceinline__ void fast_p0_weights(const Args& A, int wg, int nwg, LAS float* sm, int item_lo, int item_hi) {
    const int tid = opaque_tid(), lane = tid & 63, wave = tid >> 6;
    LAS float* scr = sm + wave * (64 * 33);
    for (int it = item_lo + wg * NWAVES + wave; it < item_hi; it += nwg * NWAVES) {
        const int l = it / PER_LAYER; int r = it % PER_LAYER;
        unsigned char* wb = A.ws + WS_WB + (size_t)l * WB_LAYER;
        const float* Win = A.in[I_WIN] + (size_t)l * DM * DIN; const float* g1 = A.in[I_N1G] + l * DM;
        if (r < NI_W1) { const int rb = r / 16, kb = r % 16; p0_titem(Win, DIN, p1_src_col(rb >> 3, (rb & 7) * 32), g1, (bf16_t*)(wb + WB_W1), DM, 32 * rb, 64 * kb, scr, lane); continue; } r -= NI_W1;
        if (r < NI_WG) { const int rb = r / 16, kb = r % 16; p0_titem(Win, DIN, NU + 32 * rb, g1, (bf16_t*)(wb + WB_WG), DM, 32 * rb, 64 * kb, scr, lane); continue; } r -= NI_WG;
        if (r < NI_WBR) { const int n = r / 256, rr = r % 256, rb = rr / 8, kb = rr % 8;
            p0_titem(A.in[I_WBR] + ((size_t)l * 3 + n) * BW * DM, DM, 32 * rb, nullptr, (bf16_t*)(wb + WB_WBR) + (size_t)n * DM * BW, BW, 32 * rb, 64 * kb, scr, lane); continue; } r -= NI_WBR;
        if (r < NI_WO) { const int rb = r / 16, kb = r % 16; p0_titem(A.in[I_WOUT] + (size_t)l * DM * DM, DM, 32 * rb, nullptr, (bf16_t*)(wb + WB_WO), DM, 32 * rb, 64 * kb, scr, lane); continue; } r -= NI_WO;
        if (r < NI_F1) { const int rb = r / 16, kb = r % 16, tile = rb >> 3, p = (rb & 7) * 32; const int src = (p < 128) ? 128 * tile + p : DFF + 128 * tile + (p - 128);
            p0_titem(A.in[I_WF1] + (size_t)l * DM * 2 * DFF, 2 * DFF, src, A.in[I_N2G] + l * DM, (bf16_t*)(wb + WB_WF1), DM, 32 * rb, 64 * kb, scr, lane); continue; } r -= NI_F1;
        { const int rb = r / 44, kb = r % 44; p0_titem(A.in[I_WF2] + (size_t)l * DFF * DM, DM, 32 * rb, nullptr, (bf16_t*)(wb + WB_WF2), DFF, 32 * rb, 64 * kb, scr, lane); }
    }
}

struct SchedPlain {
    pg8::TileOrder o; const char* A; const char* B; int lda2, ldb2, nt;
    __device__ __forceinline__ bool next(int i, GUnit& u) const {
        int pm, pn; if (!o.tile(i, pm, pn)) return false;
        u.A = A + (size_t)pm * 256 * lda2; u.B = B + (size_t)pn * 256 * ldb2; u.lda2 = lda2; u.ldb2 = ldb2; u.nt = nt; u.pm = pm; u.pn = pn; u.kind = 0; return true;
    }
};
struct SchedP3 {
    pg8::TileOrder o; const char* ws; const char* wb;
    __device__ __forceinline__ bool next(int i, GUnit& u) const {
        int pm, pn; if (!o.tile(i / 6, pm, pn)) return false;
        const int sub = i % 6, n = sub >> 1; const bool proj = (sub & 1) != 0;
        u.pm = pm; u.pn = pn; u.kind = sub;
        const size_t aoff = !proj ? WS_XB : (n == 0 ? WS_YA : (n == 1 ? WS_YB : WS_YC));
        const int ld2 = proj ? BW * 2 : DM * 2;
        u.A = ws + aoff + (size_t)pm * 256 * ld2; u.lda2 = ld2;
        u.B = wb + (proj ? WB_WBR : WB_WG) + (size_t)(n * DM + pn * 256) * ld2; u.ldb2 = ld2; u.nt = ld2 >> 7;
        return true;
    }
};

__device__ __forceinline__ float fast_sigmoid(float x) { return __builtin_amdgcn_rcpf(1.0f + __builtin_amdgcn_exp2f(-LOG2E * x)); }
__device__ __forceinline__ f32x4 sig4(const f32x4& v) { return (f32x4){fast_sigmoid(v[0]), fast_sigmoid(v[1]), fast_sigmoid(v[2]), fast_sigmoid(v[3])}; }
__device__ __forceinline__ float sigx(float z) { return __builtin_amdgcn_rcpf(1.0f + __builtin_amdgcn_exp2f(z)); }
__device__ __forceinline__ f32x4 sigx4(const f32x4& v) { return (f32x4){sigx(v[0]), sigx(v[1]), sigx(v[2]), sigx(v[3])}; }
__device__ __forceinline__ float dot4(const f32x4& a) { return (a[0] * a[0] + a[1] * a[1]) + (a[2] * a[2] + a[3] * a[3]); }

struct EpiP1 {
    unsigned char* ws; const float* rowss; const float* qg; const float* kg;
    __device__ __forceinline__ void operator()(const f32x4 (&acc)[2][2][4][2], const GUnit& u, int wr, int wc, int fr, int fq) const {
        const int pn = u.pn;
        if (pn < 4) {
            const bool isq = pn < 2; const float* gg = isq ? qg : kg; const float sc = isq ? QSCALE : 1.0f;
            const f32x4 ga0 = *(const f32x4*)(gg + 8 * fq), ga1 = *(const f32x4*)(gg + 8 * fq + 4), gb0 = *(const f32x4*)(gg + 32 + 8 * fq), gb1 = *(const f32x4*)(gg + 32 + 8 * fq + 4);
            bf16_t* base = (bf16_t*)(ws + (isq ? WS_AQ : WS_AK)) + (pn & 1) * 256 + 64 * wc + 8 * fq;
#pragma unroll
            for (int ai = 0; ai < 2; ++ai)
#pragma unroll
                for (int m = 0; m < 4; ++m) {
                    const int row = u.pm * 256 + ai * 128 + wr * 64 + m * 16 + fr;
                    const float rstd = rsqrtf(rowss[row] * (1.0f / DM) + RMS_EPS);
                    const f32x4 a0 = acc[ai][0][m][0] * rstd, a1 = acc[ai][0][m][1] * rstd, b0 = acc[ai][1][m][0] * rstd, b1 = acc[ai][1][m][1] * rstd;
                    float ss = (dot4(a0) + dot4(a1)) + (dot4(b0) + dot4(b1));
                    ss += __shfl_xor(ss, 16); ss += __shfl_xor(ss, 32);
                    const float rn = rsqrtf(ss * (1.0f / 64.0f) + RMS_EPS) * sc;
                    bf16_t* o = base + (size_t)row * BW;
                    *(u32x4*)o = pg8::pack8(a0 * ga0 * rn, a1 * ga1 * rn);
                    *(u32x4*)(o + 32) = pg8::pack8(b0 * gb0 * rn, b1 * gb1 * rn);
                }
        } else if (pn >= 6 && pn < 10) {
            bf16_t* base = (bf16_t*)(ws + WS_Z) + 128 * (pn - 6) + 32 * wc + 8 * fq;
#pragma unroll
            for (int ai = 0; ai < 2; ++ai)
#pragma unroll
                for (int m = 0; m < 4; ++m) {
                    const int row = u.pm * 256 + ai * 128 + wr * 64 + m * 16 + fr;
                    const float rstd = rsqrtf(rowss[row] * (1.0f / DM) + RMS_EPS), nr = -LOG2E * rstd;
                    const f32x4 z0 = acc[ai][0][m][0] * rstd * sigx4(acc[ai][1][m][0] * nr), z1 = acc[ai][0][m][1] * rstd * sigx4(acc[ai][1][m][1] * nr);
                    *(u32x4*)(base + (size_t)row * BW) = pg8::pack8(z0, z1);
                }
        } else {
            size_t wsoff; int kind;
            if (pn < 6) { wsoff = WS_AV; kind = 0; } else if (pn < 12) { wsoff = WS_RQ; kind = 1; } else if (pn < 14) { wsoff = WS_RK; kind = 2; } else if (pn < 16) { wsoff = WS_RV; kind = 0; } else { wsoff = WS_RG; kind = 3; }
            bf16_t* base = (bf16_t*)(ws + wsoff) + (pn & 1) * 256 + 32 * wc + 8 * fq;
            const float l2g0 = log2_gamma((pn & 1) * 2), l2g1 = log2_gamma((pn & 1) * 2 + 1);
#pragma unroll
            for (int ai = 0; ai < 2; ++ai)
#pragma unroll
                for (int m = 0; m < 4; ++m) {
                    const int row = u.pm * 256 + ai * 128 + wr * 64 + m * 16 + fr;
                    const float rstd = rsqrtf(rowss[row] * (1.0f / DM) + RMS_EPS);
                    const float tp = (float)(row & 127);
                    float f0 = rstd, f1 = rstd;
                    if (kind == 1) { f0 *= exp2f(tp * l2g0); f1 *= exp2f(tp * l2g1); }
                    if (kind == 2) { f0 *= 0.08838834764831845f * exp2f(-tp * l2g0); f1 *= 0.08838834764831845f * exp2f(-tp * l2g1); }
                    f32x4 a0 = acc[ai][0][m][0] * f0, a1 = acc[ai][0][m][1] * f0, b0 = acc[ai][1][m][0] * f1, b1 = acc[ai][1][m][1] * f1;
                    if (kind == 3) { a0 = a0 * sigx4(a0 * -LOG2E); a1 = a1 * sigx4(a1 * -LOG2E); b0 = b0 * sigx4(b0 * -LOG2E); b1 = b1 * sigx4(b1 * -LOG2E); }
                    bf16_t* o = base + (size_t)row * BW;
                    *(u32x4*)o = pg8::pack8(a0, a1);
                    *(u32x4*)(o + 128) = pg8::pack8(b0, b1);
                }
        }
    }
};
struct EpiP3 {
    const float* rowss; const float* bg; unsigned char* gscr; bf16_t* Y;
    __device__ __forceinline__ void operator()(const f32x4 (&acc)[2][2][4][2], const GUnit& u, int wr, int wc, int fr, int fq) const {
        const int n = u.kind >> 1;
        u32x4* gs = (u32x4*)gscr + ((wr * 4 + wc) * 64 + fq * 16 + fr);
        if (!(u.kind & 1)) {
            const float* bp = bg + n * DM + u.pn * 256 + 32 * wc + 8 * fq;
            const f32x4 ba0 = *(const f32x4*)bp * -LOG2E, ba1 = *(const f32x4*)(bp + 4) * -LOG2E, bb0 = *(const f32x4*)(bp + 128) * -LOG2E, bb1 = *(const f32x4*)(bp + 132) * -LOG2E;
#pragma unroll
            for (int ai = 0; ai < 2; ++ai)
#pragma unroll
                for (int m = 0; m < 4; ++m) {
                    const int row = u.pm * 256 + ai * 128 + wr * 64 + m * 16 + fr;
                    const float nr = -LOG2E * rsqrtf(rowss[row] * (1.0f / DM) + RMS_EPS);
                    gs[((ai * 4 + m) * 2 + 0) * NTHREADS] = pg8::pack8(sigx4(acc[ai][0][m][0] * nr + ba0), sigx4(acc[ai][0][m][1] * nr + ba1));
                    gs[((ai * 4 + m) * 2 + 1) * NTHREADS] = pg8::pack8(sigx4(acc[ai][1][m][0] * nr + bb0), sigx4(acc[ai][1][m][1] * nr + bb1));
                }
        } else {
#pragma unroll
            for (int ai = 0; ai < 2; ++ai) {
                u32x4 gq[4][2], pq[4][2];
#pragma unroll
                for (int m = 0; m < 4; ++m)
#pragma unroll
                    for (int bj = 0; bj < 2; ++bj) {
                        gq[m][bj] = gs[((ai * 4 + m) * 2 + bj) * NTHREADS];
                        if (n > 0) pq[m][bj] = *(const u32x4*)(Y + (size_t)(u.pm * 256 + ai * 128 + wr * 64 + m * 16 + fr) * DM + u.pn * 256 + 128 * bj + 32 * wc + 8 * fq);
                    }
#pragma unroll
                for (int m = 0; m < 4; ++m) {
                    const int row = u.pm * 256 + ai * 128 + wr * 64 + m * 16 + fr;
#pragma unroll
                    for (int bj = 0; bj < 2; ++bj) {
                        const u32x4 g = gq[m][bj];
                        bf16_t* yp = Y + (size_t)row * DM + u.pn * 256 + 128 * bj + 32 * wc + 8 * fq;
                        f32x4 y0 = acc[ai][bj][m][0], y1 = acc[ai][bj][m][1];
                        y0[0] *= __uint_as_float(g.x << 16); y0[1] *= __uint_as_float(g.x & 0xffff0000u); y0[2] *= __uint_as_float(g.y << 16); y0[3] *= __uint_as_float(g.y & 0xffff0000u);
                        y1[0] *= __uint_as_float(g.z << 16); y1[1] *= __uint_as_float(g.z & 0xffff0000u); y1[2] *= __uint_as_float(g.w << 16); y1[3] *= __uint_as_float(g.w & 0xffff0000u);
                        if (n > 0) { const u32x4 p = pq[m][bj];
                            y0[0] += __uint_as_float(p.x << 16); y0[1] += __uint_as_float(p.x & 0xffff0000u); y0[2] += __uint_as_float(p.y << 16); y0[3] += __uint_as_float(p.y & 0xffff0000u);
                            y1[0] += __uint_as_float(p.z << 16); y1[1] += __uint_as_float(p.z & 0xffff0000u); y1[2] += __uint_as_float(p.w << 16); y1[3] += __uint_as_float(p.w & 0xffff0000u); }
                        *(u32x4*)yp = pg8::pack8(y0, y1);
                    }
                }
                asm volatile("" ::: "memory");
            }
        }
    }
};
struct EpiResid {
    bf16_t* XB; float* out; float* rowss_next;
    __device__ __forceinline__ void operator()(const f32x4 (&acc)[2][2][4][2], const GUnit& u, int wr, int wc, int fr, int fq) const {
#pragma unroll
        for (int ai = 0; ai < 2; ++ai) {
            u32x4 xo[4][2];
#pragma unroll
            for (int m = 0; m < 4; ++m)
#pragma unroll
                for (int bj = 0; bj < 2; ++bj)
                    xo[m][bj] = *(const u32x4*)(XB + (size_t)(u.pm * 256 + ai * 128 + wr * 64 + m * 16 + fr) * DM + u.pn * 256 + 128 * bj + 32 * wc + 8 * fq);
#pragma unroll
            for (int m = 0; m < 4; ++m) {
                const int row = u.pm * 256 + ai * 128 + wr * 64 + m * 16 + fr;
                float ss = 0.f;
#pragma unroll
                for (int bj = 0; bj < 2; ++bj) {
                    const size_t off = (size_t)row * DM + u.pn * 256 + 128 * bj + 32 * wc + 8 * fq;
                    const u32x4 p = xo[m][bj];
                    f32x4 x0 = acc[ai][bj][m][0], x1 = acc[ai][bj][m][1];
                    x0[0] += __uint_as_float(p.x << 16); x0[1] += __uint_as_float(p.x & 0xffff0000u); x0[2] += __uint_as_float(p.y << 16); x0[3] += __uint_as_float(p.y & 0xffff0000u);
                    x1[0] += __uint_as_float(p.z << 16); x1[1] += __uint_as_float(p.z & 0xffff0000u); x1[2] += __uint_as_float(p.w << 16); x1[3] += __uint_as_float(p.w & 0xffff0000u);
                    if (out) { *(f32x4*)(out + off) = x0; *(f32x4*)(out + off + 4) = x1; }
                    else { *(u32x4*)(XB + off) = pg8::pack8(x0, x1); ss += dot4(x0) + dot4(x1); }
                }
                if (!out) { ss += __shfl_xor(ss, 16); ss += __shfl_xor(ss, 32); if (fq == 0) atomicAdd(rowss_next + row, ss); }
            }
            asm volatile("" ::: "memory");
        }
    }
};
struct EpiSwiglu {
    const float* rowss; bf16_t* MID;
    __device__ __forceinline__ void operator()(const f32x4 (&acc)[2][2][4][2], const GUnit& u, int wr, int wc, int fr, int fq) const {
        bf16_t* base = MID + 128 * u.pn + 32 * wc + 8 * fq;
#pragma unroll
        for (int ai = 0; ai < 2; ++ai)
#pragma unroll
            for (int m = 0; m < 4; ++m) {
                const int row = u.pm * 256 + ai * 128 + wr * 64 + m * 16 + fr;
                const float rstd = rsqrtf(rowss[row] * (1.0f / DM) + RMS_EPS); const float nr = -LOG2E * rstd, r2 = rstd * rstd;
                const f32x4 a0 = acc[ai][0][m][0], a1 = acc[ai][0][m][1];
                *(u32x4*)(base + (size_t)row * DFF) = pg8::pack8(a0 * acc[ai][1][m][0] * r2 * sigx4(a0 * nr), a1 * acc[ai][1][m][1] * r2 * sigx4(a1 * nr));
            }
    }
};

__device__ __forceinline__ void fast_gemm(const Args& A, int l, int k, LAS unsigned char* lds) {
    const int G = gridDim.x, c = blockIdx.x;
    const char* wb = (const char*)(A.ws + WS_WB + (size_t)l * WB_LAYER);
    const char* XB = (const char*)(A.ws + WS_XB);
    float* rowss = (float*)(A.ws + WS_ROWSS);
    if (k == 0) {
        SchedPlain S; S.o.init(M / 256, NU / 256, G, c); S.A = XB; S.lda2 = DM * 2; S.B = wb + WB_W1; S.ldb2 = DM * 2; S.nt = DM / 64;
        EpiP1 E{A.ws, rowss + (size_t)(l == 0 ? 0 : 2) * M, A.in[I_QG] + l * 64, A.in[I_KG] + l * 64};
        pg8::gemm_phase(lds, S, E);
        if (l == 0) { const int full = S.o.nwg / G, rem = S.o.nwg - full * G;
            if (rem > 0 && c >= rem) fast_p0_weights(A, c - rem, G - rem, (LAS float*)lds, NI_W1, PER_LAYER);
            else if (rem == 0) fast_p0_weights(A, c, G, (LAS float*)lds, NI_W1, PER_LAYER); }
    } else if (k == 2) {
        SchedP3 S; S.o.init(M / 256, DM / 256, G, c); S.ws = (const char*)A.ws; S.wb = wb;
        EpiP3 E{rowss + (size_t)(l == 0 ? 0 : 2) * M, A.in[I_BGATE] + l * NGATE, A.ws + WS_GSCR + (size_t)blockIdx.x * (128 * 1024), (bf16_t*)(A.ws + WS_Y)};
        pg8::gemm_phase(lds, S, E);
    } else if (k == 3) {
        SchedPlain S; S.o.init(M / 256, DM / 256, G, c); S.A = (const char*)(A.ws + WS_Y); S.lda2 = DM * 2; S.B = wb + WB_WO; S.ldb2 = DM * 2; S.nt = DM / 64;
        EpiResid E{(bf16_t*)(A.ws + WS_XB), nullptr, rowss + (size_t)(l == 0 ? 1 : 3) * M};
        pg8::gemm_phase(lds, S, E);
    } else if (k == 4) {
        SchedPlain S; S.o.init(M / 256, 2 * DFF / 256, G, c); S.A = XB; S.lda2 = DM * 2; S.B = wb + WB_WF1; S.ldb2 = DM * 2; S.nt = DM / 64;
        EpiSwiglu E{rowss + (size_t)(l == 0 ? 1 : 3) * M, (bf16_t*)(A.ws + WS_MID)};
        pg8::gemm_phase(lds, S, E);
        if (l == 0) { const int full = S.o.nwg / G, rem = S.o.nwg - full * G;
            if (rem > 0 && c >= rem) fast_p0_weights(A, c - rem, G - rem, (LAS float*)lds, PER_LAYER, DEPTH * PER_LAYER);
            else if (rem == 0) fast_p0_weights(A, c, G, (LAS float*)lds, PER_LAYER, DEPTH * PER_LAYER); }
    } else {
        SchedPlain S; S.o.init(M / 256, DM / 256, G, c); S.A = (const char*)(A.ws + WS_MID); S.lda2 = DFF * 2; S.B = wb + WB_WF2; S.ldb2 = DFF * 2; S.nt = DFF / 64;
        EpiResid E{(bf16_t*)(A.ws + WS_XB), l + 1 < DEPTH ? nullptr : A.out, rowss + (size_t)2 * M};
        pg8::gemm_phase(lds, S, E);
    }
}


namespace mx {
typedef short bf16x8 __attribute__((ext_vector_type(8)));
typedef short s16x4 __attribute__((ext_vector_type(4)));
typedef short v4i16_t __attribute__((ext_vector_type(4)));
typedef float f32x16 __attribute__((ext_vector_type(16)));
typedef LAS unsigned char* lptr;
typedef unsigned u32x2 __attribute__((ext_vector_type(2)));
__device__ __forceinline__ int crow(int r, int hi) { return (r & 3) + 8 * (r >> 2) + 4 * hi; }
__device__ __forceinline__ s16x4 vtr(lptr p) { return __builtin_bit_cast(s16x4, __builtin_amdgcn_ds_read_tr16_b64_v4i16((LAS v4i16_t*)p)); }
__device__ __forceinline__ bf16x8 cat8(s16x4 lo, s16x4 hi) { return (bf16x8){lo[0], lo[1], lo[2], lo[3], hi[0], hi[1], hi[2], hi[3]}; }
__device__ __forceinline__ bf16x8 ld8(lptr p) { return *(const LAS bf16x8*)p; }
__device__ __forceinline__ float swap_max(float v) { auto rr = __builtin_amdgcn_permlane32_swap(__float_as_uint(v), __float_as_uint(v), false, false); return fmaxf(__uint_as_float(rr[0]), __uint_as_float(rr[1])); }
__device__ __forceinline__ float swap_sum(float v) { auto rr = __builtin_amdgcn_permlane32_swap(__float_as_uint(v), __float_as_uint(v), false, false); return __uint_as_float(rr[0]) + __uint_as_float(rr[1]); }
__device__ __forceinline__ bf16x8 pack_p(const f32x16& p, int b) {
    pg8::u32x4 w; w.x = pg8::cvt_pk_bf16(p[b], p[b + 1]); w.y = pg8::cvt_pk_bf16(p[b + 2], p[b + 3]); w.z = pg8::cvt_pk_bf16(p[b + 4], p[b + 5]); w.w = pg8::cvt_pk_bf16(p[b + 6], p[b + 7]);
    return __builtin_bit_cast(bf16x8, w);
}
#define MFMA32(a, b, c) __builtin_amdgcn_mfma_f32_32x32x16_bf16((a), (b), (c), 0, 0, 0)
#define DPP_ADD(v, ctrl, rmask) ((v) + __builtin_bit_cast(float, __builtin_amdgcn_update_dpp(0, __builtin_bit_cast(int, (v)), (ctrl), (rmask), 0xf, false)))
__device__ __forceinline__ float half_sum32(float v) {
    v = DPP_ADD(v, 0xB1, 0xf);
    v = DPP_ADD(v, 0x4E, 0xf);
    v = DPP_ADD(v, 0x141, 0xf);
    v = DPP_ADD(v, 0x140, 0xf);
    v = DPP_ADD(v, 0x142, 0xa);
    return v;
}

#define LDS_BAR() asm volatile("s_waitcnt lgkmcnt(0)\n\ts_barrier" ::: "memory")

constexpr int A_KSLOT = 8192, A_KBUF = 16384, A_V0 = 32768, A_VBUF = 16384, A_STAGE = 98304, A_WS = 131072 + 4096;
template <int ABL>
__device__ __forceinline__ void attn_unit(const Args& A, int l, int b, int h, int qb, lptr lds) {
    const int tid = opaque_tid(), lane = tid & 63, r32 = lane & 31, hi = lane >> 5; const int wid = __builtin_amdgcn_readfirstlane(tid >> 6), mp = wid >> 2, qw = wid & 3;
    const bf16_t* AQ = (const bf16_t*)(A.ws + WS_AQ); const bf16_t* AK = (const bf16_t*)(A.ws + WS_AK); const bf16_t* AV = (const bf16_t*)(A.ws + WS_AV);
    const size_t rowbase = (size_t)b * SEQ;
    const int q0 = 128 * qb + 32 * qw;
    const int NT = 2 * (qb + 1);
    LAS float* wsf = (LAS float*)(lds + A_WS) + wid * 64;
    const bf16_t* ksrc[2]; const bf16_t* vsrc[2]; int kdst[2], vdst[2];
#pragma unroll
    for (int j = 0; j < 2; ++j) { const int P = 2 * wid + j;
        ksrc[j] = AK + (rowbase + 8 * (P & 7) + (lane >> 3)) * BW + h * 128 + (P >> 3) * 64 + (((lane & 7) ^ (lane >> 3)) * 8);
        vsrc[j] = AV + (rowbase + 8 * (P >> 1) + ((lane >> 2) & 7)) * BW + h * 128 + 32 * (2 * (P & 1) + (lane >> 5)) + 8 * (lane & 3);
        kdst[j] = (P >> 3) * A_KSLOT + (P & 7) * 1024; vdst[j] = (P >> 1) * 2048 + (P & 1) * 1024; }
#define ATT_DMA(t, kb_, vb_) do { _Pragma("unroll") for (int j = 0; j < 2; ++j) { \
        __builtin_amdgcn_global_load_lds((const unsigned*)(ksrc[j] + (size_t)64 * (t) * BW), (LAS unsigned*)((kb_) + kdst[j]), 16, 0, 0); \
        __builtin_amdgcn_global_load_lds((const unsigned*)(vsrc[j] + (size_t)64 * (t) * BW), (LAS unsigned*)((vb_) + vdst[j]), 16, 0, 0); } } while (0)
    bf16x8 qf[4];
#pragma unroll
    for (int d0 = 0; d0 < 4; ++d0) qf[d0] = *(const bf16x8*)(AQ + (rowbase + q0 + r32) * BW + h * 128 + mp * 64 + d0 * 16 + hi * 8);
    const float slope2 = exp2f(-2.0f * (float)(h + 1)) * LOG2E;
    float m = 0.f, lsum = 0.f; bool first = true;
    f32x16 o[4];
#pragma unroll
    for (int d0 = 0; d0 < 4; ++d0) o[d0] = f32x16{};
    bf16x8 pa0 = bf16x8{}, pa1 = bf16x8{}, pa2 = bf16x8{}, pa3 = bf16x8{};
    const int kroff = mp * A_KSLOT + r32 * 128;
    const int vroff = (4 * hi + ((lane & 15) >> 2)) * 64 + ((lane >> 4) & 1) * 32 + (lane & 3) * 8;
#define ATT_A(P0, P1, t, kb_) do { \
        const float sb_ = slope2 * (float)(64 * (t) + 4 * hi - (q0 + r32)) - m; \
        _Pragma("unroll") for (int r = 0; r < 16; ++r) { P0[r] = fmaf(slope2, (float)((r & 3) + 8 * (r >> 2)), sb_); P1[r] = fmaf(slope2, (float)(32 + (r & 3) + 8 * (r >> 2)), sb_); } \
        _Pragma("unroll") for (int d0 = 0; d0 < 4; ++d0) { const int ch_ = ((2 * d0 + hi) ^ (r32 & 7)) * 16; \
            P0 = MFMA32(ld8((kb_) + kroff + ch_), qf[d0], P0); P1 = MFMA32(ld8((kb_) + kroff + 32 * 128 + ch_), qf[d0], P1); } } while (0)
#define ATT_MASK(P0, P1, t) do { const int krel_ = 64 * (t) + 4 * hi - (q0 + r32); \
        _Pragma("unroll") for (int r = 0; r < 16; ++r) { const int d_ = krel_ + (r & 3) + 8 * (r >> 2); if (d_ > 0) P0[r] = -INFINITY; if (d_ + 32 > 0) P1[r] = -INFINITY; } } while (0)
    __syncthreads();
    {
        *(LAS u32x4*)(lds + A_V0 + 3 * A_VBUF + tid * 32) = (u32x4){0u, 0u, 0u, 0u}; *(LAS u32x4*)(lds + A_V0 + 3 * A_VBUF + tid * 32 + 16) = (u32x4){0u, 0u, 0u, 0u}; }
    ATT_DMA(NT - 1, lds, lds + A_V0);
    ATT_DMA(NT - 2, lds + A_KBUF, lds + A_V0 + A_VBUF);
    __syncthreads();
    f32x16 s0, s1;
    ATT_A(s0, s1, NT - 1, lds); ATT_MASK(s0, s1, NT - 1);
    __syncthreads();
    bool resc = false;
#define ATT_RESC() do { if (resc) { _Pragma("unroll") for (int r = 0; r < 16; ++r) { const float a = wsf[crow(r, hi)]; _Pragma("unroll") for (int d0 = 0; d0 < 4; ++d0) o[d0][r] *= a; } resc = false; } } while (0)
#define ATT_TRIP(i, S0, S1, N0, N1, PR0, PR1, PR2, PR3, PW0, PW1, PW2, PW3) do { \
        const int t = NT - 1 - (i); \
        if ((i) == 1) ATT_MASK(S0, S1, t); \
        ATT_RESC(); \
        if (!(ABL & 8) && (i) + 2 < NT) ATT_DMA(t - 2, lds + ((i) & 1) * A_KBUF, lds + A_V0 + (((i) + 2) & 3) * A_VBUF); \
        float mx_; \
        { const int tn = (t > 0) ? t - 1 : 0; lptr kb = lds + (((i) + (t > 0 ? 1 : 0)) & 1) * A_KBUF; \
          __builtin_amdgcn_sched_barrier(0); \
          ATT_A(N0, N1, tn, kb); \
          mx_ = fmaxf(S0[0], S1[0]); \
          _Pragma("unroll") for (int r = 1; r < 16; ++r) mx_ = fmaxf(mx_, fmaxf(S0[r], S1[r])); \
          __builtin_amdgcn_sched_group_barrier(0x2, 34, 0); \
          _Pragma("unroll") for (int k = 0; k < 8; ++k) { __builtin_amdgcn_sched_group_barrier(0x100, 1, 0); __builtin_amdgcn_sched_group_barrier(0x8, 1, 0); __builtin_amdgcn_sched_group_barrier(0x2, 3, 0); } \
          __builtin_amdgcn_sched_barrier(0); } \
        mx_ = swap_max(mx_); \
        const bool live = mx_ > -INFINITY; \
        const float dl = first ? (live ? mx_ : 0.f) : fmaxf(mx_, 0.f); \
        if (__any(first || dl > 0.f)) { \
            m += dl; \
            _Pragma("unroll") for (int r = 0; r < 16; ++r) { S0[r] -= dl; S1[r] -= dl; N0[r] -= dl; N1[r] -= dl; } \
            if (!first) { const float alpha = __builtin_amdgcn_exp2f(-dl); lsum *= alpha; if (hi == 0) wsf[r32] = alpha; resc = true; } \
            if (live) first = false; } \
        { __builtin_amdgcn_sched_barrier(0); \
          lptr vb = lds + A_V0 + (((i) + 3) & 3) * A_VBUF + vroff; \
          bf16x8 vfa = ATT_VF(0), vfb = ATT_VF(1); \
          float ps = 0.f; \
          _Pragma("unroll") for (int k = 0; k < 16; ++k) { \
              bf16x8 vfn = vfb; \
              if (k + 2 < 16) vfn = ATT_VF(k + 2); \
              const bf16x8 cc = (k & 3) == 0 ? PR0 : (k & 3) == 1 ? PR1 : (k & 3) == 2 ? PR2 : PR3; \
              if (!(ABL & 4)) o[k >> 2] = MFMA32(cc, vfa, o[k >> 2]); else { asm volatile("" :: "v"(cc), "v"(vfa)); } \
              if (k < 8) { S0[2 * k] = ATT_EXP(S0[2 * k]); S0[2 * k + 1] = ATT_EXP(S0[2 * k + 1]); ps += S0[2 * k] + S0[2 * k + 1]; } \
              else { S1[2 * k - 16] = ATT_EXP(S1[2 * k - 16]); S1[2 * k - 15] = ATT_EXP(S1[2 * k - 15]); ps += S1[2 * k - 16] + S1[2 * k - 15]; } \
              if (k == 3) PW0 = pack_p(S0, 0); \
              if (k == 7) PW1 = pack_p(S0, 8); \
              if (k == 11) PW2 = pack_p(S1, 0); \
              if (k == 15) PW3 = pack_p(S1, 8); \
              vfa = vfb; vfb = vfn; \
              __builtin_amdgcn_sched_barrier(0); } \
          lsum += ps; } \
        if (!(ABL & 16)) __syncthreads(); } while (0)
#define ATT_EXP(x_) ((ABL & 2) ? (x_) * 0.001f : __builtin_amdgcn_exp2f(x_))
#define ATT_VF(k_) cat8(vtr(vb + ((k_) >> 2) * 512 + ((k_) & 3) * 4096), vtr(vb + ((k_) >> 2) * 512 + ((k_) & 3) * 4096 + 2048))
    f32x16 n0, n1;
    bf16x8 pb0 = bf16x8{}, pb1 = bf16x8{}, pb2 = bf16x8{}, pb3 = bf16x8{};
    for (int i = 0; i < NT; i += 2) {
        ATT_TRIP(i, s0, s1, n0, n1, pa0, pa1, pa2, pa3, pb0, pb1, pb2, pb3);
        ATT_TRIP(i + 1, n0, n1, s0, s1, pb0, pb1, pb2, pb3, pa0, pa1, pa2, pa3);
    }
    ATT_RESC();
#undef ATT_RESC
#undef ATT_TRIP
#undef ATT_VF
#undef ATT_EXP
    { lptr vb = lds + A_V0 + ((NT - 1) & 3) * A_VBUF + vroff;
#pragma unroll
      for (int d0 = 0; d0 < 4; ++d0) { lptr vp_ = vb + d0 * 512;
        const bf16x8 v0 = cat8(vtr(vp_), vtr(vp_ + 2048)), v1 = cat8(vtr(vp_ + 4096), vtr(vp_ + 4096 + 2048));
        const bf16x8 v2 = cat8(vtr(vp_ + 8192), vtr(vp_ + 8192 + 2048)), v3 = cat8(vtr(vp_ + 12288), vtr(vp_ + 12288 + 2048));
        o[d0] = MFMA32(pa0, v0, o[d0]); o[d0] = MFMA32(pa1, v1, o[d0]); o[d0] = MFMA32(pa2, v2, o[d0]); o[d0] = MFMA32(pa3, v3, o[d0]); } }
    __syncthreads();
#undef ATT_DMA
#undef ATT_A
#undef ATT_MASK
    lsum = swap_sum(lsum);
    if (hi == 0) wsf[32 + r32] = 1.0f / lsum;
    const float lam = ((const float*)(A.ws + WS_LAM))[l];
    LAS float* xch = (LAS float*)lds + qw * (4 * 16 * 64) + lane;
    if (mp == 1) {
#pragma unroll
        for (int r = 0; r < 16; ++r) { const float il = wsf[32 + crow(r, hi)] * lam;
#pragma unroll
            for (int d0 = 0; d0 < 4; ++d0) xch[(d0 * 16 + r) * 64] = o[d0][r] * il; }
    }
    __syncthreads();
    if (mp == 0) {
        float ss[16];
#pragma unroll
        for (int r = 0; r < 16; ++r) { const float il = wsf[32 + crow(r, hi)]; float s_ = 0.f;
#pragma unroll
            for (int d0 = 0; d0 < 4; ++d0) { const float y = o[d0][r] * il - xch[(d0 * 16 + r) * 64]; o[d0][r] = y; s_ += y * y; }
            ss[r] = s_; }
#pragma unroll
        for (int r = 0; r < 16; ++r) { float v = ss[r]; v += __shfl_xor(v, 1); v += __shfl_xor(v, 2); v += __shfl_xor(v, 4); v += __shfl_xor(v, 8); v += __shfl_xor(v, 16); ss[r] = v; }
        int l_ = l; asm volatile("" : "+s"(l_));
        const float osc = 1.0f - lam_init_of(l_);
        const float* asg = A.in[I_ASG] + l * 128;
        float gv[4];
#pragma unroll
        for (int d0 = 0; d0 < 4; ++d0) gv[d0] = asg[32 * d0 + r32] * osc;
        LAS bf16_t* stg = (LAS bf16_t*)(lds + A_STAGE) + qw * (32 * 128);
#pragma unroll
        for (int r = 0; r < 16; ++r) { const float rn = rsqrtf(ss[r] * (1.0f / 128.0f) + RMS_EPS); const int row = crow(r, hi);
#pragma unroll
            for (int d0 = 0; d0 < 4; ++d0) stg[row * 128 + 32 * d0 + r32] = (bf16_t)f2bf(o[d0][r] * rn * gv[d0]); }
        bf16_t* YA = ABL ? (bf16_t*)(A.ws + 254 * MiB) + (size_t)(blockIdx.x & 63) * 32 * BW : (bf16_t*)(A.ws + WS_YA) + (rowbase + q0) * BW + h * 128;
#pragma unroll
        for (int i = 0; i < 8; ++i) { const int idx = lane + 64 * i, row = idx >> 4, ch = idx & 15;
            *(u32x4*)(YA + (size_t)row * BW + ch * 8) = *(const LAS u32x4*)(stg + row * 128 + ch * 8); }
    }
}

__device__ __forceinline__ int offa(int row, int ch) { return 2048 * (row >> 3) + 512 * (ch >> 2) + 64 * (row & 7) + 16 * ((ch & 3) ^ ((row >> 2) & 3)); }
constexpr int R_K = 0, R_V = 32768, R_RT = 65536, R_ST = 98304, R_SS = 131072 + 1024;
constexpr size_t WS_RSTATE = 76 * MiB;
constexpr int CW_RFLAG = 12288;
struct RetLane { int r32, hi, tnb0, tnb1, tpb0, tpb1, rb0, rb1, w; };
__device__ __forceinline__ RetLane ret_lane(int lane) {
    int ln = lane; asm volatile("" : "+v"(ln));
    RetLane L; L.r32 = ln & 31; L.hi = ln >> 5; const int tq = (ln & 15) >> 2, tp = ln & 3, tg = (ln >> 4) & 1, z = 2 * tg + (tp >> 1); L.w = (L.r32 >> 2) & 3;
    L.tnb0 = 2048 * L.hi + 64 * tq + 8 * (tp & 1) + 16 * (z ^ (2 * L.hi));
    L.tnb1 = 2048 * L.hi + 64 * (tq + 4) + 8 * (tp & 1) + 16 * (z ^ (2 * L.hi + 1));
    L.tpb0 = 64 * (4 * L.hi + tq) + 8 * (tp & 1) + 16 * (z ^ L.hi);
    L.tpb1 = 2048 + 64 * (4 * L.hi + tq) + 8 * (tp & 1) + 16 * (z ^ (2 + L.hi));
    L.rb0 = 2048 * (L.r32 >> 3) + 64 * (L.r32 & 7) + 16 * (L.hi ^ L.w);
    L.rb1 = 2048 * (L.r32 >> 3) + 64 * (L.r32 & 7) + 16 * ((2 + L.hi) ^ L.w);
    return L;
}
__device__ __forceinline__ void ret_update(f32x16& R0, f32x16& R1, lptr lds, const RetLane& L, int qb, int vh, float g127, float g128) {
    f32x16 t0 = f32x16{}, t1 = f32x16{};
    lptr ka = lds + R_K + 512 * qb, va = lds + R_V + 512 * (2 * vh);
#pragma unroll
    for (int ks = 0; ks < 8; ++ks) {
        const bf16x8 kf = cat8(vtr(ka + L.tnb0 + 4096 * ks), vtr(ka + L.tnb1 + 4096 * ks));
        const bf16x8 v0 = cat8(vtr(va + L.tnb0 + 4096 * ks), vtr(va + L.tnb1 + 4096 * ks));
        const bf16x8 v1 = cat8(vtr(va + 512 + L.tnb0 + 4096 * ks), vtr(va + 512 + L.tnb1 + 4096 * ks));
        t0 = MFMA32(kf, v0, t0); t1 = MFMA32(kf, v1, t1);
    }
#pragma unroll
    for (int r = 0; r < 16; ++r) { R0[r] = g128 * R0[r] + g127 * t0[r]; R1[r] = g128 * R1[r] + g127 * t1[r]; }
}
#define RET_KV_LOAD(stK, stV, c_) do { const size_t r0_ = ((size_t)b * SEQ + 128 * (c_) + srow) * BW + h * 128 + sch * 8; \
    _Pragma("unroll") for (int j = 0; j < 4; ++j) { stK[j] = *(const u32x4*)(RK + r0_ + (size_t)32 * j * BW); stV[j] = *(const u32x4*)(RV + r0_ + (size_t)32 * j * BW); } } while (0)
#define RET_KV_WRITE(stK, stV) do { _Pragma("unroll") for (int j = 0; j < 4; ++j) { *(LAS u32x4*)(lds + R_K + sb + 8192 * j) = stK[j]; *(LAS u32x4*)(lds + R_V + sb + 8192 * j) = stV[j]; } } while (0)

__device__ __forceinline__ void ret_a_task(const Args& A, int l, int b, int h, int seg, lptr lds) {
    const int tid = opaque_tid(), lane = tid & 63; const int wid = __builtin_amdgcn_readfirstlane(tid >> 6), qb = wid & 3, vh = wid >> 2;
    const bf16_t* RK = (const bf16_t*)(A.ws + WS_RK); const bf16_t* RV = (const bf16_t*)(A.ws + WS_RV);
    const float l2g = log2_gamma(h); const float g127 = exp2f(127.0f * l2g), g128 = exp2f(128.0f * l2g);
    const int srow = tid >> 4, sch = tid & 15;
    const int sb = 2048 * (srow >> 3) + 512 * (sch >> 2) + 64 * (srow & 7) + 16 * ((sch & 3) ^ ((srow >> 2) & 3));
    f32x16 R0 = f32x16{}, R1 = f32x16{};
    u32x4 stK[4], stV[4];
    RET_KV_LOAD(stK, stV, 8 * seg);
    for (int cc = 0; cc < 8; ++cc) {
        const RetLane L = ret_lane(lane);
        LDS_BAR();
        RET_KV_WRITE(stK, stV);
        if (cc < 7) RET_KV_LOAD(stK, stV, 8 * seg + cc + 1);
        LDS_BAR();
        ret_update(R0, R1, lds, L, qb, vh, g127, g128);
    }
    unsigned long long* dst = (unsigned long long*)(A.ws + WS_RSTATE) + ((size_t)((b * 4 + h) * 3 + seg) * 8 + wid) * 512 + lane;
#pragma unroll
    for (int g = 0; g < 4; ++g) {
        __hip_atomic_store(dst + (2 * g) * 64, (unsigned long long)pg8::cvt_pk_bf16(R0[4 * g], R0[4 * g + 1]) | ((unsigned long long)pg8::cvt_pk_bf16(R0[4 * g + 2], R0[4 * g + 3]) << 32), RLX_AGENT);
        __hip_atomic_store(dst + (2 * g + 1) * 64, (unsigned long long)pg8::cvt_pk_bf16(R1[4 * g], R1[4 * g + 1]) | ((unsigned long long)pg8::cvt_pk_bf16(R1[4 * g + 2], R1[4 * g + 3]) << 32), RLX_AGENT);
    }
    asm volatile("s_waitcnt vmcnt(0)" ::: "memory");
    __syncthreads();
    if (threadIdx.x == 0) __hip_atomic_store((unsigned*)(A.ws + WS_CTL) + CW_RFLAG + 64 * ((l * 16 + b * 4 + h) * 4 + seg), 1u, RLX_AGENT);
}

__device__ __forceinline__ void ret_b_task(const Args& A, int l, int b, int h, int seg, lptr lds) {
    const int tid = opaque_tid(), lane = tid & 63; const int wid = __builtin_amdgcn_readfirstlane(tid >> 6), qb = wid & 3, vh = wid >> 2;
    const bf16_t* RQ = (const bf16_t*)(A.ws + WS_RQ); const bf16_t* RK = (const bf16_t*)(A.ws + WS_RK); const bf16_t* RV = (const bf16_t*)(A.ws + WS_RV);
    const bf16_t* RG = (const bf16_t*)(A.ws + WS_RG); bf16_t* YC = (bf16_t*)(A.ws + WS_YC);
    const float l2g = log2_gamma(h); const float gam = exp2f(l2g), g127 = exp2f(127.0f * l2g), g128 = exp2f(128.0f * l2g);
    const float* gn = A.in[I_RGN] + l * 128;
    LAS float* ssq = (LAS float*)(lds + R_SS);
    const int srow = tid >> 4, sch = tid & 15;
    const int sb = 2048 * (srow >> 3) + 512 * (sch >> 2) + 64 * (srow & 7) + 16 * ((sch & 3) ^ ((srow >> 2) & 3));
    u32x4 stK[4], stV[4];
    RET_KV_LOAD(stK, stV, 8 * seg);
    f32x16 R0 = f32x16{}, R1 = f32x16{};
    if (seg > 0) {
        if (threadIdx.x < 64) {
            unsigned* fl = (unsigned*)(A.ws + WS_CTL) + CW_RFLAG + 64 * ((l * 16 + b * 4 + h) * 4);
            unsigned spins = 0;
            for (;;) {
                unsigned ok = 1u;
                for (int s2 = 0; s2 < seg; ++s2) ok &= __hip_atomic_load(fl + 64 * s2, RLX_AGENT);
                if (__builtin_amdgcn_readfirstlane(ok)) break;
                __builtin_amdgcn_s_sleep(8);
                if (++spins > (1u << 22)) break;
            }
        }
        __syncthreads();
        const float g1024 = exp2f(1024.0f * l2g);
        for (int s2 = 0; s2 < seg; ++s2) {
            const unsigned long long* src = (const unsigned long long*)(A.ws + WS_RSTATE) + ((size_t)((b * 4 + h) * 3 + s2) * 8 + wid) * 512 + lane;
#pragma unroll
            for (int r = 0; r < 16; ++r) { R0[r] *= g1024; R1[r] *= g1024; }
#pragma unroll
            for (int g = 0; g < 4; ++g) {
                const unsigned long long a0 = __hip_atomic_load(src + (2 * g) * 64, RLX_AGENT), a1 = __hip_atomic_load(src + (2 * g + 1) * 64, RLX_AGENT);
                R0[4 * g] += bf2f((unsigned)a0 & 0xffffu); R0[4 * g + 1] += __uint_as_float((unsigned)a0 & 0xffff0000u); R0[4 * g + 2] += bf2f((unsigned)(a0 >> 32) & 0xffffu); R0[4 * g + 3] += __uint_as_float((unsigned)(a0 >> 32) & 0xffff0000u);
                R1[4 * g] += bf2f((unsigned)a1 & 0xffffu); R1[4 * g + 1] += __uint_as_float((unsigned)a1 & 0xffff0000u); R1[4 * g + 2] += bf2f((unsigned)(a1 >> 32) & 0xffffu); R1[4 * g + 3] += __uint_as_float((unsigned)(a1 >> 32) & 0xffff0000u);
            }
        }
    }
    bf16x8 qf[8];
    u32x4 gst[4];
#define RET_Q_LOAD(c_) do { const size_t r0_ = ((size_t)b * SEQ + 128 * (c_) + 32 * qb + (lane & 31)) * BW + h * 128 + (lane >> 5) * 8; \
    _Pragma("unroll") for (int ds = 0; ds < 8; ++ds) qf[ds] = *(const bf16x8*)(RQ + r0_ + ds * 16); } while (0)
#define RET_G_LOAD(c_) do { _Pragma("unroll") for (int i = 0; i < 4; ++i) { const int idx_ = lane + 64 * i; \
    gst[i] = *(const u32x4*)(RG + ((size_t)b * SEQ + 128 * (c_) + 32 * qb + (idx_ >> 3)) * BW + h * 128 + 64 * vh + (idx_ & 7) * 8); } } while (0)
    RET_Q_LOAD(8 * seg); RET_G_LOAD(8 * seg);
    for (int cc = 0; cc < 8; ++cc) {
        const int c = 8 * seg + cc;
        const RetLane L = ret_lane(lane);
        const int r32 = L.r32, hi = L.hi, w = L.w;
        const size_t crow0 = (size_t)b * SEQ + 128 * c;
        lptr stg = lds + R_ST + 4096 * wid;
        LDS_BAR();
        RET_KV_WRITE(stK, stV);
        if (c > 0) {
            lptr rw = lds + R_RT + 256 * (64 * vh) + 2048 * (r32 >> 3) + 64 * (r32 & 7) + 512 * qb + 8 * hi;
#pragma unroll
            for (int g = 0; g < 4; ++g) {
                *(LAS u32x2*)(rw + 16 * (g ^ w)) = (u32x2){pg8::cvt_pk_bf16(R0[4 * g], R0[4 * g + 1]), pg8::cvt_pk_bf16(R0[4 * g + 2], R0[4 * g + 3])};
                *(LAS u32x2*)(rw + 8192 + 16 * (g ^ w)) = (u32x2){pg8::cvt_pk_bf16(R1[4 * g], R1[4 * g + 1]), pg8::cvt_pk_bf16(R1[4 * g + 2], R1[4 * g + 3])};
            }
        }
#pragma unroll
        for (int i = 0; i < 4; ++i) { const int idx = lane + 64 * i; *(LAS u32x4*)(stg + (idx >> 3) * 128 + (idx & 7) * 16) = gst[i]; }
        LDS_BAR();
        f32x16 o0 = f32x16{}, o1 = f32x16{};
        for (int kb = 0; kb <= qb; ++kb) {
            f32x16 p = f32x16{};
            lptr kr = lds + R_K + 8192 * kb;
#pragma unroll
            for (int ds = 0; ds < 8; ++ds) p = MFMA32(ld8(kr + ((ds & 1) ? L.rb1 : L.rb0) + 512 * (ds >> 1)), qf[ds], p);
            if (kb == qb) {
#pragma unroll
                for (int r = 0; r < 16; ++r) if (crow(r, hi) > r32) p[r] = 0.f;
            }
            const bf16x8 pa0 = pack_p(p, 0), pa1 = pack_p(p, 8);
            lptr vr = lds + R_V + 8192 * kb + 512 * (2 * vh);
#pragma unroll
            for (int s2 = 0; s2 < 2; ++s2) {
                const bf16x8 pa = s2 ? pa1 : pa0;
                const bf16x8 vf0 = cat8(vtr(vr + L.tpb0 + 4096 * s2), vtr(vr + L.tpb1 + 4096 * s2));
                const bf16x8 vf1 = cat8(vtr(vr + 512 + L.tpb0 + 4096 * s2), vtr(vr + 512 + L.tpb1 + 4096 * s2));
                o0 = MFMA32(pa, vf0, o0); o1 = MFMA32(pa, vf1, o1);
            }
        }
        if (c > 0) {
            f32x16 x0 = f32x16{}, x1 = f32x16{};
            lptr rr = lds + R_RT + 256 * (64 * vh);
#pragma unroll
            for (int ds = 0; ds < 8; ++ds) {
                const int ob = ((ds & 1) ? L.rb1 : L.rb0) + 512 * (ds >> 1);
                x0 = MFMA32(qf[ds], ld8(rr + ob), x0);
                x1 = MFMA32(qf[ds], ld8(rr + 8192 + ob), x1);
            }
#pragma unroll
            for (int r = 0; r < 16; ++r) { o0[r] += gam * x0[r]; o1[r] += gam * x1[r]; }
        }
#pragma unroll
        for (int r = 0; r < 16; ++r) { const float v = half_sum32(o0[r] * o0[r] + o1[r] * o1[r]);
            if (r32 == 16) ssq[vh * 128 + 32 * qb + crow(r, hi)] = v; }
        if (cc < 7) RET_KV_LOAD(stK, stV, c + 1);
        LDS_BAR();
        if (c < SEQ / 128 - 1) ret_update(R0, R1, lds, L, qb, vh, g127, g128);
        if (cc < 7) { RET_Q_LOAD(c + 1); RET_G_LOAD(c + 1); }
        const float gn0 = gn[64 * vh + r32], gn1 = gn[64 * vh + 32 + r32];
#pragma unroll
        for (int r = 0; r < 16; ++r) {
            const int row = crow(r, hi);
            const float rn = rsqrtf((ssq[32 * qb + row] + ssq[128 + 32 * qb + row]) * (1.0f / 128.0f) + RMS_EPS);
            LAS bf16_t* sp = (LAS bf16_t*)(stg + row * 128) + r32;
            sp[0] = (bf16_t)f2bf(o0[r] * rn * gn0 * bf2f(sp[0]));
            sp[32] = (bf16_t)f2bf(o1[r] * rn * gn1 * bf2f(sp[32]));
        }
#pragma unroll
        for (int i = 0; i < 4; ++i) { const int idx = lane + 64 * i;
            *(u32x4*)(YC + (crow0 + 32 * qb + (idx >> 3)) * BW + h * 128 + 64 * vh + (idx & 7) * 8) = *(const LAS u32x4*)(stg + (idx >> 3) * 128 + (idx & 7) * 16); }
    }
#undef RET_Q_LOAD
#undef RET_G_LOAD
}
#undef RET_KV_LOAD
#undef RET_KV_WRITE
#undef MFMA32

constexpr int C_Z = 65536;
__device__ __forceinline__ void conv_task(const Args& A, int l, int task, lptr lds) {
    const int tid = opaque_tid(), lane = tid & 63; const int wave = __builtin_amdgcn_readfirstlane(tid >> 6);
    const bf16_t* Z = (const bf16_t*)(A.ws + WS_Z); bf16_t* YB = (bf16_t*)(A.ws + WS_YB);
    const float* cw = A.in[I_CW] + (size_t)l * 31 * BW; const float* cb = A.in[I_CB] + l * BW;
    const float* lg = A.in[I_CLG] + l * BW; const float* lb = A.in[I_CLB] + l * BW;
    const int m0 = task * 32, t0 = m0 & (SEQ - 1);
    __syncthreads();
    for (int pc = wave; pc < 62; pc += NWAVES) {
        const int j = pc >> 1, hf = pc & 1;
        __builtin_amdgcn_global_load_lds((const unsigned*)(cw + (size_t)j * BW + 8 * lane + 4 * hf), (LAS unsigned*)(lds + pc * 1024), 16, 0, 0);
    }
    for (int r = wave; r < 62; r += NWAVES) {
        if (t0 - 30 + r >= 0) __builtin_amdgcn_global_load_lds((const unsigned*)(Z + (size_t)(m0 - 30 + r) * BW + lane * 8), (LAS unsigned*)(lds + C_Z + r * 1024), 16, 0, 0);
        else { unsigned zz = 0u; asm volatile("" : "+v"(zz)); *(LAS u32x4*)(lds + C_Z + r * 1024 + lane * 16) = (u32x4){zz, zz, zz, zz}; }
    }
    __syncthreads();
    const int c0 = lane * 8;
    float acc[4][8];
    { const f32x4 b0 = *(const f32x4*)(cb + c0), b1 = *(const f32x4*)(cb + c0 + 4);
#pragma unroll
      for (int k = 0; k < 4; ++k) { acc[k][0] = b0[0]; acc[k][1] = b0[1]; acc[k][2] = b0[2]; acc[k][3] = b0[3]; acc[k][4] = b1[0]; acc[k][5] = b1[1]; acc[k][6] = b1[2]; acc[k][7] = b1[3]; } }
    float zf[4][8];
    lptr zb = lds + C_Z + (4 * wave) * 1024 + lane * 16;
#define CONV_ZROW(slot, rr) do { const u32x4 v_ = *(const LAS u32x4*)(zb + (rr) * 1024); \
        zf[slot][0] = __uint_as_float(v_.x << 16); zf[slot][1] = __uint_as_float(v_.x & 0xffff0000u); zf[slot][2] = __uint_as_float(v_.y << 16); zf[slot][3] = __uint_as_float(v_.y & 0xffff0000u); \
        zf[slot][4] = __uint_as_float(v_.z << 16); zf[slot][5] = __uint_as_float(v_.z & 0xffff0000u); zf[slot][6] = __uint_as_float(v_.w << 16); zf[slot][7] = __uint_as_float(v_.w & 0xffff0000u); } while (0)
    CONV_ZROW(0, 0); CONV_ZROW(1, 1); CONV_ZROW(2, 2); CONV_ZROW(3, 3);
#pragma unroll
    for (int j = 0; j < 31; ++j) {
        const f32x4 w0 = *(const LAS f32x4*)(lds + ((j * 2 + 0) * 64 + lane) * 16), w1 = *(const LAS f32x4*)(lds + ((j * 2 + 1) * 64 + lane) * 16);
#pragma unroll
        for (int k = 0; k < 4; ++k) {
            const int sl = (j + k) & 3;
            acc[k][0] += w0[0] * zf[sl][0]; acc[k][1] += w0[1] * zf[sl][1]; acc[k][2] += w0[2] * zf[sl][2]; acc[k][3] += w0[3] * zf[sl][3];
            acc[k][4] += w1[0] * zf[sl][4]; acc[k][5] += w1[1] * zf[sl][5]; acc[k][6] += w1[2] * zf[sl][6]; acc[k][7] += w1[3] * zf[sl][7];
        }
        if (j < 30) CONV_ZROW(j & 3, j + 4);
    }
#undef CONV_ZROW
    const f32x4 g0 = *(const f32x4*)(lg + c0), g1 = *(const f32x4*)(lg + c0 + 4), h0 = *(const f32x4*)(lb + c0), h1 = *(const f32x4*)(lb + c0 + 4);
#pragma unroll
    for (int k = 0; k < 4; ++k) {
        float s_ = 0.f;
#pragma unroll
        for (int e = 0; e < 8; ++e) s_ += acc[k][e];
        const float mu = wave_sum(s_) * (1.0f / BW);
        float q = 0.f;
#pragma unroll
        for (int e = 0; e < 8; ++e) { acc[k][e] -= mu; q += acc[k][e] * acc[k][e]; }
        const float rstd = rsqrtf(wave_sum(q) * (1.0f / BW) + LN_EPS);
        float o[8];
#pragma unroll
        for (int e = 0; e < 4; ++e) { const float a_ = acc[k][e] * rstd * g0[e] + h0[e], b_ = acc[k][4 + e] * rstd * g1[e] + h1[e]; o[e] = a_ * sigx(-LOG2E * a_); o[4 + e] = b_ * sigx(-LOG2E * b_); }
        *(uint4*)(YB + (size_t)(m0 + 4 * wave + k) * BW + c0) = make_uint4(pk2(o[0], o[1]), pk2(o[2], o[3]), pk2(o[4], o[5]), pk2(o[6], o[7]));
    }
}

constexpr int Q_RA = 6, Q_AT = 32, Q_RB = 8, Q_CONV = 64, Q_TASKS = Q_RA + Q_AT + Q_RB + Q_AT + Q_CONV;
constexpr int CW_QUEUE = 8192;
__device__ __forceinline__ void mixer_phase(const Args& A, int l, lptr lds, volatile LAS unsigned* slot) {
    const int x0 = (int)(xb_xcc_id() & 7u);
    int qi = 0;
    for (;;) {
        const int x = (x0 + qi) & 7;
        unsigned* ctr = (unsigned*)(A.ws + WS_CTL) + CW_QUEUE + 64 * (8 * l + x);
        __syncthreads();
        if (threadIdx.x == 0) *slot = __hip_atomic_fetch_add(ctr, 1u, __ATOMIC_RELAXED, __HIP_MEMORY_SCOPE_AGENT);
        __syncthreads();
        int id = (int)*slot;
        if (id >= Q_TASKS) { if (++qi == 8) break; continue; }
#if PROBE_PHASE >= 10
        const unsigned t0_ = (unsigned)__builtin_amdgcn_s_memrealtime(); int kind = 0;
#endif
        if (id < Q_RA) { const int bh = 2 * x + id / 3; ret_a_task(A, l, bh >> 2, bh & 3, id % 3, lds); }
        else if ((id -= Q_RA) < Q_AT) { const int bh = 2 * x + (id & 1); attn_unit<0>(A, l, bh >> 2, bh & 3, 31 - (id >> 1), lds);
#if PROBE_PHASE >= 10
            kind = 1;
#endif
        }
        else if ((id -= Q_AT) < Q_RB) { const int bh = 2 * x + (id >> 2); ret_b_task(A, l, bh >> 2, bh & 3, id & 3, lds); }
        else if ((id -= Q_RB) < Q_AT) { const int bh = 2 * x + (id & 1); attn_unit<0>(A, l, bh >> 2, bh & 3, 15 - (id >> 1), lds);
#if PROBE_PHASE >= 10
            kind = 1;
#endif
        }
        else { id -= Q_AT; conv_task(A, l, 64 * x + id, lds);
#if PROBE_PHASE >= 10
            kind = 2;
#endif
        }
#if PROBE_PHASE >= 10
        __syncthreads();
        if (threadIdx.x == 0 && kind == PROBE_PHASE - 10) atomicAdd((unsigned*)(A.ws + WS_CTL) + CW_QUEUE + 2048, (unsigned)__builtin_amdgcn_s_memrealtime() - t0_);
#endif
    }
#if ABL_ATTN > 0
    if (l == 0) {
        unsigned* ctr2 = (unsigned*)(A.ws + WS_CTL) + CW_QUEUE + 4096;
        for (;;) {
            __syncthreads();
            if (threadIdx.x == 0) *slot = __hip_atomic_fetch_add(ctr2, 1u, __ATOMIC_RELAXED, __HIP_MEMORY_SCOPE_AGENT);
            __syncthreads();
            const int id = (int)*slot;
            if (id >= 512) break;
            attn_unit<ABL_ATTN>(A, l, (id & 15) >> 2, id & 3, 31 - (id >> 4), lds);
        }
    }
#endif
}
}

constexpr int N_PHASES = 1 + 6 * DEPTH;
constexpr int RING_BYTES = 131072, MISC_OFF = RING_BYTES + 320, LDS_BYTES = 147456;
#ifndef FAST_GEMM
#define FAST_GEMM 1
#endif
#ifndef FAST_MIX
#define FAST_MIX 1
#endif
#ifndef FAST_MASK
#define FAST_MASK 0x3f
#endif
__global__ void __launch_bounds__(NTHREADS, 2) fwd_kernel(Args A) {
    extern __shared__ __attribute__((aligned(16))) unsigned char lds[];
    float* sm = (float*)lds;
    LAS unsigned char* ldsl = (LAS unsigned char*)lds;
    volatile LAS unsigned* MISC = (volatile LAS unsigned*)(ldsl + MISC_OFF);
    const int wg = blockIdx.x, nwg = gridDim.x;
    const bool multi = (A.ph_hi - A.ph_lo) > 1;
    XcdBarrier bar; bar.bar = nullptr; bar.x = 0; bar.st = nullptr;
    if (multi) {
        if (threadIdx.x < 2) MISC[threadIdx.x] = 0u;
        __syncthreads();
        bar = xcd_barrier_post((unsigned*)(A.ws + WS_CTL) + CW_BAR, MISC);
    }
    const Args& A0 = A;
#if PROBE_PHASE >= 0
    if (blockIdx.x == 0 && threadIdx.x == 0) { const unsigned now = (unsigned)__builtin_amdgcn_s_memrealtime(); MISC[8] = now; MISC[9] = 0u; MISC[10] = now; }
#endif
    for (int ph = A0.ph_lo; ph < A0.ph_hi; ++ph) {
        Args A = A0;
        asm volatile("" : "+s"(A.out), "+s"(A.ws));
        if (ph == 0) { nv_p0(A, wg, nwg); if (FAST_GEMM) fast_p0_weights(A, wg, nwg, (LAS float*)ldsl, 0, NI_W1); }
        else {
            const int l = (ph - 1) / 6, k = (ph - 1) % 6;
            if (k == 1) {
#if FAST_MIX
                mx::mixer_phase(A, l, ldsl, MISC + 4);
#else
                nv_attn(A, l, wg, nwg, sm); nv_conv(A, l, wg, nwg); nv_ret(A, l, wg, nwg, sm);
#endif
            }
            else if (FAST_GEMM && ((FAST_MASK >> k) & 1)) fast_gemm(A, l, k, ldsl);
            else if (k == 0) nv_p1(A, l, wg, nwg, sm);
            else if (k == 2) nv_p3(A, l, wg, nwg, sm);
            else if (k == 3) nv_resid_gemm(A, (const bf16_t*)(A.ws + WS_Y), DM, DM, A.in[I_WOUT] + (size_t)l * DM * DM, l == 0 ? A.in[I_X] : A.out,
                                           (float*)(A.ws + WS_ROWSS) + (size_t)(l == 0 ? 1 : 3) * M, wg, nwg, sm);
            else if (k == 4) nv_p5(A, l, wg, nwg, sm);
            else nv_resid_gemm(A, (const bf16_t*)(A.ws + WS_MID), DFF, DFF, A.in[I_WF2] + (size_t)l * DFF * DM, A.out,
                               l + 1 < DEPTH ? (float*)(A.ws + WS_ROWSS) + (size_t)2 * M : nullptr, wg, nwg, sm);
        }
        if (ph + 1 < A0.ph_hi) xcd_barrier(bar);
#if PROBE_PHASE >= 0
        if (blockIdx.x == 0 && threadIdx.x == 0) { const unsigned long long now = __builtin_amdgcn_s_memrealtime(); const int k = ph == 0 ? 0 : 1 + (ph - 1) % 6;
            if (k == PROBE_PHASE) MISC[9] += (unsigned)now - MISC[10]; MISC[10] = (unsigned)now; }
#endif
    }
#if PROBE_PHASE >= 0
    xcd_barrier(bar);
    if (blockIdx.x == 0 && threadIdx.x == 0) { const unsigned now = (unsigned)__builtin_amdgcn_s_memrealtime(); float frac = (float)MISC[9] / (float)(now - MISC[8]);
        if (PROBE_PHASE >= 10) frac = (float)__hip_atomic_load((unsigned*)(A0.ws + WS_CTL) + mx::CW_QUEUE + 2048, __ATOMIC_RELAXED, __HIP_MEMORY_SCOPE_AGENT) / ((float)gridDim.x * (float)(now - MISC[8]));
        A0.out[0] += 2.0f + 28.0f * frac; }
#endif
}

extern "C" void kernel_launch(void* const* d_in, const int* in_sizes, int n_in, void* d_out, int out_size, void* d_ws, size_t ws_size, hipStream_t stream) {
    static int grid = 0;
    if (grid == 0) {
        if (n_in != N_IN || out_size != M * DM || ws_size < WS_END) { fprintf(stderr, "kernel_launch: unexpected shapes (n_in %d out %d ws %zu)\n", n_in, out_size, ws_size); grid = -1; return; }
        int dev = 0, cus = 0, per_cu = 0;
        (void)hipGetDevice(&dev); (void)hipDeviceGetAttribute(&cus, hipDeviceAttributeMultiprocessorCount, dev);
        (void)hipFuncSetAttribute((const void*)fwd_kernel, hipFuncAttributeMaxDynamicSharedMemorySize, LDS_BYTES);
        (void)hipOccupancyMaxActiveBlocksPerMultiprocessor(&per_cu, (const void*)fwd_kernel, NTHREADS, LDS_BYTES);
        (void)hipGetLastError();
        if (per_cu < 1) fprintf(stderr, "kernel_launch: occupancy query says %d blocks per CU\n", per_cu);
        grid = cus;
    }
    if (grid < 0) return;
    (void)hipMemsetAsync((char*)d_ws + WS_CTL, 0, CTL_ZERO_BYTES, stream);
    Args a{};
    for (int i = 0; i < N_IN; ++i) a.in[i] = (const float*)d_in[i];
    a.out = (float*)d_out; a.ws = (unsigned char*)d_ws;
    a.ph_lo = 0; a.ph_hi = N_PHASES;
    void* args[] = {&a};
    hipError_t e = hipLaunchCooperativeKernel((const void*)fwd_kernel, dim3(grid), dim3(NTHREADS), args, LDS_BYTES, stream);
    if (e != hipSuccess) fprintf(stderr, "cooperative launch failed: %s (grid %d)\n", hipGetErrorString(e), grid);
}
```

```cpp
#include <hip/hip_runtime.h>
#include <cstdio>
#include <cstdint>
#ifndef ABL_ATTN
#define ABL_ATTN 0
#endif
#ifndef PROBE_PHASE
#define PROBE_PHASE -1
#endif

#define GAS __attribute__((address_space(1)))
#define LAS __attribute__((address_space(3)))
typedef unsigned short bf16_t;
typedef GAS unsigned gu32;
#define RLX_AGENT __ATOMIC_RELAXED, __HIP_MEMORY_SCOPE_AGENT

constexpr int BATCH = 4, SEQ = 4096, DM = 1024, M = BATCH * SEQ, DEPTH = 2;
constexpr int DIN = 7680, NU = 4608, NGATE = 3072, DFF = 2816, BW = 512;
constexpr float RMS_EPS = 1e-6f, LN_EPS = 1e-5f;
constexpr float LOG2E = 1.4426950408889634f;
constexpr float QSCALE = 0.125f * LOG2E;
constexpr int NTHREADS = 512, NWAVES = 8;

enum { I_X = 0, I_N1G, I_WIN, I_QG, I_KG, I_DLAM, I_ASG, I_CW, I_CB, I_CLG, I_CLB, I_RGN, I_BGATE, I_WBR, I_WOUT, I_N2G, I_WF1, I_WF2, N_IN };

constexpr size_t MiB = 1u << 20;
constexpr size_t WS_CTL = 0, CTL_ZERO_BYTES = 1 * MiB;
constexpr size_t WS_ROWSS = 256 * 1024;
constexpr size_t WS_LAM = 512 * 1024;
constexpr size_t WS_XB = 78 * MiB;
constexpr size_t WS_AQ = 110 * MiB, WS_AK = 126 * MiB, WS_AV = 142 * MiB, WS_Z = 158 * MiB, WS_RQ = 174 * MiB, WS_RK = 190 * MiB, WS_RV = 206 * MiB, WS_RG = 222 * MiB, WS_YB = 238 * MiB;
constexpr size_t WS_YA = WS_AQ, WS_YC = WS_RQ;
constexpr size_t WS_Y = 126 * MiB;
constexpr size_t WS_MID = 110 * MiB;
constexpr size_t WS_END = 256 * MiB;
constexpr int CW_BAR = 4096;

struct Args { const float* in[N_IN]; float* out; unsigned char* ws; int ph_lo, ph_hi; };

__device__ __forceinline__ float bf2f(unsigned v) { return __uint_as_float(v << 16); }
__device__ __forceinline__ unsigned f2bf(float f) { unsigned u = __float_as_uint(f); return (u + 0x7fffu + ((u >> 16) & 1u)) >> 16; }
__device__ __forceinline__ unsigned pk2(float lo, float hi) { return f2bf(lo) | (f2bf(hi) << 16); }
__device__ __forceinline__ float wave_sum(float v) {
#pragma unroll
    for (int o = 1; o < 64; o <<= 1) v += __shfl_xor(v, o);
    return v;
}
__device__ __forceinline__ float wave_max(float v) {
#pragma unroll
    for (int o = 1; o < 64; o <<= 1) v = fmaxf(v, __shfl_xor(v, o));
    return v;
}
__device__ __forceinline__ int opaque_tid() { int t = threadIdx.x; asm volatile("" : "+v"(t)); return t; }
__device__ __forceinline__ float sigmoidf_(float x) { return 1.0f / (1.0f + __expf(-x)); }
__device__ __forceinline__ float siluf_(float x) { return x / (1.0f + __expf(-x)); }
__device__ __forceinline__ float lam_init_of(int l) { return l == 0 ? 0.2f : (0.8f - 0.6f * 0.74081822068171788f); }
__device__ __forceinline__ float log2_gamma(int h) { return log2f(1.0f - exp2f(-5.0f - (float)h)); }

#define XB_TMO      128
#define XB_XCNT(j)  (256  + 64 * (j))
#define XB_XSUB(j)  (1280 + 64 * (j))
#define XB_XGEN(j)  (2304 + 64 * (j))
#define XB_TOP      3328
#define XB_TOPGEN   3392
#define XCD_BAR_WORDS 3456
#define XB_SPIN_CAP (1u << 22)
__device__ __forceinline__ unsigned xb_ld(unsigned* p)              { return __hip_atomic_load(p, __ATOMIC_RELAXED, __HIP_MEMORY_SCOPE_AGENT); }
__device__ __forceinline__ unsigned xb_add(unsigned* p, unsigned v) { return __hip_atomic_fetch_add(p, v, __ATOMIC_RELAXED, __HIP_MEMORY_SCOPE_AGENT); }
__device__ __forceinline__ unsigned xb_xcc_id() { return (unsigned)__builtin_amdgcn_s_getreg((3 << 11) | 20) & 0xFu; }
#define XB_SPIN(cond, bar) do { unsigned _sp = 0; while (cond) { __builtin_amdgcn_s_sleep(1); \
    if ((++_sp & 255u) == 0u) { if (xb_ld(&(bar)[XB_TMO])) break; if (_sp > XB_SPIN_CAP) { atomicAdd(&(bar)[XB_TMO], 1u); break; } } } } while (0)
struct XcdBarrier { unsigned* bar; unsigned x; volatile LAS unsigned* st; };
__device__ __forceinline__ XcdBarrier xcd_barrier_post(unsigned* bar, volatile LAS unsigned* st) {
    XcdBarrier b; b.bar = bar; b.x = xb_xcc_id(); b.st = st;
    if (threadIdx.x == 0) (void)xb_add(&bar[XB_XCNT(b.x)], 1u);
    return b;
}
__device__ __forceinline__ void xcd_barrier_complete(unsigned* bar, unsigned x, unsigned& nloc, unsigned& nx) {
    const unsigned G = gridDim.x * gridDim.y * gridDim.z;
    unsigned sum, cnt, mine, sp = 0u;
    for (;;) {
        sum = 0u; cnt = 0u; mine = 0u;
#pragma unroll
        for (unsigned j = 0; j < 16; ++j) { const unsigned c = xb_ld(&bar[XB_XCNT(j)]); sum += c; cnt += (c > 0u) ? 1u : 0u; mine = (j == x) ? c : mine; }
        if (sum == G) break;
        __builtin_amdgcn_s_sleep(1);
        if ((++sp & 255u) == 0u) { if (xb_ld(&bar[XB_TMO])) break; if (sp > XB_SPIN_CAP) { atomicAdd(&bar[XB_TMO], 1u); break; } }
    }
    nloc = mine > 0u ? mine : 1u; nx = cnt > 0u ? cnt : 1u;
}
__device__ __forceinline__ void xcd_barrier(const XcdBarrier& b) {
    asm volatile("s_waitcnt vmcnt(0)" ::: "memory");
    __syncthreads();
    if (threadIdx.x == 0) {
        unsigned* bar = b.bar;
        __builtin_amdgcn_s_waitcnt(0);
        unsigned nloc = b.st[0], nx = b.st[1];
        if (nloc == 0u) { xcd_barrier_complete(bar, b.x, nloc, nx); b.st[0] = nloc; b.st[1] = nx; }
        const unsigned old = xb_add(&bar[XB_XSUB(b.x)], 1u);
        const unsigned gen = old / nloc;
        if (old + 1u == (gen + 1u) * nloc) {
            __builtin_amdgcn_fence(__ATOMIC_RELEASE, "agent");
            asm volatile("s_waitcnt vmcnt(0)" ::: "memory");
            const unsigned og = xb_add(&bar[XB_TOP], 1u);
            const unsigned tg = og / nx;
            if (og + 1u == (tg + 1u) * nx) xb_add(&bar[XB_TOPGEN], 1u);
            else XB_SPIN(xb_ld(&bar[XB_TOPGEN]) == tg, bar);
            __builtin_amdgcn_fence(__ATOMIC_ACQUIRE, "agent");
            xb_add(&bar[XB_XGEN(b.x)], 1u);
            asm volatile("s_waitcnt vmcnt(0)" ::: "memory");
        } else {
            XB_SPIN(xb_ld(&bar[XB_XGEN(b.x)]) == gen, bar);
            __builtin_amdgcn_fence(__ATOMIC_ACQUIRE, "agent");
            asm volatile("s_waitcnt vmcnt(0)" ::: "memory");
        }
    }
    __syncthreads();
}


__device__ __forceinline__ void nv_p0(const Args& A, int wg, int nwg) {
    const int tid = opaque_tid(), lane = tid & 63, wave = tid >> 6;
    const float* x = A.in[I_X];
    bf16_t* XB = (bf16_t*)(A.ws + WS_XB);
    float* rowss = (float*)(A.ws + WS_ROWSS);
    for (int m0 = wg * NWAVES + wave; m0 < M; m0 += 4 * nwg * NWAVES) {
        float4 v[4][4];
#pragma unroll
        for (int r = 0; r < 4; ++r) { const int m = m0 + r * nwg * NWAVES; if (m < M) { const float4* xr = (const float4*)(x + (size_t)m * DM) + lane;
#pragma unroll
            for (int j = 0; j < 4; ++j) v[r][j] = xr[64 * j]; } }
#pragma unroll
        for (int r = 0; r < 4; ++r) { const int m = m0 + r * nwg * NWAVES; if (m < M) { uint2* o = (uint2*)(XB + (size_t)m * DM) + lane; float s = 0.f;
#pragma unroll
            for (int j = 0; j < 4; ++j) { const float4 q = v[r][j]; s += q.x * q.x + q.y * q.y + q.z * q.z + q.w * q.w; o[64 * j] = make_uint2(pk2(q.x, q.y), pk2(q.z, q.w)); }
            s = wave_sum(s);
            if (lane == 0) rowss[m] = s; } }
    }
    if (wg == 0 && wave < DEPTH) {
        const float* dl = A.in[I_DLAM] + wave * 4 * 64;
        float a = dl[lane] * dl[64 + lane], b = dl[128 + lane] * dl[192 + lane];
        a = wave_sum(a); b = wave_sum(b);
        if (lane == 0) ((float*)(A.ws + WS_LAM))[wave] = __expf(a) - __expf(b) + lam_init_of(wave);
    }
}

template <class AL, class WL>
__device__ __forceinline__ void nv_core(float (&acc)[4][4], int K, const AL& aload, const WL& wload, float* sA, float* sB, int tid) {
    const int tx = tid & 15, ty = tid >> 4;
#pragma unroll
    for (int i = 0; i < 4; ++i)
#pragma unroll
        for (int j = 0; j < 4; ++j) acc[i][j] = 0.f;
    const int ar = tid & 127, akq = tid >> 7;
    const int wk = tid >> 5, wc = (tid & 31) * 2;
#pragma unroll 1
    for (int k0 = 0; k0 < K; k0 += 16) {
        float a0, a1, a2, a3; aload(ar, k0 + 4 * akq, a0, a1, a2, a3);
        const float w0 = wload(k0 + wk, wc), w1 = wload(k0 + wk, wc + 1);
        __syncthreads();
        sA[(4 * akq + 0) * 128 + ar] = a0; sA[(4 * akq + 1) * 128 + ar] = a1; sA[(4 * akq + 2) * 128 + ar] = a2; sA[(4 * akq + 3) * 128 + ar] = a3;
        sB[wk * 64 + wc] = w0; sB[wk * 64 + wc + 1] = w1;
        __syncthreads();
#pragma unroll 2
        for (int kk = 0; kk < 16; ++kk) {
            const float4 a = *(const float4*)&sA[kk * 128 + ty * 4];
            const float4 b = *(const float4*)&sB[kk * 64 + tx * 4];
            const float av[4] = {a.x, a.y, a.z, a.w}, bv[4] = {b.x, b.y, b.z, b.w};
#pragma unroll
            for (int i = 0; i < 4; ++i)
#pragma unroll
                for (int j = 0; j < 4; ++j) acc[i][j] += av[i] * bv[j];
        }
    }
    __syncthreads();
}
struct ALbf {
    const bf16_t* A; int lda; int row0;
    __device__ __forceinline__ void operator()(int r, int k, float& a0, float& a1, float& a2, float& a3) const {
        const uint2 v = *(const uint2*)(A + (size_t)(row0 + r) * lda + k);
        a0 = __uint_as_float(v.x << 16); a1 = __uint_as_float(v.x & 0xffff0000u); a2 = __uint_as_float(v.y << 16); a3 = __uint_as_float(v.y & 0xffff0000u);
    }
};
struct WLf32 {
    const float* W; int ldw; int c0, c1; const float* g;
    __device__ __forceinline__ float operator()(int k, int j) const {
        const float w = W[(size_t)k * ldw + (j < 32 ? c0 + j : c1 + j - 32)];
        return g ? w * g[k] : w;
    }
};

__device__ __forceinline__ void nv_p1(const Args& A, int l, int wg, int nwg, float* sm) {
    float* sA = sm; float* sB = sm + 16 * 128; float* sC = sB + 16 * 64;
    const int tid = opaque_tid(), tx = tid & 15, ty = tid >> 4;
    const float* Win = A.in[I_WIN] + (size_t)l * DM * DIN;
    const float* g1 = A.in[I_N1G] + l * DM;
    const bf16_t* XB = (const bf16_t*)(A.ws + WS_XB);
    const float* rowss = (const float*)(A.ws + WS_ROWSS) + (size_t)(l == 0 ? 0 : 2) * M;
    const float* qg = A.in[I_QG] + l * 64; const float* kg = A.in[I_KG] + l * 64;
    for (int it = wg; it < 128 * 72; it += nwg) {
        const int rt = it / 72, cg = it % 72, row0 = rt * 128;
        int c0 = 64 * cg, c1 = 64 * cg + 32;
        if (cg >= 24 && cg < 40) { c0 = 1536 + 32 * (cg - 24); c1 = 2048 + 32 * (cg - 24); }
        float acc[4][4];
        nv_core(acc, DM, ALbf{XB, DM, row0}, WLf32{Win, DIN, c0, c1, g1}, sA, sB, tid);
#pragma unroll
        for (int i = 0; i < 4; ++i) {
            const int r = ty * 4 + i; const float rstd = rsqrtf(rowss[row0 + r] * (1.0f / DM) + RMS_EPS);
#pragma unroll
            for (int j = 0; j < 4; ++j) sC[r * 65 + tx * 4 + j] = acc[i][j] * rstd;
        }
        __syncthreads();
        const int r = tid >> 2, q4 = tid & 3, m = row0 + r, t = m & (SEQ - 1);
        const float* cr = sC + r * 65;
        if (cg < 16) {
            float ss = 0.f;
#pragma unroll
            for (int j = 0; j < 16; ++j) { const float v = cr[q4 * 16 + j]; ss += v * v; }
            ss += __shfl_xor(ss, 1); ss += __shfl_xor(ss, 2);
            const float rn = rsqrtf(ss * (1.0f / 64.0f) + RMS_EPS);
            const bool isq = cg < 8; const float* gg = isq ? qg : kg; const float sc = isq ? QSCALE : 1.0f;
            bf16_t* o = (bf16_t*)(A.ws + (isq ? WS_AQ : WS_AK)) + (size_t)m * BW + (cg & 7) * 64 + q4 * 16;
#pragma unroll
            for (int j = 0; j < 16; ++j) o[j] = (bf16_t)f2bf(cr[q4 * 16 + j] * rn * gg[q4 * 16 + j] * sc);
        } else if (cg >= 24 && cg < 40) {
            bf16_t* o = (bf16_t*)(A.ws + WS_Z) + (size_t)m * BW + (cg - 24) * 32 + q4 * 8;
#pragma unroll
            for (int j = 0; j < 8; ++j) o[j] = (bf16_t)f2bf(cr[q4 * 8 + j] * sigmoidf_(cr[32 + q4 * 8 + j]));
        } else {
            size_t base; int cb; int kind;
            if (cg < 24)      { base = WS_AV; cb = cg - 16; kind = 0; }
            else if (cg < 48) { base = WS_RQ; cb = cg - 40; kind = 1; }
            else if (cg < 56) { base = WS_RK; cb = cg - 48; kind = 2; }
            else if (cg < 64) { base = WS_RV; cb = cg - 56; kind = 0; }
            else              { base = WS_RG; cb = cg - 64; kind = 3; }
            const int h = cb >> 1; const float l2g = log2_gamma(h); const float tp = (float)(t & 127);
            float f = 1.0f;
            if (kind == 1) f = exp2f(tp * l2g);
            if (kind == 2) f = 0.08838834764831845f * exp2f(-tp * l2g);
            bf16_t* o = (bf16_t*)(A.ws + base) + (size_t)m * BW + cb * 64 + q4 * 16;
#pragma unroll
            for (int j = 0; j < 16; ++j) { float v = cr[q4 * 16 + j]; v = (kind == 3) ? siluf_(v) : v * f; o[j] = (bf16_t)f2bf(v); }
        }
        __syncthreads();
    }
}

__device__ __forceinline__ void nv_attn(const Args& A, int l, int wg, int nwg, float* sm) {
    const int tid = opaque_tid(), lane = tid & 63, wave = tid >> 6;
    float* sq = sm + wave * 256;
    const bf16_t* AQ = (const bf16_t*)(A.ws + WS_AQ); const bf16_t* AK = (const bf16_t*)(A.ws + WS_AK); const bf16_t* AV = (const bf16_t*)(A.ws + WS_AV);
    bf16_t* YA = (bf16_t*)(A.ws + WS_YA);
    const float lam = ((const float*)(A.ws + WS_LAM))[l];
    const float* asg = A.in[I_ASG] + l * 128;
    const float osc = 1.0f - lam_init_of(l);
    for (int it = wg * NWAVES + wave; it < BATCH * 4 * SEQ; it += nwg * NWAVES) {
        const int t = it & (SEQ - 1), h = (it >> 12) & 3, b = it >> 14;
        const size_t mq = (size_t)b * SEQ + t;
        const float slope2 = exp2f(-2.0f * (float)(h + 1)) * LOG2E;
        sq[lane] = bf2f(AQ[mq * BW + h * 128 + lane]); sq[64 + lane] = bf2f(AQ[mq * BW + h * 128 + 64 + lane]);
        float m1 = -INFINITY, m2 = -INFINITY, l1 = 0.f, l2 = 0.f, o1a = 0.f, o1b = 0.f, o2a = 0.f, o2b = 0.f;
        for (int s0 = 0; s0 <= t; s0 += 64) {
            const int s = s0 + lane; const bool valid = s <= t;
            float d1 = 0.f, d2 = 0.f;
            if (valid) {
                const uint4* kr = (const uint4*)(AK + ((size_t)b * SEQ + s) * BW + h * 128);
#pragma unroll 2
                for (int c = 0; c < 8; ++c) {
                    const uint4 v = kr[c]; const unsigned w[4] = {v.x, v.y, v.z, v.w};
#pragma unroll
                    for (int e = 0; e < 4; ++e) { d1 += sq[c * 8 + 2 * e] * __uint_as_float(w[e] << 16) + sq[c * 8 + 2 * e + 1] * __uint_as_float(w[e] & 0xffff0000u); }
                }
#pragma unroll 2
                for (int c = 0; c < 8; ++c) {
                    const uint4 v = kr[8 + c]; const unsigned w[4] = {v.x, v.y, v.z, v.w};
#pragma unroll
                    for (int e = 0; e < 4; ++e) { d2 += sq[64 + c * 8 + 2 * e] * __uint_as_float(w[e] << 16) + sq[64 + c * 8 + 2 * e + 1] * __uint_as_float(w[e] & 0xffff0000u); }
                }
            }
            const float bias = slope2 * (float)(s - t);
            const float s1 = valid ? d1 + bias : -INFINITY, s2 = valid ? d2 + bias : -INFINITY;
            const float n1 = fmaxf(m1, wave_max(s1)), n2 = fmaxf(m2, wave_max(s2));
            const float a1 = exp2f(m1 - n1), a2 = exp2f(m2 - n2);
            const float p1 = exp2f(s1 - n1), p2 = exp2f(s2 - n2);
            l1 = l1 * a1 + wave_sum(p1); l2 = l2 * a2 + wave_sum(p2);
            o1a *= a1; o1b *= a1; o2a *= a2; o2b *= a2; m1 = n1; m2 = n2;
            sq[128 + lane] = p1; sq[192 + lane] = p2;
            const int nk = min(64, t - s0 + 1);
            const unsigned* vr = (const unsigned*)(AV + ((size_t)b * SEQ + s0) * BW + h * 128) + lane;
            for (int j = 0; j < nk; ++j) {
                const unsigned v = vr[(size_t)j * (BW / 2)];
                const float va = __uint_as_float(v << 16), vb = __uint_as_float(v & 0xffff0000u);
                const float q1 = sq[128 + j], q2 = sq[192 + j];
                o1a += q1 * va; o1b += q1 * vb; o2a += q2 * va; o2b += q2 * vb;
            }
        }
        const float i1 = 1.0f / l1, i2 = lam / l2;
        const float ya = o1a * i1 - o2a * i2, yb = o1b * i1 - o2b * i2;
        const float ss = wave_sum(ya * ya + yb * yb);
        const float rn = rsqrtf(ss * (1.0f / 128.0f) + RMS_EPS) * osc;
        ((unsigned*)(YA + mq * BW + h * 128))[lane] = pk2(ya * rn * asg[2 * lane], yb * rn * asg[2 * lane + 1]);
    }
}

__device__ __forceinline__ void nv_conv(const Args& A, int l, int wg, int nwg) {
    const int tid = opaque_tid(), lane = tid & 63, wave = tid >> 6;
    const bf16_t* Z = (const bf16_t*)(A.ws + WS_Z); bf16_t* YB = (bf16_t*)(A.ws + WS_YB);
    const float* cw = A.in[I_CW] + (size_t)l * 31 * BW; const float* cb = A.in[I_CB] + l * BW;
    const float* lg = A.in[I_CLG] + l * BW; const float* lb = A.in[I_CLB] + l * BW;
    const int c0 = lane * 8;
    for (int m = wg * NWAVES + wave; m < M; m += nwg * NWAVES) {
        const int t = m & (SEQ - 1);
        float acc[8];
#pragma unroll
        for (int e = 0; e < 8; ++e) acc[e] = cb[c0 + e];
        const int j0 = max(0, 30 - t);
        for (int j = j0; j < 31; ++j) {
            const uint4 v = *(const uint4*)(Z + (size_t)(m - 30 + j) * BW + c0);
            const float4 wa = *(const float4*)(cw + j * BW + c0), wb = *(const float4*)(cw + j * BW + c0 + 4);
            acc[0] += wa.x * __uint_as_float(v.x << 16); acc[1] += wa.y * __uint_as_float(v.x & 0xffff0000u);
            acc[2] += wa.z * __uint_as_float(v.y << 16); acc[3] += wa.w * __uint_as_float(v.y & 0xffff0000u);
            acc[4] += wb.x * __uint_as_float(v.z << 16); acc[5] += wb.y * __uint_as_float(v.z & 0xffff0000u);
            acc[6] += wb.z * __uint_as_float(v.w << 16); acc[7] += wb.w * __uint_as_float(v.w & 0xffff0000u);
        }
        float s = 0.f;
#pragma unroll
        for (int e = 0; e < 8; ++e) s += acc[e];
        const float mu = wave_sum(s) * (1.0f / BW);
        float q = 0.f;
#pragma unroll
        for (int e = 0; e < 8; ++e) { acc[e] -= mu; q += acc[e] * acc[e]; }
        const float rstd = rsqrtf(wave_sum(q) * (1.0f / BW) + LN_EPS);
        float o[8];
#pragma unroll
        for (int e = 0; e < 8; ++e) o[e] = siluf_(acc[e] * rstd * lg[c0 + e] + lb[c0 + e]);
        *(uint4*)(YB + (size_t)m * BW + c0) = make_uint4(pk2(o[0], o[1]), pk2(o[2], o[3]), pk2(o[4], o[5]), pk2(o[6], o[7]));
    }
}

__device__ __forceinline__ void nv_ret(const Args& A, int l, int wg, int nwg, float* sm) {
    const int tid = opaque_tid(), lane = tid & 63, wave = tid >> 6;
    float* sq = sm + wave * 256;
    const bf16_t* RQ = (const bf16_t*)(A.ws + WS_RQ); const bf16_t* RK = (const bf16_t*)(A.ws + WS_RK); const bf16_t* RV = (const bf16_t*)(A.ws + WS_RV);
    const bf16_t* RG = (const bf16_t*)(A.ws + WS_RG); bf16_t* YC = (bf16_t*)(A.ws + WS_YC);
    const float* gn = A.in[I_RGN] + l * 128;
    for (int it = wg * NWAVES + wave; it < BATCH * 4 * SEQ; it += nwg * NWAVES) {
        const int t = it & (SEQ - 1), h = (it >> 12) & 3, b = it >> 14;
        const size_t mq = (size_t)b * SEQ + t;
        const float l2g128 = 128.0f * log2_gamma(h);
        { const unsigned v = ((const unsigned*)(RQ + mq * BW + h * 128))[lane]; sq[2 * lane] = __uint_as_float(v << 16); sq[2 * lane + 1] = __uint_as_float(v & 0xffff0000u); }
        float oa = 0.f, ob = 0.f;
        const int ct = t >> 7;
        for (int s0 = 0; s0 <= t; s0 += 64) {
            const int s = s0 + lane; const bool valid = s <= t;
            float d = 0.f;
            if (valid) {
                const uint4* kr = (const uint4*)(RK + ((size_t)b * SEQ + s) * BW + h * 128);
#pragma unroll 2
                for (int c = 0; c < 16; ++c) {
                    const uint4 v = kr[c]; const unsigned w[4] = {v.x, v.y, v.z, v.w};
#pragma unroll
                    for (int e = 0; e < 4; ++e) { d += sq[c * 8 + 2 * e] * __uint_as_float(w[e] << 16) + sq[c * 8 + 2 * e + 1] * __uint_as_float(w[e] & 0xffff0000u); }
                }
                d *= exp2f(l2g128 * (float)(ct - (s >> 7)));
            }
            sq[128 + lane] = d;
            const int nk = min(64, t - s0 + 1);
            const unsigned* vr = (const unsigned*)(RV + ((size_t)b * SEQ + s0) * BW + h * 128) + lane;
            for (int j = 0; j < nk; ++j) {
                const unsigned v = vr[(size_t)j * (BW / 2)];
                const float a = sq[128 + j];
                oa += a * __uint_as_float(v << 16); ob += a * __uint_as_float(v & 0xffff0000u);
            }
        }
        const float ss = wave_sum(oa * oa + ob * ob);
        const float rn = rsqrtf(ss * (1.0f / 128.0f) + RMS_EPS);
        const unsigned gv = ((const unsigned*)(RG + mq * BW + h * 128))[lane];
        ((unsigned*)(YC + mq * BW + h * 128))[lane] = pk2(oa * rn * gn[2 * lane] * __uint_as_float(gv << 16), ob * rn * gn[2 * lane + 1] * __uint_as_float(gv & 0xffff0000u));
    }
}

__device__ __forceinline__ void nv_p3(const Args& A, int l, int wg, int nwg, float* sm) {
    float* sA = sm; float* sB = sm + 16 * 128;
    const int tid = opaque_tid(), tx = tid & 15, ty = tid >> 4;
    const float* Win = A.in[I_WIN] + (size_t)l * DM * DIN;
    const float* g1 = A.in[I_N1G] + l * DM;
    const float* bg = A.in[I_BGATE] + l * NGATE;
    const float* Wbr = A.in[I_WBR] + (size_t)l * 3 * BW * DM;
    const bf16_t* XB = (const bf16_t*)(A.ws + WS_XB);
    const float* rowss = (const float*)(A.ws + WS_ROWSS) + (size_t)(l == 0 ? 0 : 2) * M;
    bf16_t* Y = (bf16_t*)(A.ws + WS_Y);
    for (int it = wg; it < 128 * 16; it += nwg) {
        const int rt = it / 16, cg = it % 16, row0 = rt * 128;
        float y[4][4];
#pragma unroll
        for (int i = 0; i < 4; ++i)
#pragma unroll
            for (int j = 0; j < 4; ++j) y[i][j] = 0.f;
#pragma unroll 1
        for (int n = 0; n < 3; ++n) {
            float ga[4][4], pa[4][4];
            nv_core(ga, DM, ALbf{XB, DM, row0}, WLf32{Win, DIN, NU + n * DM + 64 * cg, NU + n * DM + 64 * cg + 32, g1}, sA, sB, tid);
            const bf16_t* br = (const bf16_t*)(A.ws + (n == 0 ? WS_YA : n == 1 ? WS_YB : WS_YC));
            nv_core(pa, BW, ALbf{br, BW, row0}, WLf32{Wbr + (size_t)n * BW * DM, DM, 64 * cg, 64 * cg + 32, nullptr}, sA, sB, tid);
#pragma unroll
            for (int i = 0; i < 4; ++i) {
                const float rstd = rsqrtf(rowss[row0 + ty * 4 + i] * (1.0f / DM) + RMS_EPS);
#pragma unroll
                for (int j = 0; j < 4; ++j) y[i][j] += sigmoidf_(ga[i][j] * rstd + bg[n * DM + 64 * cg + tx * 4 + j]) * pa[i][j];
            }
        }
#pragma unroll
        for (int i = 0; i < 4; ++i)
            *(uint2*)(Y + (size_t)(row0 + ty * 4 + i) * DM + 64 * cg + tx * 4) = make_uint2(pk2(y[i][0], y[i][1]), pk2(y[i][2], y[i][3]));
    }
}

__device__ __forceinline__ void nv_resid_gemm(const Args& A, const bf16_t* Am, int lda, int K, const float* W, const float* xold, float* rowss_next, int wg, int nwg, float* sm) {
    float* sA = sm; float* sB = sm + 16 * 128;
    const int tid = opaque_tid(), tx = tid & 15, ty = tid >> 4;
    bf16_t* XB = (bf16_t*)(A.ws + WS_XB);
    for (int it = wg; it < 128 * 16; it += nwg) {
        const int rt = it / 16, cg = it % 16, row0 = rt * 128;
        float acc[4][4];
        nv_core(acc, K, ALbf{Am, lda, row0}, WLf32{W, DM, 64 * cg, 64 * cg + 32, nullptr}, sA, sB, tid);
#pragma unroll
        for (int i = 0; i < 4; ++i) {
            const size_t off = (size_t)(row0 + ty * 4 + i) * DM + 64 * cg + tx * 4;
            const float4 xo = *(const float4*)(xold + off);
            const float4 xn = make_float4(xo.x + acc[i][0], xo.y + acc[i][1], xo.z + acc[i][2], xo.w + acc[i][3]);
            *(float4*)(A.out + off) = xn;
            *(uint2*)(XB + off) = make_uint2(pk2(xn.x, xn.y), pk2(xn.z, xn.w));
            float s = xn.x * xn.x + xn.y * xn.y + xn.z * xn.z + xn.w * xn.w;
            s += __shfl_xor(s, 1); s += __shfl_xor(s, 2); s += __shfl_xor(s, 4); s += __shfl_xor(s, 8);
            if (tx == 0 && rowss_next) atomicAdd(rowss_next + row0 + ty * 4 + i, s);
        }
    }
}

__device__ __forceinline__ void nv_p5(const Args& A, int l, int wg, int nwg, float* sm) {
    float* sA = sm; float* sB = sm + 16 * 128; float* sC = sB + 16 * 64;
    const int tid = opaque_tid(), tx = tid & 15, ty = tid >> 4;
    const float* W = A.in[I_WF1] + (size_t)l * DM * 2 * DFF;
    const float* g2 = A.in[I_N2G] + l * DM;
    const bf16_t* XB = (const bf16_t*)(A.ws + WS_XB);
    const float* rowss = (const float*)(A.ws + WS_ROWSS) + (size_t)(l == 0 ? 1 : 3) * M;
    bf16_t* MID = (bf16_t*)(A.ws + WS_MID);
    for (int it = wg; it < 128 * 88; it += nwg) {
        const int rt = it / 88, jj = it % 88, row0 = rt * 128;
        float acc[4][4];
        nv_core(acc, DM, ALbf{XB, DM, row0}, WLf32{W, 2 * DFF, 32 * jj, DFF + 32 * jj, g2}, sA, sB, tid);
#pragma unroll
        for (int i = 0; i < 4; ++i) {
            const int r = ty * 4 + i; const float rstd = rsqrtf(rowss[row0 + r] * (1.0f / DM) + RMS_EPS);
#pragma unroll
            for (int j = 0; j < 4; ++j) sC[r * 65 + tx * 4 + j] = acc[i][j] * rstd;
        }
        __syncthreads();
        const int r = tid >> 2, q4 = tid & 3;
        const float* cr = sC + r * 65;
        bf16_t* o = MID + (size_t)(row0 + r) * DFF + 32 * jj + q4 * 8;
#pragma unroll
        for (int j = 0; j < 8; ++j) o[j] = (bf16_t)f2bf(siluf_(cr[q4 * 8 + j]) * cr[32 + q4 * 8 + j]);
        __syncthreads();
    }
}


namespace pg8 {
typedef short bf16x8 __attribute__((ext_vector_type(8)));
typedef float f32x4 __attribute__((ext_vector_type(4)));
typedef unsigned u32x4 __attribute__((ext_vector_type(4)));
constexpr int BM = 256, BK = 64, HALF = 128, HTB = HALF * BK * 2, STAGE_BYTES = 8 * HTB, NXCD = 8, WGM = 4;
__host__ __device__ __forceinline__ int lds_byte(int r, int c) { const int st = (r >> 4) * 2 + (c >> 5), rr = r & 15, cc = c & 31, ob = rr * 64 + cc * 2; return st * 1024 + (ob ^ (((ob >> 9) & 1) << 5)); }
__host__ __device__ __forceinline__ void stage_rc(int b, int& R, int& C) { const int st = b / 1024, sb = b % 1024, swz = sb ^ (((sb >> 9) & 1) << 5); R = (st >> 1) * 16 + swz / 64; C = (st & 1) * 32 + (swz % 64) / 2; }
__host__ __device__ __forceinline__ int perm32(int rho) { const int n = rho >> 4, i = rho & 15; return 8 * (i >> 2) + 4 * n + (i & 3); }

struct GUnit { const char* A; const char* B; int lda2, ldb2, nt, pm, pn, kind; };

struct TileOrder {
    int nM, nN, nwg, G, c;
    __device__ __forceinline__ void init(int nM_, int nN_, int G_, int c_) { nM = nM_; nN = nN_; nwg = nM * nN; G = G_; c = c_; }
    __device__ __forceinline__ bool tile(int i, int& pm, int& pn) const {
        const long L = (long)i * G + c; if (L >= nwg) return false;
        int wgid = (int)L; { const int q = nwg / NXCD, r = nwg % NXCD, xcd = wgid % NXCD, off = wgid / NXCD; wgid = (xcd < r ? xcd * (q + 1) : r * (q + 1) + (xcd - r) * q) + off; }
        const int nig = WGM * nN, gid = wgid / nig, fm = gid * WGM, gsz = (nM - fm) < WGM ? (nM - fm) : WGM;
        pm = fm + ((wgid % nig) % gsz); pn = (wgid % nig) / gsz; return true;
    }
};

typedef float f32x2_t __attribute__((ext_vector_type(2))); typedef __bf16 bf16x2_t __attribute__((ext_vector_type(2)));
__device__ __forceinline__ unsigned cvt_pk_bf16(float lo, float hi) { f32x2_t v = {lo, hi}; bf16x2_t b = __builtin_convertvector(v, bf16x2_t); return __builtin_bit_cast(unsigned, b); }
__device__ __forceinline__ u32x4 pack8(const f32x4& a, const f32x4& b) { u32x4 w; w.x = cvt_pk_bf16(a[0], a[1]); w.y = cvt_pk_bf16(a[2], a[3]); w.z = cvt_pk_bf16(b[0], b[1]); w.w = cvt_pk_bf16(b[2], b[3]); return w; }

template <class Epi, class Sched>
__device__ __forceinline__ void gemm_phase(LAS unsigned char* lds, const Sched& S, const Epi& E) {
    const int tid = opaque_tid(), wid = __builtin_amdgcn_readfirstlane(tid >> 6), lane = tid & 63, wr = wid >> 2, wc = wid & 3, fr = lane & 15, fq = lane >> 4;
    const size_t kstep = (size_t)(BK * 2);
    const unsigned ldsw = (unsigned)wid * 1024u;
    const int aoff = lds_byte(wr * 64 + fr, fq * 8), boff = lds_byte(wc * 32 + fr, fq * 8);
#define PG8_SA(b, h) (((b) * 2 + (h)) * HTB)
#define PG8_SB(b, h) ((4 + (b) * 2 + (h)) * HTB)
#define PG8_STAGE(bufoff, gbase, voff) do { _Pragma("unroll") for (int _i = 0; _i < 2; ++_i) \
        __builtin_amdgcn_global_load_lds((const unsigned*)((const char*)(gbase) + (voff)[_i]), (LAS unsigned*)(lds + (bufoff) + ldsw + _i * 8192), 16, 0, 0); } while (0)
#define PG8_LDA(dst, b, h) do { _Pragma("unroll") for (int m = 0; m < 4; ++m) _Pragma("unroll") for (int k = 0; k < 2; ++k) dst[m][k] = *(const LAS bf16x8*)(lds + PG8_SA(b, h) + aoff + m * 2048 + k * 1024); } while (0)
#define PG8_LDB(dst, b, h) do { _Pragma("unroll") for (int n = 0; n < 2; ++n) _Pragma("unroll") for (int k = 0; k < 2; ++k) dst[n][k] = *(const LAS bf16x8*)(lds + PG8_SB(b, h) + boff + n * 2048 + k * 1024); } while (0)
#define PG8_MMA(ai, bj, At, Bt) do { __builtin_amdgcn_s_setprio(1); _Pragma("unroll") for (int m = 0; m < 4; ++m) _Pragma("unroll") for (int n = 0; n < 2; ++n) _Pragma("unroll") for (int k = 0; k < 2; ++k) \
        acc[ai][bj][m][n] = __builtin_amdgcn_mfma_f32_16x16x32_bf16(Bt[n][k], At[m][k], acc[ai][bj][m][n], 0, 0, 0); __builtin_amdgcn_s_setprio(0); } while (0)
#define PG8_WAIT_V(n) asm volatile("s_waitcnt vmcnt(" #n ")" ::: "memory")
#define PG8_WAIT_L(n) asm volatile("s_waitcnt lgkmcnt(" #n ")" ::: "memory")
#define PG8_BAR __builtin_amdgcn_s_barrier()
#define PG8_SCHED __builtin_amdgcn_sched_barrier(0)
    GUnit cur, nxt; int ui = 0;
    if (!S.next(0, cur)) return;
    f32x4 acc[2][2][4][2];
#pragma unroll
    for (int a = 0; a < 2; ++a)
#pragma unroll
        for (int b = 0; b < 2; ++b)
#pragma unroll
            for (int m = 0; m < 4; ++m)
#pragma unroll
                for (int n = 0; n < 2; ++n) acc[a][b][m][n] = (f32x4){0.f, 0.f, 0.f, 0.f};
    bf16x8 At[4][2], B0[2][2], B1[2][2];
#define PG8_VOFF(vA_, vB_, lda2_, ldb2_) do { int tt_ = tid; asm volatile("" : "+v"(tt_)); _Pragma("unroll") for (int i_ = 0; i_ < 2; ++i_) { int R_, C_; stage_rc(tt_ * 16 + i_ * 8192, R_, C_); \
        vA_[i_] = (unsigned)(R_ * (lda2_) + C_ * 2); vB_[i_] = (unsigned)(((R_ & ~31) + perm32(R_ & 31)) * (ldb2_) + C_ * 2); } } while (0)
    const char* cA = cur.A; const char* cB = cur.B; size_t hA = (size_t)HALF * cur.lda2, hB = (size_t)HALF * cur.ldb2;
    unsigned vA[2], vB[2]; PG8_VOFF(vA, vB, cur.lda2, cur.ldb2);
    {
    PG8_STAGE(PG8_SB(0, 0), cB, vB); PG8_STAGE(PG8_SB(0, 1), cB + hB, vB); PG8_STAGE(PG8_SA(0, 0), cA, vA); PG8_STAGE(PG8_SA(0, 1), cA + hA, vA);
    if (wr == 1) PG8_BAR;
    PG8_WAIT_V(2); PG8_BAR;
    PG8_STAGE(PG8_SB(1, 0), cB + kstep, vB); PG8_STAGE(PG8_SA(1, 0), cA + kstep, vA); PG8_STAGE(PG8_SB(1, 1), cB + hB + kstep, vB);
    PG8_WAIT_V(6); PG8_BAR; }
    for (;;) {
        const bool has_next = S.next(ui + 1, nxt);
        if (!has_next) nxt = cur;
        const size_t nhA = (size_t)HALF * nxt.lda2, nhB = (size_t)HALF * nxt.ldb2;
        const int nt = cur.nt;
        unsigned wA[2], wB[2];
        for (int t = 0; t < nt; t += 2) {
            const bool last = (t == nt - 2);
            const char* a1 = cA + (size_t)(t + 1) * kstep;
            const char* a2 = last ? nxt.A : cA + (size_t)(t + 2) * kstep; const char* b2 = last ? nxt.B : cB + (size_t)(t + 2) * kstep;
            const char* a3 = a2 + kstep; const char* b3 = b2 + kstep;
            const size_t whA = last ? nhA : hA, whB = last ? nhB : hB;
            PG8_LDB(B0, 0, 0); PG8_LDB(B1, 0, 1); PG8_SCHED; PG8_LDA(At, 0, 0);
            PG8_STAGE(PG8_SA(1, 1), a1 + hA, vA);
            if (last) PG8_VOFF(wA, wB, nxt.lda2, nxt.ldb2); else { wA[0] = vA[0]; wA[1] = vA[1]; wB[0] = vB[0]; wB[1] = vB[1]; }
            PG8_WAIT_V(8); PG8_WAIT_L(0); PG8_BAR; PG8_MMA(0, 0, At, B0); PG8_MMA(0, 1, At, B1); PG8_BAR; PG8_SCHED;
            PG8_LDA(At, 0, 1); PG8_STAGE(PG8_SB(0, 0), b2, wB); PG8_STAGE(PG8_SB(0, 1), b2 + whB, wB); PG8_STAGE(PG8_SA(0, 0), a2, wA);
            PG8_WAIT_V(8); PG8_WAIT_L(0); PG8_BAR; PG8_MMA(1, 0, At, B0); PG8_MMA(1, 1, At, B1); PG8_BAR; PG8_SCHED;
            PG8_LDB(B0, 1, 0); PG8_LDB(B1, 1, 1); PG8_SCHED; PG8_LDA(At, 1, 0); PG8_STAGE(PG8_SA(0, 1), a2 + whA, wA);
            PG8_WAIT_V(8); PG8_WAIT_L(0); PG8_BAR; PG8_MMA(0, 0, At, B0); PG8_MMA(0, 1, At, B1); PG8_BAR; PG8_SCHED;
            PG8_LDA(At, 1, 1); PG8_STAGE(PG8_SB(1, 0), b3, wB); PG8_STAGE(PG8_SB(1, 1), b3 + whB, wB); PG8_STAGE(PG8_SA(1, 0), a3, wA);
            PG8_WAIT_V(8); PG8_WAIT_L(0); PG8_BAR; PG8_MMA(1, 0, At, B0); PG8_MMA(1, 1, At, B1); PG8_BAR; PG8_SCHED;
        }
        if (wr == 0) PG8_BAR;
        { int fr_ = fr, fq_ = fq; asm volatile("" : "+v"(fr_), "+v"(fq_));
          E(acc, cur, wr, wc, fr_, fq_); }
        if (!has_next) break;
#pragma unroll
        for (int a = 0; a < 2; ++a)
#pragma unroll
            for (int b = 0; b < 2; ++b)
#pragma unroll
                for (int m = 0; m < 4; ++m)
#pragma unroll
                    for (int n = 0; n < 2; ++n) acc[a][b][m][n] = (f32x4){0.f, 0.f, 0.f, 0.f};
        cur = nxt; cA = cur.A; cB = cur.B; hA = nhA; hB = nhB;
        vA[0] = wA[0]; vA[1] = wA[1]; vB[0] = wB[0]; vB[1] = wB[1];
        ++ui;
        if (wr == 1) PG8_BAR;
    }
    PG8_WAIT_V(0);
    PG8_BAR;
#undef PG8_VOFF
#undef PG8_SA
#undef PG8_SB
#undef PG8_STAGE
#undef PG8_LDA
#undef PG8_LDB
#undef PG8_MMA
#undef PG8_WAIT_V
#undef PG8_WAIT_L
#undef PG8_BAR
#undef PG8_SCHED
}
}
using pg8::f32x4; using pg8::u32x4; using pg8::GUnit;

constexpr size_t WS_WB = 2 * MiB, WB_LAYER = 37 * MiB;
constexpr size_t WB_W1 = 0, WB_WG = 9 * MiB, WB_WBR = 15 * MiB, WB_WO = 18 * MiB, WB_WF1 = 20 * MiB, WB_WF2 = 31 * MiB;
constexpr size_t WS_GSCR = 190 * MiB;
static_assert(WS_WB + 2 * WB_LAYER <= WS_XB, "weights vs XB");

__device__ __forceinline__ int p1_src_col(int tile, int p) {
    if (tile < 4) return (tile >> 1) * 512 + (tile & 1) * 256 + 64 * ((p >> 5) & 3) + 32 * (p >> 7);
    if (tile < 6) return 1024 + (tile - 4) * 256 + p;
    if (tile < 10) return (p < 128) ? 1536 + 128 * (tile - 6) + p : 2048 + 128 * (tile - 6) + (p - 128);
    return 2560 + (tile - 10) * 256 + p;
}
__device__ __forceinline__ void p0_titem(const float* W, int ldw, int src0, const float* g, bf16_t* WT, int K, int prow0, int k0, LAS float* scr, int lane) {
    const int kr = lane >> 3, cq = (lane & 7) * 4;
    f32x4 v[8];
#pragma unroll
    for (int i = 0; i < 8; ++i) v[i] = *(const f32x4*)(W + (size_t)(k0 + 8 * i + kr) * ldw + src0 + cq);
    if (g) {
#pragma unroll
        for (int i = 0; i < 8; ++i) v[i] = v[i] * g[k0 + 8 * i + kr];
    }
#pragma unroll
    for (int i = 0; i < 8; ++i) { LAS float* d = scr + (8 * i + kr) * 33 + cq; d[0] = v[i][0]; d[1] = v[i][1]; d[2] = v[i][2]; d[3] = v[i][3]; }
    asm volatile("s_waitcnt lgkmcnt(0)" ::: "memory");
    const int c = lane & 7;
#pragma unroll
    for (int j = 0; j < 4; ++j) { const int n = (lane >> 3) + 8 * j; const LAS float* s_ = scr + (8 * c) * 33 + n;
        u32x4 o; o.x = pg8::cvt_pk_bf16(s_[0 * 33], s_[1 * 33]); o.y = pg8::cvt_pk_bf16(s_[2 * 33], s_[3 * 33]); o.z = pg8::cvt_pk_bf16(s_[4 * 33], s_[5 * 33]); o.w = pg8::cvt_pk_bf16(s_[6 * 33], s_[7 * 33]);
        *(u32x4*)(WT + (size_t)(prow0 + n) * K + k0 + 8 * c) = o; }
    asm volatile("s_waitcnt lgkmcnt(0)" ::: "memory");
}
constexpr int NI_W1 = 144 * 16, NI_WG = 96 * 16, NI_WBR = 3 * 32 * 8, NI_WO = 32 * 16, NI_F1 = 176 * 16, NI_F2 = 32 * 44;
constexpr int PER_LAYER = NI_W1 + NI_WG + NI_WBR + NI_WO + NI_F1 + NI_F2;
__device__ __forceinline__ void fast_p0_weights(const Args& A, int wg, int nwg, LAS float* sm, int item_lo, int item_hi) {
    const int tid = opaque_tid(), lane = tid & 63, wave = tid >> 6;
    LAS float* scr = sm + wave * (64 * 33);
    for (int it = item_lo + wg * NWAVES + wave; it < item_hi; it += nwg * NWAVES) {
        const int l = it / PER_LAYER; int r = it % PER_LAYER;
        unsigned char* wb = A.ws + WS_WB + (size_t)l * WB_LAYER;
        const float* Win = A.in[I_WIN] + (size_t)l * DM * DIN; const float* g1 = A.in[I_N1G] + l * DM;
        if (r < NI_W1) { const int rb = r / 16, kb = r % 16; p0_titem(Win, DIN, p1_src_col(rb >> 3, (rb & 7) * 32), g1, (bf16_t*)(wb + WB_W1), DM, 32 * rb, 64 * kb, scr, lane); continue; } r -= NI_W1;
        if (r < NI_WG) { const int rb = r / 16, kb = r % 16; p0_titem(Win, DIN, NU + 32 * rb, g1, (bf16_t*)(wb + WB_WG), DM, 32 * rb, 64 * kb, scr, lane); continue; } r -= NI_WG;
        if (r < NI_WBR) { const int n = r / 256, rr = r % 256, rb = rr / 8, kb = rr % 8;
            p0_titem(A.in[I_WBR] + ((size_t)l * 3 + n) * BW * DM, DM, 32 * rb, nullptr, (bf16_t*)(wb + WB_WBR) + (size_t)n * DM * BW, BW, 32 * rb, 64 * kb, scr, lane); continue; } r -= NI_WBR;
        if (r < NI_WO) { const int rb = r / 16, kb = r % 16; p0_titem(A.in[I_WOUT] + (size_t)l * DM * DM, DM, 32 * rb, nullptr, (bf16_t*)(wb + WB_WO), DM, 32 * rb, 64 * kb, scr, lane); continue; } r -= NI_WO;
        if (r < NI_F1) { const int rb = r / 16, kb = r % 16, tile = rb >> 3, p = (rb & 7) * 32; const int src = (p < 128) ? 128 * tile + p : DFF + 128 * tile + (p - 128);
            p0_titem(A.in[I_WF1] + (size_t)l * DM * 2 * DFF, 2 * DFF, src, A.in[I_N2G] + l * DM, (bf16_t*)(wb + WB_WF1), DM, 32 * rb, 64 * kb, scr, lane); continue; } r -= NI_F1;
        { const int rb = r / 44, kb = r % 44; p0_titem(A.in[I_WF2] + (size_t)l * DFF * DM, DM, 32 * rb, nullptr, (bf16_t*)(wb + WB_WF2), DFF, 32 * rb, 64 * kb, scr, lane); }
    }
}

struct SchedPlain {
    pg8::TileOrder o; const char* A; const char* B; int lda2, ldb2, nt;
    __device__ __forceinline__ bool next(int i, GUnit& u) const {
        int pm, pn; if (!o.tile(i, pm, pn)) return false;
        u.A = A + (size_t)pm * 256 * lda2; u.B = B + (size_t)pn * 256 * ldb2; u.lda2 = lda2; u.ldb2 = ldb2; u.nt = nt; u.pm = pm; u.pn = pn; u.kind = 0; return true;
    }
};
struct SchedP3 {
    pg8::TileOrder o; const char* ws; const char* wb;
    __device__ __forceinline__ bool next(int i, GUnit& u) const {
        int pm, pn; if (!o.tile(i / 6, pm, pn)) return false;
        const int sub = i % 6, n = sub >> 1; const bool proj = (sub & 1) != 0;
        u.pm = pm; u.pn = pn; u.kind = sub;
        const size_t aoff = !proj ? WS_XB : (n == 0 ? WS_YA : (n == 1 ? WS_YB : WS_YC));
        const int ld2 = proj ? BW * 2 : DM * 2;
        u.A = ws + aoff + (size_t)pm * 256 * ld2; u.lda2 = ld2;
        u.B = wb + (proj ? WB_WBR : WB_WG) + (size_t)(n * DM + pn * 256) * ld2; u.ldb2 = ld2; u.nt = ld2 >> 7;
        return true;
    }
};

__device__ __forceinline__ float fast_sigmoid(float x) { return __builtin_amdgcn_rcpf(1.0f + __builtin_amdgcn_exp2f(-LOG2E * x)); }
__device__ __forceinline__ f32x4 sig4(const f32x4& v) { return (f32x4){fast_sigmoid(v[0]), fast_sigmoid(v[1]), fast_sigmoid(v[2]), fast_sigmoid(v[3])}; }
__device__ __forceinline__ float sigx(float z) { return __builtin_amdgcn_rcpf(1.0f + __builtin_amdgcn_exp2f(z)); }
__device__ __forceinline__ f32x4 sigx4(const f32x4& v) { return (f32x4){sigx(v[0]), sigx(v[1]), sigx(v[2]), sigx(v[3])}; }
__device__ __forceinline__ float dot4(const f32x4& a) { return (a[0] * a[0] + a[1] * a[1]) + (a[2] * a[2] + a[3] * a[3]); }

struct EpiP1 {
    unsigned char* ws; const float* rowss; const float* qg; const float* kg;
    __device__ __forceinline__ void operator()(const f32x4 (&acc)[2][2][4][2], const GUnit& u, int wr, int wc, int fr, int fq) const {
        const int pn = u.pn;
        if (pn < 4) {
            const bool isq = pn < 2; const float* gg = isq ? qg : kg; const float sc = isq ? QSCALE : 1.0f;
            const f32x4 ga0 = *(const f32x4*)(gg + 8 * fq), ga1 = *(const f32x4*)(gg + 8 * fq + 4), gb0 = *(const f32x4*)(gg + 32 + 8 * fq), gb1 = *(const f32x4*)(gg + 32 + 8 * fq + 4);
            bf16_t* base = (bf16_t*)(ws + (isq ? WS_AQ : WS_AK)) + (pn & 1) * 256 + 64 * wc + 8 * fq;
#pragma unroll
            for (int ai = 0; ai < 2; ++ai)
#pragma unroll
                for (int m = 0; m < 4; ++m) {
                    const int row = u.pm * 256 + ai * 128 + wr * 64 + m * 16 + fr;
                    const float rstd = rsqrtf(rowss[row] * (1.0f / DM) + RMS_EPS);
                    const f32x4 a0 = acc[ai][0][m][0] * rstd, a1 = acc[ai][0][m][1] * rstd, b0 = acc[ai][1][m][0] * rstd, b1 = acc[ai][1][m][1] * rstd;
                    float ss = (dot4(a0) + dot4(a1)) + (dot4(b0) + dot4(b1));
                    ss += __shfl_xor(ss, 16); ss += __shfl_xor(ss, 32);
                    const float rn = rsqrtf(ss * (1.0f / 64.0f) + RMS_EPS) * sc;
                    bf16_t* o = base + (size_t)row * BW;
                    *(u32x4*)o = pg8::pack8(a0 * ga0 * rn, a1 * ga1 * rn);
                    *(u32x4*)(o + 32) = pg8::pack8(b0 * gb0 * rn, b1 * gb1 * rn);
                }
        } else if (pn >= 6 && pn < 10) {
            bf16_t* base = (bf16_t*)(ws + WS_Z) + 128 * (pn - 6) + 32 * wc + 8 * fq;
#pragma unroll
            for (int ai = 0; ai < 2; ++ai)
#pragma unroll
                for (int m = 0; m < 4; ++m) {
                    const int row = u.pm * 256 + ai * 128 + wr * 64 + m * 16 + fr;
                    const float rstd = rsqrtf(rowss[row] * (1.0f / DM) + RMS_EPS), nr = -LOG2E * rstd;
                    const f32x4 z0 = acc[ai][0][m][0] * rstd * sigx4(acc[ai][1][m][0] * nr), z1 = acc[ai][0][m][1] * rstd * sigx4(acc[ai][1][m][1] * nr);
                    *(u32x4*)(base + (size_t)row * BW) = pg8::pack8(z0, z1);
                }
        } else {
            size_t wsoff; int kind;
            if (pn < 6) { wsoff = WS_AV; kind = 0; } else if (pn < 12) { wsoff = WS_RQ; kind = 1; } else if (pn < 14) { wsoff = WS_RK; kind = 2; } else if (pn < 16) { wsoff = WS_RV; kind = 0; } else { wsoff = WS_RG; kind = 3; }
            bf16_t* base = (bf16_t*)(ws + wsoff) + (pn & 1) * 256 + 32 * wc + 8 * fq;
            const float l2g0 = log2_gamma((pn & 1) * 2), l2g1 = log2_gamma((pn & 1) * 2 + 1);
#pragma unroll
            for (int ai = 0; ai < 2; ++ai)
#pragma unroll
                for (int m = 0; m < 4; ++m) {
                    const int row = u.pm * 256 + ai * 128 + wr * 64 + m * 16 + fr;
                    const float rstd = rsqrtf(rowss[row] * (1.0f / DM) + RMS_EPS);
                    const float tp = (float)(row & 127);
                    float f0 = rstd, f1 = rstd;
                    if (kind == 1) { f0 *= exp2f(tp * l2g0); f1 *= exp2f(tp * l2g1); }
                    if (kind == 2) { f0 *= 0.08838834764831845f * exp2f(-tp * l2g0); f1 *= 0.08838834764831845f * exp2f(-tp * l2g1); }
                    f32x4 a0 = acc[ai][0][m][0] * f0, a1 = acc[ai][0][m][1] * f0, b0 = acc[ai][1][m][0] * f1, b1 = acc[ai][1][m][1] * f1;
                    if (kind == 3) { a0 = a0 * sigx4(a0 * -LOG2E); a1 = a1 * sigx4(a1 * -LOG2E); b0 = b0 * sigx4(b0 * -LOG2E); b1 = b1 * sigx4(b1 * -LOG2E); }
                    bf16_t* o = base + (size_t)row * BW;
                    *(u32x4*)o = pg8::pack8(a0, a1);
                    *(u32x4*)(o + 128) = pg8::pack8(b0, b1);
                }
        }
    }
};
struct EpiP3 {
    const float* rowss; const float* bg; unsigned char* gscr; bf16_t* Y;
    __device__ __forceinline__ void operator()(const f32x4 (&acc)[2][2][4][2], const GUnit& u, int wr, int wc, int fr, int fq) const {
        const int n = u.kind >> 1;
        u32x4* gs = (u32x4*)gscr + ((wr * 4 + wc) * 64 + fq * 16 + fr);
        if (!(u.kind & 1)) {
            const float* bp = bg + n * DM + u.pn * 256 + 32 * wc + 8 * fq;
            const f32x4 ba0 = *(const f32x4*)bp * -LOG2E, ba1 = *(const f32x4*)(bp + 4) * -LOG2E, bb0 = *(const f32x4*)(bp + 128) * -LOG2E, bb1 = *(const f32x4*)(bp + 132) * -LOG2E;
#pragma unroll
            for (int ai = 0; ai < 2; ++ai)
#pragma unroll
                for (int m = 0; m < 4; ++m) {
                    const int row = u.pm * 256 + ai * 128 + wr * 64 + m * 16 + fr;
                    const float nr = -LOG2E * rsqrtf(rowss[row] * (1.0f / DM) + RMS_EPS);
                    gs[((ai * 4 + m) * 2 + 0) * NTHREADS] = pg8::pack8(sigx4(acc[ai][0][m][0] * nr + ba0), sigx4(acc[ai][0][m][1] * nr + ba1));
                    gs[((ai * 4 + m) * 2 + 1) * NTHREADS] = pg8::pack8(sigx4(acc[ai][1][m][0] * nr + bb0), sigx4(acc[ai][1][m][1] * nr + bb1));
                }
        } else {
#pragma unroll
            for (int ai = 0; ai < 2; ++ai) {
                u32x4 gq[4][2], pq[4][2];
#pragma unroll
                for (int m = 0; m < 4; ++m)
#pragma unroll
                    for (int bj = 0; bj < 2; ++bj) {
                        gq[m][bj] = gs[((ai * 4 + m) * 2 + bj) * NTHREADS];
                        if (n > 0) pq[m][bj] = *(const u32x4*)(Y + (size_t)(u.pm * 256 + ai * 128 + wr * 64 + m * 16 + fr) * DM + u.pn * 256 + 128 * bj + 32 * wc + 8 * fq);
                    }
#pragma unroll
                for (int m = 0; m < 4; ++m) {
                    const int row = u.pm * 256 + ai * 128 + wr * 64 + m * 16 + fr;
#pragma unroll
                    for (int bj = 0; bj < 2; ++bj) {
                        const u32x4 g = gq[m][bj];
                        bf16_t* yp = Y + (size_t)row * DM + u.pn * 256 + 128 * bj + 32 * wc + 8 * fq;
                        f32x4 y0 = acc[ai][bj][m][0], y1 = acc[ai][bj][m][1];
                        y0[0] *= __uint_as_float(g.x << 16); y0[1] *= __uint_as_float(g.x & 0xffff0000u); y0[2] *= __uint_as_float(g.y << 16); y0[3] *= __uint_as_float(g.y & 0xffff0000u);
                        y1[0] *= __uint_as_float(g.z << 16); y1[1] *= __uint_as_float(g.z & 0xffff0000u); y1[2] *= __uint_as_float(g.w << 16); y1[3] *= __uint_as_float(g.w & 0xffff0000u);
                        if (n > 0) { const u32x4 p = pq[m][bj];
                            y0[0] += __uint_as_float(p.x << 16); y0[1] += __uint_as_float(p.x & 0xffff0000u); y0[2] += __uint_as_float(p.y << 16); y0[3] += __uint_as_float(p.y & 0xffff0000u);
                            y1[0] += __uint_as_float(p.z << 16); y1[1] += __uint_as_float(p.z & 0xffff0000u); y1[2] += __uint_as_float(p.w << 16); y1[3] += __uint_as_float(p.w & 0xffff0000u); }
                        *(u32x4*)yp = pg8::pack8(y0, y1);
                    }
                }
                asm volatile("" ::: "memory");
            }
        }
    }
};
struct EpiResid {
    bf16_t* XB; float* out; float* rowss_next;
    __device__ __forceinline__ void operator()(const f32x4 (&acc)[2][2][4][2], const GUnit& u, int wr, int wc, int fr, int fq) const {
#pragma unroll
        for (int ai = 0; ai < 2; ++ai) {
            u32x4 xo[4][2];
#pragma unroll
            for (int m = 0; m < 4; ++m)
#pragma unroll
                for (int bj = 0; bj < 2; ++bj)
                    xo[m][bj] = *(const u32x4*)(XB + (size_t)(u.pm * 256 + ai * 128 + wr * 64 + m * 16 + fr) * DM + u.pn * 256 + 128 * bj + 32 * wc + 8 * fq);
#pragma unroll
            for (int m = 0; m < 4; ++m) {
                const int row = u.pm * 256 + ai * 128 + wr * 64 + m * 16 + fr;
                float ss = 0.f;
#pragma unroll
                for (int bj = 0; bj < 2; ++bj) {
                    const size_t off = (size_t)row * DM + u.pn * 256 + 128 * bj + 32 * wc + 8 * fq;
                    const u32x4 p = xo[m][bj];
                    f32x4 x0 = acc[ai][bj][m][0], x1 = acc[ai][bj][m][1];
                    x0[0] += __uint_as_float(p.x << 16); x0[1] += __uint_as_float(p.x & 0xffff0000u); x0[2] += __uint_as_float(p.y << 16); x0[3] += __uint_as_float(p.y & 0xffff0000u);
                    x1[0] += __uint_as_float(p.z << 16); x1[1] += __uint_as_float(p.z & 0xffff0000u); x1[2] += __uint_as_float(p.w << 16); x1[3] += __uint_as_float(p.w & 0xffff0000u);
                    if (out) { *(f32x4*)(out + off) = x0; *(f32x4*)(out + off + 4) = x1; }
                    else { *(u32x4*)(XB + off) = pg8::pack8(x0, x1); ss += dot4(x0) + dot4(x1); }
                }
                if (!out) { ss += __shfl_xor(ss, 16); ss += __shfl_xor(ss, 32); if (fq == 0) atomicAdd(rowss_next + row, ss); }
            }
            asm volatile("" ::: "memory");
        }
    }
};
struct EpiSwiglu {
    const float* rowss; bf16_t* MID;
    __device__ __forceinline__ void operator()(const f32x4 (&acc)[2][2][4][2], const GUnit& u, int wr, int wc, int fr, int fq) const {
        bf16_t* base = MID + 128 * u.pn + 32 * wc + 8 * fq;
#pragma unroll
        for (int ai = 0; ai < 2; ++ai)
#pragma unroll
            for (int m = 0; m < 4; ++m) {
                const int row = u.pm * 256 + ai * 128 + wr * 64 + m * 16 + fr;
                const float rstd = rsqrtf(rowss[row] * (1.0f / DM) + RMS_EPS); const float nr = -LOG2E * rstd, r2 = rstd * rstd;
                const f32x4 a0 = acc[ai][0][m][0], a1 = acc[ai][0][m][1];
                *(u32x4*)(base + (size_t)row * DFF) = pg8::pack8(a0 * acc[ai][1][m][0] * r2 * sigx4(a0 * nr), a1 * acc[ai][1][m][1] * r2 * sigx4(a1 * nr));
            }
    }
};

__device__ __forceinline__ void fast_gemm(const Args& A, int l, int k, LAS unsigned char* lds) {
    const int G = gridDim.x, c = blockIdx.x;
    const char* wb = (const char*)(A.ws + WS_WB + (size_t)l * WB_LAYER);
    const char* XB = (const char*)(A.ws + WS_XB);
    float* rowss = (float*)(A.ws + WS_ROWSS);
    if (k == 0) {
        SchedPlain S; S.o.init(M / 256, NU / 256, G, c); S.A = XB; S.lda2 = DM * 2; S.B = wb + WB_W1; S.ldb2 = DM * 2; S.nt = DM / 64;
        EpiP1 E{A.ws, rowss + (size_t)(l == 0 ? 0 : 2) * M, A.in[I_QG] + l * 64, A.in[I_KG] + l * 64};
        pg8::gemm_phase(lds, S, E);
        if (l == 0) { const int full = S.o.nwg / G, rem = S.o.nwg - full * G;
            if (rem > 0 && c >= rem) fast_p0_weights(A, c - rem, G - rem, (LAS float*)lds, NI_W1, PER_LAYER);
            else if (rem == 0) fast_p0_weights(A, c, G, (LAS float*)lds, NI_W1, PER_LAYER); }
    } else if (k == 2) {
        SchedP3 S; S.o.init(M / 256, DM / 256, G, c); S.ws = (const char*)A.ws; S.wb = wb;
        EpiP3 E{rowss + (size_t)(l == 0 ? 0 : 2) * M, A.in[I_BGATE] + l * NGATE, A.ws + WS_GSCR + (size_t)blockIdx.x * (128 * 1024), (bf16_t*)(A.ws + WS_Y)};
        pg8::gemm_phase(lds, S, E);
    } else if (k == 3) {
        SchedPlain S; S.o.init(M / 256, DM / 256, G, c); S.A = (const char*)(A.ws + WS_Y); S.lda2 = DM * 2; S.B = wb + WB_WO; S.ldb2 = DM * 2; S.nt = DM / 64;
        EpiResid E{(bf16_t*)(A.ws + WS_XB), nullptr, rowss + (size_t)(l == 0 ? 1 : 3) * M};
        pg8::gemm_phase(lds, S, E);
    } else if (k == 4) {
        SchedPlain S; S.o.init(M / 256, 2 * DFF / 256, G, c); S.A = XB; S.lda2 = DM * 2; S.B = wb + WB_WF1; S.ldb2 = DM * 2; S.nt = DM / 64;
        EpiSwiglu E{rowss + (size_t)(l == 0 ? 1 : 3) * M, (bf16_t*)(A.ws + WS_MID)};
        pg8::gemm_phase(lds, S, E);
        if (l == 0) { const int full = S.o.nwg / G, rem = S.o.nwg - full * G;
            if (rem > 0 && c >= rem) fast_p0_weights(A, c - rem, G - rem, (LAS float*)lds, PER_LAYER, DEPTH * PER_LAYER);
            else if (rem == 0) fast_p0_weights(A, c, G, (LAS float*)lds, PER_LAYER, DEPTH * PER_LAYER); }
    } else {
        SchedPlain S; S.o.init(M / 256, DM / 256, G, c); S.A = (const char*)(A.ws + WS_MID); S.lda2 = DFF * 2; S.B = wb + WB_WF2; S.ldb2 = DFF * 2; S.nt = DFF / 64;
        EpiResid E{(bf16_t*)(A.ws + WS_XB), l + 1 < DEPTH ? nullptr : A.out, rowss + (size_t)2 * M};
        pg8::gemm_phase(lds, S, E);
    }
}


namespace mx {
typedef short bf16x8 __attribute__((ext_vector_type(8)));
typedef short s16x4 __attribute__((ext_vector_type(4)));
typedef short v4i16_t __attribute__((ext_vector_type(4)));
typedef float f32x16 __attribute__((ext_vector_type(16)));
typedef LAS unsigned char* lptr;
typedef unsigned u32x2 __attribute__((ext_vector_type(2)));
__device__ __forceinline__ int crow(int r, int hi) { return (r & 3) + 8 * (r >> 2) + 4 * hi; }
__device__ __forceinline__ s16x4 vtr(lptr p) { return __builtin_bit_cast(s16x4, __builtin_amdgcn_ds_read_tr16_b64_v4i16((LAS v4i16_t*)p)); }
__device__ __forceinline__ bf16x8 cat8(s16x4 lo, s16x4 hi) { return (bf16x8){lo[0], lo[1], lo[2], lo[3], hi[0], hi[1], hi[2], hi[3]}; }
__device__ __forceinline__ bf16x8 ld8(lptr p) { return *(const LAS bf16x8*)p; }
__device__ __forceinline__ float swap_max(float v) { auto rr = __builtin_amdgcn_permlane32_swap(__float_as_uint(v), __float_as_uint(v), false, false); return fmaxf(__uint_as_float(rr[0]), __uint_as_float(rr[1])); }
__device__ __forceinline__ float swap_sum(float v) { auto rr = __builtin_amdgcn_permlane32_swap(__float_as_uint(v), __float_as_uint(v), false, false); return __uint_as_float(rr[0]) + __uint_as_float(rr[1]); }
__device__ __forceinline__ bf16x8 pack_p(const f32x16& p, int b) {
    pg8::u32x4 w; w.x = pg8::cvt_pk_bf16(p[b], p[b + 1]); w.y = pg8::cvt_pk_bf16(p[b + 2], p[b + 3]); w.z = pg8::cvt_pk_bf16(p[b + 4], p[b + 5]); w.w = pg8::cvt_pk_bf16(p[b + 6], p[b + 7]);
    return __builtin_bit_cast(bf16x8, w);
}
#define MFMA32(a, b, c) __builtin_amdgcn_mfma_f32_32x32x16_bf16((a), (b), (c), 0, 0, 0)
#define DPP_ADD(v, ctrl, rmask) ((v) + __builtin_bit_cast(float, __builtin_amdgcn_update_dpp(0, __builtin_bit_cast(int, (v)), (ctrl), (rmask), 0xf, false)))
__device__ __forceinline__ float half_sum32(float v) {
    v = DPP_ADD(v, 0xB1, 0xf);
    v = DPP_ADD(v, 0x4E, 0xf);
    v = DPP_ADD(v, 0x141, 0xf);
    v = DPP_ADD(v, 0x140, 0xf);
    v = DPP_ADD(v, 0x142, 0xa);
    return v;
}

#define LDS_BAR() asm volatile("s_waitcnt lgkmcnt(0)\n\ts_barrier" ::: "memory")

constexpr int A_KSLOT = 8192, A_KBUF = 16384, A_V0 = 32768, A_VBUF = 16384, A_STAGE = 98304, A_WS = 131072 + 4096;
template <int ABL>
__device__ __forceinline__ void attn_unit(const Args& A, int l, int b, int h, int qb, lptr lds) {
    const int tid = opaque_tid(), lane = tid & 63, r32 = lane & 31, hi = lane >> 5; const int wid = __builtin_amdgcn_readfirstlane(tid >> 6), mp = wid >> 2, qw = wid & 3;
    const bf16_t* AQ = (const bf16_t*)(A.ws + WS_AQ); const bf16_t* AK = (const bf16_t*)(A.ws + WS_AK); const bf16_t* AV = (const bf16_t*)(A.ws + WS_AV);
    const size_t rowbase = (size_t)b * SEQ;
    const int q0 = 128 * qb + 32 * qw;
    const int NT = 2 * (qb + 1);
    LAS float* wsf = (LAS float*)(lds + A_WS) + wid * 64;
    const bf16_t* ksrc[2]; const bf16_t* vsrc[2]; int kdst[2], vdst[2];
#pragma unroll
    for (int j = 0; j < 2; ++j) { const int P = 2 * wid + j;
        ksrc[j] = AK + (rowbase + 8 * (P & 7) + (lane >> 3)) * BW + h * 128 + (P >> 3) * 64 + (((lane & 7) ^ (lane >> 3)) * 8);
        vsrc[j] = AV + (rowbase + 8 * (P >> 1) + ((lane >> 2) & 7)) * BW + h * 128 + 32 * (2 * (P & 1) + (lane >> 5)) + 8 * (lane & 3);
        kdst[j] = (P >> 3) * A_KSLOT + (P & 7) * 1024; vdst[j] = (P >> 1) * 2048 + (P & 1) * 1024; }
#define ATT_DMA(t, kb_, vb_) do { _Pragma("unroll") for (int j = 0; j < 2; ++j) { \
        __builtin_amdgcn_global_load_lds((const unsigned*)(ksrc[j] + (size_t)64 * (t) * BW), (LAS unsigned*)((kb_) + kdst[j]), 16, 0, 0); \
        __builtin_amdgcn_global_load_lds((const unsigned*)(vsrc[j] + (size_t)64 * (t) * BW), (LAS unsigned*)((vb_) + vdst[j]), 16, 0, 0); } } while (0)
    bf16x8 qf[4];
#pragma unroll
    for (int d0 = 0; d0 < 4; ++d0) qf[d0] = *(const bf16x8*)(AQ + (rowbase + q0 + r32) * BW + h * 128 + mp * 64 + d0 * 16 + hi * 8);
    const float slope2 = exp2f(-2.0f * (float)(h + 1)) * LOG2E;
    float m = 0.f, lsum = 0.f; bool first = true;
    f32x16 o[4];
#pragma unroll
    for (int d0 = 0; d0 < 4; ++d0) o[d0] = f32x16{};
    bf16x8 pa0 = bf16x8{}, pa1 = bf16x8{}, pa2 = bf16x8{}, pa3 = bf16x8{};
    const int kroff = mp * A_KSLOT + r32 * 128;
    const int vroff = (4 * hi + ((lane & 15) >> 2)) * 64 + ((lane >> 4) & 1) * 32 + (lane & 3) * 8;
#define ATT_A(P0, P1, t, kb_) do { \
        const float sb_ = slope2 * (float)(64 * (t) + 4 * hi - (q0 + r32)) - m; \
        _Pragma("unroll") for (int r = 0; r < 16; ++r) { P0[r] = fmaf(slope2, (float)((r & 3) + 8 * (r >> 2)), sb_); P1[r] = fmaf(slope2, (float)(32 + (r & 3) + 8 * (r >> 2)), sb_); } \
        _Pragma("unroll") for (int d0 = 0; d0 < 4; ++d0) { const int ch_ = ((2 * d0 + hi) ^ (r32 & 7)) * 16; \
            P0 = MFMA32(ld8((kb_) + kroff + ch_), qf[d0], P0); P1 = MFMA32(ld8((kb_) + kroff + 32 * 128 + ch_), qf[d0], P1); } } while (0)
#define ATT_MASK(P0, P1, t) do { const int krel_ = 64 * (t) + 4 * hi - (q0 + r32); \
        _Pragma("unroll") for (int r = 0; r < 16; ++r) { const int d_ = krel_ + (r & 3) + 8 * (r >> 2); if (d_ > 0) P0[r] = -INFINITY; if (d_ + 32 > 0) P1[r] = -INFINITY; } } while (0)
    __syncthreads();
    {
        *(LAS u32x4*)(lds + A_V0 + 3 * A_VBUF + tid * 32) = (u32x4){0u, 0u, 0u, 0u}; *(LAS u32x4*)(lds + A_V0 + 3 * A_VBUF + tid * 32 + 16) = (u32x4){0u, 0u, 0u, 0u}; }
    ATT_DMA(NT - 1, lds, lds + A_V0);
    ATT_DMA(NT - 2, lds + A_KBUF, lds + A_V0 + A_VBUF);
    __syncthreads();
    f32x16 s0, s1;
    ATT_A(s0, s1, NT - 1, lds); ATT_MASK(s0, s1, NT - 1);
    __syncthreads();
    bool resc = false;
#define ATT_RESC() do { if (resc) { _Pragma("unroll") for (int r = 0; r < 16; ++r) { const float a = wsf[crow(r, hi)]; _Pragma("unroll") for (int d0 = 0; d0 < 4; ++d0) o[d0][r] *= a; } resc = false; } } while (0)
#define ATT_TRIP(i, S0, S1, N0, N1, PR0, PR1, PR2, PR3, PW0, PW1, PW2, PW3) do { \
        const int t = NT - 1 - (i); \
        if ((i) == 1) ATT_MASK(S0, S1, t); \
        ATT_RESC(); \
        if (!(ABL & 8) && (i) + 2 < NT) ATT_DMA(t - 2, lds + ((i) & 1) * A_KBUF, lds + A_V0 + (((i) + 2) & 3) * A_VBUF); \
        float mx_; \
        { const int tn = (t > 0) ? t - 1 : 0; lptr kb = lds + (((i) + (t > 0 ? 1 : 0)) & 1) * A_KBUF; \
          __builtin_amdgcn_sched_barrier(0); \
          ATT_A(N0, N1, tn, kb); \
          mx_ = fmaxf(S0[0], S1[0]); \
          _Pragma("unroll") for (int r = 1; r < 16; ++r) mx_ = fmaxf(mx_, fmaxf(S0[r], S1[r])); \
          __builtin_amdgcn_sched_group_barrier(0x2, 34, 0); \
          _Pragma("unroll") for (int k = 0; k < 8; ++k) { __builtin_amdgcn_sched_group_barrier(0x100, 1, 0); __builtin_amdgcn_sched_group_barrier(0x8, 1, 0); __builtin_amdgcn_sched_group_barrier(0x2, 3, 0); } \
          __builtin_amdgcn_sched_barrier(0); } \
        mx_ = swap_max(mx_); \
        const bool live = mx_ > -INFINITY; \
        const float dl = first ? (live ? mx_ : 0.f) : fmaxf(mx_, 0.f); \
        if (__any(first || dl > 0.f)) { \
            m += dl; \
            _Pragma("unroll") for (int r = 0; r < 16; ++r) { S0[r] -= dl; S1[r] -= dl; N0[r] -= dl; N1[r] -= dl; } \
            if (!first) { const float alpha = __builtin_amdgcn_exp2f(-dl); lsum *= alpha; if (hi == 0) wsf[r32] = alpha; resc = true; } \
            if (live) first = false; } \
        { __builtin_amdgcn_sched_barrier(0); \
          lptr vb = lds + A_V0 + (((i) + 3) & 3) * A_VBUF + vroff; \
          bf16x8 vfa = ATT_VF(0), vfb = ATT_VF(1); \
          float ps = 0.f; \
          _Pragma("unroll") for (int k = 0; k < 16; ++k) { \
              bf16x8 vfn = vfb; \
              if (k + 2 < 16) vfn = ATT_VF(k + 2); \
              const bf16x8 cc = (k & 3) == 0 ? PR0 : (k & 3) == 1 ? PR1 : (k & 3) == 2 ? PR2 : PR3; \
              if (!(ABL & 4)) o[k >> 2] = MFMA32(cc, vfa, o[k >> 2]); else { asm volatile("" :: "v"(cc), "v"(vfa)); } \
              if (k < 8) { S0[2 * k] = ATT_EXP(S0[2 * k]); S0[2 * k + 1] = ATT_EXP(S0[2 * k + 1]); ps += S0[2 * k] + S0[2 * k + 1]; } \
              else { S1[2 * k - 16] = ATT_EXP(S1[2 * k - 16]); S1[2 * k - 15] = ATT_EXP(S1[2 * k - 15]); ps += S1[2 * k - 16] + S1[2 * k - 15]; } \
              if (k == 3) PW0 = pack_p(S0, 0); \
              if (k == 7) PW1 = pack_p(S0, 8); \
              if (k == 11) PW2 = pack_p(S1, 0); \
              if (k == 15) PW3 = pack_p(S1, 8); \
              vfa = vfb; vfb = vfn; \
              __builtin_amdgcn_sched_barrier(0); } \
          lsum += ps; } \
        if (!(ABL & 16)) __syncthreads(); } while (0)
#define ATT_EXP(x_) ((ABL & 2) ? (x_) * 0.001f : __builtin_amdgcn_exp2f(x_))
#define ATT_VF(k_) cat8(vtr(vb + ((k_) >> 2) * 512 + ((k_) & 3) * 4096), vtr(vb + ((k_) >> 2) * 512 + ((k_) & 3) * 4096 + 2048))
    f32x16 n0, n1;
    bf16x8 pb0 = bf16x8{}, pb1 = bf16x8{}, pb2 = bf16x8{}, pb3 = bf16x8{};
    for (int i = 0; i < NT; i += 2) {
        ATT_TRIP(i, s0, s1, n0, n1, pa0, pa1, pa2, pa3, pb0, pb1, pb2, pb3);
        ATT_TRIP(i + 1, n0, n1, s0, s1, pb0, pb1, pb2, pb3, pa0, pa1, pa2, pa3);
    }
    ATT_RESC();
#undef ATT_RESC
#undef ATT_TRIP
#undef ATT_VF
#undef ATT_EXP
    { lptr vb = lds + A_V0 + ((NT - 1) & 3) * A_VBUF + vroff;
#pragma unroll
      for (int d0 = 0; d0 < 4; ++d0) { lptr vp_ = vb + d0 * 512;
        const bf16x8 v0 = cat8(vtr(vp_), vtr(vp_ + 2048)), v1 = cat8(vtr(vp_ + 4096), vtr(vp_ + 4096 + 2048));
        const bf16x8 v2 = cat8(vtr(vp_ + 8192), vtr(vp_ + 8192 + 2048)), v3 = cat8(vtr(vp_ + 12288), vtr(vp_ + 12288 + 2048));
        o[d0] = MFMA32(pa0, v0, o[d0]); o[d0] = MFMA32(pa1, v1, o[d0]); o[d0] = MFMA32(pa2, v2, o[d0]); o[d0] = MFMA32(pa3, v3, o[d0]); } }
    __syncthreads();
#undef ATT_DMA
#undef ATT_A
#undef ATT_MASK
    lsum = swap_sum(lsum);
    if (hi == 0) wsf[32 + r32] = 1.0f / lsum;
    const float lam = ((const float*)(A.ws + WS_LAM))[l];
    LAS float* xch = (LAS float*)lds + qw * (4 * 16 * 64) + lane;
    if (mp == 1) {
#pragma unroll
        for (int r = 0; r < 16; ++r) { const float il = wsf[32 + crow(r, hi)] * lam;
#pragma unroll
            for (int d0 = 0; d0 < 4; ++d0) xch[(d0 * 16 + r) * 64] = o[d0][r] * il; }
    }
    __syncthreads();
    if (mp == 0) {
        float ss[16];
#pragma unroll
        for (int r = 0; r < 16; ++r) { const float il = wsf[32 + crow(r, hi)]; float s_ = 0.f;
#pragma unroll
            for (int d0 = 0; d0 < 4; ++d0) { const float y = o[d0][r] * il - xch[(d0 * 16 + r) * 64]; o[d0][r] = y; s_ += y * y; }
            ss[r] = s_; }
#pragma unroll
        for (int r = 0; r < 16; ++r) { float v = ss[r]; v += __shfl_xor(v, 1); v += __shfl_xor(v, 2); v += __shfl_xor(v, 4); v += __shfl_xor(v, 8); v += __shfl_xor(v, 16); ss[r] = v; }
        int l_ = l; asm volatile("" : "+s"(l_));
        const float osc = 1.0f - lam_init_of(l_);
        const float* asg = A.in[I_ASG] + l * 128;
        float gv[4];
#pragma unroll
        for (int d0 = 0; d0 < 4; ++d0) gv[d0] = asg[32 * d0 + r32] * osc;
        LAS bf16_t* stg = (LAS bf16_t*)(lds + A_STAGE) + qw * (32 * 128);
#pragma unroll
        for (int r = 0; r < 16; ++r) { const float rn = rsqrtf(ss[r] * (1.0f / 128.0f) + RMS_EPS); const int row = crow(r, hi);
#pragma unroll
            for (int d0 = 0; d0 < 4; ++d0) stg[row * 128 + 32 * d0 + r32] = (bf16_t)f2bf(o[d0][r] * rn * gv[d0]); }
        bf16_t* YA = ABL ? (bf16_t*)(A.ws + 254 * MiB) + (size_t)(blockIdx.x & 63) * 32 * BW : (bf16_t*)(A.ws + WS_YA) + (rowbase + q0) * BW + h * 128;
#pragma unroll
        for (int i = 0; i < 8; ++i) { const int idx = lane + 64 * i, row = idx >> 4, ch = idx & 15;
            *(u32x4*)(YA + (size_t)row * BW + ch * 8) = *(const LAS u32x4*)(stg + row * 128 + ch * 8); }
    }
}

__device__ __forceinline__ int offa(int row, int ch) { return 2048 * (row >> 3) + 512 * (ch >> 2) + 64 * (row & 7) + 16 * ((ch & 3) ^ ((row >> 2) & 3)); }
constexpr int R_K = 0, R_V = 32768, R_RT = 65536, R_ST = 98304, R_SS = 131072 + 1024;
constexpr size_t WS_RSTATE = 76 * MiB;
constexpr int CW_RFLAG = 12288;
struct RetLane { int r32, hi, tnb0, tnb1, tpb0, tpb1, rb0, rb1, w; };
__device__ __forceinline__ RetLane ret_lane(int lane) {
    int ln = lane; asm volatile("" : "+v"(ln));
    RetLane L; L.r32 = ln & 31; L.hi = ln >> 5; const int tq = (ln & 15) >> 2, tp = ln & 3, tg = (ln >> 4) & 1, z = 2 * tg + (tp >> 1); L.w = (L.r32 >> 2) & 3;
    L.tnb0 = 2048 * L.hi + 64 * tq + 8 * (tp & 1) + 16 * (z ^ (2 * L.hi));
    L.tnb1 = 2048 * L.hi + 64 * (tq + 4) + 8 * (tp & 1) + 16 * (z ^ (2 * L.hi + 1));
    L.tpb0 = 64 * (4 * L.hi + tq) + 8 * (tp & 1) + 16 * (z ^ L.hi);
    L.tpb1 = 2048 + 64 * (4 * L.hi + tq) + 8 * (tp & 1) + 16 * (z ^ (2 + L.hi));
    L.rb0 = 2048 * (L.r32 >> 3) + 64 * (L.r32 & 7) + 16 * (L.hi ^ L.w);
    L.rb1 = 2048 * (L.r32 >> 3) + 64 * (L.r32 & 7) + 16 * ((2 + L.hi) ^ L.w);
    return L;
}
__device__ __forceinline__ void ret_update(f32x16& R0, f32x16& R1, lptr lds, const RetLane& L, int qb, int vh, float g127, float g128) {
    f32x16 t0 = f32x16{}, t1 = f32x16{};
    lptr ka = lds + R_K + 512 * qb, va = lds + R_V + 512 * (2 * vh);
#pragma unroll
    for (int ks = 0; ks < 8; ++ks) {
        const bf16x8 kf = cat8(vtr(ka + L.tnb0 + 4096 * ks), vtr(ka + L.tnb1 + 4096 * ks));
        const bf16x8 v0 = cat8(vtr(va + L.tnb0 + 4096 * ks), vtr(va + L.tnb1 + 4096 * ks));
        const bf16x8 v1 = cat8(vtr(va + 512 + L.tnb0 + 4096 * ks), vtr(va + 512 + L.tnb1 + 4096 * ks));
        t0 = MFMA32(kf, v0, t0); t1 = MFMA32(kf, v1, t1);
    }
#pragma unroll
    for (int r = 0; r < 16; ++r) { R0[r] = g128 * R0[r] + g127 * t0[r]; R1[r] = g128 * R1[r] + g127 * t1[r]; }
}
#define RET_KV_LOAD(stK, stV, c_) do { const size_t r0_ = ((size_t)b * SEQ + 128 * (c_) + srow) * BW + h * 128 + sch * 8; \
    _Pragma("unroll") for (int j = 0; j < 4; ++j) { stK[j] = *(const u32x4*)(RK + r0_ + (size_t)32 * j * BW); stV[j] = *(const u32x4*)(RV + r0_ + (size_t)32 * j * BW); } } while (0)
#define RET_KV_WRITE(stK, stV) do { _Pragma("unroll") for (int j = 0; j < 4; ++j) { *(LAS u32x4*)(lds + R_K + sb + 8192 * j) = stK[j]; *(LAS u32x4*)(lds + R_V + sb + 8192 * j) = stV[j]; } } while (0)

__device__ __forceinline__ void ret_a_task(const Args& A, int l, int b, int h, int seg, lptr lds) {
    const int tid = opaque_tid(), lane = tid & 63; const int wid = __builtin_amdgcn_readfirstlane(tid >> 6), qb = wid & 3, vh = wid >> 2;
    const bf16_t* RK = (const bf16_t*)(A.ws + WS_RK); const bf16_t* RV = (const bf16_t*)(A.ws + WS_RV);
    const float l2g = log2_gamma(h); const float g127 = exp2f(127.0f * l2g), g128 = exp2f(128.0f * l2g);
    const int srow = tid >> 4, sch = tid & 15;
    const int sb = 2048 * (srow >> 3) + 512 * (sch >> 2) + 64 * (srow & 7) + 16 * ((sch & 3) ^ ((srow >> 2) & 3));
    f32x16 R0 = f32x16{}, R1 = f32x16{};
    u32x4 stK[4], stV[4];
    RET_KV_LOAD(stK, stV, 8 * seg);
    for (int cc = 0; cc < 8; ++cc) {
        const RetLane L = ret_lane(lane);
        LDS_BAR();
        RET_KV_WRITE(stK, stV);
        if (cc < 7) RET_KV_LOAD(stK, stV, 8 * seg + cc + 1);
        LDS_BAR();
        ret_update(R0, R1, lds, L, qb, vh, g127, g128);
    }
    unsigned long long* dst = (unsigned long long*)(A.ws + WS_RSTATE) + ((size_t)((b * 4 + h) * 3 + seg) * 8 + wid) * 512 + lane;
#pragma unroll
    for (int g = 0; g < 4; ++g) {
        __hip_atomic_store(dst + (2 * g) * 64, (unsigned long long)pg8::cvt_pk_bf16(R0[4 * g], R0[4 * g + 1]) | ((unsigned long long)pg8::cvt_pk_bf16(R0[4 * g + 2], R0[4 * g + 3]) << 32), RLX_AGENT);
        __hip_atomic_store(dst + (2 * g + 1) * 64, (unsigned long long)pg8::cvt_pk_bf16(R1[4 * g], R1[4 * g + 1]) | ((unsigned long long)pg8::cvt_pk_bf16(R1[4 * g + 2], R1[4 * g + 3]) << 32), RLX_AGENT);
    }
    asm volatile("s_waitcnt vmcnt(0)" ::: "memory");
    __syncthreads();
    if (threadIdx.x == 0) __hip_atomic_store((unsigned*)(A.ws + WS_CTL) + CW_RFLAG + 64 * ((l * 16 + b * 4 + h) * 4 + seg), 1u, RLX_AGENT);
}

__device__ __forceinline__ void ret_b_task(const Args& A, int l, int b, int h, int seg, lptr lds) {
    const int tid = opaque_tid(), lane = tid & 63; const int wid = __builtin_amdgcn_readfirstlane(tid >> 6), qb = wid & 3, vh = wid >> 2;
    const bf16_t* RQ = (const bf16_t*)(A.ws + WS_RQ); const bf16_t* RK = (const bf16_t*)(A.ws + WS_RK); const bf16_t* RV = (const bf16_t*)(A.ws + WS_RV);
    const bf16_t* RG = (const bf16_t*)(A.ws + WS_RG); bf16_t* YC = (bf16_t*)(A.ws + WS_YC);
    const float l2g = log2_gamma(h); const float gam = exp2f(l2g), g127 = exp2f(127.0f * l2g), g128 = exp2f(128.0f * l2g);
    const float* gn = A.in[I_RGN] + l * 128;
    LAS float* ssq = (LAS float*)(lds + R_SS);
    const int srow = tid >> 4, sch = tid & 15;
    const int sb = 2048 * (srow >> 3) + 512 * (sch >> 2) + 64 * (srow & 7) + 16 * ((sch & 3) ^ ((srow >> 2) & 3));
    u32x4 stK[4], stV[4];
    RET_KV_LOAD(stK, stV, 8 * seg);
    f32x16 R0 = f32x16{}, R1 = f32x16{};
    if (seg > 0) {
        if (threadIdx.x < 64) {
            unsigned* fl = (unsigned*)(A.ws + WS_CTL) + CW_RFLAG + 64 * ((l * 16 + b * 4 + h) * 4);
            unsigned spins = 0;
            for (;;) {
                unsigned ok = 1u;
                for (int s2 = 0; s2 < seg; ++s2) ok &= __hip_atomic_load(fl + 64 * s2, RLX_AGENT);
                if (__builtin_amdgcn_readfirstlane(ok)) break;
                __builtin_amdgcn_s_sleep(8);
                if (++spins > (1u << 22)) break;
            }
        }
        __syncthreads();
        const float g1024 = exp2f(1024.0f * l2g);
        for (int s2 = 0; s2 < seg; ++s2) {
            const unsigned long long* src = (const unsigned long long*)(A.ws + WS_RSTATE) + ((size_t)((b * 4 + h) * 3 + s2) * 8 + wid) * 512 + lane;
#pragma unroll
            for (int r = 0; r < 16; ++r) { R0[r] *= g1024; R1[r] *= g1024; }
#pragma unroll
            for (int g = 0; g < 4; ++g) {
                const unsigned long long a0 = __hip_atomic_load(src + (2 * g) * 64, RLX_AGENT), a1 = __hip_atomic_load(src + (2 * g + 1) * 64, RLX_AGENT);
                R0[4 * g] += bf2f((unsigned)a0 & 0xffffu); R0[4 * g + 1] += __uint_as_float((unsigned)a0 & 0xffff0000u); R0[4 * g + 2] += bf2f((unsigned)(a0 >> 32) & 0xffffu); R0[4 * g + 3] += __uint_as_float((unsigned)(a0 >> 32) & 0xffff0000u);
                R1[4 * g] += bf2f((unsigned)a1 & 0xffffu); R1[4 * g + 1] += __uint_as_float((unsigned)a1 & 0xffff0000u); R1[4 * g + 2] += bf2f((unsigned)(a1 >> 32) & 0xffffu); R1[4 * g + 3] += __uint_as_float((unsigned)(a1 >> 32) & 0xffff0000u);
            }
        }
    }
    bf16x8 qf[8];
    u32x4 gst[4];
#define RET_Q_LOAD(c_) do { const size_t r0_ = ((size_t)b * SEQ + 128 * (c_) + 32 * qb + (lane & 31)) * BW + h * 128 + (lane >> 5) * 8; \
    _Pragma("unroll") for (int ds = 0; ds < 8; ++ds) qf[ds] = *(const bf16x8*)(RQ + r0_ + ds * 16); } while (0)
#define RET_G_LOAD(c_) do { _Pragma("unroll") for (int i = 0; i < 4; ++i) { const int idx_ = lane + 64 * i; \
    gst[i] = *(const u32x4*)(RG + ((size_t)b * SEQ + 128 * (c_) + 32 * qb + (idx_ >> 3)) * BW + h * 128 + 64 * vh + (idx_ & 7) * 8); } } while (0)
    RET_Q_LOAD(8 * seg); RET_G_LOAD(8 * seg);
    for (int cc = 0; cc < 8; ++cc) {
        const int c = 8 * seg + cc;
        const RetLane L = ret_lane(lane);
        const int r32 = L.r32, hi = L.hi, w = L.w;
        const size_t crow0 = (size_t)b * SEQ + 128 * c;
        lptr stg = lds + R_ST + 4096 * wid;
        LDS_BAR();
        RET_KV_WRITE(stK, stV);
        if (c > 0) {
            lptr rw = lds + R_RT + 256 * (64 * vh) + 2048 * (r32 >> 3) + 64 * (r32 & 7) + 512 * qb + 8 * hi;
#pragma unroll
            for (int g = 0; g < 4; ++g) {
                *(LAS u32x2*)(rw + 16 * (g ^ w)) = (u32x2){pg8::cvt_pk_bf16(R0[4 * g], R0[4 * g + 1]), pg8::cvt_pk_bf16(R0[4 * g + 2], R0[4 * g + 3])};
                *(LAS u32x2*)(rw + 8192 + 16 * (g ^ w)) = (u32x2){pg8::cvt_pk_bf16(R1[4 * g], R1[4 * g + 1]), pg8::cvt_pk_bf16(R1[4 * g + 2], R1[4 * g + 3])};
            }
        }
#pragma unroll
        for (int i = 0; i < 4; ++i) { const int idx = lane + 64 * i; *(LAS u32x4*)(stg + (idx >> 3) * 128 + (idx & 7) * 16) = gst[i]; }
        LDS_BAR();
        f32x16 o0 = f32x16{}, o1 = f32x16{};
        for (int kb = 0; kb <= qb; ++kb) {
            f32x16 p = f32x16{};
            lptr kr = lds + R_K + 8192 * kb;
#pragma unroll
            for (int ds = 0; ds < 8; ++ds) p = MFMA32(ld8(kr + ((ds & 1) ? L.rb1 : L.rb0) + 512 * (ds >> 1)), qf[ds], p);
            if (kb == qb) {
#pragma unroll
                for (int r = 0; r < 16; ++r) if (crow(r, hi) > r32) p[r] = 0.f;
            }
            const bf16x8 pa0 = pack_p(p, 0), pa1 = pack_p(p, 8);
            lptr vr = lds + R_V + 8192 * kb + 512 * (2 * vh);
#pragma unroll
            for (int s2 = 0; s2 < 2; ++s2) {
                const bf16x8 pa = s2 ? pa1 : pa0;
                const bf16x8 vf0 = cat8(vtr(vr + L.tpb0 + 4096 * s2), vtr(vr + L.tpb1 + 4096 * s2));
                const bf16x8 vf1 = cat8(vtr(vr + 512 + L.tpb0 + 4096 * s2), vtr(vr + 512 + L.tpb1 + 4096 * s2));
                o0 = MFMA32(pa, vf0, o0); o1 = MFMA32(pa, vf1, o1);
            }
        }
        if (c > 0) {
            f32x16 x0 = f32x16{}, x1 = f32x16{};
            lptr rr = lds + R_RT + 256 * (64 * vh);
#pragma unroll
            for (int ds = 0; ds < 8; ++ds) {
                const int ob = ((ds & 1) ? L.rb1 : L.rb0) + 512 * (ds >> 1);
                x0 = MFMA32(qf[ds], ld8(rr + ob), x0);
                x1 = MFMA32(qf[ds], ld8(rr + 8192 + ob), x1);
            }
#pragma unroll
            for (int r = 0; r < 16; ++r) { o0[r] += gam * x0[r]; o1[r] += gam * x1[r]; }
        }
#pragma unroll
        for (int r = 0; r < 16; ++r) { const float v = half_sum32(o0[r] * o0[r] + o1[r] * o1[r]);
            if (r32 == 16) ssq[vh * 128 + 32 * qb + crow(r, hi)] = v; }
        if (cc < 7) RET_KV_LOAD(stK, stV, c + 1);
        LDS_BAR();
        if (c < SEQ / 128 - 1) ret_update(R0, R1, lds, L, qb, vh, g127, g128);
        if (cc < 7) { RET_Q_LOAD(c + 1); RET_G_LOAD(c + 1); }
        const float gn0 = gn[64 * vh + r32], gn1 = gn[64 * vh + 32 + r32];
#pragma unroll
        for (int r = 0; r < 16; ++r) {
            const int row = crow(r, hi);
            const float rn = rsqrtf((ssq[32 * qb + row] + ssq[128 + 32 * qb + row]) * (1.0f / 128.0f) + RMS_EPS);
            LAS bf16_t* sp = (LAS bf16_t*)(stg + row * 128) + r32;
            sp[0] = (bf16_t)f2bf(o0[r] * rn * gn0 * bf2f(sp[0]));
            sp[32] = (bf16_t)f2bf(o1[r] * rn * gn1 * bf2f(sp[32]));
        }
#pragma unroll
        for (int i = 0; i < 4; ++i) { const int idx = lane + 64 * i;
            *(u32x4*)(YC + (crow0 + 32 * qb + (idx >> 3)) * BW + h * 128 + 64 * vh + (idx & 7) * 8) = *(const LAS u32x4*)(stg + (idx >> 3) * 128 + (idx & 7) * 16); }
    }
#undef RET_Q_LOAD
#undef RET_G_LOAD
}
#undef RET_KV_LOAD
#undef RET_KV_WRITE
#undef MFMA32

constexpr int C_Z = 65536;
__device__ __forceinline__ void conv_task(const Args& A, int l, int task, lptr lds) {
    const int tid = opaque_tid(), lane = tid & 63; const int wave = __builtin_amdgcn_readfirstlane(tid >> 6);
    const bf16_t* Z = (const bf16_t*)(A.ws + WS_Z); bf16_t* YB = (bf16_t*)(A.ws + WS_YB);
    const float* cw = A.in[I_CW] + (size_t)l * 31 * BW; const float* cb = A.in[I_CB] + l * BW;
    const float* lg = A.in[I_CLG] + l * BW; const float* lb = A.in[I_CLB] + l * BW;
    const int m0 = task * 32, t0 = m0 & (SEQ - 1);
    __syncthreads();
    for (int pc = wave; pc < 62; pc += NWAVES) {
        const int j = pc >> 1, hf = pc & 1;
        __builtin_amdgcn_global_load_lds((const unsigned*)(cw + (size_t)j * BW + 8 * lane + 4 * hf), (LAS unsigned*)(lds + pc * 1024), 16, 0, 0);
    }
    for (int r = wave; r < 62; r += NWAVES) {
        if (t0 - 30 + r >= 0) __builtin_amdgcn_global_load_lds((const unsigned*)(Z + (size_t)(m0 - 30 + r) * BW + lane * 8), (LAS unsigned*)(lds + C_Z + r * 1024), 16, 0, 0);
        else { unsigned zz = 0u; asm volatile("" : "+v"(zz)); *(LAS u32x4*)(lds + C_Z + r * 1024 + lane * 16) = (u32x4){zz, zz, zz, zz}; }
    }
    __syncthreads();
    const int c0 = lane * 8;
    float acc[4][8];
    { const f32x4 b0 = *(const f32x4*)(cb + c0), b1 = *(const f32x4*)(cb + c0 + 4);
#pragma unroll
      for (int k = 0; k < 4; ++k) { acc[k][0] = b0[0]; acc[k][1] = b0[1]; acc[k][2] = b0[2]; acc[k][3] = b0[3]; acc[k][4] = b1[0]; acc[k][5] = b1[1]; acc[k][6] = b1[2]; acc[k][7] = b1[3]; } }
    float zf[4][8];
    lptr zb = lds + C_Z + (4 * wave) * 1024 + lane * 16;
#define CONV_ZROW(slot, rr) do { const u32x4 v_ = *(const LAS u32x4*)(zb + (rr) * 1024); \
        zf[slot][0] = __uint_as_float(v_.x << 16); zf[slot][1] = __uint_as_float(v_.x & 0xffff0000u); zf[slot][2] = __uint_as_float(v_.y << 16); zf[slot][3] = __uint_as_float(v_.y & 0xffff0000u); \
        zf[slot][4] = __uint_as_float(v_.z << 16); zf[slot][5] = __uint_as_float(v_.z & 0xffff0000u); zf[slot][6] = __uint_as_float(v_.w << 16); zf[slot][7] = __uint_as_float(v_.w & 0xffff0000u); } while (0)
    CONV_ZROW(0, 0); CONV_ZROW(1, 1); CONV_ZROW(2, 2); CONV_ZROW(3, 3);
#pragma unroll
    for (int j = 0; j < 31; ++j) {
        const f32x4 w0 = *(const LAS f32x4*)(lds + ((j * 2 + 0) * 64 + lane) * 16), w1 = *(const LAS f32x4*)(lds + ((j * 2 + 1) * 64 + lane) * 16);
#pragma unroll
        for (int k = 0; k < 4; ++k) {
            const int sl = (j + k) & 3;
            acc[k][0] += w0[0] * zf[sl][0]; acc[k][1] += w0[1] * zf[sl][1]; acc[k][2] += w0[2] * zf[sl][2]; acc[k][3] += w0[3] * zf[sl][3];
            acc[k][4] += w1[0] * zf[sl][4]; acc[k][5] += w1[1] * zf[sl][5]; acc[k][6] += w1[2] * zf[sl][6]; acc[k][7] += w1[3] * zf[sl][7];
        }
        if (j < 30) CONV_ZROW(j & 3, j + 4);
    }
#undef CONV_ZROW
    const f32x4 g0 = *(const f32x4*)(lg + c0), g1 = *(const f32x4*)(lg + c0 + 4), h0 = *(const f32x4*)(lb + c0), h1 = *(const f32x4*)(lb + c0 + 4);
#pragma unroll
    for (int k = 0; k < 4; ++k) {
        float s_ = 0.f;
#pragma unroll
        for (int e = 0; e < 8; ++e) s_ += acc[k][e];
        const float mu = wave_sum(s_) * (1.0f / BW);
        float q = 0.f;
#pragma unroll
        for (int e = 0; e < 8; ++e) { acc[k][e] -= mu; q += acc[k][e] * acc[k][e]; }
        const float rstd = rsqrtf(wave_sum(q) * (1.0f / BW) + LN_EPS);
        float o[8];
#pragma unroll
        for (int e = 0; e < 4; ++e) { const float a_ = acc[k][e] * rstd * g0[e] + h0[e], b_ = acc[k][4 + e] * rstd * g1[e] + h1[e]; o[e] = a_ * sigx(-LOG2E * a_); o[4 + e] = b_ * sigx(-LOG2E * b_); }
        *(uint4*)(YB + (size_t)(m0 + 4 * wave + k) * BW + c0) = make_uint4(pk2(o[0], o[1]), pk2(o[2], o[3]), pk2(o[4], o[5]), pk2(o[6], o[7]));
    }
}

constexpr int Q_RA = 6, Q_AT = 32, Q_RB = 8, Q_CONV = 64, Q_TASKS = Q_RA + Q_AT + Q_RB + Q_AT + Q_CONV;
constexpr int CW_QUEUE = 8192;
__device__ __forceinline__ void mixer_phase(const Args& A, int l, lptr lds, volatile LAS unsigned* slot) {
    const int x0 = (int)(xb_xcc_id() & 7u);
    int qi = 0;
    for (;;) {
        const int x = (x0 + qi) & 7;
        unsigned* ctr = (unsigned*)(A.ws + WS_CTL) + CW_QUEUE + 64 * (8 * l + x);
        __syncthreads();
        if (threadIdx.x == 0) *slot = __hip_atomic_fetch_add(ctr, 1u, __ATOMIC_RELAXED, __HIP_MEMORY_SCOPE_AGENT);
        __syncthreads();
        int id = (int)*slot;
        if (id >= Q_TASKS) { if (++qi == 8) break; continue; }
#if PROBE_PHASE >= 10
        const unsigned t0_ = (unsigned)__builtin_amdgcn_s_memrealtime(); int kind = 0;
#endif
        if (id < Q_RA) { const int bh = 2 * x + id / 3; ret_a_task(A, l, bh >> 2, bh & 3, id % 3, lds); }
        else if ((id -= Q_RA) < Q_AT) { const int bh = 2 * x + (id & 1); attn_unit<0>(A, l, bh >> 2, bh & 3, 31 - (id >> 1), lds);
#if PROBE_PHASE >= 10
            kind = 1;
#endif
        }
        else if ((id -= Q_AT) < Q_RB) { const int bh = 2 * x + (id >> 2); ret_b_task(A, l, bh >> 2, bh & 3, id & 3, lds); }
        else if ((id -= Q_RB) < Q_AT) { const int bh = 2 * x + (id & 1); attn_unit<0>(A, l, bh >> 2, bh & 3, 15 - (id >> 1), lds);
#if PROBE_PHASE >= 10
            kind = 1;
#endif
        }
        else { id -= Q_AT; conv_task(A, l, 64 * x + id, lds);
#if PROBE_PHASE >= 10
            kind = 2;
#endif
        }
#if PROBE_PHASE >= 10
        __syncthreads();
        if (threadIdx.x == 0 && kind == PROBE_PHASE - 10) atomicAdd((unsigned*)(A.ws + WS_CTL) + CW_QUEUE + 2048, (unsigned)__builtin_amdgcn_s_memrealtime() - t0_);
#endif
    }
#if ABL_ATTN > 0
    if (l == 0) {
        unsigned* ctr2 = (unsigned*)(A.ws + WS_CTL) + CW_QUEUE + 4096;
        for (;;) {
            __syncthreads();
            if (threadIdx.x == 0) *slot = __hip_atomic_fetch_add(ctr2, 1u, __ATOMIC_RELAXED, __HIP_MEMORY_SCOPE_AGENT);
            __syncthreads();
            const int id = (int)*slot;
            if (id >= 512) break;
            attn_unit<ABL_ATTN>(A, l, (id & 15) >> 2, id & 3, 31 - (id >> 4), lds);
        }
    }
#endif
}
}

constexpr int N_PHASES = 1 + 6 * DEPTH;
constexpr int RING_BYTES = 131072, MISC_OFF = RING_BYTES + 320, LDS_BYTES = 147456;
#ifndef FAST_GEMM
#define FAST_GEMM 1
#endif
#ifndef FAST_MIX
#define FAST_MIX 1
#endif
#ifndef FAST_MASK
#define FAST_MASK 0x3f
#endif
__global__ void __launch_bounds__(NTHREADS, 2) fwd_kernel(Args A) {
    extern __shared__ __attribute__((aligned(16))) unsigned char lds[];
    float* sm = (float*)lds;
    LAS unsigned char* ldsl = (LAS unsigned char*)lds;
    volatile LAS unsigned* MISC = (volatile LAS unsigned*)(ldsl + MISC_OFF);
    const int wg = blockIdx.x, nwg = gridDim.x;
    const bool multi = (A.ph_hi - A.ph_lo) > 1;
    XcdBarrier bar; bar.bar = nullptr; bar.x = 0; bar.st = nullptr;
    if (multi) {
        if (threadIdx.x < 2) MISC[threadIdx.x] = 0u;
        __syncthreads();
        bar = xcd_barrier_post((unsigned*)(A.ws + WS_CTL) + CW_BAR, MISC);
    }
    const Args& A0 = A;
#if PROBE_PHASE >= 0
    if (blockIdx.x == 0 && threadIdx.x == 0) { const unsigned now = (unsigned)__builtin_amdgcn_s_memrealtime(); MISC[8] = now; MISC[9] = 0u; MISC[10] = now; }
#endif
    for (int ph = A0.ph_lo; ph < A0.ph_hi; ++ph) {
        Args A = A0;
        asm volatile("" : "+s"(A.out), "+s"(A.ws));
        if (ph == 0) { nv_p0(A, wg, nwg); if (FAST_GEMM) fast_p0_weights(A, wg, nwg, (LAS float*)ldsl, 0, NI_W1); }
        else {
            const int l = (ph - 1) / 6, k = (ph - 1) % 6;
            if (k == 1) {
#if FAST_MIX
                mx::mixer_phase(A, l, ldsl, MISC + 4);
#else
                nv_attn(A, l, wg, nwg, sm); nv_conv(A, l, wg, nwg); nv_ret(A, l, wg, nwg, sm);
#endif
            }
            else if (FAST_GEMM && ((FAST_MASK >> k) & 1)) fast_gemm(A, l, k, ldsl);
            else if (k == 0) nv_p1(A, l, wg, nwg, sm);
            else if (k == 2) nv_p3(A, l, wg, nwg, sm);
            else if (k == 3) nv_resid_gemm(A, (const bf16_t*)(A.ws + WS_Y), DM, DM, A.in[I_WOUT] + (size_t)l * DM * DM, l == 0 ? A.in[I_X] : A.out,
                                           (float*)(A.ws + WS_ROWSS) + (size_t)(l == 0 ? 1 : 3) * M, wg, nwg, sm);
            else if (k == 4) nv_p5(A, l, wg, nwg, sm);
            else nv_resid_gemm(A, (const bf16_t*)(A.ws + WS_MID), DFF, DFF, A.in[I_WF2] + (size_t)l * DFF * DM, A.out,
                               l + 1 < DEPTH ? (float*)(A.ws + WS_ROWSS) + (size_t)2 * M : nullptr, wg, nwg, sm);
        }
        if (ph + 1 < A0.ph_hi) xcd_barrier(bar);
#if PROBE_PHASE >= 0
        if (blockIdx.x == 0 && threadIdx.x == 0) { const unsigned long long now = __builtin_amdgcn_s_memrealtime(); const int k = ph == 0 ? 0 : 1 + (ph - 1) % 6;
            if (k == PROBE_PHASE) MISC[9] += (unsigned)now - MISC[10]; MISC[10] = (unsigned)now; }
#endif
    }
#if PROBE_PHASE >= 0
    xcd_barrier(bar);
    if (blockIdx.x == 0 && threadIdx.x == 0) { const unsigned now = (unsigned)__builtin_amdgcn_s_memrealtime(); float frac = (float)MISC[9] / (float)(now - MISC[8]);
        if (PROBE_PHASE >= 10) frac = (float)__hip_atomic_load((unsigned*)(A0.ws + WS_CTL) + mx::CW_QUEUE + 2048, __ATOMIC_RELAXED, __HIP_MEMORY_SCOPE_AGENT) / ((float)gridDim.x * (float)(now - MISC[8]));
        A0.out[0] += 2.0f + 28.0f * frac; }
#endif
}

extern "C" void kernel_launch(void* const* d_in, const int* in_sizes, int n_in, void* d_out, int out_size, void* d_ws, size_t ws_size, hipStream_t stream) {
    static int grid = 0;
    if (grid == 0) {
        if (n_in != N_IN || out_size != M * DM || ws_size < WS_END) { fprintf(stderr, "kernel_launch: unexpected shapes (n_in %d out %d ws %zu)\n", n_in, out_size, ws_size); grid = -1; return; }
        int dev = 0, cus = 0, per_cu = 0;
        (void)hipGetDevice(&dev); (void)hipDeviceGetAttribute(&cus, hipDeviceAttributeMultiprocessorCount, dev);
        (void)hipFuncSetAttribute((const void*)fwd_kernel, hipFuncAttributeMaxDynamicSharedMemorySize, LDS_BYTES);
        (void)hipOccupancyMaxActiveBlocksPerMultiprocessor(&per_cu, (const void*)fwd_kernel, NTHREADS, LDS_BYTES);
        (void)hipGetLastError();
        if (per_cu < 1) fprintf(stderr, "kernel_launch: occupancy query says %d blocks per CU\n", per_cu);
        grid = cus;
    }
    if (grid < 0) return;
    (void)hipMemsetAsync((char*)d_ws + WS_CTL, 0, CTL_ZERO_BYTES, stream);
    Args a{};
    for (int i = 0; i < N_IN; ++i) a.in[i] = (const float*)d_in[i];
    a.out = (float*)d_out; a.ws = (unsigned char*)d_ws;
    a.ph_lo = 0; a.ph_hi = N_PHASES;
    void* args[] = {&a};
    hipError_t e = hipLaunchCooperativeKernel((const void*)fwd_kernel, dim3(grid), dim3(NTHREADS), args, LDS_BYTES, stream);
    if (e != hipSuccess) fprintf(stderr, "cooperative launch failed: %s (grid %d)\n", hipGetErrorString(e), grid);
}
```

```cpp
#include <hip/hip_runtime.h>
#include <cstdio>
#include <cstdint>
#ifndef ABL_ATTN
#define ABL_ATTN 0
#endif
#ifndef PROBE_PHASE
#define PROBE_PHASE -1
#endif

#define GAS __attribute__((address_space(1)))
#define LAS __attribute__((address_space(3)))
typedef unsigned short bf16_t;
typedef GAS unsigned gu32;
#define RLX_AGENT __ATOMIC_RELAXED, __HIP_MEMORY_SCOPE_AGENT

constexpr int BATCH = 4, SEQ = 4096, DM = 1024, M = BATCH * SEQ, DEPTH = 2;
constexpr int DIN = 7680, NU = 4608, NGATE = 3072, DFF = 2816, BW = 512;
constexpr float RMS_EPS = 1e-6f, LN_EPS = 1e-5f;
constexpr float LOG2E = 1.4426950408889634f;
constexpr float QSCALE = 0.125f * LOG2E;
constexpr int NTHREADS = 512, NWAVES = 8;

enum { I_X = 0, I_N1G, I_WIN, I_QG, I_KG, I_DLAM, I_ASG, I_CW, I_CB, I_CLG, I_CLB, I_RGN, I_BGATE, I_WBR, I_WOUT, I_N2G, I_WF1, I_WF2, N_IN };

constexpr size_t MiB = 1u << 20;
constexpr size_t WS_CTL = 0, CTL_ZERO_BYTES = 1 * MiB;
constexpr size_t WS_ROWSS = 256 * 1024;
constexpr size_t WS_LAM = 512 * 1024;
constexpr size_t WS_XB = 78 * MiB;
constexpr size_t WS_AQ = 110 * MiB, WS_AK = 126 * MiB, WS_AV = 142 * MiB, WS_Z = 158 * MiB, WS_RQ = 174 * MiB, WS_RK = 190 * MiB, WS_RV = 206 * MiB, WS_RG = 222 * MiB, WS_YB = 238 * MiB;
constexpr size_t WS_YA = WS_AQ, WS_YC = WS_RQ;
constexpr size_t WS_Y = 126 * MiB;
constexpr size_t WS_MID = 110 * MiB;
constexpr size_t WS_END = 256 * MiB;
constexpr int CW_BAR = 4096;

struct Args { const float* in[N_IN]; float* out; unsigned char* ws; int ph_lo, ph_hi; };

__device__ __forceinline__ float bf2f(unsigned v) { return __uint_as_float(v << 16); }
__device__ __forceinline__ unsigned f2bf(float f) { unsigned u = __float_as_uint(f); return (u + 0x7fffu + ((u >> 16) & 1u)) >> 16; }
__device__ __forceinline__ unsigned pk2(float lo, float hi) { return f2bf(lo) | (f2bf(hi) << 16); }
__device__ __forceinline__ float wave_sum(float v) {
#pragma unroll
    for (int o = 1; o < 64; o <<= 1) v += __shfl_xor(v, o);
    return v;
}
__device__ __forceinline__ float wave_max(float v) {
#pragma unroll
    for (int o = 1; o < 64; o <<= 1) v = fmaxf(v, __shfl_xor(v, o));
    return v;
}
__device__ __forceinline__ int opaque_tid() { int t = threadIdx.x; asm volatile("" : "+v"(t)); return t; }
__device__ __forceinline__ float sigmoidf_(float x) { return 1.0f / (1.0f + __expf(-x)); }
__device__ __forceinline__ float siluf_(float x) { return x / (1.0f + __expf(-x)); }
__device__ __forceinline__ float lam_init_of(int l) { return l == 0 ? 0.2f : (0.8f - 0.6f * 0.74081822068171788f); }
__device__ __forceinline__ float log2_gamma(int h) { return log2f(1.0f - exp2f(-5.0f - (float)h)); }

#define XB_TMO      128
#define XB_XCNT(j)  (256  + 64 * (j))
#define XB_XSUB(j)  (1280 + 64 * (j))
#define XB_XGEN(j)  (2304 + 64 * (j))
#define XB_TOP      3328
#define XB_TOPGEN   3392
#define XCD_BAR_WORDS 3456
#define XB_SPIN_CAP (1u << 22)
__device__ __forceinline__ unsigned xb_ld(unsigned* p)              { return __hip_atomic_load(p, __ATOMIC_RELAXED, __HIP_MEMORY_SCOPE_AGENT); }
__device__ __forceinline__ unsigned xb_add(unsigned* p, unsigned v) { return __hip_atomic_fetch_add(p, v, __ATOMIC_RELAXED, __HIP_MEMORY_SCOPE_AGENT); }
__device__ __forceinline__ unsigned xb_xcc_id() { return (unsigned)__builtin_amdgcn_s_getreg((3 << 11) | 20) & 0xFu; }
#define XB_SPIN(cond, bar) do { unsigned _sp = 0; while (cond) { __builtin_amdgcn_s_sleep(1); \
    if ((++_sp & 255u) == 0u) { if (xb_ld(&(bar)[XB_TMO])) break; if (_sp > XB_SPIN_CAP) { atomicAdd(&(bar)[XB_TMO], 1u); break; } } } } while (0)
struct XcdBarrier { unsigned* bar; unsigned x; volatile LAS unsigned* st; };
__device__ __forceinline__ XcdBarrier xcd_barrier_post(unsigned* bar, volatile LAS unsigned* st) {
    XcdBarrier b; b.bar = bar; b.x = xb_xcc_id(); b.st = st;
    if (threadIdx.x == 0) (void)xb_add(&bar[XB_XCNT(b.x)], 1u);
    return b;
}
__device__ __forceinline__ void xcd_barrier_complete(unsigned* bar, unsigned x, unsigned& nloc, unsigned& nx) {
    const unsigned G = gridDim.x * gridDim.y * gridDim.z;
    unsigned sum, cnt, mine, sp = 0u;
    for (;;) {
        sum = 0u; cnt = 0u; mine = 0u;
#pragma unroll
        for (unsigned j = 0; j < 16; ++j) { const unsigned c = xb_ld(&bar[XB_XCNT(j)]); sum += c; cnt += (c > 0u) ? 1u : 0u; mine = (j == x) ? c : mine; }
        if (sum == G) break;
        __builtin_amdgcn_s_sleep(1);
        if ((++sp & 255u) == 0u) { if (xb_ld(&bar[XB_TMO])) break; if (sp > XB_SPIN_CAP) { atomicAdd(&bar[XB_TMO], 1u); break; } }
    }
    nloc = mine > 0u ? mine : 1u; nx = cnt > 0u ? cnt : 1u;
}
__device__ __forceinline__ void xcd_barrier(const XcdBarrier& b) {
    asm volatile("s_waitcnt vmcnt(0)" ::: "memory");
    __syncthreads();
    if (threadIdx.x == 0) {
        unsigned* bar = b.bar;
        __builtin_amdgcn_s_waitcnt(0);
        unsigned nloc = b.st[0], nx = b.st[1];
        if (nloc == 0u) { xcd_barrier_complete(bar, b.x, nloc, nx); b.st[0] = nloc; b.st[1] = nx; }
        const unsigned old = xb_add(&bar[XB_XSUB(b.x)], 1u);
        const unsigned gen = old / nloc;
        if (old + 1u == (gen + 1u) * nloc) {
            __builtin_amdgcn_fence(__ATOMIC_RELEASE, "agent");
            asm volatile("s_waitcnt vmcnt(0)" ::: "memory");
            const unsigned og = xb_add(&bar[XB_TOP], 1u);
            const unsigned tg = og / nx;
            if (og + 1u == (tg + 1u) * nx) xb_add(&bar[XB_TOPGEN], 1u);
            else XB_SPIN(xb_ld(&bar[XB_TOPGEN]) == tg, bar);
            __builtin_amdgcn_fence(__ATOMIC_ACQUIRE, "agent");
            xb_add(&bar[XB_XGEN(b.x)], 1u);
            asm volatile("s_waitcnt vmcnt(0)" ::: "memory");
        } else {
            XB_SPIN(xb_ld(&bar[XB_XGEN(b.x)]) == gen, bar);
            __builtin_amdgcn_fence(__ATOMIC_ACQUIRE, "agent");
            asm volatile("s_waitcnt vmcnt(0)" ::: "memory");
        }
    }
    __syncthreads();
}


__device__ __forceinline__ void nv_p0(const Args& A, int wg, int nwg) {
    const int tid = opaque_tid(), lane = tid & 63, wave = tid >> 6;
    const float* x = A.in[I_X];
    bf16_t* XB = (bf16_t*)(A.ws + WS_XB);
    float* rowss = (float*)(A.ws + WS_ROWSS);
    for (int m0 = wg * NWAVES + wave; m0 < M; m0 += 4 * nwg * NWAVES) {
        float4 v[4][4];
#pragma unroll
        for (int r = 0; r < 4; ++r) { const int m = m0 + r * nwg * NWAVES; if (m < M) { const float4* xr = (const float4*)(x + (size_t)m * DM) + lane;
#pragma unroll
            for (int j = 0; j < 4; ++j) v[r][j] = xr[64 * j]; } }
#pragma unroll
        for (int r = 0; r < 4; ++r) { const int m = m0 + r * nwg * NWAVES; if (m < M) { uint2* o = (uint2*)(XB + (size_t)m * DM) + lane; float s = 0.f;
#pragma unroll
            for (int j = 0; j < 4; ++j) { const float4 q = v[r][j]; s += q.x * q.x + q.y * q.y + q.z * q.z + q.w * q.w; o[64 * j] = make_uint2(pk2(q.x, q.y), pk2(q.z, q.w)); }
            s = wave_sum(s);
            if (lane == 0) rowss[m] = s; } }
    }
    if (wg == 0 && wave < DEPTH) {
        const float* dl = A.in[I_DLAM] + wave * 4 * 64;
        float a = dl[lane] * dl[64 + lane], b = dl[128 + lane] * dl[192 + lane];
        a = wave_sum(a); b = wave_sum(b);
        if (lane == 0) ((float*)(A.ws + WS_LAM))[wave] = __expf(a) - __expf(b) + lam_init_of(wave);
    }
}

template <class AL, class WL>
__device__ __forceinline__ void nv_core(float (&acc)[4][4], int K, const AL& aload, const WL& wload, float* sA, float* sB, int tid) {
    const int tx = tid & 15, ty = tid >> 4;
#pragma unroll
    for (int i = 0; i < 4; ++i)
#pragma unroll
        for (int j = 0; j < 4; ++j) acc[i][j] = 0.f;
    const int ar = tid & 127, akq = tid >> 7;
    const int wk = tid >> 5, wc = (tid & 31) * 2;
#pragma unroll 1
    for (int k0 = 0; k0 < K; k0 += 16) {
        float a0, a1, a2, a3; aload(ar, k0 + 4 * akq, a0, a1, a2, a3);
        const float w0 = wload(k0 + wk, wc), w1 = wload(k0 + wk, wc + 1);
        __syncthreads();
        sA[(4 * akq + 0) * 128 + ar] = a0; sA[(4 * akq + 1) * 128 + ar] = a1; sA[(4 * akq + 2) * 128 + ar] = a2; sA[(4 * akq + 3) * 128 + ar] = a3;
        sB[wk * 64 + wc] = w0; sB[wk * 64 + wc + 1] = w1;
        __syncthreads();
#pragma unroll 2
        for (int kk = 0; kk < 16; ++kk) {
            const float4 a = *(const float4*)&sA[kk * 128 + ty * 4];
            const float4 b = *(const float4*)&sB[kk * 64 + tx * 4];
            const float av[4] = {a.x, a.y, a.z, a.w}, bv[4] = {b.x, b.y, b.z, b.w};
#pragma unroll
            for (int i = 0; i < 4; ++i)
#pragma unroll
                for (int j = 0; j < 4; ++j) acc[i][j] += av[i] * bv[j];
        }
    }
    __syncthreads();
}
struct ALbf {
    const bf16_t* A; int lda; int row0;
    __device__ __forceinline__ void operator()(int r, int k, float& a0, float& a1, float& a2, float& a3) const {
        const uint2 v = *(const uint2*)(A + (size_t)(row0 + r) * lda + k);
        a0 = __uint_as_float(v.x << 16); a1 = __uint_as_float(v.x & 0xffff0000u); a2 = __uint_as_float(v.y << 16); a3 = __uint_as_float(v.y & 0xffff0000u);
    }
};
struct WLf32 {
    const float* W; int ldw; int c0, c1; const float* g;
    __device__ __forceinline__ float operator()(int k, int j) const {
        const float w = W[(size_t)k * ldw + (j < 32 ? c0 + j : c1 + j - 32)];
        return g ? w * g[k] : w;
    }
};

__device__ __forceinline__ void nv_p1(const Args& A, int l, int wg, int nwg, float* sm) {
    float* sA = sm; float* sB = sm + 16 * 128; float* sC = sB + 16 * 64;
    const int tid = opaque_tid(), tx = tid & 15, ty = tid >> 4;
    const float* Win = A.in[I_WIN] + (size_t)l * DM * DIN;
    const float* g1 = A.in[I_N1G] + l * DM;
    const bf16_t* XB = (const bf16_t*)(A.ws + WS_XB);
    const float* rowss = (const float*)(A.ws + WS_ROWSS) + (size_t)(l == 0 ? 0 : 2) * M;
    const float* qg = A.in[I_QG] + l * 64; const float* kg = A.in[I_KG] + l * 64;
    for (int it = wg; it < 128 * 72; it += nwg) {
        const int rt = it / 72, cg = it % 72, row0 = rt * 128;
        int c0 = 64 * cg, c1 = 64 * cg + 32;
        if (cg >= 24 && cg < 40) { c0 = 1536 + 32 * (cg - 24); c1 = 2048 + 32 * (cg - 24); }
        float acc[4][4];
        nv_core(acc, DM, ALbf{XB, DM, row0}, WLf32{Win, DIN, c0, c1, g1}, sA, sB, tid);
#pragma unroll
        for (int i = 0; i < 4; ++i) {
            const int r = ty * 4 + i; const float rstd = rsqrtf(rowss[row0 + r] * (1.0f / DM) + RMS_EPS);
#pragma unroll
            for (int j = 0; j < 4; ++j) sC[r * 65 + tx * 4 + j] = acc[i][j] * rstd;
        }
        __syncthreads();
        const int r = tid >> 2, q4 = tid & 3, m = row0 + r, t = m & (SEQ - 1);
        const float* cr = sC + r * 65;
        if (cg < 16) {
            float ss = 0.f;
#pragma unroll
            for (int j = 0; j < 16; ++j) { const float v = cr[q4 * 16 + j]; ss += v * v; }
            ss += __shfl_xor(ss, 1); ss += __shfl_xor(ss, 2);
            const float rn = rsqrtf(ss * (1.0f / 64.0f) + RMS_EPS);
            const bool isq = cg < 8; const float* gg = isq ? qg : kg; const float sc = isq ? QSCALE : 1.0f;
            bf16_t* o = (bf16_t*)(A.ws + (isq ? WS_AQ : WS_AK)) + (size_t)m * BW + (cg & 7) * 64 + q4 * 16;
#pragma unroll
            for (int j = 0; j < 16; ++j) o[j] = (bf16_t)f2bf(cr[q4 * 16 + j] * rn * gg[q4 * 16 + j] * sc);
        } else if (cg >= 24 && cg < 40) {
            bf16_t* o = (bf16_t*)(A.ws + WS_Z) + (size_t)m * BW + (cg - 24) * 32 + q4 * 8;
#pragma unroll
            for (int j = 0; j < 8; ++j) o[j] = (bf16_t)f2bf(cr[q4 * 8 + j] * sigmoidf_(cr[32 + q4 * 8 + j]));
        } else {
            size_t base; int cb; int kind;
            if (cg < 24)      { base = WS_AV; cb = cg - 16; kind = 0; }
            else if (cg < 48) { base = WS_RQ; cb = cg - 40; kind = 1; }
            else if (cg < 56) { base = WS_RK; cb = cg - 48; kind = 2; }
            else if (cg < 64) { base = WS_RV; cb = cg - 56; kind = 0; }
            else              { base = WS_RG; cb = cg - 64; kind = 3; }
            const int h = cb >> 1; const float l2g = log2_gamma(h); const float tp = (float)(t & 127);
            float f = 1.0f;
            if (kind == 1) f = exp2f(tp * l2g);
            if (kind == 2) f = 0.08838834764831845f * exp2f(-tp * l2g);
            bf16_t* o = (bf16_t*)(A.ws + base) + (size_t)m * BW + cb * 64 + q4 * 16;
#pragma unroll
            for (int j = 0; j < 16; ++j) { float v = cr[q4 * 16 + j]; v = (kind == 3) ? siluf_(v) : v * f; o[j] = (bf16_t)f2bf(v); }
        }
        __syncthreads();
    }
}

__device__ __forceinline__ void nv_attn(const Args& A, int l, int wg, int nwg, float* sm) {
    const int tid = opaque_tid(), lane = tid & 63, wave = tid >> 6;
    float* sq = sm + wave * 256;
    const bf16_t* AQ = (const bf16_t*)(A.ws + WS_AQ); const bf16_t* AK = (const bf16_t*)(A.ws + WS_AK); const bf16_t* AV = (const bf16_t*)(A.ws + WS_AV);
    bf16_t* YA = (bf16_t*)(A.ws + WS_YA);
    const float lam = ((const float*)(A.ws + WS_LAM))[l];
    const float* asg = A.in[I_ASG] + l * 128;
    const float osc = 1.0f - lam_init_of(l);
    for (int it = wg * NWAVES + wave; it < BATCH * 4 * SEQ; it += nwg * NWAVES) {
        const int t = it & (SEQ - 1), h = (it >> 12) & 3, b = it >> 14;
        const size_t mq = (size_t)b * SEQ + t;
        const float slope2 = exp2f(-2.0f * (float)(h + 1)) * LOG2E;
        sq[lane] = bf2f(AQ[mq * BW + h * 128 + lane]); sq[64 + lane] = bf2f(AQ[mq * BW + h * 128 + 64 + lane]);
        float m1 = -INFINITY, m2 = -INFINITY, l1 = 0.f, l2 = 0.f, o1a = 0.f, o1b = 0.f, o2a = 0.f, o2b = 0.f;
        for (int s0 = 0; s0 <= t; s0 += 64) {
            const int s = s0 + lane; const bool valid = s <= t;
            float d1 = 0.f, d2 = 0.f;
            if (valid) {
                const uint4* kr = (const uint4*)(AK + ((size_t)b * SEQ + s) * BW + h * 128);
#pragma unroll 2
                for (int c = 0; c < 8; ++c) {
                    const uint4 v = kr[c]; const unsigned w[4] = {v.x, v.y, v.z, v.w};
#pragma unroll
                    for (int e = 0; e < 4; ++e) { d1 += sq[c * 8 + 2 * e] * __uint_as_float(w[e] << 16) + sq[c * 8 + 2 * e + 1] * __uint_as_float(w[e] & 0xffff0000u); }
                }
#pragma unroll 2
                for (int c = 0; c < 8; ++c) {
                    const uint4 v = kr[8 + c]; const unsigned w[4] = {v.x, v.y, v.z, v.w};
#pragma unroll
                    for (int e = 0; e < 4; ++e) { d2 += sq[64 + c * 8 + 2 * e] * __uint_as_float(w[e] << 16) + sq[64 + c * 8 + 2 * e + 1] * __uint_as_float(w[e] & 0xffff0000u); }
                }
            }
            const float bias = slope2 * (float)(s - t);
            const float s1 = valid ? d1 + bias : -INFINITY, s2 = valid ? d2 + bias : -INFINITY;
            const float n1 = fmaxf(m1, wave_max(s1)), n2 = fmaxf(m2, wave_max(s2));
            const float a1 = exp2f(m1 - n1), a2 = exp2f(m2 - n2);
            const float p1 = exp2f(s1 - n1), p2 = exp2f(s2 - n2);
            l1 = l1 * a1 + wave_sum(p1); l2 = l2 * a2 + wave_sum(p2);
            o1a *= a1; o1b *= a1; o2a *= a2; o2b *= a2; m1 = n1; m2 = n2;
            sq[128 + lane] = p1; sq[192 + lane] = p2;
            const int nk = min(64, t - s0 + 1);
            const unsigned* vr = (const unsigned*)(AV + ((size_t)b * SEQ + s0) * BW + h * 128) + lane;
            for (int j = 0; j < nk; ++j) {
                const unsigned v = vr[(size_t)j * (BW / 2)];
                const float va = __uint_as_float(v << 16), vb = __uint_as_float(v & 0xffff0000u);
                const float q1 = sq[128 + j], q2 = sq[192 + j];
                o1a += q1 * va; o1b += q1 * vb; o2a += q2 * va; o2b += q2 * vb;
            }
        }
        const float i1 = 1.0f / l1, i2 = lam / l2;
        const float ya = o1a * i1 - o2a * i2, yb = o1b * i1 - o2b * i2;
        const float ss = wave_sum(ya * ya + yb * yb);
        const float rn = rsqrtf(ss * (1.0f / 128.0f) + RMS_EPS) * osc;
        ((unsigned*)(YA + mq * BW + h * 128))[lane] = pk2(ya * rn * asg[2 * lane], yb * rn * asg[2 * lane + 1]);
    }
}

__device__ __forceinline__ void nv_conv(const Args& A, int l, int wg, int nwg) {
    const int tid = opaque_tid(), lane = tid & 63, wave = tid >> 6;
    const bf16_t* Z = (const bf16_t*)(A.ws + WS_Z); bf16_t* YB = (bf16_t*)(A.ws + WS_YB);
    const float* cw = A.in[I_CW] + (size_t)l * 31 * BW; const float* cb = A.in[I_CB] + l * BW;
    const float* lg = A.in[I_CLG] + l * BW; const float* lb = A.in[I_CLB] + l * BW;
    const int c0 = lane * 8;
    for (int m = wg * NWAVES + wave; m < M; m += nwg * NWAVES) {
        const int t = m & (SEQ - 1);
        float acc[8];
#pragma unroll
        for (int e = 0; e < 8; ++e) acc[e] = cb[c0 + e];
        const int j0 = max(0, 30 - t);
        for (int j = j0; j < 31; ++j) {
            const uint4 v = *(const uint4*)(Z + (size_t)(m - 30 + j) * BW + c0);
            const float4 wa = *(const float4*)(cw + j * BW + c0), wb = *(const float4*)(cw + j * BW + c0 + 4);
            acc[0] += wa.x * __uint_as_float(v.x << 16); acc[1] += wa.y * __uint_as_float(v.x & 0xffff0000u);
            acc[2] += wa.z * __uint_as_float(v.y << 16); acc[3] += wa.w * __uint_as_float(v.y & 0xffff0000u);
            acc[4] += wb.x * __uint_as_float(v.z << 16); acc[5] += wb.y * __uint_as_float(v.z & 0xffff0000u);
            acc[6] += wb.z * __uint_as_float(v.w << 16); acc[7] += wb.w * __uint_as_float(v.w & 0xffff0000u);
        }
        float s = 0.f;
#pragma unroll
        for (int e = 0; e < 8; ++e) s += acc[e];
        const float mu = wave_sum(s) * (1.0f / BW);
        float q = 0.f;
#pragma unroll
        for (int e = 0; e < 8; ++e) { acc[e] -= mu; q += acc[e] * acc[e]; }
        const float rstd = rsqrtf(wave_sum(q) * (1.0f / BW) + LN_EPS);
        float o[8];
#pragma unroll
        for (int e = 0; e < 8; ++e) o[e] = siluf_(acc[e] * rstd * lg[c0 + e] + lb[c0 + e]);
        *(uint4*)(YB + (size_t)m * BW + c0) = make_uint4(pk2(o[0], o[1]), pk2(o[2], o[3]), pk2(o[4], o[5]), pk2(o[6], o[7]));
    }
}

__device__ __forceinline__ void nv_ret(const Args& A, int l, int wg, int nwg, float* sm) {
    const int tid = opaque_tid(), lane = tid & 63, wave = tid >> 6;
    float* sq = sm + wave * 256;
    const bf16_t* RQ = (const bf16_t*)(A.ws + WS_RQ); const bf16_t* RK = (const bf16_t*)(A.ws + WS_RK); const bf16_t* RV = (const bf16_t*)(A.ws + WS_RV);
    const bf16_t* RG = (const bf16_t*)(A.ws + WS_RG); bf16_t* YC = (bf16_t*)(A.ws + WS_YC);
    const float* gn = A.in[I_RGN] + l * 128;
    for (int it = wg * NWAVES + wave; it < BATCH * 4 * SEQ; it += nwg * NWAVES) {
        const int t = it & (SEQ - 1), h = (it >> 12) & 3, b = it >> 14;
        const size_t mq = (size_t)b * SEQ + t;
        const float l2g128 = 128.0f * log2_gamma(h);
        { const unsigned v = ((const unsigned*)(RQ + mq * BW + h * 128))[lane]; sq[2 * lane] = __uint_as_float(v << 16); sq[2 * lane + 1] = __uint_as_float(v & 0xffff0000u); }
        float oa = 0.f, ob = 0.f;
        const int ct = t >> 7;
        for (int s0 = 0; s0 <= t; s0 += 64) {
            const int s = s0 + lane; const bool valid = s <= t;
            float d = 0.f;
            if (valid) {
                const uint4* kr = (const uint4*)(RK + ((size_t)b * SEQ + s) * BW + h * 128);
#pragma unroll 2
                for (int c = 0; c < 16; ++c) {
                    const uint4 v = kr[c]; const unsigned w[4] = {v.x, v.y, v.z, v.w};
#pragma unroll
                    for (int e = 0; e < 4; ++e) { d += sq[c * 8 + 2 * e] * __uint_as_float(w[e] << 16) + sq[c * 8 + 2 * e + 1] * __uint_as_float(w[e] & 0xffff0000u); }
                }
                d *= exp2f(l2g128 * (float)(ct - (s >> 7)));
            }
            sq[128 + lane] = d;
            const int nk = min(64, t - s0 + 1);
            const unsigned* vr = (const unsigned*)(RV + ((size_t)b * SEQ + s0) * BW + h * 128) + lane;
            for (int j = 0; j < nk; ++j) {
                const unsigned v = vr[(size_t)j * (BW / 2)];
                const float a = sq[128 + j];
                oa += a * __uint_as_float(v << 16); ob += a * __uint_as_float(v & 0xffff0000u);
            }
        }
        const float ss = wave_sum(oa * oa + ob * ob);
        const float rn = rsqrtf(ss * (1.0f / 128.0f) + RMS_EPS);
        const unsigned gv = ((const unsigned*)(RG + mq * BW + h * 128))[lane];
        ((unsigned*)(YC + mq * BW + h * 128))[lane] = pk2(oa * rn * gn[2 * lane] * __uint_as_float(gv << 16), ob * rn * gn[2 * lane + 1] * __uint_as_float(gv & 0xffff0000u));
    }
}

__device__ __forceinline__ void nv_p3(const Args& A, int l, int wg, int nwg, float* sm) {
    float* sA = sm; float* sB = sm + 16 * 128;
    const int tid = opaque_tid(), tx = tid & 15, ty = tid >> 4;
    const float* Win = A.in[I_WIN] + (size_t)l * DM * DIN;
    const float* g1 = A.in[I_N1G] + l * DM;
    const float* bg = A.in[I_BGATE] + l * NGATE;
    const float* Wbr = A.in[I_WBR] + (size_t)l * 3 * BW * DM;
    const bf16_t* XB = (const bf16_t*)(A.ws + WS_XB);
    const float* rowss = (const float*)(A.ws + WS_ROWSS) + (size_t)(l == 0 ? 0 : 2) * M;
    bf16_t* Y = (bf16_t*)(A.ws + WS_Y);
    for (int it = wg; it < 128 * 16; it += nwg) {
        const int rt = it / 16, cg = it % 16, row0 = rt * 128;
        float y[4][4];
#pragma unroll
        for (int i = 0; i < 4; ++i)
#pragma unroll
            for (int j = 0; j < 4; ++j) y[i][j] = 0.f;
#pragma unroll 1
        for (int n = 0; n < 3; ++n) {
            float ga[4][4], pa[4][4];
            nv_core(ga, DM, ALbf{XB, DM, row0}, WLf32{Win, DIN, NU + n * DM + 64 * cg, NU + n * DM + 64 * cg + 32, g1}, sA, sB, tid);
            const bf16_t* br = (const bf16_t*)(A.ws + (n == 0 ? WS_YA : n == 1 ? WS_YB : WS_YC));
            nv_core(pa, BW, ALbf{br, BW, row0}, WLf32{Wbr + (size_t)n * BW * DM, DM, 64 * cg, 64 * cg + 32, nullptr}, sA, sB, tid);
#pragma unroll
            for (int i = 0; i < 4; ++i) {
                const float rstd = rsqrtf(rowss[row0 + ty * 4 + i] * (1.0f / DM) + RMS_EPS);
#pragma unroll
                for (int j = 0; j < 4; ++j) y[i][j] += sigmoidf_(ga[i][j] * rstd + bg[n * DM + 64 * cg + tx * 4 + j]) * pa[i][j];
            }
        }
#pragma unroll
        for (int i = 0; i < 4; ++i)
            *(uint2*)(Y + (size_t)(row0 + ty * 4 + i) * DM + 64 * cg + tx * 4) = make_uint2(pk2(y[i][0], y[i][1]), pk2(y[i][2], y[i][3]));
    }
}

__device__ __forceinline__ void nv_resid_gemm(const Args& A, const bf16_t* Am, int lda, int K, const float* W, const float* xold, float* rowss_next, int wg, int nwg, float* sm) {
    float* sA = sm; float* sB = sm + 16 * 128;
    const int tid = opaque_tid(), tx = tid & 15, ty = tid >> 4;
    bf16_t* XB = (bf16_t*)(A.ws + WS_XB);
    for (int it = wg; it < 128 * 16; it += nwg) {
        const int rt = it / 16, cg = it % 16, row0 = rt * 128;
        float acc[4][4];
        nv_core(acc, K, ALbf{Am, lda, row0}, WLf32{W, DM, 64 * cg, 64 * cg + 32, nullptr}, sA, sB, tid);
#pragma unroll
        for (int i = 0; i < 4; ++i) {
            const size_t off = (size_t)(row0 + ty * 4 + i) * DM + 64 * cg + tx * 4;
            const float4 xo = *(const float4*)(xold + off);
            const float4 xn = make_float4(xo.x + acc[i][0], xo.y + acc[i][1], xo.z + acc[i][2], xo.w + acc[i][3]);
            *(float4*)(A.out + off) = xn;
            *(uint2*)(XB + off) = make_uint2(pk2(xn.x, xn.y), pk2(xn.z, xn.w));
            float s = xn.x * xn.x + xn.y * xn.y + xn.z * xn.z + xn.w * xn.w;
            s += __shfl_xor(s, 1); s += __shfl_xor(s, 2); s += __shfl_xor(s, 4); s += __shfl_xor(s, 8);
            if (tx == 0 && rowss_next) atomicAdd(rowss_next + row0 + ty * 4 + i, s);
        }
    }
}

__device__ __forceinline__ void nv_p5(const Args& A, int l, int wg, int nwg, float* sm) {
    float* sA = sm; float* sB = sm + 16 * 128; float* sC = sB + 16 * 64;
    const int tid = opaque_tid(), tx = tid & 15, ty = tid >> 4;
    const float* W = A.in[I_WF1] + (size_t)l * DM * 2 * DFF;
    const float* g2 = A.in[I_N2G] + l * DM;
    const bf16_t* XB = (const bf16_t*)(A.ws + WS_XB);
    const float* rowss = (const float*)(A.ws + WS_ROWSS) + (size_t)(l == 0 ? 1 : 3) * M;
    bf16_t* MID = (bf16_t*)(A.ws + WS_MID);
    for (int it = wg; it < 128 * 88; it += nwg) {
        const int rt = it / 88, jj = it % 88, row0 = rt * 128;
        float acc[4][4];
        nv_core(acc, DM, ALbf{XB, DM, row0}, WLf32{W, 2 * DFF, 32 * jj, DFF + 32 * jj, g2}, sA, sB, tid);
#pragma unroll
        for (int i = 0; i < 4; ++i) {
            const int r = ty * 4 + i; const float rstd = rsqrtf(rowss[row0 + r] * (1.0f / DM) + RMS_EPS);
#pragma unroll
            for (int j = 0; j < 4; ++j) sC[r * 65 + tx * 4 + j] = acc[i][j] * rstd;
        }
        __syncthreads();
        const int r = tid >> 2, q4 = tid & 3;
        const float* cr = sC + r * 65;
        bf16_t* o = MID + (size_t)(row0 + r) * DFF + 32 * jj + q4 * 8;
#pragma unroll
        for (int j = 0; j < 8; ++j) o[j] = (bf16_t)f2bf(siluf_(cr[q4 * 8 + j]) * cr[32 + q4 * 8 + j]);
        __syncthreads();
    }
}


namespace pg8 {
typedef short bf16x8 __attribute__((ext_vector_type(8)));
typedef float f32x4 __attribute__((ext_vector_type(4)));
typedef unsigned u32x4 __attribute__((ext_vector_type(4)));
constexpr int BM = 256, BK = 64, HALF = 128, HTB = HALF * BK * 2, STAGE_BYTES = 8 * HTB, NXCD = 8, WGM = 4;
__host__ __device__ __forceinline__ int lds_byte(int r, int c) { const int st = (r >> 4) * 2 + (c >> 5), rr = r & 15, cc = c & 31, ob = rr * 64 + cc * 2; return st * 1024 + (ob ^ (((ob >> 9) & 1) << 5)); }
__host__ __device__ __forceinline__ void stage_rc(int b, int& R, int& C) { const int st = b / 1024, sb = b % 1024, swz = sb ^ (((sb >> 9) & 1) << 5); R = (st >> 1) * 16 + swz / 64; C = (st & 1) * 32 + (swz % 64) / 2; }
__host__ __device__ __forceinline__ int perm32(int rho) { const int n = rho >> 4, i = rho & 15; return 8 * (i >> 2) + 4 * n + (i & 3); }

struct GUnit { const char* A; const char* B; int lda2, ldb2, nt, pm, pn, kind; };

struct TileOrder {
    int nM, nN, nwg, G, c;
    __device__ __forceinline__ void init(int nM_, int nN_, int G_, int c_) { nM = nM_; nN = nN_; nwg = nM * nN; G = G_; c = c_; }
    __device__ __forceinline__ bool tile(int i, int& pm, int& pn) const {
        const long L = (long)i * G + c; if (L >= nwg) return false;
        int wgid = (int)L; { const int q = nwg / NXCD, r = nwg % NXCD, xcd = wgid % NXCD, off = wgid / NXCD; wgid = (xcd < r ? xcd * (q + 1) : r * (q + 1) + (xcd - r) * q) + off; }
        const int nig = WGM * nN, gid = wgid / nig, fm = gid * WGM, gsz = (nM - fm) < WGM ? (nM - fm) : WGM;
        pm = fm + ((wgid % nig) % gsz); pn = (wgid % nig) / gsz; return true;
    }
};

typedef float f32x2_t __attribute__((ext_vector_type(2))); typedef __bf16 bf16x2_t __attribute__((ext_vector_type(2)));
__device__ __forceinline__ unsigned cvt_pk_bf16(float lo, float hi) { f32x2_t v = {lo, hi}; bf16x2_t b = __builtin_convertvector(v, bf16x2_t); return __builtin_bit_cast(unsigned, b); }
__device__ __forceinline__ u32x4 pack8(const f32x4& a, const f32x4& b) { u32x4 w; w.x = cvt_pk_bf16(a[0], a[1]); w.y = cvt_pk_bf16(a[2], a[3]); w.z = cvt_pk_bf16(b[0], b[1]); w.w = cvt_pk_bf16(b[2], b[3]); return w; }

template <class Epi, class Sched>
__device__ __forceinline__ void gemm_phase(LAS unsigned char* lds, const Sched& S, const Epi& E) {
    const int tid = opaque_tid(), wid = __builtin_amdgcn_readfirstlane(tid >> 6), lane = tid & 63, wr = wid >> 2, wc = wid & 3, fr = lane & 15, fq = lane >> 4;
    const size_t kstep = (size_t)(BK * 2);
    const unsigned ldsw = (unsigned)wid * 1024u;
    const int aoff = lds_byte(wr * 64 + fr, fq * 8), boff = lds_byte(wc * 32 + fr, fq * 8);
#define PG8_SA(b, h) (((b) * 2 + (h)) * HTB)
#define PG8_SB(b, h) ((4 + (b) * 2 + (h)) * HTB)
#define PG8_STAGE(bufoff, gbase, voff) do { _Pragma("unroll") for (int _i = 0; _i < 2; ++_i) \
        __builtin_amdgcn_global_load_lds((const unsigned*)((const char*)(gbase) + (voff)[_i]), (LAS unsigned*)(lds + (bufoff) + ldsw + _i * 8192), 16, 0, 0); } while (0)
#define PG8_LDA(dst, b, h) do { _Pragma("unroll") for (int m = 0; m < 4; ++m) _Pragma("unroll") for (int k = 0; k < 2; ++k) dst[m][k] = *(const LAS bf16x8*)(lds + PG8_SA(b, h) + aoff + m * 2048 + k * 1024); } while (0)
#define PG8_LDB(dst, b, h) do { _Pragma("unroll") for (int n = 0; n < 2; ++n) _Pragma("unroll") for (int k = 0; k < 2; ++k) dst[n][k] = *(const LAS bf16x8*)(lds + PG8_SB(b, h) + boff + n * 2048 + k * 1024); } while (0)
#define PG8_MMA(ai, bj, At, Bt) do { __builtin_amdgcn_s_setprio(1); _Pragma("unroll") for (int m = 0; m < 4; ++m) _Pragma("unroll") for (int n = 0; n < 2; ++n) _Pragma("unroll") for (int k = 0; k < 2; ++k) \
        acc[ai][bj][m][n] = __builtin_amdgcn_mfma_f32_16x16x32_bf16(Bt[n][k], At[m][k], acc[ai][bj][m][n], 0, 0, 0); __builtin_amdgcn_s_setprio(0); } while (0)
#define PG8_WAIT_V(n) asm volatile("s_waitcnt vmcnt(" #n ")" ::: "memory")
#define PG8_WAIT_L(n) asm volatile("s_waitcnt lgkmcnt(" #n ")" ::: "memory")
#define PG8_BAR __builtin_amdgcn_s_barrier()
#define PG8_SCHED __builtin_amdgcn_sched_barrier(0)
    GUnit cur, nxt; int ui = 0;
    if (!S.next(0, cur)) return;
    f32x4 acc[2][2][4][2];
#pragma unroll
    for (int a = 0; a < 2; ++a)
#pragma unroll
        for (int b = 0; b < 2; ++b)
#pragma unroll
            for (int m = 0; m < 4; ++m)
#pragma unroll
                for (int n = 0; n < 2; ++n) acc[a][b][m][n] = (f32x4){0.f, 0.f, 0.f, 0.f};
    bf16x8 At[4][2], B0[2][2], B1[2][2];
#define PG8_VOFF(vA_, vB_, lda2_, ldb2_) do { int tt_ = tid; asm volatile("" : "+v"(tt_)); _Pragma("unroll") for (int i_ = 0; i_ < 2; ++i_) { int R_, C_; stage_rc(tt_ * 16 + i_ * 8192, R_, C_); \
        vA_[i_] = (unsigned)(R_ * (lda2_) + C_ * 2); vB_[i_] = (unsigned)(((R_ & ~31) + perm32(R_ & 31)) * (ldb2_) + C_ * 2); } } while (0)
    const char* cA = cur.A; const char* cB = cur.B; size_t hA = (size_t)HALF * cur.lda2, hB = (size_t)HALF * cur.ldb2;
    unsigned vA[2], vB[2]; PG8_VOFF(vA, vB, cur.lda2, cur.ldb2);
    {
    PG8_STAGE(PG8_SB(0, 0), cB, vB); PG8_STAGE(PG8_SB(0, 1), cB + hB, vB); PG8_STAGE(PG8_SA(0, 0), cA, vA); PG8_STAGE(PG8_SA(0, 1), cA + hA, vA);
    if (wr == 1) PG8_BAR;
    PG8_WAIT_V(2); PG8_BAR;
    PG8_STAGE(PG8_SB(1, 0), cB + kstep, vB); PG8_STAGE(PG8_SA(1, 0), cA + kstep, vA); PG8_STAGE(PG8_SB(1, 1), cB + hB + kstep, vB);
    PG8_WAIT_V(6); PG8_BAR; }
    for (;;) {
        const bool has_next = S.next(ui + 1, nxt);
        if (!has_next) nxt = cur;
        const size_t nhA = (size_t)HALF * nxt.lda2, nhB = (size_t)HALF * nxt.ldb2;
        const int nt = cur.nt;
        unsigned wA[2], wB[2];
        for (int t = 0; t < nt; t += 2) {
            const bool last = (t == nt - 2);
            const char* a1 = cA + (size_t)(t + 1) * kstep;
            const char* a2 = last ? nxt.A : cA + (size_t)(t + 2) * kstep; const char* b2 = last ? nxt.B : cB + (size_t)(t + 2) * kstep;
            const char* a3 = a2 + kstep; const char* b3 = b2 + kstep;
            const size_t whA = last ? nhA : hA, whB = last ? nhB : hB;
            PG8_LDB(B0, 0, 0); PG8_LDB(B1, 0, 1); PG8_SCHED; PG8_LDA(At, 0, 0);
            PG8_STAGE(PG8_SA(1, 1), a1 + hA, vA);
            if (last) PG8_VOFF(wA, wB, nxt.lda2, nxt.ldb2); else { wA[0] = vA[0]; wA[1] = vA[1]; wB[0] = vB[0]; wB[1] = vB[1]; }
            PG8_WAIT_V(8); PG8_WAIT_L(0); PG8_BAR; PG8_MMA(0, 0, At, B0); PG8_MMA(0, 1, At, B1); PG8_BAR; PG8_SCHED;
            PG8_LDA(At, 0, 1); PG8_STAGE(PG8_SB(0, 0), b2, wB); PG8_STAGE(PG8_SB(0, 1), b2 + whB, wB); PG8_STAGE(PG8_SA(0, 0), a2, wA);
            PG8_WAIT_V(8); PG8_WAIT_L(0); PG8_BAR; PG8_MMA(1, 0, At, B0); PG8_MMA(1, 1, At, B1); PG8_BAR; PG8_SCHED;
            PG8_LDB(B0, 1, 0); PG8_LDB(B1, 1, 1); PG8_SCHED; PG8_LDA(At, 1, 0); PG8_STAGE(PG8_SA(0, 1), a2 + whA, wA);
            PG8_WAIT_V(8); PG8_WAIT_L(0); PG8_BAR; PG8_MMA(0, 0, At, B0); PG8_MMA(0, 1, At, B1); PG8_BAR; PG8_SCHED;
            PG8_LDA(At, 1, 1); PG8_STAGE(PG8_SB(1, 0), b3, wB); PG8_STAGE(PG8_SB(1, 1), b3 + whB, wB); PG8_STAGE(PG8_SA(1, 0), a3, wA);
            PG8_WAIT_V(8); PG8_WAIT_L(0); PG8_BAR; PG8_MMA(1, 0, At, B0); PG8_MMA(1, 1, At, B1); PG8_BAR; PG8_SCHED;
        }
        if (wr == 0) PG8_BAR;
        { int fr_ = fr, fq_ = fq; asm volatile("" : "+v"(fr_), "+v"(fq_));
          E(acc, cur, wr, wc, fr_, fq_); }
        if (!has_next) break;
#pragma unroll
        for (int a = 0; a < 2; ++a)
#pragma unroll
            for (int b = 0; b < 2; ++b)
#pragma unroll
                for (int m = 0; m < 4; ++m)
#pragma unroll
                    for (int n = 0; n < 2; ++n) acc[a][b][m][n] = (f32x4){0.f, 0.f, 0.f, 0.f};
        cur = nxt; cA = cur.A; cB = cur.B; hA = nhA; hB = nhB;
        vA[0] = wA[0]; vA[1] = wA[1]; vB[0] = wB[0]; vB[1] = wB[1];
        ++ui;
        if (wr == 1) PG8_BAR;
    }
    PG8_WAIT_V(0);
    PG8_BAR;
#undef PG8_VOFF
#undef PG8_SA
#undef PG8_SB
#undef PG8_STAGE
#undef PG8_LDA
#undef PG8_LDB
#undef PG8_MMA
#undef PG8_WAIT_V
#undef PG8_WAIT_L
#undef PG8_BAR
#undef PG8_SCHED
}
}
using pg8::f32x4; using pg8::u32x4; using pg8::GUnit;

constexpr size_t WS_WB = 2 * MiB, WB_LAYER = 37 * MiB;
constexpr size_t WB_W1 = 0, WB_WG = 9 * MiB, WB_WBR = 15 * MiB, WB_WO = 18 * MiB, WB_WF1 = 20 * MiB, WB_WF2 = 31 * MiB;
constexpr size_t WS_GSCR = 190 * MiB;
static_assert(WS_WB + 2 * WB_LAYER <= WS_XB, "weights vs XB");

__device__ __forceinline__ int p1_src_col(int tile, int p) {
    if (tile < 4) return (tile >> 1) * 512 + (tile & 1) * 256 + 64 * ((p >> 5) & 3) + 32 * (p >> 7);
    if (tile < 6) return 1024 + (tile - 4) * 256 + p;
    if (tile < 10) return (p < 128) ? 1536 + 128 * (tile - 6) + p : 2048 + 128 * (tile - 6) + (p - 128);
    return 2560 + (tile - 10) * 256 + p;
}
__device__ __forceinline__ void p0_titem(const float* W, int ldw, int src0, const float* g, bf16_t* WT, int K, int prow0, int k0, LAS float* scr, int lane) {
    const int kr = lane >> 3, cq = (lane & 7) * 4;
    f32x4 v[8];
#pragma unroll
    for (int i = 0; i < 8; ++i) v[i] = *(const f32x4*)(W + (size_t)(k0 + 8 * i + kr) * ldw + src0 + cq);
    if (g) {
#pragma unroll
        for (int i = 0; i < 8; ++i) v[i] = v[i] * g[k0 + 8 * i + kr];
    }
#pragma unroll
    for (int i = 0; i < 8; ++i) { LAS float* d = scr + (8 * i + kr) * 33 + cq; d[0] = v[i][0]; d[1] = v[i][1]; d[2] = v[i][2]; d[3] = v[i][3]; }
    asm volatile("s_waitcnt lgkmcnt(0)" ::: "memory");
    const int c = lane & 7;
#pragma unroll
    for (int j = 0; j < 4; ++j) { const int n = (lane >> 3) + 8 * j; const LAS float* s_ = scr + (8 * c) * 33 + n;
        u32x4 o; o.x = pg8::cvt_pk_bf16(s_[0 * 33], s_[1 * 33]); o.y = pg8::cvt_pk_bf16(s_[2 * 33], s_[3 * 33]); o.z = pg8::cvt_pk_bf16(s_[4 * 33], s_[5 * 33]); o.w = pg8::cvt_pk_bf16(s_[6 * 33], s_[7 * 33]);
        *(u32x4*)(WT + (size_t)(prow0 + n) * K + k0 + 8 * c) = o; }
    asm volatile("s_waitcnt lgkmcnt(0)" ::: "memory");
}
constexpr int NI_W1 = 144 * 16, NI_WG = 96 * 16, NI_WBR = 3 * 32 * 8, NI_WO = 32 * 16, NI_F1 = 176 * 16, NI_F2 = 32 * 44;
constexpr int PER_LAYER = NI_W1 + NI_WG + NI_WBR + NI_WO + NI_F1 + NI_F2;
__device__ __forceinline__ void fast_p0_weights(const Args& A, int wg, int nwg, LAS float* sm, int item_lo, int item_hi) {
    const int tid = opaque_tid(), lane = tid & 63, wave = tid >> 6;
    LAS float* scr = sm + wave * (64 * 33);
    for (int it = item_lo + wg * NWAVES + wave; it < item_hi; it += nwg * NWAVES) {
        const int l = it / PER_LAYER; int r = it % PER_LAYER;
        unsigned char* wb = A.ws + WS_WB + (size_t)l * WB_LAYER;
        const float* Win = A.in[I_WIN] + (size_t)l * DM * DIN; const float* g1 = A.in[I_N1G] + l * DM;
        if (r < NI_W1) { const int rb = r / 16, kb = r % 16; p0_titem(Win, DIN, p1_src_col(rb >> 3, (rb & 7) * 32), g1, (bf16_t*)(wb + WB_W1), DM, 32 * rb, 64 * kb, scr, lane); continue; } r -= NI_W1;
        if (r < NI_WG) { const int rb = r / 16, kb = r % 16; p0_titem(Win, DIN, NU + 32 * rb, g1, (bf16_t*)(wb + WB_WG), DM, 32 * rb, 64 * kb, scr, lane); continue; } r -= NI_WG;
        if (r < NI_WBR) { const int n = r / 256, rr = r % 256, rb = rr / 8, kb = rr % 8;
            p0_titem(A.in[I_WBR] + ((size_t)l * 3 + n) * BW * DM, DM, 32 * rb, nullptr, (bf16_t*)(wb + WB_WBR) + (size_t)n * DM * BW, BW, 32 * rb, 64 * kb, scr, lane); continue; } r -= NI_WBR;
        if (r < NI_WO) { const int rb = r / 16, kb = r % 16; p0_titem(A.in[I_WOUT] + (size_t)l * DM * DM, DM, 32 * rb, nullptr, (bf16_t*)(wb + WB_WO), DM, 32 * rb, 64 * kb, scr, lane); continue; } r -= NI_WO;
        if (r < NI_F1) { const int rb = r / 16, kb = r % 16, tile = rb >> 3, p = (rb & 7) * 32; const int src = (p < 128) ? 128 * tile + p : DFF + 128 * tile + (p - 128);
            p0_titem(A.in[I_WF1] + (size_t)l * DM * 2 * DFF, 2 * DFF, src, A.in[I_N2G] + l * DM, (bf16_t*)(wb + WB_WF1), DM, 32 * rb, 64 * kb, scr, lane); continue; } r -= NI_F1;
        { const int rb = r / 44, kb = r % 44; p0_titem(A.in[I_WF2] + (size_t)l * DFF * DM, DM, 32 * rb, nullptr, (bf16_t*)(wb + WB_WF2), DFF, 32 * rb, 64 * kb, scr, lane); }
    }
}

struct SchedPlain {
    pg8::TileOrder o; const char* A; const char* B; int lda2, ldb2, nt;
    __device__ __forceinline__ bool next(int i, GUnit& u) const {
        int pm, pn; if (!o.tile(i, pm, pn)) return false;
        u.A = A + (size_t)pm * 256 * lda2; u.B = B + (size_t)pn * 256 * ldb2; u.lda2 = lda2; u.ldb2 = ldb2; u.nt = nt; u.pm = pm; u.pn = pn; u.kind = 0; return true;
    }
};
struct SchedP3 {
    pg8::TileOrder o; const char* ws; const char* wb;
    __device__ __forceinline__ bool next(int i, GUnit& u) const {
        int pm, pn; if (!o.tile(i / 6, pm, pn)) return false;
        const int sub = i % 6, n = sub >> 1; const bool proj = (sub & 1) != 0;
        u.pm = pm; u.pn = pn; u.kind = sub;
        const size_t aoff = !proj ? WS_XB : (n == 0 ? WS_YA : (n == 1 ? WS_YB : WS_YC));
        const int ld2 = proj ? BW * 2 : DM * 2;
        u.A = ws + aoff + (size_t)pm * 256 * ld2; u.lda2 = ld2;
        u.B = wb + (proj ? WB_WBR : WB_WG) + (size_t)(n * DM + pn * 256) * ld2; u.ldb2 = ld2; u.nt = ld2 >> 7;
        return true;
    }
};

__device__ __forceinline__ float fast_sigmoid(float x) { return __builtin_amdgcn_rcpf(1.0f + __builtin_amdgcn_exp2f(-LOG2E * x)); }
__device__ __forceinline__ f32x4 sig4(const f32x4& v) { return (f32x4){fast_sigmoid(v[0]), fast_sigmoid(v[1]), fast_sigmoid(v[2]), fast_sigmoid(v[3])}; }
__device__ __forceinline__ float sigx(float z) { return __builtin_amdgcn_rcpf(1.0f + __builtin_amdgcn_exp2f(z)); }
__device__ __forceinline__ f32x4 sigx4(const f32x4& v) { return (f32x4){sigx(v[0]), sigx(v[1]), sigx(v[2]), sigx(v[3])}; }
__device__ __forceinline__ float dot4(const f32x4& a) { return (a[0] * a[0] + a[1] * a[1]) + (a[2] * a[2] + a[3] * a[3]); }
__device__ __forceinline__ void gst16(void* p, const u32x4& v) { *(GAS u32x4*)p = v; }
__device__ __forceinline__ u32x4 gld16(const void* p) { return *(const GAS u32x4*)p; }
__device__ __forceinline__ f32x4 gld4f(const float* p) { return *(const GAS f32x4*)p; }
#define EPI_RSTD8(rs, rowss_, u_, wr_, fr_) float rs[8]; do { const GAS float* rp_ = (const GAS float*)(rowss_) + (u_).pm * 256 + (wr_) * 64 + (fr_); \
    _Pragma("unroll") for (int i_ = 0; i_ < 8; ++i_) rs[i_] = rp_[(i_ >> 2) * 128 + (i_ & 3) * 16]; \
    _Pragma("unroll") for (int i_ = 0; i_ < 8; ++i_) rs[i_] = rsqrtf(rs[i_] * (1.0f / DM) + RMS_EPS); } while (0)

struct EpiP1 {
    unsigned char* ws; const float* rowss; const float* qg; const float* kg;
    __device__ __forceinline__ void operator()(const f32x4 (&acc)[2][2][4][2], const GUnit& u, int wr, int wc, int fr, int fq) const {
        const int pn = u.pn;
        if (pn < 4) {
            const bool isq = pn < 2; const float* gg = isq ? qg : kg; const float sc = isq ? QSCALE : 1.0f;
            const f32x4 ga0 = gld4f(gg + 8 * fq), ga1 = gld4f(gg + 8 * fq + 4), gb0 = gld4f(gg + 32 + 8 * fq), gb1 = gld4f(gg + 32 + 8 * fq + 4);
            EPI_RSTD8(rs, rowss, u, wr, fr);
            bf16_t* base = (bf16_t*)(ws + (isq ? WS_AQ : WS_AK)) + (pn & 1) * 256 + 64 * wc + 8 * fq;
#pragma unroll
            for (int ai = 0; ai < 2; ++ai)
#pragma unroll
                for (int m = 0; m < 4; ++m) {
                    const int row = u.pm * 256 + ai * 128 + wr * 64 + m * 16 + fr;
                    const float rstd = rs[ai * 4 + m];
                    const f32x4 a0 = acc[ai][0][m][0] * rstd, a1 = acc[ai][0][m][1] * rstd, b0 = acc[ai][1][m][0] * rstd, b1 = acc[ai][1][m][1] * rstd;
                    float ss = (dot4(a0) + dot4(a1)) + (dot4(b0) + dot4(b1));
                    ss += __shfl_xor(ss, 16); ss += __shfl_xor(ss, 32);
                    const float rn = rsqrtf(ss * (1.0f / 64.0f) + RMS_EPS) * sc;
                    bf16_t* o = base + (size_t)row * BW;
                    gst16(o, pg8::pack8(a0 * ga0 * rn, a1 * ga1 * rn));
                    gst16(o + 32, pg8::pack8(b0 * gb0 * rn, b1 * gb1 * rn));
                }
        } else if (pn >= 6 && pn < 10) {
            EPI_RSTD8(rs, rowss, u, wr, fr);
            bf16_t* base = (bf16_t*)(ws + WS_Z) + 128 * (pn - 6) + 32 * wc + 8 * fq;
#pragma unroll
            for (int ai = 0; ai < 2; ++ai)
#pragma unroll
                for (int m = 0; m < 4; ++m) {
                    const int row = u.pm * 256 + ai * 128 + wr * 64 + m * 16 + fr;
                    const float rstd = rs[ai * 4 + m], nr = -LOG2E * rstd;
                    const f32x4 z0 = acc[ai][0][m][0] * rstd * sigx4(acc[ai][1][m][0] * nr), z1 = acc[ai][0][m][1] * rstd * sigx4(acc[ai][1][m][1] * nr);
                    gst16(base + (size_t)row * BW, pg8::pack8(z0, z1));
                }
        } else {
            size_t wsoff; int kind;
            if (pn < 6) { wsoff = WS_AV; kind = 0; } else if (pn < 12) { wsoff = WS_RQ; kind = 1; } else if (pn < 14) { wsoff = WS_RK; kind = 2; } else if (pn < 16) { wsoff = WS_RV; kind = 0; } else { wsoff = WS_RG; kind = 3; }
            EPI_RSTD8(rs, rowss, u, wr, fr);
            bf16_t* base = (bf16_t*)(ws + wsoff) + (pn & 1) * 256 + 32 * wc + 8 * fq;
            const float l2g0 = log2_gamma((pn & 1) * 2), l2g1 = log2_gamma((pn & 1) * 2 + 1);
#pragma unroll
            for (int ai = 0; ai < 2; ++ai)
#pragma unroll
                for (int m = 0; m < 4; ++m) {
                    const int row = u.pm * 256 + ai * 128 + wr * 64 + m * 16 + fr;
                    const float rstd = rs[ai * 4 + m];
                    const float tp = (float)(row & 127);
                    float f0 = rstd, f1 = rstd;
                    if (kind == 1) { f0 *= exp2f(tp * l2g0); f1 *= exp2f(tp * l2g1); }
                    if (kind == 2) { f0 *= 0.08838834764831845f * exp2f(-tp * l2g0); f1 *= 0.08838834764831845f * exp2f(-tp * l2g1); }
                    f32x4 a0 = acc[ai][0][m][0] * f0, a1 = acc[ai][0][m][1] * f0, b0 = acc[ai][1][m][0] * f1, b1 = acc[ai][1][m][1] * f1;
                    if (kind == 3) { a0 = a0 * sigx4(a0 * -LOG2E); a1 = a1 * sigx4(a1 * -LOG2E); b0 = b0 * sigx4(b0 * -LOG2E); b1 = b1 * sigx4(b1 * -LOG2E); }
                    bf16_t* o = base + (size_t)row * BW;
                    gst16(o, pg8::pack8(a0, a1));
                    gst16(o + 128, pg8::pack8(b0, b1));
                }
        }
    }
};
struct EpiP3 {
    const float* rowss; const float* bg; unsigned char* gscr; bf16_t* Y;
    __device__ __forceinline__ void operator()(const f32x4 (&acc)[2][2][4][2], const GUnit& u, int wr, int wc, int fr, int fq) const {
        const int n = u.kind >> 1;
        u32x4* gs = (u32x4*)gscr + ((wr * 4 + wc) * 64 + fq * 16 + fr);
        if (!(u.kind & 1)) {
            const float* bp = bg + n * DM + u.pn * 256 + 32 * wc + 8 * fq;
            const f32x4 ba0 = gld4f(bp) * -LOG2E, ba1 = gld4f(bp + 4) * -LOG2E, bb0 = gld4f(bp + 128) * -LOG2E, bb1 = gld4f(bp + 132) * -LOG2E;
            EPI_RSTD8(rs, rowss, u, wr, fr);
#pragma unroll
            for (int ai = 0; ai < 2; ++ai)
#pragma unroll
                for (int m = 0; m < 4; ++m) {
                    const float nr = -LOG2E * rs[ai * 4 + m];
                    gst16(gs + ((ai * 4 + m) * 2 + 0) * NTHREADS, pg8::pack8(sigx4(acc[ai][0][m][0] * nr + ba0), sigx4(acc[ai][0][m][1] * nr + ba1)));
                    gst16(gs + ((ai * 4 + m) * 2 + 1) * NTHREADS, pg8::pack8(sigx4(acc[ai][1][m][0] * nr + bb0), sigx4(acc[ai][1][m][1] * nr + bb1)));
                }
        } else {
            bf16_t* yb = Y + (size_t)(u.pm * 256 + wr * 64 + fr) * DM + u.pn * 256 + 32 * wc + 8 * fq;
            u32x4 gq[2][2][2], pq[2][2][2];
#define P3_LOAD(q_, b_) do { _Pragma("unroll") for (int mm = 0; mm < 2; ++mm) _Pragma("unroll") for (int bj = 0; bj < 2; ++bj) { const int ai_ = (q_) >> 1, m_ = ((q_) & 1) * 2 + mm; \
            gq[b_][mm][bj] = gld16(gs + ((ai_ * 4 + m_) * 2 + bj) * NTHREADS); \
            if (n > 0) pq[b_][mm][bj] = gld16(yb + (size_t)(ai_ * 128 + m_ * 16) * DM + 128 * bj); } } while (0)
            P3_LOAD(0, 0);
#pragma unroll
            for (int q = 0; q < 4; ++q) {
                if (q + 1 < 4) { if (q & 1) P3_LOAD(q + 1, 0); else P3_LOAD(q + 1, 1); }
#pragma unroll
                for (int mm = 0; mm < 2; ++mm)
#pragma unroll
                    for (int bj = 0; bj < 2; ++bj) {
                        const int ai = q >> 1, m = (q & 1) * 2 + mm;
                        const u32x4 g = gq[q & 1][mm][bj];
                        f32x4 y0 = acc[ai][bj][m][0], y1 = acc[ai][bj][m][1];
                        y0[0] *= __uint_as_float(g.x << 16); y0[1] *= __uint_as_float(g.x & 0xffff0000u); y0[2] *= __uint_as_float(g.y << 16); y0[3] *= __uint_as_float(g.y & 0xffff0000u);
                        y1[0] *= __uint_as_float(g.z << 16); y1[1] *= __uint_as_float(g.z & 0xffff0000u); y1[2] *= __uint_as_float(g.w << 16); y1[3] *= __uint_as_float(g.w & 0xffff0000u);
                        if (n > 0) { const u32x4 p = pq[q & 1][mm][bj];
                            y0[0] += __uint_as_float(p.x << 16); y0[1] += __uint_as_float(p.x & 0xffff0000u); y0[2] += __uint_as_float(p.y << 16); y0[3] += __uint_as_float(p.y & 0xffff0000u);
                            y1[0] += __uint_as_float(p.z << 16); y1[1] += __uint_as_float(p.z & 0xffff0000u); y1[2] += __uint_as_float(p.w << 16); y1[3] += __uint_as_float(p.w & 0xffff0000u); }
                        gst16(yb + (size_t)(ai * 128 + m * 16) * DM + 128 * bj, pg8::pack8(y0, y1));
                    }
            }
#undef P3_LOAD
        }
    }
};
struct EpiResid {
    bf16_t* XB; float* out; float* rowss_next;
    __device__ __forceinline__ void operator()(const f32x4 (&acc)[2][2][4][2], const GUnit& u, int wr, int wc, int fr, int fq) const {
        const size_t off0 = (size_t)(u.pm * 256 + wr * 64 + fr) * DM + u.pn * 256 + 32 * wc + 8 * fq;
        u32x4 xo[2][4][2];
#pragma unroll
        for (int ai = 0; ai < 2; ++ai)
#pragma unroll
            for (int m = 0; m < 4; ++m)
#pragma unroll
                for (int bj = 0; bj < 2; ++bj) xo[ai][m][bj] = gld16(XB + off0 + (size_t)(ai * 128 + m * 16) * DM + 128 * bj);
#pragma unroll
        for (int ai = 0; ai < 2; ++ai)
#pragma unroll
            for (int m = 0; m < 4; ++m) {
                const int row = u.pm * 256 + ai * 128 + wr * 64 + m * 16 + fr;
                float ss = 0.f;
#pragma unroll
                for (int bj = 0; bj < 2; ++bj) {
                    const size_t off = off0 + (size_t)(ai * 128 + m * 16) * DM + 128 * bj;
                    const u32x4 p = xo[ai][m][bj];
                    f32x4 x0 = acc[ai][bj][m][0], x1 = acc[ai][bj][m][1];
                    x0[0] += __uint_as_float(p.x << 16); x0[1] += __uint_as_float(p.x & 0xffff0000u); x0[2] += __uint_as_float(p.y << 16); x0[3] += __uint_as_float(p.y & 0xffff0000u);
                    x1[0] += __uint_as_float(p.z << 16); x1[1] += __uint_as_float(p.z & 0xffff0000u); x1[2] += __uint_as_float(p.w << 16); x1[3] += __uint_as_float(p.w & 0xffff0000u);
                    if (out) { *(GAS f32x4*)(out + off) = x0; *(GAS f32x4*)(out + off + 4) = x1; }
                    else { gst16(XB + off, pg8::pack8(x0, x1)); ss += dot4(x0) + dot4(x1); }
                }
                if (!out) { ss += __shfl_xor(ss, 16); ss += __shfl_xor(ss, 32); if (fq == 0) atomicAdd(rowss_next + row, ss); }
            }
    }
};
struct EpiSwiglu {
    const float* rowss; bf16_t* MID;
    __device__ __forceinline__ void operator()(const f32x4 (&acc)[2][2][4][2], const GUnit& u, int wr, int wc, int fr, int fq) const {
        bf16_t* base = MID + 128 * u.pn + 32 * wc + 8 * fq;
        EPI_RSTD8(rs, rowss, u, wr, fr);
#pragma unroll
        for (int ai = 0; ai < 2; ++ai)
#pragma unroll
            for (int m = 0; m < 4; ++m) {
                const int row = u.pm * 256 + ai * 128 + wr * 64 + m * 16 + fr;
                const float rstd = rs[ai * 4 + m]; const float nr = -LOG2E * rstd, r2 = rstd * rstd;
                const f32x4 a0 = acc[ai][0][m][0], a1 = acc[ai][0][m][1];
                gst16(base + (size_t)row * DFF, pg8::pack8(a0 * acc[ai][1][m][0] * r2 * sigx4(a0 * nr), a1 * acc[ai][1][m][1] * r2 * sigx4(a1 * nr)));
            }
    }
};

__device__ __forceinline__ void fast_gemm(const Args& A, int l, int k, LAS unsigned char* lds) {
    const int G = gridDim.x, c = blockIdx.x;
    const char* wb = (const char*)(A.ws + WS_WB + (size_t)l * WB_LAYER);
    const char* XB = (const char*)(A.ws + WS_XB);
    float* rowss = (float*)(A.ws + WS_ROWSS);
    if (k == 0) {
        SchedPlain S; S.o.init(M / 256, NU / 256, G, c); S.A = XB; S.lda2 = DM * 2; S.B = wb + WB_W1; S.ldb2 = DM * 2; S.nt = DM / 64;
        EpiP1 E{A.ws, rowss + (size_t)(l == 0 ? 0 : 2) * M, A.in[I_QG] + l * 64, A.in[I_KG] + l * 64};
        pg8::gemm_phase(lds, S, E);
        if (l == 0) { const int full = S.o.nwg / G, rem = S.o.nwg - full * G;
            if (rem > 0 && c >= rem) fast_p0_weights(A, c - rem, G - rem, (LAS float*)lds, NI_W1, PER_LAYER);
            else if (rem == 0) fast_p0_weights(A, c, G, (LAS float*)lds, NI_W1, PER_LAYER); }
    } else if (k == 2) {
        SchedP3 S; S.o.init(M / 256, DM / 256, G, c); S.ws = (const char*)A.ws; S.wb = wb;
        EpiP3 E{rowss + (size_t)(l == 0 ? 0 : 2) * M, A.in[I_BGATE] + l * NGATE, A.ws + WS_GSCR + (size_t)blockIdx.x * (128 * 1024), (bf16_t*)(A.ws + WS_Y)};
        pg8::gemm_phase(lds, S, E);
    } else if (k == 3) {
        SchedPlain S; S.o.init(M / 256, DM / 256, G, c); S.A = (const char*)(A.ws + WS_Y); S.lda2 = DM * 2; S.B = wb + WB_WO; S.ldb2 = DM * 2; S.nt = DM / 64;
        EpiResid E{(bf16_t*)(A.ws + WS_XB), nullptr, rowss + (size_t)(l == 0 ? 1 : 3) * M};
        pg8::gemm_phase(lds, S, E);
    } else if (k == 4) {
        SchedPlain S; S.o.init(M / 256, 2 * DFF / 256, G, c); S.A = XB; S.lda2 = DM * 2; S.B = wb + WB_WF1; S.ldb2 = DM * 2; S.nt = DM / 64;
        EpiSwiglu E{rowss + (size_t)(l == 0 ? 1 : 3) * M, (bf16_t*)(A.ws + WS_MID)};
        pg8::gemm_phase(lds, S, E);
        if (l == 0) { const int full = S.o.nwg / G, rem = S.o.nwg - full * G;
            if (rem > 0 && c >= rem) fast_p0_weights(A, c - rem, G - rem, (LAS float*)lds, PER_LAYER, DEPTH * PER_LAYER);
            else if (rem == 0) fast_p0_weights(A, c, G, (LAS float*)lds, PER_LAYER, DEPTH * PER_LAYER); }
    } else {
        SchedPlain S; S.o.init(M / 256, DM / 256, G, c); S.A = (const char*)(A.ws + WS_MID); S.lda2 = DFF * 2; S.B = wb + WB_WF2; S.ldb2 = DFF * 2; S.nt = DFF / 64;
        EpiResid E{(bf16_t*)(A.ws + WS_XB), l + 1 < DEPTH ? nullptr : A.out, rowss + (size_t)2 * M};
        pg8::gemm_phase(lds, S, E);
    }
}


namespace mx {
typedef short bf16x8 __attribute__((ext_vector_type(8)));
typedef short s16x4 __attribute__((ext_vector_type(4)));
typedef short v4i16_t __attribute__((ext_vector_type(4)));
typedef float f32x16 __attribute__((ext_vector_type(16)));
typedef LAS unsigned char* lptr;
typedef unsigned u32x2 __attribute__((ext_vector_type(2)));
__device__ __forceinline__ int crow(int r, int hi) { return (r & 3) + 8 * (r >> 2) + 4 * hi; }
__device__ __forceinline__ s16x4 vtr(lptr p) { return __builtin_bit_cast(s16x4, __builtin_amdgcn_ds_read_tr16_b64_v4i16((LAS v4i16_t*)p)); }
__device__ __forceinline__ bf16x8 cat8(s16x4 lo, s16x4 hi) { return (bf16x8){lo[0], lo[1], lo[2], lo[3], hi[0], hi[1], hi[2], hi[3]}; }
__device__ __forceinline__ bf16x8 ld8(lptr p) { return *(const LAS bf16x8*)p; }
__device__ __forceinline__ float swap_max(float v) { auto rr = __builtin_amdgcn_permlane32_swap(__float_as_uint(v), __float_as_uint(v), false, false); return fmaxf(__uint_as_float(rr[0]), __uint_as_float(rr[1])); }
__device__ __forceinline__ float swap_sum(float v) { auto rr = __builtin_amdgcn_permlane32_swap(__float_as_uint(v), __float_as_uint(v), false, false); return __uint_as_float(rr[0]) + __uint_as_float(rr[1]); }
__device__ __forceinline__ bf16x8 pack_p(const f32x16& p, int b) {
    pg8::u32x4 w; w.x = pg8::cvt_pk_bf16(p[b], p[b + 1]); w.y = pg8::cvt_pk_bf16(p[b + 2], p[b + 3]); w.z = pg8::cvt_pk_bf16(p[b + 4], p[b + 5]); w.w = pg8::cvt_pk_bf16(p[b + 6], p[b + 7]);
    return __builtin_bit_cast(bf16x8, w);
}
#define MFMA32(a, b, c) __builtin_amdgcn_mfma_f32_32x32x16_bf16((a), (b), (c), 0, 0, 0)
#define DPP_ADD(v, ctrl, rmask) ((v) + __builtin_bit_cast(float, __builtin_amdgcn_update_dpp(0, __builtin_bit_cast(int, (v)), (ctrl), (rmask), 0xf, false)))
__device__ __forceinline__ float half_sum32(float v) {
    v = DPP_ADD(v, 0xB1, 0xf);
    v = DPP_ADD(v, 0x4E, 0xf);
    v = DPP_ADD(v, 0x141, 0xf);
    v = DPP_ADD(v, 0x140, 0xf);
    v = DPP_ADD(v, 0x142, 0xa);
    return v;
}

#define LDS_BAR() asm volatile("s_waitcnt lgkmcnt(0)\n\ts_barrier" ::: "memory")

constexpr int A_KSLOT = 8192, A_KBUF = 16384, A_V0 = 32768, A_VBUF = 16384, A_STAGE = 98304, A_WS = 131072 + 4096;
template <int ABL>
__device__ __forceinline__ void attn_unit(const Args& A, int l, int b, int h, int qb, lptr lds) {
    const int tid = opaque_tid(), lane = tid & 63, r32 = lane & 31, hi = lane >> 5; const int wid = __builtin_amdgcn_readfirstlane(tid >> 6), mp = wid >> 2, qw = wid & 3;
    const bf16_t* AQ = (const bf16_t*)(A.ws + WS_AQ); const bf16_t* AK = (const bf16_t*)(A.ws + WS_AK); const bf16_t* AV = (const bf16_t*)(A.ws + WS_AV);
    const size_t rowbase = (size_t)b * SEQ;
    const int q0 = 128 * qb + 32 * qw;
    const int NT = 2 * (qb + 1);
    LAS float* wsf = (LAS float*)(lds + A_WS) + wid * 64;
    const bf16_t* ksrc[2]; const bf16_t* vsrc[2]; int kdst[2], vdst[2];
#pragma unroll
    for (int j = 0; j < 2; ++j) { const int P = 2 * wid + j;
        ksrc[j] = AK + (rowbase + 8 * (P & 7) + (lane >> 3)) * BW + h * 128 + (P >> 3) * 64 + (((lane & 7) ^ (lane >> 3)) * 8);
        vsrc[j] = AV + (rowbase + 8 * (P >> 1) + ((lane >> 2) & 7)) * BW + h * 128 + 32 * (2 * (P & 1) + (lane >> 5)) + 8 * (lane & 3);
        kdst[j] = (P >> 3) * A_KSLOT + (P & 7) * 1024; vdst[j] = (P >> 1) * 2048 + (P & 1) * 1024; }
#define ATT_DMA(t, kb_, vb_) do { _Pragma("unroll") for (int j = 0; j < 2; ++j) { \
        __builtin_amdgcn_global_load_lds((const unsigned*)(ksrc[j] + (size_t)64 * (t) * BW), (LAS unsigned*)((kb_) + kdst[j]), 16, 0, 0); \
        __builtin_amdgcn_global_load_lds((const unsigned*)(vsrc[j] + (size_t)64 * (t) * BW), (LAS unsigned*)((vb_) + vdst[j]), 16, 0, 0); } } while (0)
    bf16x8 qf[4];
#pragma unroll
    for (int d0 = 0; d0 < 4; ++d0) qf[d0] = *(const bf16x8*)(AQ + (rowbase + q0 + r32) * BW + h * 128 + mp * 64 + d0 * 16 + hi * 8);
    const float slope2 = exp2f(-2.0f * (float)(h + 1)) * LOG2E;
    float m = 0.f, lsum = 0.f; bool first = true;
    f32x16 o[4];
#pragma unroll
    for (int d0 = 0; d0 < 4; ++d0) o[d0] = f32x16{};
    bf16x8 pa0 = bf16x8{}, pa1 = bf16x8{}, pa2 = bf16x8{}, pa3 = bf16x8{};
    const int kroff = mp * A_KSLOT + r32 * 128;
    const int vroff = (4 * hi + ((lane & 15) >> 2)) * 64 + ((lane >> 4) & 1) * 32 + (lane & 3) * 8;
#define ATT_A(P0, P1, t, kb_) do { \
        const float sb_ = slope2 * (float)(64 * (t) + 4 * hi - (q0 + r32)) - m; \
        _Pragma("unroll") for (int r = 0; r < 16; ++r) { P0[r] = fmaf(slope2, (float)((r & 3) + 8 * (r >> 2)), sb_); P1[r] = fmaf(slope2, (float)(32 + (r & 3) + 8 * (r >> 2)), sb_); } \
        _Pragma("unroll") for (int d0 = 0; d0 < 4; ++d0) { const int ch_ = ((2 * d0 + hi) ^ (r32 & 7)) * 16; \
            P0 = MFMA32(ld8((kb_) + kroff + ch_), qf[d0], P0); P1 = MFMA32(ld8((kb_) + kroff + 32 * 128 + ch_), qf[d0], P1); } } while (0)
#define ATT_MASK(P0, P1, t) do { const int krel_ = 64 * (t) + 4 * hi - (q0 + r32); \
        _Pragma("unroll") for (int r = 0; r < 16; ++r) { const int d_ = krel_ + (r & 3) + 8 * (r >> 2); if (d_ > 0) P0[r] = -INFINITY; if (d_ + 32 > 0) P1[r] = -INFINITY; } } while (0)
    __syncthreads();
    {
        *(LAS u32x4*)(lds + A_V0 + 3 * A_VBUF + tid * 32) = (u32x4){0u, 0u, 0u, 0u}; *(LAS u32x4*)(lds + A_V0 + 3 * A_VBUF + tid * 32 + 16) = (u32x4){0u, 0u, 0u, 0u}; }
    ATT_DMA(NT - 1, lds, lds + A_V0);
    ATT_DMA(NT - 2, lds + A_KBUF, lds + A_V0 + A_VBUF);
    __syncthreads();
    f32x16 s0, s1;
    ATT_A(s0, s1, NT - 1, lds); ATT_MASK(s0, s1, NT - 1);
    __syncthreads();
    bool resc = false;
#define ATT_RESC() do { if (resc) { _Pragma("unroll") for (int r = 0; r < 16; ++r) { const float a = wsf[crow(r, hi)]; _Pragma("unroll") for (int d0 = 0; d0 < 4; ++d0) o[d0][r] *= a; } resc = false; } } while (0)
#define ATT_TRIP(i, S0, S1, N0, N1, PR0, PR1, PR2, PR3, PW0, PW1, PW2, PW3) do { \
        const int t = NT - 1 - (i); \
        if ((i) == 1) ATT_MASK(S0, S1, t); \
        ATT_RESC(); \
        if (!(ABL & 8) && (i) + 2 < NT) ATT_DMA(t - 2, lds + ((i) & 1) * A_KBUF, lds + A_V0 + (((i) + 2) & 3) * A_VBUF); \
        float mx_; \
        { const int tn = (t > 0) ? t - 1 : 0; lptr kb = lds + (((i) + (t > 0 ? 1 : 0)) & 1) * A_KBUF; \
          __builtin_amdgcn_sched_barrier(0); \
          ATT_A(N0, N1, tn, kb); \
          mx_ = fmaxf(S0[0], S1[0]); \
          _Pragma("unroll") for (int r = 1; r < 16; ++r) mx_ = fmaxf(mx_, fmaxf(S0[r], S1[r])); \
          __builtin_amdgcn_sched_group_barrier(0x2, 34, 0); \
          _Pragma("unroll") for (int k = 0; k < 8; ++k) { __builtin_amdgcn_sched_group_barrier(0x100, 1, 0); __builtin_amdgcn_sched_group_barrier(0x8, 1, 0); __builtin_amdgcn_sched_group_barrier(0x2, 3, 0); } \
          __builtin_amdgcn_sched_barrier(0); } \
        mx_ = swap_max(mx_); \
        const bool live = mx_ > -INFINITY; \
        const float dl = first ? (live ? mx_ : 0.f) : fmaxf(mx_, 0.f); \
        if (__any(first || dl > 0.f)) { \
            m += dl; \
            _Pragma("unroll") for (int r = 0; r < 16; ++r) { S0[r] -= dl; S1[r] -= dl; N0[r] -= dl; N1[r] -= dl; } \
            if (!first) { const float alpha = __builtin_amdgcn_exp2f(-dl); lsum *= alpha; if (hi == 0) wsf[r32] = alpha; resc = true; } \
            if (live) first = false; } \
        { __builtin_amdgcn_sched_barrier(0); \
          lptr vb = lds + A_V0 + (((i) + 3) & 3) * A_VBUF + vroff; \
          bf16x8 vfa = ATT_VF(0), vfb = ATT_VF(1); \
          float ps = 0.f; \
          _Pragma("unroll") for (int k = 0; k < 16; ++k) { \
              bf16x8 vfn = vfb; \
              if (k + 2 < 16) vfn = ATT_VF(k + 2); \
              const bf16x8 cc = (k & 3) == 0 ? PR0 : (k & 3) == 1 ? PR1 : (k & 3) == 2 ? PR2 : PR3; \
              if (!(ABL & 4)) o[k >> 2] = MFMA32(cc, vfa, o[k >> 2]); else { asm volatile("" :: "v"(cc), "v"(vfa)); } \
              if (k < 8) { S0[2 * k] = ATT_EXP(S0[2 * k]); S0[2 * k + 1] = ATT_EXP(S0[2 * k + 1]); ps += S0[2 * k] + S0[2 * k + 1]; } \
              else { S1[2 * k - 16] = ATT_EXP(S1[2 * k - 16]); S1[2 * k - 15] = ATT_EXP(S1[2 * k - 15]); ps += S1[2 * k - 16] + S1[2 * k - 15]; } \
              if (k == 3) PW0 = pack_p(S0, 0); \
              if (k == 7) PW1 = pack_p(S0, 8); \
              if (k == 11) PW2 = pack_p(S1, 0); \
              if (k == 15) PW3 = pack_p(S1, 8); \
              vfa = vfb; vfb = vfn; \
              __builtin_amdgcn_sched_barrier(0); } \
          lsum += ps; } \
        if (!(ABL & 16)) __syncthreads(); } while (0)
#define ATT_EXP(x_) ((ABL & 2) ? (x_) * 0.001f : __builtin_amdgcn_exp2f(x_))
#define ATT_VF(k_) cat8(vtr(vb + ((k_) >> 2) * 512 + ((k_) & 3) * 4096), vtr(vb + ((k_) >> 2) * 512 + ((k_) & 3) * 4096 + 2048))
    f32x16 n0, n1;
    bf16x8 pb0 = bf16x8{}, pb1 = bf16x8{}, pb2 = bf16x8{}, pb3 = bf16x8{};
    for (int i = 0; i < NT; i += 2) {
        ATT_TRIP(i, s0, s1, n0, n1, pa0, pa1, pa2, pa3, pb0, pb1, pb2, pb3);
        ATT_TRIP(i + 1, n0, n1, s0, s1, pb0, pb1, pb2, pb3, pa0, pa1, pa2, pa3);
    }
    ATT_RESC();
#undef ATT_RESC
#undef ATT_TRIP
#undef ATT_VF
#undef ATT_EXP
    { lptr vb = lds + A_V0 + ((NT - 1) & 3) * A_VBUF + vroff;
#pragma unroll
      for (int d0 = 0; d0 < 4; ++d0) { lptr vp_ = vb + d0 * 512;
        const bf16x8 v0 = cat8(vtr(vp_), vtr(vp_ + 2048)), v1 = cat8(vtr(vp_ + 4096), vtr(vp_ + 4096 + 2048));
        const bf16x8 v2 = cat8(vtr(vp_ + 8192), vtr(vp_ + 8192 + 2048)), v3 = cat8(vtr(vp_ + 12288), vtr(vp_ + 12288 + 2048));
        o[d0] = MFMA32(pa0, v0, o[d0]); o[d0] = MFMA32(pa1, v1, o[d0]); o[d0] = MFMA32(pa2, v2, o[d0]); o[d0] = MFMA32(pa3, v3, o[d0]); } }
    __syncthreads();
#undef ATT_DMA
#undef ATT_A
#undef ATT_MASK
    lsum = swap_sum(lsum);
    if (hi == 0) wsf[32 + r32] = 1.0f / lsum;
    const float lam = ((const float*)(A.ws + WS_LAM))[l];
    LAS float* xch = (LAS float*)lds + qw * (4 * 16 * 64) + lane;
    if (mp == 1) {
#pragma unroll
        for (int r = 0; r < 16; ++r) { const float il = wsf[32 + crow(r, hi)] * lam;
#pragma unroll
            for (int d0 = 0; d0 < 4; ++d0) xch[(d0 * 16 + r) * 64] = o[d0][r] * il; }
    }
    __syncthreads();
    if (mp == 0) {
        float ss[16];
#pragma unroll
        for (int r = 0; r < 16; ++r) { const float il = wsf[32 + crow(r, hi)]; float s_ = 0.f;
#pragma unroll
            for (int d0 = 0; d0 < 4; ++d0) { const float y = o[d0][r] * il - xch[(d0 * 16 + r) * 64]; o[d0][r] = y; s_ += y * y; }
            ss[r] = s_; }
#pragma unroll
        for (int r = 0; r < 16; ++r) { float v = ss[r]; v += __shfl_xor(v, 1); v += __shfl_xor(v, 2); v += __shfl_xor(v, 4); v += __shfl_xor(v, 8); v += __shfl_xor(v, 16); ss[r] = v; }
        int l_ = l; asm volatile("" : "+s"(l_));
        const float osc = 1.0f - lam_init_of(l_);
        const float* asg = A.in[I_ASG] + l * 128;
        float gv[4];
#pragma unroll
        for (int d0 = 0; d0 < 4; ++d0) gv[d0] = asg[32 * d0 + r32] * osc;
        LAS bf16_t* stg = (LAS bf16_t*)(lds + A_STAGE) + qw * (32 * 128);
#pragma unroll
        for (int r = 0; r < 16; ++r) { const float rn = rsqrtf(ss[r] * (1.0f / 128.0f) + RMS_EPS); const int row = crow(r, hi);
#pragma unroll
            for (int d0 = 0; d0 < 4; ++d0) stg[row * 128 + 32 * d0 + r32] = (bf16_t)f2bf(o[d0][r] * rn * gv[d0]); }
        bf16_t* YA = ABL ? (bf16_t*)(A.ws + 254 * MiB) + (size_t)(blockIdx.x & 63) * 32 * BW : (bf16_t*)(A.ws + WS_YA) + (rowbase + q0) * BW + h * 128;
#pragma unroll
        for (int i = 0; i < 8; ++i) { const int idx = lane + 64 * i, row = idx >> 4, ch = idx & 15;
            *(u32x4*)(YA + (size_t)row * BW + ch * 8) = *(const LAS u32x4*)(stg + row * 128 + ch * 8); }
    }
}

__device__ __forceinline__ int offa(int row, int ch) { return 2048 * (row >> 3) + 512 * (ch >> 2) + 64 * (row & 7) + 16 * ((ch & 3) ^ ((row >> 2) & 3)); }
constexpr int R_K = 0, R_V = 32768, R_RT = 65536, R_ST = 98304, R_SS = 131072 + 1024;
constexpr size_t WS_RSTATE = 76 * MiB;
constexpr int CW_RFLAG = 12288;
struct RetLane { int r32, hi, tnb0, tnb1, tpb0, tpb1, rb0, rb1, w; };
__device__ __forceinline__ RetLane ret_lane(int lane) {
    int ln = lane; asm volatile("" : "+v"(ln));
    RetLane L; L.r32 = ln & 31; L.hi = ln >> 5; const int tq = (ln & 15) >> 2, tp = ln & 3, tg = (ln >> 4) & 1, z = 2 * tg + (tp >> 1); L.w = (L.r32 >> 2) & 3;
    L.tnb0 = 2048 * L.hi + 64 * tq + 8 * (tp & 1) + 16 * (z ^ (2 * L.hi));
    L.tnb1 = 2048 * L.hi + 64 * (tq + 4) + 8 * (tp & 1) + 16 * (z ^ (2 * L.hi + 1));
    L.tpb0 = 64 * (4 * L.hi + tq) + 8 * (tp & 1) + 16 * (z ^ L.hi);
    L.tpb1 = 2048 + 64 * (4 * L.hi + tq) + 8 * (tp & 1) + 16 * (z ^ (2 + L.hi));
    L.rb0 = 2048 * (L.r32 >> 3) + 64 * (L.r32 & 7) + 16 * (L.hi ^ L.w);
    L.rb1 = 2048 * (L.r32 >> 3) + 64 * (L.r32 & 7) + 16 * ((2 + L.hi) ^ L.w);
    return L;
}
__device__ __forceinline__ void ret_update(f32x16& R0, f32x16& R1, lptr lds, const RetLane& L, int qb, int vh, float g127, float g128) {
    f32x16 t0 = f32x16{}, t1 = f32x16{};
    lptr ka = lds + R_K + 512 * qb, va = lds + R_V + 512 * (2 * vh);
#pragma unroll
    for (int ks = 0; ks < 8; ++ks) {
        const bf16x8 kf = cat8(vtr(ka + L.tnb0 + 4096 * ks), vtr(ka + L.tnb1 + 4096 * ks));
        const bf16x8 v0 = cat8(vtr(va + L.tnb0 + 4096 * ks), vtr(va + L.tnb1 + 4096 * ks));
        const bf16x8 v1 = cat8(vtr(va + 512 + L.tnb0 + 4096 * ks), vtr(va + 512 + L.tnb1 + 4096 * ks));
        t0 = MFMA32(kf, v0, t0); t1 = MFMA32(kf, v1, t1);
    }
#pragma unroll
    for (int r = 0; r < 16; ++r) { R0[r] = g128 * R0[r] + g127 * t0[r]; R1[r] = g128 * R1[r] + g127 * t1[r]; }
}
#define RET_KV_LOAD(stK, stV, c_) do { const size_t r0_ = ((size_t)b * SEQ + 128 * (c_) + srow) * BW + h * 128 + sch * 8; \
    _Pragma("unroll") for (int j = 0; j < 4; ++j) { stK[j] = *(const u32x4*)(RK + r0_ + (size_t)32 * j * BW); stV[j] = *(const u32x4*)(RV + r0_ + (size_t)32 * j * BW); } } while (0)
#define RET_KV_WRITE(stK, stV) do { _Pragma("unroll") for (int j = 0; j < 4; ++j) { *(LAS u32x4*)(lds + R_K + sb + 8192 * j) = stK[j]; *(LAS u32x4*)(lds + R_V + sb + 8192 * j) = stV[j]; } } while (0)

__device__ __forceinline__ void ret_a_task(const Args& A, int l, int b, int h, int seg, lptr lds) {
    const int tid = opaque_tid(), lane = tid & 63; const int wid = __builtin_amdgcn_readfirstlane(tid >> 6), qb = wid & 3, vh = wid >> 2;
    const bf16_t* RK = (const bf16_t*)(A.ws + WS_RK); const bf16_t* RV = (const bf16_t*)(A.ws + WS_RV);
    const float l2g = log2_gamma(h); const float g127 = exp2f(127.0f * l2g), g128 = exp2f(128.0f * l2g);
    const int srow = tid >> 4, sch = tid & 15;
    const int sb = 2048 * (srow >> 3) + 512 * (sch >> 2) + 64 * (srow & 7) + 16 * ((sch & 3) ^ ((srow >> 2) & 3));
    f32x16 R0 = f32x16{}, R1 = f32x16{};
    u32x4 stK[4], stV[4];
    RET_KV_LOAD(stK, stV, 8 * seg);
    for (int cc = 0; cc < 8; ++cc) {
        const RetLane L = ret_lane(lane);
        LDS_BAR();
        RET_KV_WRITE(stK, stV);
        if (cc < 7) RET_KV_LOAD(stK, stV, 8 * seg + cc + 1);
        LDS_BAR();
        ret_update(R0, R1, lds, L, qb, vh, g127, g128);
    }
    unsigned long long* dst = (unsigned long long*)(A.ws + WS_RSTATE) + ((size_t)((b * 4 + h) * 3 + seg) * 8 + wid) * 512 + lane;
#pragma unroll
    for (int g = 0; g < 4; ++g) {
        __hip_atomic_store(dst + (2 * g) * 64, (unsigned long long)pg8::cvt_pk_bf16(R0[4 * g], R0[4 * g + 1]) | ((unsigned long long)pg8::cvt_pk_bf16(R0[4 * g + 2], R0[4 * g + 3]) << 32), RLX_AGENT);
        __hip_atomic_store(dst + (2 * g + 1) * 64, (unsigned long long)pg8::cvt_pk_bf16(R1[4 * g], R1[4 * g + 1]) | ((unsigned long long)pg8::cvt_pk_bf16(R1[4 * g + 2], R1[4 * g + 3]) << 32), RLX_AGENT);
    }
    asm volatile("s_waitcnt vmcnt(0)" ::: "memory");
    __syncthreads();
    if (threadIdx.x == 0) __hip_atomic_store((unsigned*)(A.ws + WS_CTL) + CW_RFLAG + 64 * ((l * 16 + b * 4 + h) * 4 + seg), 1u, RLX_AGENT);
}

__device__ __forceinline__ void ret_b_task(const Args& A, int l, int b, int h, int seg, lptr lds) {
    const int tid = opaque_tid(), lane = tid & 63; const int wid = __builtin_amdgcn_readfirstlane(tid >> 6), qb = wid & 3, vh = wid >> 2;
    const bf16_t* RQ = (const bf16_t*)(A.ws + WS_RQ); const bf16_t* RK = (const bf16_t*)(A.ws + WS_RK); const bf16_t* RV = (const bf16_t*)(A.ws + WS_RV);
    const bf16_t* RG = (const bf16_t*)(A.ws + WS_RG); bf16_t* YC = (bf16_t*)(A.ws + WS_YC);
    const float l2g = log2_gamma(h); const float gam = exp2f(l2g), g127 = exp2f(127.0f * l2g), g128 = exp2f(128.0f * l2g);
    const float* gn = A.in[I_RGN] + l * 128;
    LAS float* ssq = (LAS float*)(lds + R_SS);
    const int srow = tid >> 4, sch = tid & 15;
    const int sb = 2048 * (srow >> 3) + 512 * (sch >> 2) + 64 * (srow & 7) + 16 * ((sch & 3) ^ ((srow >> 2) & 3));
    u32x4 stK[4], stV[4];
    RET_KV_LOAD(stK, stV, 8 * seg);
    f32x16 R0 = f32x16{}, R1 = f32x16{};
    if (seg > 0) {
        if (threadIdx.x < 64) {
            unsigned* fl = (unsigned*)(A.ws + WS_CTL) + CW_RFLAG + 64 * ((l * 16 + b * 4 + h) * 4);
            unsigned spins = 0;
            for (;;) {
                unsigned ok = 1u;
                for (int s2 = 0; s2 < seg; ++s2) ok &= __hip_atomic_load(fl + 64 * s2, RLX_AGENT);
                if (__builtin_amdgcn_readfirstlane(ok)) break;
                __builtin_amdgcn_s_sleep(8);
                if (++spins > (1u << 22)) break;
            }
        }
        __syncthreads();
        const float g1024 = exp2f(1024.0f * l2g);
        for (int s2 = 0; s2 < seg; ++s2) {
            const unsigned long long* src = (const unsigned long long*)(A.ws + WS_RSTATE) + ((size_t)((b * 4 + h) * 3 + s2) * 8 + wid) * 512 + lane;
#pragma unroll
            for (int r = 0; r < 16; ++r) { R0[r] *= g1024; R1[r] *= g1024; }
#pragma unroll
            for (int g = 0; g < 4; ++g) {
                const unsigned long long a0 = __hip_atomic_load(src + (2 * g) * 64, RLX_AGENT), a1 = __hip_atomic_load(src + (2 * g + 1) * 64, RLX_AGENT);
                R0[4 * g] += bf2f((unsigned)a0 & 0xffffu); R0[4 * g + 1] += __uint_as_float((unsigned)a0 & 0xffff0000u); R0[4 * g + 2] += bf2f((unsigned)(a0 >> 32) & 0xffffu); R0[4 * g + 3] += __uint_as_float((unsigned)(a0 >> 32) & 0xffff0000u);
                R1[4 * g] += bf2f((unsigned)a1 & 0xffffu); R1[4 * g + 1] += __uint_as_float((unsigned)a1 & 0xffff0000u); R1[4 * g + 2] += bf2f((unsigned)(a1 >> 32) & 0xffffu); R1[4 * g + 3] += __uint_as_float((unsigned)(a1 >> 32) & 0xffff0000u);
            }
        }
    }
    bf16x8 qf[8];
    u32x4 gst[4];
#define RET_Q_LOAD(c_) do { const size_t r0_ = ((size_t)b * SEQ + 128 * (c_) + 32 * qb + (lane & 31)) * BW + h * 128 + (lane >> 5) * 8; \
    _Pragma("unroll") for (int ds = 0; ds < 8; ++ds) qf[ds] = *(const bf16x8*)(RQ + r0_ + ds * 16); } while (0)
#define RET_G_LOAD(c_) do { _Pragma("unroll") for (int i = 0; i < 4; ++i) { const int idx_ = lane + 64 * i; \
    gst[i] = *(const u32x4*)(RG + ((size_t)b * SEQ + 128 * (c_) + 32 * qb + (idx_ >> 3)) * BW + h * 128 + 64 * vh + (idx_ & 7) * 8); } } while (0)
    RET_Q_LOAD(8 * seg); RET_G_LOAD(8 * seg);
    for (int cc = 0; cc < 8; ++cc) {
        const int c = 8 * seg + cc;
        const RetLane L = ret_lane(lane);
        const int r32 = L.r32, hi = L.hi, w = L.w;
        const size_t crow0 = (size_t)b * SEQ + 128 * c;
        lptr stg = lds + R_ST + 4096 * wid;
        LDS_BAR();
        RET_KV_WRITE(stK, stV);
        if (c > 0) {
            lptr rw = lds + R_RT + 256 * (64 * vh) + 2048 * (r32 >> 3) + 64 * (r32 & 7) + 512 * qb + 8 * hi;
#pragma unroll
            for (int g = 0; g < 4; ++g) {
                *(LAS u32x2*)(rw + 16 * (g ^ w)) = (u32x2){pg8::cvt_pk_bf16(R0[4 * g], R0[4 * g + 1]), pg8::cvt_pk_bf16(R0[4 * g + 2], R0[4 * g + 3])};
                *(LAS u32x2*)(rw + 8192 + 16 * (g ^ w)) = (u32x2){pg8::cvt_pk_bf16(R1[4 * g], R1[4 * g + 1]), pg8::cvt_pk_bf16(R1[4 * g + 2], R1[4 * g + 3])};
            }
        }
#pragma unroll
        for (int i = 0; i < 4; ++i) { const int idx = lane + 64 * i; *(LAS u32x4*)(stg + (idx >> 3) * 128 + (idx & 7) * 16) = gst[i]; }
        LDS_BAR();
        f32x16 o0 = f32x16{}, o1 = f32x16{};
        for (int kb = 0; kb <= qb; ++kb) {
            f32x16 p = f32x16{};
            lptr kr = lds + R_K + 8192 * kb;
#pragma unroll
            for (int ds = 0; ds < 8; ++ds) p = MFMA32(ld8(kr + ((ds & 1) ? L.rb1 : L.rb0) + 512 * (ds >> 1)), qf[ds], p);
            if (kb == qb) {
#pragma unroll
                for (int r = 0; r < 16; ++r) if (crow(r, hi) > r32) p[r] = 0.f;
            }
            const bf16x8 pa0 = pack_p(p, 0), pa1 = pack_p(p, 8);
            lptr vr = lds + R_V + 8192 * kb + 512 * (2 * vh);
#pragma unroll
            for (int s2 = 0; s2 < 2; ++s2) {
                const bf16x8 pa = s2 ? pa1 : pa0;
                const bf16x8 vf0 = cat8(vtr(vr + L.tpb0 + 4096 * s2), vtr(vr + L.tpb1 + 4096 * s2));
                const bf16x8 vf1 = cat8(vtr(vr + 512 + L.tpb0 + 4096 * s2), vtr(vr + 512 + L.tpb1 + 4096 * s2));
                o0 = MFMA32(pa, vf0, o0); o1 = MFMA32(pa, vf1, o1);
            }
        }
        if (c > 0) {
            f32x16 x0 = f32x16{}, x1 = f32x16{};
            lptr rr = lds + R_RT + 256 * (64 * vh);
#pragma unroll
            for (int ds = 0; ds < 8; ++ds) {
                const int ob = ((ds & 1) ? L.rb1 : L.rb0) + 512 * (ds >> 1);
                x0 = MFMA32(qf[ds], ld8(rr + ob), x0);
                x1 = MFMA32(qf[ds], ld8(rr + 8192 + ob), x1);
            }
#pragma unroll
            for (int r = 0; r < 16; ++r) { o0[r] += gam * x0[r]; o1[r] += gam * x1[r]; }
        }
#pragma unroll
        for (int r = 0; r < 16; ++r) { const float v = half_sum32(o0[r] * o0[r] + o1[r] * o1[r]);
            if (r32 == 16) ssq[vh * 128 + 32 * qb + crow(r, hi)] = v; }
        if (cc < 7) RET_KV_LOAD(stK, stV, c + 1);
        LDS_BAR();
        if (c < SEQ / 128 - 1) ret_update(R0, R1, lds, L, qb, vh, g127, g128);
        if (cc < 7) { RET_Q_LOAD(c + 1); RET_G_LOAD(c + 1); }
        const float gn0 = gn[64 * vh + r32], gn1 = gn[64 * vh + 32 + r32];
#pragma unroll
        for (int r = 0; r < 16; ++r) {
            const int row = crow(r, hi);
            const float rn = rsqrtf((ssq[32 * qb + row] + ssq[128 + 32 * qb + row]) * (1.0f / 128.0f) + RMS_EPS);
            LAS bf16_t* sp = (LAS bf16_t*)(stg + row * 128) + r32;
            sp[0] = (bf16_t)f2bf(o0[r] * rn * gn0 * bf2f(sp[0]));
            sp[32] = (bf16_t)f2bf(o1[r] * rn * gn1 * bf2f(sp[32]));
        }
#pragma unroll
        for (int i = 0; i < 4; ++i) { const int idx = lane + 64 * i;
            *(u32x4*)(YC + (crow0 + 32 * qb + (idx >> 3)) * BW + h * 128 + 64 * vh + (idx & 7) * 8) = *(const LAS u32x4*)(stg + (idx >> 3) * 128 + (idx & 7) * 16); }
    }
#undef RET_Q_LOAD
#undef RET_G_LOAD
}
#undef RET_KV_LOAD
#undef RET_KV_WRITE
#undef MFMA32

constexpr int C_Z = 65536;
__device__ __forceinline__ void conv_task(const Args& A, int l, int task, lptr lds) {
    const int tid = opaque_tid(), lane = tid & 63; const int wave = __builtin_amdgcn_readfirstlane(tid >> 6);
    const bf16_t* Z = (const bf16_t*)(A.ws + WS_Z); bf16_t* YB = (bf16_t*)(A.ws + WS_YB);
    const float* cw = A.in[I_CW] + (size_t)l * 31 * BW; const float* cb = A.in[I_CB] + l * BW;
    const float* lg = A.in[I_CLG] + l * BW; const float* lb = A.in[I_CLB] + l * BW;
    const int m0 = task * 32, t0 = m0 & (SEQ - 1);
    __syncthreads();
    for (int pc = wave; pc < 62; pc += NWAVES) {
        const int j = pc >> 1, hf = pc & 1;
        __builtin_amdgcn_global_load_lds((const unsigned*)(cw + (size_t)j * BW + 8 * lane + 4 * hf), (LAS unsigned*)(lds + pc * 1024), 16, 0, 0);
    }
    for (int r = wave; r < 62; r += NWAVES) {
        if (t0 - 30 + r >= 0) __builtin_amdgcn_global_load_lds((const unsigned*)(Z + (size_t)(m0 - 30 + r) * BW + lane * 8), (LAS unsigned*)(lds + C_Z + r * 1024), 16, 0, 0);
        else { unsigned zz = 0u; asm volatile("" : "+v"(zz)); *(LAS u32x4*)(lds + C_Z + r * 1024 + lane * 16) = (u32x4){zz, zz, zz, zz}; }
    }
    __syncthreads();
    const int c0 = lane * 8;
    float acc[4][8];
    { const f32x4 b0 = *(const f32x4*)(cb + c0), b1 = *(const f32x4*)(cb + c0 + 4);
#pragma unroll
      for (int k = 0; k < 4; ++k) { acc[k][0] = b0[0]; acc[k][1] = b0[1]; acc[k][2] = b0[2]; acc[k][3] = b0[3]; acc[k][4] = b1[0]; acc[k][5] = b1[1]; acc[k][6] = b1[2]; acc[k][7] = b1[3]; } }
    float zf[4][8];
    lptr zb = lds + C_Z + (4 * wave) * 1024 + lane * 16;
#define CONV_ZROW(slot, rr) do { const u32x4 v_ = *(const LAS u32x4*)(zb + (rr) * 1024); \
        zf[slot][0] = __uint_as_float(v_.x << 16); zf[slot][1] = __uint_as_float(v_.x & 0xffff0000u); zf[slot][2] = __uint_as_float(v_.y << 16); zf[slot][3] = __uint_as_float(v_.y & 0xffff0000u); \
        zf[slot][4] = __uint_as_float(v_.z << 16); zf[slot][5] = __uint_as_float(v_.z & 0xffff0000u); zf[slot][6] = __uint_as_float(v_.w << 16); zf[slot][7] = __uint_as_float(v_.w & 0xffff0000u); } while (0)
    CONV_ZROW(0, 0); CONV_ZROW(1, 1); CONV_ZROW(2, 2); CONV_ZROW(3, 3);
#pragma unroll
    for (int j = 0; j < 31; ++j) {
        const f32x4 w0 = *(const LAS f32x4*)(lds + ((j * 2 + 0) * 64 + lane) * 16), w1 = *(const LAS f32x4*)(lds + ((j * 2 + 1) * 64 + lane) * 16);
#pragma unroll
        for (int k = 0; k < 4; ++k) {
            const int sl = (j + k) & 3;
            acc[k][0] += w0[0] * zf[sl][0]; acc[k][1] += w0[1] * zf[sl][1]; acc[k][2] += w0[2] * zf[sl][2]; acc[k][3] += w0[3] * zf[sl][3];
            acc[k][4] += w1[0] * zf[sl][4]; acc[k][5] += w1[1] * zf[sl][5]; acc[k][6] += w1[2] * zf[sl][6]; acc[k][7] += w1[3] * zf[sl][7];
        }
        if (j < 30) CONV_ZROW(j & 3, j + 4);
    }
#undef CONV_ZROW
    const f32x4 g0 = *(const f32x4*)(lg + c0), g1 = *(const f32x4*)(lg + c0 + 4), h0 = *(const f32x4*)(lb + c0), h1 = *(const f32x4*)(lb + c0 + 4);
#pragma unroll
    for (int k = 0; k < 4; ++k) {
        float s_ = 0.f;
#pragma unroll
        for (int e = 0; e < 8; ++e) s_ += acc[k][e];
        const float mu = wave_sum(s_) * (1.0f / BW);
        float q = 0.f;
#pragma unroll
        for (int e = 0; e < 8; ++e) { acc[k][e] -= mu; q += acc[k][e] * acc[k][e]; }
        const float rstd = rsqrtf(wave_sum(q) * (1.0f / BW) + LN_EPS);
        float o[8];
#pragma unroll
        for (int e = 0; e < 4; ++e) { const float a_ = acc[k][e] * rstd * g0[e] + h0[e], b_ = acc[k][4 + e] * rstd * g1[e] + h1[e]; o[e] = a_ * sigx(-LOG2E * a_); o[4 + e] = b_ * sigx(-LOG2E * b_); }
        *(uint4*)(YB + (size_t)(m0 + 4 * wave + k) * BW + c0) = make_uint4(pk2(o[0], o[1]), pk2(o[2], o[3]), pk2(o[4], o[5]), pk2(o[6], o[7]));
    }
}

constexpr int Q_RA = 6, Q_AT = 32, Q_RB = 8, Q_CONV = 64, Q_TASKS = Q_RA + Q_AT + Q_RB + Q_AT + Q_CONV;
constexpr int CW_QUEUE = 8192;
__device__ __forceinline__ void mixer_phase(const Args& A, int l, lptr lds, volatile LAS unsigned* slot) {
    const int x0 = (int)(xb_xcc_id() & 7u);
    int qi = 0;
    for (;;) {
        const int x = (x0 + qi) & 7;
        unsigned* ctr = (unsigned*)(A.ws + WS_CTL) + CW_QUEUE + 64 * (8 * l + x);
        __syncthreads();
        if (threadIdx.x == 0) *slot = __hip_atomic_fetch_add(ctr, 1u, __ATOMIC_RELAXED, __HIP_MEMORY_SCOPE_AGENT);
        __syncthreads();
        int id = (int)*slot;
        if (id >= Q_TASKS) { if (++qi == 8) break; continue; }
#if PROBE_PHASE >= 10
        const unsigned t0_ = (unsigned)__builtin_amdgcn_s_memrealtime(); int kind = 0;
#endif
        if (id < Q_RA) { const int bh = 2 * x + id / 3; ret_a_task(A, l, bh >> 2, bh & 3, id % 3, lds); }
        else if ((id -= Q_RA) < Q_AT) { const int bh = 2 * x + (id & 1); attn_unit<0>(A, l, bh >> 2, bh & 3, 31 - (id >> 1), lds);
#if PROBE_PHASE >= 10
            kind = 1;
#endif
        }
        else if ((id -= Q_AT) < Q_RB) { const int bh = 2 * x + (id >> 2); ret_b_task(A, l, bh >> 2, bh & 3, id & 3, lds); }
        else if ((id -= Q_RB) < Q_AT) { const int bh = 2 * x + (id & 1); attn_unit<0>(A, l, bh >> 2, bh & 3, 15 - (id >> 1), lds);
#if PROBE_PHASE >= 10
            kind = 1;
#endif
        }
        else { id -= Q_AT; conv_task(A, l, 64 * x + id, lds);
#if PROBE_PHASE >= 10
            kind = 2;
#endif
        }
#if PROBE_PHASE >= 10
        __syncthreads();
        if (threadIdx.x == 0 && kind == PROBE_PHASE - 10) atomicAdd((unsigned*)(A.ws + WS_CTL) + CW_QUEUE + 2048, (unsigned)__builtin_amdgcn_s_memrealtime() - t0_);
#endif
    }
#if ABL_ATTN > 0
    if (l == 0) {
        unsigned* ctr2 = (unsigned*)(A.ws + WS_CTL) + CW_QUEUE + 4096;
        for (;;) {
            __syncthreads();
            if (threadIdx.x == 0) *slot = __hip_atomic_fetch_add(ctr2, 1u, __ATOMIC_RELAXED, __HIP_MEMORY_SCOPE_AGENT);
            __syncthreads();
            const int id = (int)*slot;
            if (id >= 512) break;
            attn_unit<ABL_ATTN>(A, l, (id & 15) >> 2, id & 3, 31 - (id >> 4), lds);
        }
    }
#endif
}
}

constexpr int N_PHASES = 1 + 6 * DEPTH;
constexpr int RING_BYTES = 131072, MISC_OFF = RING_BYTES + 320, LDS_BYTES = 147456;
#ifndef FAST_GEMM
#define FAST_GEMM 1
#endif
#ifndef FAST_MIX
#define FAST_MIX 1
#endif
#ifndef FAST_MASK
#define FAST_MASK 0x3f
#endif
__global__ void __launch_bounds__(NTHREADS, 2) fwd_kernel(Args A) {
    extern __shared__ __attribute__((aligned(16))) unsigned char lds[];
    float* sm = (float*)lds;
    LAS unsigned char* ldsl = (LAS unsigned char*)lds;
    volatile LAS unsigned* MISC = (volatile LAS unsigned*)(ldsl + MISC_OFF);
    const int wg = blockIdx.x, nwg = gridDim.x;
    const bool multi = (A.ph_hi - A.ph_lo) > 1;
    XcdBarrier bar; bar.bar = nullptr; bar.x = 0; bar.st = nullptr;
    if (multi) {
        if (threadIdx.x < 2) MISC[threadIdx.x] = 0u;
        __syncthreads();
        bar = xcd_barrier_post((unsigned*)(A.ws + WS_CTL) + CW_BAR, MISC);
    }
    const Args& A0 = A;
#if PROBE_PHASE >= 0
    if (blockIdx.x == 0 && threadIdx.x == 0) { const unsigned now = (unsigned)__builtin_amdgcn_s_memrealtime(); MISC[8] = now; MISC[9] = 0u; MISC[10] = now; }
#endif
    for (int ph = A0.ph_lo; ph < A0.ph_hi; ++ph) {
        Args A = A0;
        asm volatile("" : "+s"(A.out), "+s"(A.ws));
        if (ph == 0) { nv_p0(A, wg, nwg); if (FAST_GEMM) fast_p0_weights(A, wg, nwg, (LAS float*)ldsl, 0, NI_W1); }
        else {
            const int l = (ph - 1) / 6, k = (ph - 1) % 6;
            if (k == 1) {
#if FAST_MIX
                mx::mixer_phase(A, l, ldsl, MISC + 4);
#else
                nv_attn(A, l, wg, nwg, sm); nv_conv(A, l, wg, nwg); nv_ret(A, l, wg, nwg, sm);
#endif
            }
            else if (FAST_GEMM && ((FAST_MASK >> k) & 1)) fast_gemm(A, l, k, ldsl);
            else if (k == 0) nv_p1(A, l, wg, nwg, sm);
            else if (k == 2) nv_p3(A, l, wg, nwg, sm);
            else if (k == 3) nv_resid_gemm(A, (const bf16_t*)(A.ws + WS_Y), DM, DM, A.in[I_WOUT] + (size_t)l * DM * DM, l == 0 ? A.in[I_X] : A.out,
                                           (float*)(A.ws + WS_ROWSS) + (size_t)(l == 0 ? 1 : 3) * M, wg, nwg, sm);
            else if (k == 4) nv_p5(A, l, wg, nwg, sm);
            else nv_resid_gemm(A, (const bf16_t*)(A.ws + WS_MID), DFF, DFF, A.in[I_WF2] + (size_t)l * DFF * DM, A.out,
                               l + 1 < DEPTH ? (float*)(A.ws + WS_ROWSS) + (size_t)2 * M : nullptr, wg, nwg, sm);
        }
        if (ph + 1 < A0.ph_hi) xcd_barrier(bar);
#if PROBE_PHASE >= 0
        if (blockIdx.x == 0 && threadIdx.x == 0) { const unsigned long long now = __builtin_amdgcn_s_memrealtime(); const int k = ph == 0 ? 0 : 1 + (ph - 1) % 6;
            if (k == PROBE_PHASE) MISC[9] += (unsigned)now - MISC[10]; MISC[10] = (unsigned)now; }
#endif
    }
#if PROBE_PHASE >= 0
    xcd_barrier(bar);
    if (blockIdx.x == 0 && threadIdx.x == 0) { const unsigned now = (unsigned)__builtin_amdgcn_s_memrealtime(); float frac = (float)MISC[9] / (float)(now - MISC[8]);
        if (PROBE_PHASE >= 10) frac = (float)__hip_atomic_load((unsigned*)(A0.ws + WS_CTL) + mx::CW_QUEUE + 2048, __ATOMIC_RELAXED, __HIP_MEMORY_SCOPE_AGENT) / ((float)gridDim.x * (float)(now - MISC[8]));
        A0.out[0] += 2.0f + 28.0f * frac; }
#endif
}

extern "C" void kernel_launch(void* const* d_in, const int* in_sizes, int n_in, void* d_out, int out_size, void* d_ws, size_t ws_size, hipStream_t stream) {
    static int grid = 0;
    if (grid == 0) {
        if (n_in != N_IN || out_size != M * DM || ws_size < WS_END) { fprintf(stderr, "kernel_launch: unexpected shapes (n_in %d out %d ws %zu)\n", n_in, out_size, ws_size); grid = -1; return; }
        int dev = 0, cus = 0, per_cu = 0;
        (void)hipGetDevice(&dev); (void)hipDeviceGetAttribute(&cus, hipDeviceAttributeMultiprocessorCount, dev);
        (void)hipFuncSetAttribute((const void*)fwd_kernel, hipFuncAttributeMaxDynamicSharedMemorySize, LDS_BYTES);
        (void)hipOccupancyMaxActiveBlocksPerMultiprocessor(&per_cu, (const void*)fwd_kernel, NTHREADS, LDS_BYTES);
        (void)hipGetLastError();
        if (per_cu < 1) fprintf(stderr, "kernel_launch: occupancy query says %d blocks per CU\n", per_cu);
        grid = cus;
    }
    if (grid < 0) return;
    (void)hipMemsetAsync((char*)d_ws + WS_CTL, 0, CTL_ZERO_BYTES, stream);
    Args a{};
    for (int i = 0; i < N_IN; ++i) a.in[i] = (const float*)d_in[i];
    a.out = (float*)d_out; a.ws = (unsigned char*)d_ws;
    a.ph_lo = 0; a.ph_hi = N_PHASES;
    void* args[] = {&a};
    hipError_t e = hipLaunchCooperativeKernel((const void*)fwd_kernel, dim3(grid), dim3(NTHREADS), args, LDS_BYTES, stream);
    if (e != hipSuccess) fprintf(stderr, "cooperative launch failed: %s (grid %d)\n", hipGetErrorString(e), grid);
}
```

```cpp
#include <hip/hip_runtime.h>
#include <cstdio>
#include <cstdint>
#ifndef ABL_ATTN
#define ABL_ATTN 0
#endif
#ifndef PROBE_PHASE
#define PROBE_PHASE -1
#endif

#define GAS __attribute__((address_space(1)))
#define LAS __attribute__((address_space(3)))
typedef unsigned short bf16_t;
typedef GAS unsigned gu32;
#define RLX_AGENT __ATOMIC_RELAXED, __HIP_MEMORY_SCOPE_AGENT

constexpr int BATCH = 4, SEQ = 4096, DM = 1024, M = BATCH * SEQ, DEPTH = 2;
constexpr int DIN = 7680, NU = 4608, NGATE = 3072, DFF = 2816, BW = 512;
constexpr float RMS_EPS = 1e-6f, LN_EPS = 1e-5f;
constexpr float LOG2E = 1.4426950408889634f;
constexpr float QSCALE = 0.125f * LOG2E;
constexpr int NTHREADS = 512, NWAVES = 8;

enum { I_X = 0, I_N1G, I_WIN, I_QG, I_KG, I_DLAM, I_ASG, I_CW, I_CB, I_CLG, I_CLB, I_RGN, I_BGATE, I_WBR, I_WOUT, I_N2G, I_WF1, I_WF2, N_IN };

constexpr size_t MiB = 1u << 20;
constexpr size_t WS_CTL = 0, CTL_ZERO_BYTES = 1 * MiB;
constexpr size_t WS_ROWSS = 256 * 1024;
constexpr size_t WS_LAM = 512 * 1024;
constexpr size_t WS_XB = 78 * MiB;
constexpr size_t WS_AQ = 110 * MiB, WS_AK = 126 * MiB, WS_AV = 142 * MiB, WS_Z = 158 * MiB, WS_RQ = 174 * MiB, WS_RK = 190 * MiB, WS_RV = 206 * MiB, WS_RG = 222 * MiB, WS_YB = 238 * MiB;
constexpr size_t WS_YA = WS_AQ, WS_YC = WS_RQ;
constexpr size_t WS_Y = 126 * MiB;
constexpr size_t WS_MID = 110 * MiB;
constexpr size_t WS_END = 256 * MiB;
constexpr int CW_BAR = 4096;

struct Args { const float* in[N_IN]; float* out; unsigned char* ws; int ph_lo, ph_hi; };

__device__ __forceinline__ float bf2f(unsigned v) { return __uint_as_float(v << 16); }
__device__ __forceinline__ unsigned f2bf(float f) { unsigned u = __float_as_uint(f); return (u + 0x7fffu + ((u >> 16) & 1u)) >> 16; }
__device__ __forceinline__ unsigned pk2(float lo, float hi) { return f2bf(lo) | (f2bf(hi) << 16); }
__device__ __forceinline__ float wave_sum(float v) {
#pragma unroll
    for (int o = 1; o < 64; o <<= 1) v += __shfl_xor(v, o);
    return v;
}
__device__ __forceinline__ float wave_max(float v) {
#pragma unroll
    for (int o = 1; o < 64; o <<= 1) v = fmaxf(v, __shfl_xor(v, o));
    return v;
}
__device__ __forceinline__ int opaque_tid() { int t = threadIdx.x; asm volatile("" : "+v"(t)); return t; }
__device__ __forceinline__ float sigmoidf_(float x) { return 1.0f / (1.0f + __expf(-x)); }
__device__ __forceinline__ float siluf_(float x) { return x / (1.0f + __expf(-x)); }
__device__ __forceinline__ float lam_init_of(int l) { return l == 0 ? 0.2f : (0.8f - 0.6f * 0.74081822068171788f); }
__device__ __forceinline__ float log2_gamma(int h) { return log2f(1.0f - exp2f(-5.0f - (float)h)); }

#define XB_TMO      128
#define XB_XCNT(j)  (256  + 64 * (j))
#define XB_XSUB(j)  (1280 + 64 * (j))
#define XB_XGEN(j)  (2304 + 64 * (j))
#define XB_TOP      3328
#define XB_TOPGEN   3392
#define XCD_BAR_WORDS 3456
#define XB_SPIN_CAP (1u << 22)
__device__ __forceinline__ unsigned xb_ld(unsigned* p)              { return __hip_atomic_load(p, __ATOMIC_RELAXED, __HIP_MEMORY_SCOPE_AGENT); }
__device__ __forceinline__ unsigned xb_add(unsigned* p, unsigned v) { return __hip_atomic_fetch_add(p, v, __ATOMIC_RELAXED, __HIP_MEMORY_SCOPE_AGENT); }
__device__ __forceinline__ unsigned xb_xcc_id() { return (unsigned)__builtin_amdgcn_s_getreg((3 << 11) | 20) & 0xFu; }
#define XB_SPIN(cond, bar) do { unsigned _sp = 0; while (cond) { __builtin_amdgcn_s_sleep(1); \
    if ((++_sp & 255u) == 0u) { if (xb_ld(&(bar)[XB_TMO])) break; if (_sp > XB_SPIN_CAP) { atomicAdd(&(bar)[XB_TMO], 1u); break; } } } } while (0)
struct XcdBarrier { unsigned* bar; unsigned x; volatile LAS unsigned* st; };
__device__ __forceinline__ XcdBarrier xcd_barrier_post(unsigned* bar, volatile LAS unsigned* st) {
    XcdBarrier b; b.bar = bar; b.x = xb_xcc_id(); b.st = st;
    if (threadIdx.x == 0) (void)xb_add(&bar[XB_XCNT(b.x)], 1u);
    return b;
}
__device__ __forceinline__ void xcd_barrier_complete(unsigned* bar, unsigned x, unsigned& nloc, unsigned& nx) {
    const unsigned G = gridDim.x * gridDim.y * gridDim.z;
    unsigned sum, cnt, mine, sp = 0u;
    for (;;) {
        sum = 0u; cnt = 0u; mine = 0u;
#pragma unroll
        for (unsigned j = 0; j < 16; ++j) { const unsigned c = xb_ld(&bar[XB_XCNT(j)]); sum += c; cnt += (c > 0u) ? 1u : 0u; mine = (j == x) ? c : mine; }
        if (sum == G) break;
        __builtin_amdgcn_s_sleep(1);
        if ((++sp & 255u) == 0u) { if (xb_ld(&bar[XB_TMO])) break; if (sp > XB_SPIN_CAP) { atomicAdd(&bar[XB_TMO], 1u); break; } }
    }
    nloc = mine > 0u ? mine : 1u; nx = cnt > 0u ? cnt : 1u;
}
__device__ __forceinline__ void xcd_barrier(const XcdBarrier& b) {
    asm volatile("s_waitcnt vmcnt(0)" ::: "memory");
    __syncthreads();
    if (threadIdx.x == 0) {
        unsigned* bar = b.bar;
        __builtin_amdgcn_s_waitcnt(0);
        unsigned nloc = b.st[0], nx = b.st[1];
        if (nloc == 0u) { xcd_barrier_complete(bar, b.x, nloc, nx); b.st[0] = nloc; b.st[1] = nx; }
        const unsigned old = xb_add(&bar[XB_XSUB(b.x)], 1u);
        const unsigned gen = old / nloc;
        if (old + 1u == (gen + 1u) * nloc) {
            __builtin_amdgcn_fence(__ATOMIC_RELEASE, "agent");
            asm volatile("s_waitcnt vmcnt(0)" ::: "memory");
            const unsigned og = xb_add(&bar[XB_TOP], 1u);
            const unsigned tg = og / nx;
            if (og + 1u == (tg + 1u) * nx) xb_add(&bar[XB_TOPGEN], 1u);
            else XB_SPIN(xb_ld(&bar[XB_TOPGEN]) == tg, bar);
            __builtin_amdgcn_fence(__ATOMIC_ACQUIRE, "agent");
            xb_add(&bar[XB_XGEN(b.x)], 1u);
            asm volatile("s_waitcnt vmcnt(0)" ::: "memory");
        } else {
            XB_SPIN(xb_ld(&bar[XB_XGEN(b.x)]) == gen, bar);
            __builtin_amdgcn_fence(__ATOMIC_ACQUIRE, "agent");
            asm volatile("s_waitcnt vmcnt(0)" ::: "memory");
        }
    }
    __syncthreads();
}


__device__ __forceinline__ void nv_p0(const Args& A, int wg, int nwg) {
    const int tid = opaque_tid(), lane = tid & 63, wave = tid >> 6;
    const float* x = A.in[I_X];
    bf16_t* XB = (bf16_t*)(A.ws + WS_XB);
    float* rowss = (float*)(A.ws + WS_ROWSS);
    for (int m0 = wg * NWAVES + wave; m0 < M; m0 += 4 * nwg * NWAVES) {
        float4 v[4][4];
#pragma unroll
        for (int r = 0; r < 4; ++r) { const int m = m0 + r * nwg * NWAVES; if (m < M) { const float4* xr = (const float4*)(x + (size_t)m * DM) + lane;
#pragma unroll
            for (int j = 0; j < 4; ++j) v[r][j] = xr[64 * j]; } }
#pragma unroll
        for (int r = 0; r < 4; ++r) { const int m = m0 + r * nwg * NWAVES; if (m < M) { uint2* o = (uint2*)(XB + (size_t)m * DM) + lane; float s = 0.f;
#pragma unroll
            for (int j = 0; j < 4; ++j) { const float4 q = v[r][j]; s += q.x * q.x + q.y * q.y + q.z * q.z + q.w * q.w; typedef float f2_ __attribute__((ext_vector_type(2))); typedef __bf16 b2_ __attribute__((ext_vector_type(2))); const f2_ lo_ = {q.x, q.y}, hi_ = {q.z, q.w};
                o[64 * j] = make_uint2(__builtin_bit_cast(unsigned, __builtin_convertvector(lo_, b2_)), __builtin_bit_cast(unsigned, __builtin_convertvector(hi_, b2_))); }
            s = wave_sum(s);
            if (lane == 0) rowss[m] = s; } }
    }
    if (wg == 0 && wave < DEPTH) {
        const float* dl = A.in[I_DLAM] + wave * 4 * 64;
        float a = dl[lane] * dl[64 + lane], b = dl[128 + lane] * dl[192 + lane];
        a = wave_sum(a); b = wave_sum(b);
        if (lane == 0) ((float*)(A.ws + WS_LAM))[wave] = __expf(a) - __expf(b) + lam_init_of(wave);
    }
}

template <class AL, class WL>
__device__ __forceinline__ void nv_core(float (&acc)[4][4], int K, const AL& aload, const WL& wload, float* sA, float* sB, int tid) {
    const int tx = tid & 15, ty = tid >> 4;
#pragma unroll
    for (int i = 0; i < 4; ++i)
#pragma unroll
        for (int j = 0; j < 4; ++j) acc[i][j] = 0.f;
    const int ar = tid & 127, akq = tid >> 7;
    const int wk = tid >> 5, wc = (tid & 31) * 2;
#pragma unroll 1
    for (int k0 = 0; k0 < K; k0 += 16) {
        float a0, a1, a2, a3; aload(ar, k0 + 4 * akq, a0, a1, a2, a3);
        const float w0 = wload(k0 + wk, wc), w1 = wload(k0 + wk, wc + 1);
        __syncthreads();
        sA[(4 * akq + 0) * 128 + ar] = a0; sA[(4 * akq + 1) * 128 + ar] = a1; sA[(4 * akq + 2) * 128 + ar] = a2; sA[(4 * akq + 3) * 128 + ar] = a3;
        sB[wk * 64 + wc] = w0; sB[wk * 64 + wc + 1] = w1;
        __syncthreads();
#pragma unroll 2
        for (int kk = 0; kk < 16; ++kk) {
            const float4 a = *(const float4*)&sA[kk * 128 + ty * 4];
            const float4 b = *(const float4*)&sB[kk * 64 + tx * 4];
            const float av[4] = {a.x, a.y, a.z, a.w}, bv[4] = {b.x, b.y, b.z, b.w};
#pragma unroll
            for (int i = 0; i < 4; ++i)
#pragma unroll
                for (int j = 0; j < 4; ++j) acc[i][j] += av[i] * bv[j];
        }
    }
    __syncthreads();
}
struct ALbf {
    const bf16_t* A; int lda; int row0;
    __device__ __forceinline__ void operator()(int r, int k, float& a0, float& a1, float& a2, float& a3) const {
        const uint2 v = *(const uint2*)(A + (size_t)(row0 + r) * lda + k);
        a0 = __uint_as_float(v.x << 16); a1 = __uint_as_float(v.x & 0xffff0000u); a2 = __uint_as_float(v.y << 16); a3 = __uint_as_float(v.y & 0xffff0000u);
    }
};
struct WLf32 {
    const float* W; int ldw; int c0, c1; const float* g;
    __device__ __forceinline__ float operator()(int k, int j) const {
        const float w = W[(size_t)k * ldw + (j < 32 ? c0 + j : c1 + j - 32)];
        return g ? w * g[k] : w;
    }
};

__device__ __forceinline__ void nv_p1(const Args& A, int l, int wg, int nwg, float* sm) {
    float* sA = sm; float* sB = sm + 16 * 128; float* sC = sB + 16 * 64;
    const int tid = opaque_tid(), tx = tid & 15, ty = tid >> 4;
    const float* Win = A.in[I_WIN] + (size_t)l * DM * DIN;
    const float* g1 = A.in[I_N1G] + l * DM;
    const bf16_t* XB = (const bf16_t*)(A.ws + WS_XB);
    const float* rowss = (const float*)(A.ws + WS_ROWSS) + (size_t)(l == 0 ? 0 : 2) * M;
    const float* qg = A.in[I_QG] + l * 64; const float* kg = A.in[I_KG] + l * 64;
    for (int it = wg; it < 128 * 72; it += nwg) {
        const int rt = it / 72, cg = it % 72, row0 = rt * 128;
        int c0 = 64 * cg, c1 = 64 * cg + 32;
        if (cg >= 24 && cg < 40) { c0 = 1536 + 32 * (cg - 24); c1 = 2048 + 32 * (cg - 24); }
        float acc[4][4];
        nv_core(acc, DM, ALbf{XB, DM, row0}, WLf32{Win, DIN, c0, c1, g1}, sA, sB, tid);
#pragma unroll
        for (int i = 0; i < 4; ++i) {
            const int r = ty * 4 + i; const float rstd = rsqrtf(rowss[row0 + r] * (1.0f / DM) + RMS_EPS);
#pragma unroll
            for (int j = 0; j < 4; ++j) sC[r * 65 + tx * 4 + j] = acc[i][j] * rstd;
        }
        __syncthreads();
        const int r = tid >> 2, q4 = tid & 3, m = row0 + r, t = m & (SEQ - 1);
        const float* cr = sC + r * 65;
        if (cg < 16) {
            float ss = 0.f;
#pragma unroll
            for (int j = 0; j < 16; ++j) { const float v = cr[q4 * 16 + j]; ss += v * v; }
            ss += __shfl_xor(ss, 1); ss += __shfl_xor(ss, 2);
            const float rn = rsqrtf(ss * (1.0f / 64.0f) + RMS_EPS);
            const bool isq = cg < 8; const float* gg = isq ? qg : kg; const float sc = isq ? QSCALE : 1.0f;
            bf16_t* o = (bf16_t*)(A.ws + (isq ? WS_AQ : WS_AK)) + (size_t)m * BW + (cg & 7) * 64 + q4 * 16;
#pragma unroll
            for (int j = 0; j < 16; ++j) o[j] = (bf16_t)f2bf(cr[q4 * 16 + j] * rn * gg[q4 * 16 + j] * sc);
        } else if (cg >= 24 && cg < 40) {
            bf16_t* o = (bf16_t*)(A.ws + WS_Z) + (size_t)m * BW + (cg - 24) * 32 + q4 * 8;
#pragma unroll
            for (int j = 0; j < 8; ++j) o[j] = (bf16_t)f2bf(cr[q4 * 8 + j] * sigmoidf_(cr[32 + q4 * 8 + j]));
        } else {
            size_t base; int cb; int kind;
            if (cg < 24)      { base = WS_AV; cb = cg - 16; kind = 0; }
            else if (cg < 48) { base = WS_RQ; cb = cg - 40; kind = 1; }
            else if (cg < 56) { base = WS_RK; cb = cg - 48; kind = 2; }
            else if (cg < 64) { base = WS_RV; cb = cg - 56; kind = 0; }
            else              { base = WS_RG; cb = cg - 64; kind = 3; }
            const int h = cb >> 1; const float l2g = log2_gamma(h); const float tp = (float)(t & 127);
            float f = 1.0f;
            if (kind == 1) f = exp2f(tp * l2g);
            if (kind == 2) f = 0.08838834764831845f * exp2f(-tp * l2g);
            bf16_t* o = (bf16_t*)(A.ws + base) + (size_t)m * BW + cb * 64 + q4 * 16;
#pragma unroll
            for (int j = 0; j < 16; ++j) { float v = cr[q4 * 16 + j]; v = (kind == 3) ? siluf_(v) : v * f; o[j] = (bf16_t)f2bf(v); }
        }
        __syncthreads();
    }
}

__device__ __forceinline__ void nv_attn(const Args& A, int l, int wg, int nwg, float* sm) {
    const int tid = opaque_tid(), lane = tid & 63, wave = tid >> 6;
    float* sq = sm + wave * 256;
    const bf16_t* AQ = (const bf16_t*)(A.ws + WS_AQ); const bf16_t* AK = (const bf16_t*)(A.ws + WS_AK); const bf16_t* AV = (const bf16_t*)(A.ws + WS_AV);
    bf16_t* YA = (bf16_t*)(A.ws + WS_YA);
    const float lam = ((const float*)(A.ws + WS_LAM))[l];
    const float* asg = A.in[I_ASG] + l * 128;
    const float osc = 1.0f - lam_init_of(l);
    for (int it = wg * NWAVES + wave; it < BATCH * 4 * SEQ; it += nwg * NWAVES) {
        const int t = it & (SEQ - 1), h = (it >> 12) & 3, b = it >> 14;
        const size_t mq = (size_t)b * SEQ + t;
        const float slope2 = exp2f(-2.0f * (float)(h + 1)) * LOG2E;
        sq[lane] = bf2f(AQ[mq * BW + h * 128 + lane]); sq[64 + lane] = bf2f(AQ[mq * BW + h * 128 + 64 + lane]);
        float m1 = -INFINITY, m2 = -INFINITY, l1 = 0.f, l2 = 0.f, o1a = 0.f, o1b = 0.f, o2a = 0.f, o2b = 0.f;
        for (int s0 = 0; s0 <= t; s0 += 64) {
            const int s = s0 + lane; const bool valid = s <= t;
            float d1 = 0.f, d2 = 0.f;
            if (valid) {
                const uint4* kr = (const uint4*)(AK + ((size_t)b * SEQ + s) * BW + h * 128);
#pragma unroll 2
                for (int c = 0; c < 8; ++c) {
                    const uint4 v = kr[c]; const unsigned w[4] = {v.x, v.y, v.z, v.w};
#pragma unroll
                    for (int e = 0; e < 4; ++e) { d1 += sq[c * 8 + 2 * e] * __uint_as_float(w[e] << 16) + sq[c * 8 + 2 * e + 1] * __uint_as_float(w[e] & 0xffff0000u); }
                }
#pragma unroll 2
                for (int c = 0; c < 8; ++c) {
                    const uint4 v = kr[8 + c]; const unsigned w[4] = {v.x, v.y, v.z, v.w};
#pragma unroll
                    for (int e = 0; e < 4; ++e) { d2 += sq[64 + c * 8 + 2 * e] * __uint_as_float(w[e] << 16) + sq[64 + c * 8 + 2 * e + 1] * __uint_as_float(w[e] & 0xffff0000u); }
                }
            }
            const float bias = slope2 * (float)(s - t);
            const float s1 = valid ? d1 + bias : -INFINITY, s2 = valid ? d2 + bias : -INFINITY;
            const float n1 = fmaxf(m1, wave_max(s1)), n2 = fmaxf(m2, wave_max(s2));
            const float a1 = exp2f(m1 - n1), a2 = exp2f(m2 - n2);
            const float p1 = exp2f(s1 - n1), p2 = exp2f(s2 - n2);
            l1 = l1 * a1 + wave_sum(p1); l2 = l2 * a2 + wave_sum(p2);
            o1a *= a1; o1b *= a1; o2a *= a2; o2b *= a2; m1 = n1; m2 = n2;
            sq[128 + lane] = p1; sq[192 + lane] = p2;
            const int nk = min(64, t - s0 + 1);
            const unsigned* vr = (const unsigned*)(AV + ((size_t)b * SEQ + s0) * BW + h * 128) + lane;
            for (int j = 0; j < nk; ++j) {
                const unsigned v = vr[(size_t)j * (BW / 2)];
                const float va = __uint_as_float(v << 16), vb = __uint_as_float(v & 0xffff0000u);
                const float q1 = sq[128 + j], q2 = sq[192 + j];
                o1a += q1 * va; o1b += q1 * vb; o2a += q2 * va; o2b += q2 * vb;
            }
        }
        const float i1 = 1.0f / l1, i2 = lam / l2;
        const float ya = o1a * i1 - o2a * i2, yb = o1b * i1 - o2b * i2;
        const float ss = wave_sum(ya * ya + yb * yb);
        const float rn = rsqrtf(ss * (1.0f / 128.0f) + RMS_EPS) * osc;
        ((unsigned*)(YA + mq * BW + h * 128))[lane] = pk2(ya * rn * asg[2 * lane], yb * rn * asg[2 * lane + 1]);
    }
}

__device__ __forceinline__ void nv_conv(const Args& A, int l, int wg, int nwg) {
    const int tid = opaque_tid(), lane = tid & 63, wave = tid >> 6;
    const bf16_t* Z = (const bf16_t*)(A.ws + WS_Z); bf16_t* YB = (bf16_t*)(A.ws + WS_YB);
    const float* cw = A.in[I_CW] + (size_t)l * 31 * BW; const float* cb = A.in[I_CB] + l * BW;
    const float* lg = A.in[I_CLG] + l * BW; const float* lb = A.in[I_CLB] + l * BW;
    const int c0 = lane * 8;
    for (int m = wg * NWAVES + wave; m < M; m += nwg * NWAVES) {
        const int t = m & (SEQ - 1);
        float acc[8];
#pragma unroll
        for (int e = 0; e < 8; ++e) acc[e] = cb[c0 + e];
        const int j0 = max(0, 30 - t);
        for (int j = j0; j < 31; ++j) {
            const uint4 v = *(const uint4*)(Z + (size_t)(m - 30 + j) * BW + c0);
            const float4 wa = *(const float4*)(cw + j * BW + c0), wb = *(const float4*)(cw + j * BW + c0 + 4);
            acc[0] += wa.x * __uint_as_float(v.x << 16); acc[1] += wa.y * __uint_as_float(v.x & 0xffff0000u);
            acc[2] += wa.z * __uint_as_float(v.y << 16); acc[3] += wa.w * __uint_as_float(v.y & 0xffff0000u);
            acc[4] += wb.x * __uint_as_float(v.z << 16); acc[5] += wb.y * __uint_as_float(v.z & 0xffff0000u);
            acc[6] += wb.z * __uint_as_float(v.w << 16); acc[7] += wb.w * __uint_as_float(v.w & 0xffff0000u);
        }
        float s = 0.f;
#pragma unroll
        for (int e = 0; e < 8; ++e) s += acc[e];
        const float mu = wave_sum(s) * (1.0f / BW);
        float q = 0.f;
#pragma unroll
        for (int e = 0; e < 8; ++e) { acc[e] -= mu; q += acc[e] * acc[e]; }
        const float rstd = rsqrtf(wave_sum(q) * (1.0f / BW) + LN_EPS);
        float o[8];
#pragma unroll
        for (int e = 0; e < 8; ++e) o[e] = siluf_(acc[e] * rstd * lg[c0 + e] + lb[c0 + e]);
        *(uint4*)(YB + (size_t)m * BW + c0) = make_uint4(pk2(o[0], o[1]), pk2(o[2], o[3]), pk2(o[4], o[5]), pk2(o[6], o[7]));
    }
}

__device__ __forceinline__ void nv_ret(const Args& A, int l, int wg, int nwg, float* sm) {
    const int tid = opaque_tid(), lane = tid & 63, wave = tid >> 6;
    float* sq = sm + wave * 256;
    const bf16_t* RQ = (const bf16_t*)(A.ws + WS_RQ); const bf16_t* RK = (const bf16_t*)(A.ws + WS_RK); const bf16_t* RV = (const bf16_t*)(A.ws + WS_RV);
    const bf16_t* RG = (const bf16_t*)(A.ws + WS_RG); bf16_t* YC = (bf16_t*)(A.ws + WS_YC);
    const float* gn = A.in[I_RGN] + l * 128;
    for (int it = wg * NWAVES + wave; it < BATCH * 4 * SEQ; it += nwg * NWAVES) {
        const int t = it & (SEQ - 1), h = (it >> 12) & 3, b = it >> 14;
        const size_t mq = (size_t)b * SEQ + t;
        const float l2g128 = 128.0f * log2_gamma(h);
        { const unsigned v = ((const unsigned*)(RQ + mq * BW + h * 128))[lane]; sq[2 * lane] = __uint_as_float(v << 16); sq[2 * lane + 1] = __uint_as_float(v & 0xffff0000u); }
        float oa = 0.f, ob = 0.f;
        const int ct = t >> 7;
        for (int s0 = 0; s0 <= t; s0 += 64) {
            const int s = s0 + lane; const bool valid = s <= t;
            float d = 0.f;
            if (valid) {
                const uint4* kr = (const uint4*)(RK + ((size_t)b * SEQ + s) * BW + h * 128);
#pragma unroll 2
                for (int c = 0; c < 16; ++c) {
                    const uint4 v = kr[c]; const unsigned w[4] = {v.x, v.y, v.z, v.w};
#pragma unroll
                    for (int e = 0; e < 4; ++e) { d += sq[c * 8 + 2 * e] * __uint_as_float(w[e] << 16) + sq[c * 8 + 2 * e + 1] * __uint_as_float(w[e] & 0xffff0000u); }
                }
                d *= exp2f(l2g128 * (float)(ct - (s >> 7)));
            }
            sq[128 + lane] = d;
            const int nk = min(64, t - s0 + 1);
            const unsigned* vr = (const unsigned*)(RV + ((size_t)b * SEQ + s0) * BW + h * 128) + lane;
            for (int j = 0; j < nk; ++j) {
                const unsigned v = vr[(size_t)j * (BW / 2)];
                const float a = sq[128 + j];
                oa += a * __uint_as_float(v << 16); ob += a * __uint_as_float(v & 0xffff0000u);
            }
        }
        const float ss = wave_sum(oa * oa + ob * ob);
        const float rn = rsqrtf(ss * (1.0f / 128.0f) + RMS_EPS);
        const unsigned gv = ((const unsigned*)(RG + mq * BW + h * 128))[lane];
        ((unsigned*)(YC + mq * BW + h * 128))[lane] = pk2(oa * rn * gn[2 * lane] * __uint_as_float(gv << 16), ob * rn * gn[2 * lane + 1] * __uint_as_float(gv & 0xffff0000u));
    }
}

__device__ __forceinline__ void nv_p3(const Args& A, int l, int wg, int nwg, float* sm) {
    float* sA = sm; float* sB = sm + 16 * 128;
    const int tid = opaque_tid(), tx = tid & 15, ty = tid >> 4;
    const float* Win = A.in[I_WIN] + (size_t)l * DM * DIN;
    const float* g1 = A.in[I_N1G] + l * DM;
    const float* bg = A.in[I_BGATE] + l * NGATE;
    const float* Wbr = A.in[I_WBR] + (size_t)l * 3 * BW * DM;
    const bf16_t* XB = (const bf16_t*)(A.ws + WS_XB);
    const float* rowss = (const float*)(A.ws + WS_ROWSS) + (size_t)(l == 0 ? 0 : 2) * M;
    bf16_t* Y = (bf16_t*)(A.ws + WS_Y);
    for (int it = wg; it < 128 * 16; it += nwg) {
        const int rt = it / 16, cg = it % 16, row0 = rt * 128;
        float y[4][4];
#pragma unroll
        for (int i = 0; i < 4; ++i)
#pragma unroll
            for (int j = 0; j < 4; ++j) y[i][j] = 0.f;
#pragma unroll 1
        for (int n = 0; n < 3; ++n) {
            float ga[4][4], pa[4][4];
            nv_core(ga, DM, ALbf{XB, DM, row0}, WLf32{Win, DIN, NU + n * DM + 64 * cg, NU + n * DM + 64 * cg + 32, g1}, sA, sB, tid);
            const bf16_t* br = (const bf16_t*)(A.ws + (n == 0 ? WS_YA : n == 1 ? WS_YB : WS_YC));
            nv_core(pa, BW, ALbf{br, BW, row0}, WLf32{Wbr + (size_t)n * BW * DM, DM, 64 * cg, 64 * cg + 32, nullptr}, sA, sB, tid);
#pragma unroll
            for (int i = 0; i < 4; ++i) {
                const float rstd = rsqrtf(rowss[row0 + ty * 4 + i] * (1.0f / DM) + RMS_EPS);
#pragma unroll
                for (int j = 0; j < 4; ++j) y[i][j] += sigmoidf_(ga[i][j] * rstd + bg[n * DM + 64 * cg + tx * 4 + j]) * pa[i][j];
            }
        }
#pragma unroll
        for (int i = 0; i < 4; ++i)
            *(uint2*)(Y + (size_t)(row0 + ty * 4 + i) * DM + 64 * cg + tx * 4) = make_uint2(pk2(y[i][0], y[i][1]), pk2(y[i][2], y[i][3]));
    }
}

__device__ __forceinline__ void nv_resid_gemm(const Args& A, const bf16_t* Am, int lda, int K, const float* W, const float* xold, float* rowss_next, int wg, int nwg, float* sm) {
    float* sA = sm; float* sB = sm + 16 * 128;
    const int tid = opaque_tid(), tx = tid & 15, ty = tid >> 4;
    bf16_t* XB = (bf16_t*)(A.ws + WS_XB);
    for (int it = wg; it < 128 * 16; it += nwg) {
        const int rt = it / 16, cg = it % 16, row0 = rt * 128;
        float acc[4][4];
        nv_core(acc, K, ALbf{Am, lda, row0}, WLf32{W, DM, 64 * cg, 64 * cg + 32, nullptr}, sA, sB, tid);
#pragma unroll
        for (int i = 0; i < 4; ++i) {
            const size_t off = (size_t)(row0 + ty * 4 + i) * DM + 64 * cg + tx * 4;
            const float4 xo = *(const float4*)(xold + off);
            const float4 xn = make_float4(xo.x + acc[i][0], xo.y + acc[i][1], xo.z + acc[i][2], xo.w + acc[i][3]);
            *(float4*)(A.out + off) = xn;
            *(uint2*)(XB + off) = make_uint2(pk2(xn.x, xn.y), pk2(xn.z, xn.w));
            float s = xn.x * xn.x + xn.y * xn.y + xn.z * xn.z + xn.w * xn.w;
            s += __shfl_xor(s, 1); s += __shfl_xor(s, 2); s += __shfl_xor(s, 4); s += __shfl_xor(s, 8);
            if (tx == 0 && rowss_next) atomicAdd(rowss_next + row0 + ty * 4 + i, s);
        }
    }
}

__device__ __forceinline__ void nv_p5(const Args& A, int l, int wg, int nwg, float* sm) {
    float* sA = sm; float* sB = sm + 16 * 128; float* sC = sB + 16 * 64;
    const int tid = opaque_tid(), tx = tid & 15, ty = tid >> 4;
    const float* W = A.in[I_WF1] + (size_t)l * DM * 2 * DFF;
    const float* g2 = A.in[I_N2G] + l * DM;
    const bf16_t* XB = (const bf16_t*)(A.ws + WS_XB);
    const float* rowss = (const float*)(A.ws + WS_ROWSS) + (size_t)(l == 0 ? 1 : 3) * M;
    bf16_t* MID = (bf16_t*)(A.ws + WS_MID);
    for (int it = wg; it < 128 * 88; it += nwg) {
        const int rt = it / 88, jj = it % 88, row0 = rt * 128;
        float acc[4][4];
        nv_core(acc, DM, ALbf{XB, DM, row0}, WLf32{W, 2 * DFF, 32 * jj, DFF + 32 * jj, g2}, sA, sB, tid);
#pragma unroll
        for (int i = 0; i < 4; ++i) {
            const int r = ty * 4 + i; const float rstd = rsqrtf(rowss[row0 + r] * (1.0f / DM) + RMS_EPS);
#pragma unroll
            for (int j = 0; j < 4; ++j) sC[r * 65 + tx * 4 + j] = acc[i][j] * rstd;
        }
        __syncthreads();
        const int r = tid >> 2, q4 = tid & 3;
        const float* cr = sC + r * 65;
        bf16_t* o = MID + (size_t)(row0 + r) * DFF + 32 * jj + q4 * 8;
#pragma unroll
        for (int j = 0; j < 8; ++j) o[j] = (bf16_t)f2bf(siluf_(cr[q4 * 8 + j]) * cr[32 + q4 * 8 + j]);
        __syncthreads();
    }
}


namespace pg8 {
typedef short bf16x8 __attribute__((ext_vector_type(8)));
typedef float f32x4 __attribute__((ext_vector_type(4)));
typedef unsigned u32x4 __attribute__((ext_vector_type(4)));
constexpr int BM = 256, BK = 64, HALF = 128, HTB = HALF * BK * 2, STAGE_BYTES = 8 * HTB, NXCD = 8, WGM = 4;
__host__ __device__ __forceinline__ int lds_byte(int r, int c) { const int st = (r >> 4) * 2 + (c >> 5), rr = r & 15, cc = c & 31, ob = rr * 64 + cc * 2; return st * 1024 + (ob ^ (((ob >> 9) & 1) << 5)); }
__host__ __device__ __forceinline__ void stage_rc(int b, int& R, int& C) { const int st = b / 1024, sb = b % 1024, swz = sb ^ (((sb >> 9) & 1) << 5); R = (st >> 1) * 16 + swz / 64; C = (st & 1) * 32 + (swz % 64) / 2; }
__host__ __device__ __forceinline__ int perm32(int rho) { const int n = rho >> 4, i = rho & 15; return 8 * (i >> 2) + 4 * n + (i & 3); }

struct GUnit { const char* A; const char* B; int lda2, ldb2, nt, pm, pn, kind; };

struct TileOrder {
    int nM, nN, nwg, G, c;
    __device__ __forceinline__ void init(int nM_, int nN_, int G_, int c_) { nM = nM_; nN = nN_; nwg = nM * nN; G = G_; c = c_; }
    __device__ __forceinline__ bool tile(int i, int& pm, int& pn) const {
        const long L = (long)i * G + c; if (L >= nwg) return false;
        int wgid = (int)L; { const int q = nwg / NXCD, r = nwg % NXCD, xcd = wgid % NXCD, off = wgid / NXCD; wgid = (xcd < r ? xcd * (q + 1) : r * (q + 1) + (xcd - r) * q) + off; }
        const int nig = WGM * nN, gid = wgid / nig, fm = gid * WGM, gsz = (nM - fm) < WGM ? (nM - fm) : WGM;
        pm = fm + ((wgid % nig) % gsz); pn = (wgid % nig) / gsz; return true;
    }
};

typedef float f32x2_t __attribute__((ext_vector_type(2))); typedef __bf16 bf16x2_t __attribute__((ext_vector_type(2)));
__device__ __forceinline__ unsigned cvt_pk_bf16(float lo, float hi) { f32x2_t v = {lo, hi}; bf16x2_t b = __builtin_convertvector(v, bf16x2_t); return __builtin_bit_cast(unsigned, b); }
__device__ __forceinline__ u32x4 pack8(const f32x4& a, const f32x4& b) { u32x4 w; w.x = cvt_pk_bf16(a[0], a[1]); w.y = cvt_pk_bf16(a[2], a[3]); w.z = cvt_pk_bf16(b[0], b[1]); w.w = cvt_pk_bf16(b[2], b[3]); return w; }

template <class Epi, class Sched>
__device__ __forceinline__ void gemm_phase(LAS unsigned char* lds, const Sched& S, const Epi& E) {
    const int tid = opaque_tid(), wid = __builtin_amdgcn_readfirstlane(tid >> 6), lane = tid & 63, wr = wid >> 2, wc = wid & 3, fr = lane & 15, fq = lane >> 4;
    const size_t kstep = (size_t)(BK * 2);
    const unsigned ldsw = (unsigned)wid * 1024u;
    const int aoff = lds_byte(wr * 64 + fr, fq * 8), boff = lds_byte(wc * 32 + fr, fq * 8);
#define PG8_SA(b, h) (((b) * 2 + (h)) * HTB)
#define PG8_SB(b, h) ((4 + (b) * 2 + (h)) * HTB)
#define PG8_STAGE(bufoff, gbase, voff) do { _Pragma("unroll") for (int _i = 0; _i < 2; ++_i) \
        __builtin_amdgcn_global_load_lds((const unsigned*)((const char*)(gbase) + (voff)[_i]), (LAS unsigned*)(lds + (bufoff) + ldsw + _i * 8192), 16, 0, 0); } while (0)
#define PG8_LDA(dst, b, h) do { _Pragma("unroll") for (int m = 0; m < 4; ++m) _Pragma("unroll") for (int k = 0; k < 2; ++k) dst[m][k] = *(const LAS bf16x8*)(lds + PG8_SA(b, h) + aoff + m * 2048 + k * 1024); } while (0)
#define PG8_LDB(dst, b, h) do { _Pragma("unroll") for (int n = 0; n < 2; ++n) _Pragma("unroll") for (int k = 0; k < 2; ++k) dst[n][k] = *(const LAS bf16x8*)(lds + PG8_SB(b, h) + boff + n * 2048 + k * 1024); } while (0)
#define PG8_MMA(ai, bj, At, Bt) do { __builtin_amdgcn_s_setprio(1); _Pragma("unroll") for (int m = 0; m < 4; ++m) _Pragma("unroll") for (int n = 0; n < 2; ++n) _Pragma("unroll") for (int k = 0; k < 2; ++k) \
        acc[ai][bj][m][n] = __builtin_amdgcn_mfma_f32_16x16x32_bf16(Bt[n][k], At[m][k], acc[ai][bj][m][n], 0, 0, 0); __builtin_amdgcn_s_setprio(0); } while (0)
#define PG8_WAIT_V(n) asm volatile("s_waitcnt vmcnt(" #n ")" ::: "memory")
#define PG8_WAIT_L(n) asm volatile("s_waitcnt lgkmcnt(" #n ")" ::: "memory")
#define PG8_BAR __builtin_amdgcn_s_barrier()
#define PG8_SCHED __builtin_amdgcn_sched_barrier(0)
    GUnit cur, nxt; int ui = 0;
    if (!S.next(0, cur)) return;
    f32x4 acc[2][2][4][2];
#pragma unroll
    for (int a = 0; a < 2; ++a)
#pragma unroll
        for (int b = 0; b < 2; ++b)
#pragma unroll
            for (int m = 0; m < 4; ++m)
#pragma unroll
                for (int n = 0; n < 2; ++n) acc[a][b][m][n] = (f32x4){0.f, 0.f, 0.f, 0.f};
    bf16x8 At[4][2], B0[2][2], B1[2][2];
#define PG8_VOFF(vA_, vB_, lda2_, ldb2_) do { int tt_ = tid; asm volatile("" : "+v"(tt_)); _Pragma("unroll") for (int i_ = 0; i_ < 2; ++i_) { int R_, C_; stage_rc(tt_ * 16 + i_ * 8192, R_, C_); \
        vA_[i_] = (unsigned)(R_ * (lda2_) + C_ * 2); vB_[i_] = (unsigned)(((R_ & ~31) + perm32(R_ & 31)) * (ldb2_) + C_ * 2); } } while (0)
    const char* cA = cur.A; const char* cB = cur.B; size_t hA = (size_t)HALF * cur.lda2, hB = (size_t)HALF * cur.ldb2;
    unsigned vA[2], vB[2]; PG8_VOFF(vA, vB, cur.lda2, cur.ldb2);
    {
    PG8_STAGE(PG8_SB(0, 0), cB, vB); PG8_STAGE(PG8_SB(0, 1), cB + hB, vB); PG8_STAGE(PG8_SA(0, 0), cA, vA); PG8_STAGE(PG8_SA(0, 1), cA + hA, vA);
    if (wr == 1) PG8_BAR;
    PG8_WAIT_V(2); PG8_BAR;
    PG8_STAGE(PG8_SB(1, 0), cB + kstep, vB); PG8_STAGE(PG8_SA(1, 0), cA + kstep, vA); PG8_STAGE(PG8_SB(1, 1), cB + hB + kstep, vB);
    PG8_WAIT_V(6); PG8_BAR; }
    for (;;) {
        const bool has_next = S.next(ui + 1, nxt);
        if (!has_next) nxt = cur;
        const size_t nhA = (size_t)HALF * nxt.lda2, nhB = (size_t)HALF * nxt.ldb2;
        const int nt = cur.nt;
        unsigned wA[2], wB[2];
        for (int t = 0; t < nt; t += 2) {
            const bool last = (t == nt - 2);
            const char* a1 = cA + (size_t)(t + 1) * kstep;
            const char* a2 = last ? nxt.A : cA + (size_t)(t + 2) * kstep; const char* b2 = last ? nxt.B : cB + (size_t)(t + 2) * kstep;
            const char* a3 = a2 + kstep; const char* b3 = b2 + kstep;
            const size_t whA = last ? nhA : hA, whB = last ? nhB : hB;
            PG8_LDB(B0, 0, 0); PG8_LDB(B1, 0, 1); PG8_SCHED; PG8_LDA(At, 0, 0);
            PG8_STAGE(PG8_SA(1, 1), a1 + hA, vA);
            if (last) PG8_VOFF(wA, wB, nxt.lda2, nxt.ldb2); else { wA[0] = vA[0]; wA[1] = vA[1]; wB[0] = vB[0]; wB[1] = vB[1]; }
            PG8_WAIT_V(8); PG8_WAIT_L(0); PG8_BAR; PG8_MMA(0, 0, At, B0); PG8_MMA(0, 1, At, B1); PG8_BAR; PG8_SCHED;
            PG8_LDA(At, 0, 1); PG8_STAGE(PG8_SB(0, 0), b2, wB); PG8_STAGE(PG8_SB(0, 1), b2 + whB, wB); PG8_STAGE(PG8_SA(0, 0), a2, wA);
            PG8_WAIT_V(8); PG8_WAIT_L(0); PG8_BAR; PG8_MMA(1, 0, At, B0); PG8_MMA(1, 1, At, B1); PG8_BAR; PG8_SCHED;
            PG8_LDB(B0, 1, 0); PG8_LDB(B1, 1, 1); PG8_SCHED; PG8_LDA(At, 1, 0); PG8_STAGE(PG8_SA(0, 1), a2 + whA, wA);
            PG8_WAIT_V(8); PG8_WAIT_L(0); PG8_BAR; PG8_MMA(0, 0, At, B0); PG8_MMA(0, 1, At, B1); PG8_BAR; PG8_SCHED;
            PG8_LDA(At, 1, 1); PG8_STAGE(PG8_SB(1, 0), b3, wB); PG8_STAGE(PG8_SB(1, 1), b3 + whB, wB); PG8_STAGE(PG8_SA(1, 0), a3, wA);
            PG8_WAIT_V(8); PG8_WAIT_L(0); PG8_BAR; PG8_MMA(1, 0, At, B0); PG8_MMA(1, 1, At, B1); PG8_BAR; PG8_SCHED;
        }
        if (wr == 0) PG8_BAR;
        { int fr_ = fr, fq_ = fq; asm volatile("" : "+v"(fr_), "+v"(fq_));
          E(acc, cur, wr, wc, fr_, fq_); }
        if (!has_next) break;
#pragma unroll
        for (int a = 0; a < 2; ++a)
#pragma unroll
            for (int b = 0; b < 2; ++b)
#pragma unroll
                for (int m = 0; m < 4; ++m)
#pragma unroll
                    for (int n = 0; n < 2; ++n) acc[a][b][m][n] = (f32x4){0.f, 0.f, 0.f, 0.f};
        cur = nxt; cA = cur.A; cB = cur.B; hA = nhA; hB = nhB;
        vA[0] = wA[0]; vA[1] = wA[1]; vB[0] = wB[0]; vB[1] = wB[1];
        ++ui;
        if (wr == 1) PG8_BAR;
    }
    PG8_WAIT_V(0);
    PG8_BAR;
#undef PG8_VOFF
#undef PG8_SA
#undef PG8_SB
#undef PG8_STAGE
#undef PG8_LDA
#undef PG8_LDB
#undef PG8_MMA
#undef PG8_WAIT_V
#undef PG8_WAIT_L
#undef PG8_BAR
#undef PG8_SCHED
}
}
using pg8::f32x4; using pg8::u32x4; using pg8::GUnit;

constexpr size_t WS_WB = 2 * MiB, WB_LAYER = 37 * MiB;
constexpr size_t WB_W1 = 0, WB_WG = 9 * MiB, WB_WBR = 15 * MiB, WB_WO = 18 * MiB, WB_WF1 = 20 * MiB, WB_WF2 = 31 * MiB;
constexpr size_t WS_GSCR = 190 * MiB;
static_assert(WS_WB + 2 * WB_LAYER <= WS_XB, "weights vs XB");

__device__ __forceinline__ int p1_src_col(int tile, int p) {
    if (tile < 4) return (tile >> 1) * 512 + (tile & 1) * 256 + 64 * ((p >> 5) & 3) + 32 * (p >> 7);
    if (tile < 6) return 1024 + (tile - 4) * 256 + p;
    if (tile < 10) return (p < 128) ? 1536 + 128 * (tile - 6) + p : 2048 + 128 * (tile - 6) + (p - 128);
    return 2560 + (tile - 10) * 256 + p;
}
constexpr int NI_W1 = 144 * 16, NI_WG = 96 * 16, NI_WBR = 3 * 32 * 8, NI_WO = 32 * 16, NI_F1 = 176 * 16, NI_F2 = 32 * 44;
constexpr int PER_LAYER = NI_W1 + NI_WG + NI_WBR + NI_WO + NI_F1 + NI_F2;
struct P0Item { const GAS float* src; const GAS float* g; GAS bf16_t* dst; int ldw, K, hasg; };
__device__ __forceinline__ void p0_desc(const Args& A, int it, int lane, P0Item& d) {
#define P0_DEC(nkb_) const int q_ = r >> 2, kb = q_ % (nkb_), rb = 4 * (q_ / (nkb_)) + (r & 3)
    const int l = it / PER_LAYER; int r = it % PER_LAYER;
    unsigned char* wb = A.ws + WS_WB + (size_t)l * WB_LAYER;
    const float* W; const float* g = nullptr; bf16_t* WT; int ldw, src0, K, prow0, k0;
    if (r < NI_W1) { P0_DEC(16); W = A.in[I_WIN] + (size_t)l * DM * DIN; ldw = DIN; src0 = p1_src_col(rb >> 3, (rb & 7) * 32); g = A.in[I_N1G] + l * DM; WT = (bf16_t*)(wb + WB_W1); K = DM; prow0 = 32 * rb; k0 = 64 * kb; }
    else if ((r -= NI_W1) < NI_WG) { P0_DEC(16); W = A.in[I_WIN] + (size_t)l * DM * DIN; ldw = DIN; src0 = NU + 32 * rb; g = A.in[I_N1G] + l * DM; WT = (bf16_t*)(wb + WB_WG); K = DM; prow0 = 32 * rb; k0 = 64 * kb; }
    else if ((r -= NI_WG) < NI_WBR) { const int n = r / 256; r %= 256; P0_DEC(8); W = A.in[I_WBR] + ((size_t)l * 3 + n) * BW * DM; ldw = DM; src0 = 32 * rb; WT = (bf16_t*)(wb + WB_WBR) + (size_t)n * DM * BW; K = BW; prow0 = 32 * rb; k0 = 64 * kb; }
    else if ((r -= NI_WBR) < NI_WO) { P0_DEC(16); W = A.in[I_WOUT] + (size_t)l * DM * DM; ldw = DM; src0 = 32 * rb; WT = (bf16_t*)(wb + WB_WO); K = DM; prow0 = 32 * rb; k0 = 64 * kb; }
    else if ((r -= NI_WO) < NI_F1) { P0_DEC(16); const int tile = rb >> 3, p = (rb & 7) * 32; W = A.in[I_WF1] + (size_t)l * DM * 2 * DFF; ldw = 2 * DFF; src0 = (p < 128) ? 128 * tile + p : DFF + 128 * tile + (p - 128);
        g = A.in[I_N2G] + l * DM; WT = (bf16_t*)(wb + WB_WF1); K = DM; prow0 = 32 * rb; k0 = 64 * kb; }
    else { r -= NI_F1; P0_DEC(44); W = A.in[I_WF2] + (size_t)l * DFF * DM; ldw = DM; src0 = 32 * rb; WT = (bf16_t*)(wb + WB_WF2); K = DFF; prow0 = 32 * rb; k0 = 64 * kb; }
#undef P0_DEC
    const int kr = lane >> 3, cq = (lane & 7) * 4;
    d.src = (const GAS float*)(W + (size_t)(k0 + 8 * kr) * ldw + src0 + cq); d.ldw = ldw;
    d.hasg = g != nullptr; d.g = (const GAS float*)((g ? g : A.in[I_N1G]) + k0 % DM + 8 * kr);
    d.dst = (GAS bf16_t*)(WT + (size_t)(prow0 + (lane >> 3)) * K + k0 + 8 * (lane & 7)); d.K = K;
}
__device__ __forceinline__ void p0_load(const P0Item& d, f32x4 (&v)[8], float (&gv)[8]) {
#pragma unroll
    for (int i = 0; i < 8; ++i) v[i] = *(const GAS f32x4*)(d.src + (size_t)i * d.ldw);
    const f32x4 ga = *(const GAS f32x4*)d.g, gb = *(const GAS f32x4*)(d.g + 4);
#pragma unroll
    for (int i = 0; i < 4; ++i) { gv[i] = ga[i]; gv[4 + i] = gb[i]; }
}
__device__ __forceinline__ void p0_finish(const P0Item& d, const f32x4 (&v)[8], const float (&gv)[8], LAS float* scr, int lane) {
    const int kr = lane >> 3, cq = (lane & 7) * 4;
#pragma unroll
    for (int i = 0; i < 8; ++i) { const f32x4 x = v[i] * (d.hasg ? gv[i] : 1.0f); LAS float* q = scr + (8 * kr + i) * 33 + cq; q[0] = x[0]; q[1] = x[1]; q[2] = x[2]; q[3] = x[3]; }
    asm volatile("s_waitcnt lgkmcnt(0)" ::: "memory");
    const int c = lane & 7;
#pragma unroll
    for (int j = 0; j < 4; ++j) { const int n = (lane >> 3) + 8 * j; const LAS float* s_ = scr + (8 * c) * 33 + n;
        u32x4 o; o.x = pg8::cvt_pk_bf16(s_[0 * 33], s_[1 * 33]); o.y = pg8::cvt_pk_bf16(s_[2 * 33], s_[3 * 33]); o.z = pg8::cvt_pk_bf16(s_[4 * 33], s_[5 * 33]); o.w = pg8::cvt_pk_bf16(s_[6 * 33], s_[7 * 33]);
        *(GAS u32x4*)(d.dst + (size_t)(8 * j) * d.K) = o; }
    asm volatile("s_waitcnt lgkmcnt(0)" ::: "memory");
}
__device__ __forceinline__ void fast_p0_weights(const Args& A, int wg, int nwg, LAS float* sm, int item_lo, int item_hi, bool wave_major = false) {
    const int tid = opaque_tid(), lane = tid & 63, wave = __builtin_amdgcn_readfirstlane(tid >> 6);
    LAS float* scr = sm + wave * (64 * 33);
    const int per = nwg * NWAVES, nq = (item_hi - item_lo) >> 2;
    for (int k = 0; k * per < nq; ++k) {
        const int left = nq - k * per, idx = (wave_major || left < per) ? wave * nwg + wg : wg * NWAVES + wave;
        if (idx >= left) break;
        const int it = item_lo + 4 * (k * per + idx);
        P0Item d0, d1, d2, d3; f32x4 v0[8], v1[8], v2[8], v3[8]; float g0[8], g1[8], g2[8], g3[8];
        p0_desc(A, it, lane, d0); p0_load(d0, v0, g0);
        p0_desc(A, it + 1, lane, d1); p0_load(d1, v1, g1);
        p0_desc(A, it + 2, lane, d2); p0_load(d2, v2, g2);
        p0_desc(A, it + 3, lane, d3); p0_load(d3, v3, g3);
        p0_finish(d0, v0, g0, scr, lane);
        p0_finish(d1, v1, g1, scr, lane);
        p0_finish(d2, v2, g2, scr, lane);
        p0_finish(d3, v3, g3, scr, lane);
    }
}
static_assert(NI_W1 % 4 == 0 && NI_WG % 4 == 0 && NI_WBR % 4 == 0 && NI_WO % 4 == 0 && NI_F1 % 4 == 0 && NI_F2 % 4 == 0, "item quads");

struct SchedPlain {
    pg8::TileOrder o; const char* A; const char* B; int lda2, ldb2, nt;
    __device__ __forceinline__ bool next(int i, GUnit& u) const {
        int pm, pn; if (!o.tile(i, pm, pn)) return false;
        u.A = A + (size_t)pm * 256 * lda2; u.B = B + (size_t)pn * 256 * ldb2; u.lda2 = lda2; u.ldb2 = ldb2; u.nt = nt; u.pm = pm; u.pn = pn; u.kind = 0; return true;
    }
};
struct SchedP3 {
    pg8::TileOrder o; const char* ws; const char* wb;
    __device__ __forceinline__ bool next(int i, GUnit& u) const {
        int pm, pn; if (!o.tile(i / 6, pm, pn)) return false;
        const int sub = i % 6, n = sub >> 1; const bool proj = (sub & 1) != 0;
        u.pm = pm; u.pn = pn; u.kind = sub;
        const size_t aoff = !proj ? WS_XB : (n == 0 ? WS_YA : (n == 1 ? WS_YB : WS_YC));
        const int ld2 = proj ? BW * 2 : DM * 2;
        u.A = ws + aoff + (size_t)pm * 256 * ld2; u.lda2 = ld2;
        u.B = wb + (proj ? WB_WBR : WB_WG) + (size_t)(n * DM + pn * 256) * ld2; u.ldb2 = ld2; u.nt = ld2 >> 7;
        return true;
    }
};

__device__ __forceinline__ float fast_sigmoid(float x) { return __builtin_amdgcn_rcpf(1.0f + __builtin_amdgcn_exp2f(-LOG2E * x)); }
__device__ __forceinline__ f32x4 sig4(const f32x4& v) { return (f32x4){fast_sigmoid(v[0]), fast_sigmoid(v[1]), fast_sigmoid(v[2]), fast_sigmoid(v[3])}; }
__device__ __forceinline__ float sigx(float z) { return __builtin_amdgcn_rcpf(1.0f + __builtin_amdgcn_exp2f(z)); }
__device__ __forceinline__ f32x4 sigx4(const f32x4& v) { return (f32x4){sigx(v[0]), sigx(v[1]), sigx(v[2]), sigx(v[3])}; }
__device__ __forceinline__ float dot4(const f32x4& a) { return (a[0] * a[0] + a[1] * a[1]) + (a[2] * a[2] + a[3] * a[3]); }
__device__ __forceinline__ void gst16(void* p, const u32x4& v) { *(GAS u32x4*)p = v; }
__device__ __forceinline__ u32x4 gld16(const void* p) { return *(const GAS u32x4*)p; }
__device__ __forceinline__ f32x4 gld4f(const float* p) { return *(const GAS f32x4*)p; }
#define EPI_RSTD8(rs, rowss_, u_, wr_, fr_) float rs[8]; do { const GAS float* rp_ = (const GAS float*)(rowss_) + (u_).pm * 256 + (wr_) * 64 + (fr_); \
    _Pragma("unroll") for (int i_ = 0; i_ < 8; ++i_) rs[i_] = rp_[(i_ >> 2) * 128 + (i_ & 3) * 16]; \
    _Pragma("unroll") for (int i_ = 0; i_ < 8; ++i_) rs[i_] = __builtin_amdgcn_rsqf(rs[i_] * (1.0f / DM) + RMS_EPS); } while (0)

struct EpiP1 {
    unsigned char* ws; const float* rowss; const float* qg; const float* kg;
    __device__ __forceinline__ void operator()(const f32x4 (&acc)[2][2][4][2], const GUnit& u, int wr, int wc, int fr, int fq) const {
        const int pn = u.pn;
        if (pn < 4) {
            const bool isq = pn < 2; const float* gg = isq ? qg : kg; const float sc = isq ? QSCALE : 1.0f;
            const f32x4 ga0 = gld4f(gg + 8 * fq), ga1 = gld4f(gg + 8 * fq + 4), gb0 = gld4f(gg + 32 + 8 * fq), gb1 = gld4f(gg + 32 + 8 * fq + 4);
            EPI_RSTD8(rs, rowss, u, wr, fr);
            bf16_t* base = (bf16_t*)(ws + (isq ? WS_AQ : WS_AK)) + (pn & 1) * 256 + 64 * wc + 8 * fq;
#pragma unroll
            for (int ai = 0; ai < 2; ++ai)
#pragma unroll
                for (int m = 0; m < 4; ++m) {
                    const int row = u.pm * 256 + ai * 128 + wr * 64 + m * 16 + fr;
                    const float rstd = rs[ai * 4 + m];
                    const f32x4 a0 = acc[ai][0][m][0] * rstd, a1 = acc[ai][0][m][1] * rstd, b0 = acc[ai][1][m][0] * rstd, b1 = acc[ai][1][m][1] * rstd;
                    float ss = (dot4(a0) + dot4(a1)) + (dot4(b0) + dot4(b1));
                    ss += __shfl_xor(ss, 16); ss += __shfl_xor(ss, 32);
                    const float rn = __builtin_amdgcn_rsqf(ss * (1.0f / 64.0f) + RMS_EPS) * sc;
                    bf16_t* o = base + (size_t)row * BW;
                    gst16(o, pg8::pack8(a0 * ga0 * rn, a1 * ga1 * rn));
                    gst16(o + 32, pg8::pack8(b0 * gb0 * rn, b1 * gb1 * rn));
                }
        } else if (pn >= 6 && pn < 10) {
            EPI_RSTD8(rs, rowss, u, wr, fr);
            bf16_t* base = (bf16_t*)(ws + WS_Z) + 128 * (pn - 6) + 32 * wc + 8 * fq;
#pragma unroll
            for (int ai = 0; ai < 2; ++ai)
#pragma unroll
                for (int m = 0; m < 4; ++m) {
                    const int row = u.pm * 256 + ai * 128 + wr * 64 + m * 16 + fr;
                    const float rstd = rs[ai * 4 + m], nr = -LOG2E * rstd;
                    const f32x4 z0 = acc[ai][0][m][0] * rstd * sigx4(acc[ai][1][m][0] * nr), z1 = acc[ai][0][m][1] * rstd * sigx4(acc[ai][1][m][1] * nr);
                    gst16(base + (size_t)row * BW, pg8::pack8(z0, z1));
                }
        } else {
            size_t wsoff; int kind;
            if (pn < 6) { wsoff = WS_AV; kind = 0; } else if (pn < 12) { wsoff = WS_RQ; kind = 1; } else if (pn < 14) { wsoff = WS_RK; kind = 2; } else if (pn < 16) { wsoff = WS_RV; kind = 0; } else { wsoff = WS_RG; kind = 3; }
            EPI_RSTD8(rs, rowss, u, wr, fr);
            bf16_t* base = (bf16_t*)(ws + wsoff) + (pn & 1) * 256 + 32 * wc + 8 * fq;
            const float l2g0 = log2_gamma((pn & 1) * 2), l2g1 = log2_gamma((pn & 1) * 2 + 1);
#pragma unroll
            for (int ai = 0; ai < 2; ++ai)
#pragma unroll
                for (int m = 0; m < 4; ++m) {
                    const int row = u.pm * 256 + ai * 128 + wr * 64 + m * 16 + fr;
                    const float rstd = rs[ai * 4 + m];
                    const float tp = (float)(row & 127);
                    float f0 = rstd, f1 = rstd;
                    if (kind == 1) { f0 *= exp2f(tp * l2g0); f1 *= exp2f(tp * l2g1); }
                    if (kind == 2) { f0 *= 0.08838834764831845f * exp2f(-tp * l2g0); f1 *= 0.08838834764831845f * exp2f(-tp * l2g1); }
                    f32x4 a0 = acc[ai][0][m][0] * f0, a1 = acc[ai][0][m][1] * f0, b0 = acc[ai][1][m][0] * f1, b1 = acc[ai][1][m][1] * f1;
                    if (kind == 3) { a0 = a0 * sigx4(a0 * -LOG2E); a1 = a1 * sigx4(a1 * -LOG2E); b0 = b0 * sigx4(b0 * -LOG2E); b1 = b1 * sigx4(b1 * -LOG2E); }
                    bf16_t* o = base + (size_t)row * BW;
                    gst16(o, pg8::pack8(a0, a1));
                    gst16(o + 128, pg8::pack8(b0, b1));
                }
        }
    }
};
struct EpiP3 {
    const float* rowss; const float* bg; unsigned char* gscr; bf16_t* Y;
    __device__ __forceinline__ void operator()(const f32x4 (&acc)[2][2][4][2], const GUnit& u, int wr, int wc, int fr, int fq) const {
        const int n = u.kind >> 1;
        u32x4* gs = (u32x4*)gscr + ((wr * 4 + wc) * 64 + fq * 16 + fr);
        if (!(u.kind & 1)) {
            const float* bp = bg + n * DM + u.pn * 256 + 32 * wc + 8 * fq;
            const f32x4 ba0 = gld4f(bp) * -LOG2E, ba1 = gld4f(bp + 4) * -LOG2E, bb0 = gld4f(bp + 128) * -LOG2E, bb1 = gld4f(bp + 132) * -LOG2E;
            EPI_RSTD8(rs, rowss, u, wr, fr);
#pragma unroll
            for (int ai = 0; ai < 2; ++ai)
#pragma unroll
                for (int m = 0; m < 4; ++m) {
                    const float nr = -LOG2E * rs[ai * 4 + m];
                    gst16(gs + ((ai * 4 + m) * 2 + 0) * NTHREADS, pg8::pack8(acc[ai][0][m][0] * nr + ba0, acc[ai][0][m][1] * nr + ba1));
                    gst16(gs + ((ai * 4 + m) * 2 + 1) * NTHREADS, pg8::pack8(acc[ai][1][m][0] * nr + bb0, acc[ai][1][m][1] * nr + bb1));
                }
        } else {
            bf16_t* yb = Y + (size_t)(u.pm * 256 + wr * 64 + fr) * DM + u.pn * 256 + 32 * wc + 8 * fq;
            u32x4 gq[2][2][2], pq[2][2][2];
#define P3_LOAD(q_, b_) do { _Pragma("unroll") for (int mm = 0; mm < 2; ++mm) _Pragma("unroll") for (int bj = 0; bj < 2; ++bj) { const int ai_ = (q_) >> 1, m_ = ((q_) & 1) * 2 + mm; \
            gq[b_][mm][bj] = gld16(gs + ((ai_ * 4 + m_) * 2 + bj) * NTHREADS); \
            if (n > 0) pq[b_][mm][bj] = gld16(yb + (size_t)(ai_ * 128 + m_ * 16) * DM + 128 * bj); } } while (0)
            P3_LOAD(0, 0);
#pragma unroll
            for (int q = 0; q < 4; ++q) {
                if (q + 1 < 4) { if (q & 1) P3_LOAD(q + 1, 0); else P3_LOAD(q + 1, 1); }
#pragma unroll
                for (int mm = 0; mm < 2; ++mm)
#pragma unroll
                    for (int bj = 0; bj < 2; ++bj) {
                        const int ai = q >> 1, m = (q & 1) * 2 + mm;
                        const u32x4 g = gq[q & 1][mm][bj];
                        f32x4 y0 = acc[ai][bj][m][0], y1 = acc[ai][bj][m][1];
                        y0[0] *= sigx(__uint_as_float(g.x << 16)); y0[1] *= sigx(__uint_as_float(g.x & 0xffff0000u)); y0[2] *= sigx(__uint_as_float(g.y << 16)); y0[3] *= sigx(__uint_as_float(g.y & 0xffff0000u));
                        y1[0] *= sigx(__uint_as_float(g.z << 16)); y1[1] *= sigx(__uint_as_float(g.z & 0xffff0000u)); y1[2] *= sigx(__uint_as_float(g.w << 16)); y1[3] *= sigx(__uint_as_float(g.w & 0xffff0000u));
                        if (n > 0) { const u32x4 p = pq[q & 1][mm][bj];
                            y0[0] += __uint_as_float(p.x << 16); y0[1] += __uint_as_float(p.x & 0xffff0000u); y0[2] += __uint_as_float(p.y << 16); y0[3] += __uint_as_float(p.y & 0xffff0000u);
                            y1[0] += __uint_as_float(p.z << 16); y1[1] += __uint_as_float(p.z & 0xffff0000u); y1[2] += __uint_as_float(p.w << 16); y1[3] += __uint_as_float(p.w & 0xffff0000u); }
                        gst16(yb + (size_t)(ai * 128 + m * 16) * DM + 128 * bj, pg8::pack8(y0, y1));
                    }
            }
#undef P3_LOAD
        }
    }
};
struct EpiResid {
    bf16_t* XB; float* out; float* rowss_next;
    __device__ __forceinline__ void operator()(const f32x4 (&acc)[2][2][4][2], const GUnit& u, int wr, int wc, int fr, int fq) const {
        const size_t off0 = (size_t)(u.pm * 256 + wr * 64 + fr) * DM + u.pn * 256 + 32 * wc + 8 * fq;
        u32x4 xo[2][4][2];
#pragma unroll
        for (int ai = 0; ai < 2; ++ai)
#pragma unroll
            for (int m = 0; m < 4; ++m)
#pragma unroll
                for (int bj = 0; bj < 2; ++bj) xo[ai][m][bj] = gld16(XB + off0 + (size_t)(ai * 128 + m * 16) * DM + 128 * bj);
#pragma unroll
        for (int ai = 0; ai < 2; ++ai)
#pragma unroll
            for (int m = 0; m < 4; ++m) {
                const int row = u.pm * 256 + ai * 128 + wr * 64 + m * 16 + fr;
                float ss = 0.f;
#pragma unroll
                for (int bj = 0; bj < 2; ++bj) {
                    const size_t off = off0 + (size_t)(ai * 128 + m * 16) * DM + 128 * bj;
                    const u32x4 p = xo[ai][m][bj];
                    f32x4 x0 = acc[ai][bj][m][0], x1 = acc[ai][bj][m][1];
                    x0[0] += __uint_as_float(p.x << 16); x0[1] += __uint_as_float(p.x & 0xffff0000u); x0[2] += __uint_as_float(p.y << 16); x0[3] += __uint_as_float(p.y & 0xffff0000u);
                    x1[0] += __uint_as_float(p.z << 16); x1[1] += __uint_as_float(p.z & 0xffff0000u); x1[2] += __uint_as_float(p.w << 16); x1[3] += __uint_as_float(p.w & 0xffff0000u);
                    if (out) { *(GAS f32x4*)(out + off) = x0; *(GAS f32x4*)(out + off + 4) = x1; }
                    else { gst16(XB + off, pg8::pack8(x0, x1)); ss += dot4(x0) + dot4(x1); }
                }
                if (!out) { ss += __shfl_xor(ss, 16); ss += __shfl_xor(ss, 32); if (fq == 0) atomicAdd(rowss_next + row, ss); }
            }
    }
};
struct EpiSwiglu {
    const float* rowss; bf16_t* MID;
    static __device__ __forceinline__ f32x4 sw4(const f32x4& g, const f32x4& up, float nr, float v) {
        f32x4 o;
#pragma unroll
        for (int i = 0; i < 4; ++i) { const float e = __builtin_amdgcn_exp2f(g[i] * nr); o[i] = g[i] * up[i] * __builtin_amdgcn_rcpf(fmaf(e, v, v)); }
        return o;
    }
    __device__ __forceinline__ void operator()(const f32x4 (&acc)[2][2][4][2], const GUnit& u, int wr, int wc, int fr, int fq) const {
        bf16_t* base = MID + 128 * u.pn + 32 * wc + 8 * fq;
        float vv[8], rr[8];
        { const GAS float* rp_ = (const GAS float*)rowss + u.pm * 256 + wr * 64 + fr;
#pragma unroll
          for (int i = 0; i < 8; ++i) vv[i] = rp_[(i >> 2) * 128 + (i & 3) * 16];
#pragma unroll
          for (int i = 0; i < 8; ++i) { vv[i] = vv[i] * (1.0f / DM) + RMS_EPS; rr[i] = __builtin_amdgcn_rsqf(vv[i]); } }
#pragma unroll
        for (int ai = 0; ai < 2; ++ai)
#pragma unroll
            for (int m = 0; m < 4; ++m) {
                const int row = u.pm * 256 + ai * 128 + wr * 64 + m * 16 + fr;
                const float nr = -LOG2E * rr[ai * 4 + m], v = vv[ai * 4 + m];
                gst16(base + (size_t)row * DFF, pg8::pack8(sw4(acc[ai][0][m][0], acc[ai][1][m][0], nr, v), sw4(acc[ai][0][m][1], acc[ai][1][m][1], nr, v)));
            }
    }
};

__device__ __forceinline__ void fast_gemm(const Args& A, int l, int k, LAS unsigned char* lds) {
    const int G = gridDim.x, c = blockIdx.x;
    const char* wb = (const char*)(A.ws + WS_WB + (size_t)l * WB_LAYER);
    const char* XB = (const char*)(A.ws + WS_XB);
    float* rowss = (float*)(A.ws + WS_ROWSS);
    if (k == 0) {
        SchedPlain S; S.o.init(M / 256, NU / 256, G, c); S.A = XB; S.lda2 = DM * 2; S.B = wb + WB_W1; S.ldb2 = DM * 2; S.nt = DM / 64;
        EpiP1 E{A.ws, rowss + (size_t)(l == 0 ? 0 : 2) * M, A.in[I_QG] + l * 64, A.in[I_KG] + l * 64};
        pg8::gemm_phase(lds, S, E);
        if (l == 0) { const int full = S.o.nwg / G, rem = S.o.nwg - full * G;
            if (rem > 0 && c >= rem) fast_p0_weights(A, c - rem, G - rem, (LAS float*)lds, NI_W1, PER_LAYER);
            else if (rem == 0) fast_p0_weights(A, c, G, (LAS float*)lds, NI_W1, PER_LAYER); }
    } else if (k == 2) {
        SchedP3 S; S.o.init(M / 256, DM / 256, G, c); S.ws = (const char*)A.ws; S.wb = wb;
        EpiP3 E{rowss + (size_t)(l == 0 ? 0 : 2) * M, A.in[I_BGATE] + l * NGATE, A.ws + WS_GSCR + (size_t)blockIdx.x * (128 * 1024), (bf16_t*)(A.ws + WS_Y)};
        pg8::gemm_phase(lds, S, E);
    } else if (k == 3) {
        SchedPlain S; S.o.init(M / 256, DM / 256, G, c); S.A = (const char*)(A.ws + WS_Y); S.lda2 = DM * 2; S.B = wb + WB_WO; S.ldb2 = DM * 2; S.nt = DM / 64;
        EpiResid E{(bf16_t*)(A.ws + WS_XB), nullptr, rowss + (size_t)(l == 0 ? 1 : 3) * M};
        pg8::gemm_phase(lds, S, E);
    } else if (k == 4) {
        SchedPlain S; S.o.init(M / 256, 2 * DFF / 256, G, c); S.A = XB; S.lda2 = DM * 2; S.B = wb + WB_WF1; S.ldb2 = DM * 2; S.nt = DM / 64;
        EpiSwiglu E{rowss + (size_t)(l == 0 ? 1 : 3) * M, (bf16_t*)(A.ws + WS_MID)};
        pg8::gemm_phase(lds, S, E);
        if (l == 0) { const int full = S.o.nwg / G, rem = S.o.nwg - full * G;
            if (rem > 0 && c >= rem) fast_p0_weights(A, c - rem, G - rem, (LAS float*)lds, PER_LAYER, DEPTH * PER_LAYER);
            else if (rem == 0) fast_p0_weights(A, c, G, (LAS float*)lds, PER_LAYER, DEPTH * PER_LAYER); }
    } else {
        SchedPlain S; S.o.init(M / 256, DM / 256, G, c); S.A = (const char*)(A.ws + WS_MID); S.lda2 = DFF * 2; S.B = wb + WB_WF2; S.ldb2 = DFF * 2; S.nt = DFF / 64;
        EpiResid E{(bf16_t*)(A.ws + WS_XB), l + 1 < DEPTH ? nullptr : A.out, rowss + (size_t)2 * M};
        pg8::gemm_phase(lds, S, E);
    }
}


namespace mx {
typedef short bf16x8 __attribute__((ext_vector_type(8)));
typedef short s16x4 __attribute__((ext_vector_type(4)));
typedef short v4i16_t __attribute__((ext_vector_type(4)));
typedef float f32x16 __attribute__((ext_vector_type(16)));
typedef LAS unsigned char* lptr;
typedef unsigned u32x2 __attribute__((ext_vector_type(2)));
__device__ __forceinline__ int crow(int r, int hi) { return (r & 3) + 8 * (r >> 2) + 4 * hi; }
__device__ __forceinline__ s16x4 vtr(lptr p) { return __builtin_bit_cast(s16x4, __builtin_amdgcn_ds_read_tr16_b64_v4i16((LAS v4i16_t*)p)); }
__device__ __forceinline__ bf16x8 cat8(s16x4 lo, s16x4 hi) { return (bf16x8){lo[0], lo[1], lo[2], lo[3], hi[0], hi[1], hi[2], hi[3]}; }
__device__ __forceinline__ bf16x8 ld8(lptr p) { return *(const LAS bf16x8*)p; }
__device__ __forceinline__ float swap_max(float v) { auto rr = __builtin_amdgcn_permlane32_swap(__float_as_uint(v), __float_as_uint(v), false, false); return fmaxf(__uint_as_float(rr[0]), __uint_as_float(rr[1])); }
__device__ __forceinline__ float swap_sum(float v) { auto rr = __builtin_amdgcn_permlane32_swap(__float_as_uint(v), __float_as_uint(v), false, false); return __uint_as_float(rr[0]) + __uint_as_float(rr[1]); }
__device__ __forceinline__ bf16x8 pack_p(const f32x16& p, int b) {
    pg8::u32x4 w; w.x = pg8::cvt_pk_bf16(p[b], p[b + 1]); w.y = pg8::cvt_pk_bf16(p[b + 2], p[b + 3]); w.z = pg8::cvt_pk_bf16(p[b + 4], p[b + 5]); w.w = pg8::cvt_pk_bf16(p[b + 6], p[b + 7]);
    return __builtin_bit_cast(bf16x8, w);
}
#define MFMA32(a, b, c) __builtin_amdgcn_mfma_f32_32x32x16_bf16((a), (b), (c), 0, 0, 0)
#define DPP_ADD(v, ctrl, rmask) ((v) + __builtin_bit_cast(float, __builtin_amdgcn_update_dpp(0, __builtin_bit_cast(int, (v)), (ctrl), (rmask), 0xf, false)))
__device__ __forceinline__ float half_sum32(float v) {
    v = DPP_ADD(v, 0xB1, 0xf);
    v = DPP_ADD(v, 0x4E, 0xf);
    v = DPP_ADD(v, 0x141, 0xf);
    v = DPP_ADD(v, 0x140, 0xf);
    v = DPP_ADD(v, 0x142, 0xa);
    return v;
}

#define LDS_BAR() asm volatile("s_waitcnt lgkmcnt(0)\n\ts_barrier" ::: "memory")

constexpr int A_KSLOT = 8192, A_KBUF = 16384, A_V0 = 32768, A_VBUF = 16384, A_STAGE = 98304, A_WS = 131072 + 4096;
template <int ABL>
__device__ __forceinline__ void attn_unit(const Args& A, int l, int b, int h, int qb, lptr lds) {
    const int tid = opaque_tid(), lane = tid & 63, r32 = lane & 31, hi = lane >> 5; const int wid = __builtin_amdgcn_readfirstlane(tid >> 6), mp = wid >> 2, qw = wid & 3;
    const bf16_t* AQ = (const bf16_t*)(A.ws + WS_AQ); const bf16_t* AK = (const bf16_t*)(A.ws + WS_AK); const bf16_t* AV = (const bf16_t*)(A.ws + WS_AV);
    const size_t rowbase = (size_t)b * SEQ;
    const int q0 = 128 * qb + 32 * qw;
    const int NT = 2 * (qb + 1);
    LAS float* wsf = (LAS float*)(lds + A_WS) + wid * 64;
    const bf16_t* ksrc[2]; const bf16_t* vsrc[2]; int kdst[2], vdst[2];
#pragma unroll
    for (int j = 0; j < 2; ++j) { const int P = 2 * wid + j;
        ksrc[j] = AK + (rowbase + 8 * (P & 7) + (lane >> 3)) * BW + h * 128 + (P >> 3) * 64 + (((lane & 7) ^ (lane >> 3)) * 8);
        vsrc[j] = AV + (rowbase + 8 * (P >> 1) + ((lane >> 2) & 7)) * BW + h * 128 + 32 * (2 * (P & 1) + (lane >> 5)) + 8 * (lane & 3);
        kdst[j] = (P >> 3) * A_KSLOT + (P & 7) * 1024; vdst[j] = (P >> 1) * 2048 + (P & 1) * 1024; }
#define ATT_DMA(t, kb_, vb_) do { _Pragma("unroll") for (int j = 0; j < 2; ++j) { \
        __builtin_amdgcn_global_load_lds((const unsigned*)(ksrc[j] + (size_t)64 * (t) * BW), (LAS unsigned*)((kb_) + kdst[j]), 16, 0, 0); \
        __builtin_amdgcn_global_load_lds((const unsigned*)(vsrc[j] + (size_t)64 * (t) * BW), (LAS unsigned*)((vb_) + vdst[j]), 16, 0, 0); } } while (0)
    bf16x8 qf[4];
#pragma unroll
    for (int d0 = 0; d0 < 4; ++d0) qf[d0] = *(const bf16x8*)(AQ + (rowbase + q0 + r32) * BW + h * 128 + mp * 64 + d0 * 16 + hi * 8);
    const float slope2 = exp2f(-2.0f * (float)(h + 1)) * LOG2E;
    float m = 0.f, lsum = 0.f; bool first = true;
    f32x16 o[4];
#pragma unroll
    for (int d0 = 0; d0 < 4; ++d0) o[d0] = f32x16{};
    bf16x8 pa0 = bf16x8{}, pa1 = bf16x8{}, pa2 = bf16x8{}, pa3 = bf16x8{};
    const int kroff = mp * A_KSLOT + r32 * 128;
    const int vroff = (4 * hi + ((lane & 15) >> 2)) * 64 + ((lane >> 4) & 1) * 32 + (lane & 3) * 8;
#define ATT_A(P0, P1, t, kb_) do { \
        const float sb_ = slope2 * (float)(64 * (t) + 4 * hi - (q0 + r32)) - m; \
        _Pragma("unroll") for (int r = 0; r < 16; r += 2) { P0[r] = fmaf(slope2, (float)((r & 3) + 8 * (r >> 2)), sb_); P1[r] = fmaf(slope2, (float)(32 + (r & 3) + 8 * (r >> 2)), sb_); \
            P0[r + 1] = P0[r] + slope2; P1[r + 1] = P1[r] + slope2; }     \
        _Pragma("unroll") for (int d0 = 0; d0 < 4; ++d0) { const int ch_ = ((2 * d0 + hi) ^ (r32 & 7)) * 16; \
            P0 = MFMA32(ld8((kb_) + kroff + ch_), qf[d0], P0); P1 = MFMA32(ld8((kb_) + kroff + 32 * 128 + ch_), qf[d0], P1); } } while (0)
#define ATT_MASK(P0, P1, t) do { const int krel_ = 64 * (t) + 4 * hi - (q0 + r32); \
        _Pragma("unroll") for (int r = 0; r < 16; ++r) { const int d_ = krel_ + (r & 3) + 8 * (r >> 2); if (d_ > 0) P0[r] = -INFINITY; if (d_ + 32 > 0) P1[r] = -INFINITY; } } while (0)
    __syncthreads();
    {
        *(LAS u32x4*)(lds + A_V0 + 3 * A_VBUF + tid * 32) = (u32x4){0u, 0u, 0u, 0u}; *(LAS u32x4*)(lds + A_V0 + 3 * A_VBUF + tid * 32 + 16) = (u32x4){0u, 0u, 0u, 0u}; }
    ATT_DMA(NT - 1, lds, lds + A_V0);
    ATT_DMA(NT - 2, lds + A_KBUF, lds + A_V0 + A_VBUF);
    __syncthreads();
    f32x16 s0, s1;
    ATT_A(s0, s1, NT - 1, lds); ATT_MASK(s0, s1, NT - 1);
    __syncthreads();
    bool resc = false;
#define ATT_RESC() do { if (resc) { _Pragma("unroll") for (int r = 0; r < 16; ++r) { const float a = wsf[crow(r, hi)]; _Pragma("unroll") for (int d0 = 0; d0 < 4; ++d0) o[d0][r] *= a; } resc = false; } } while (0)
#define ATT_TRIP(i, S0, S1, N0, N1, PR0, PR1, PR2, PR3, PW0, PW1, PW2, PW3) do { \
        const int t = NT - 1 - (i); \
        if ((i) == 1) ATT_MASK(S0, S1, t); \
        ATT_RESC(); \
        if (!(ABL & 8) && (i) + 2 < NT) ATT_DMA(t - 2, lds + ((i) & 1) * A_KBUF, lds + A_V0 + (((i) + 2) & 3) * A_VBUF); \
        float mx_; \
        { const int tn = (t > 0) ? t - 1 : 0; lptr kb = lds + (((i) + (t > 0 ? 1 : 0)) & 1) * A_KBUF; \
          __builtin_amdgcn_sched_barrier(0); \
          ATT_A(N0, N1, tn, kb); \
          { float ma_, mb_; ATT_MAX3(ma_, S0[0], S1[0], S0[1]); ATT_MAX3(mb_, S1[1], S0[2], S1[2]); \
            _Pragma("unroll") for (int r = 3; r < 15; r += 2) { ATT_MAX3(ma_, ma_, S0[r], S1[r]); ATT_MAX3(mb_, mb_, S0[r + 1], S1[r + 1]); } \
            ATT_MAX3(ma_, ma_, S0[15], S1[15]); ATT_MAX3(mx_, ma_, mb_, mb_); } \
          __builtin_amdgcn_sched_group_barrier(0x2, 34, 0); \
          _Pragma("unroll") for (int k = 0; k < 8; ++k) { __builtin_amdgcn_sched_group_barrier(0x100, 1, 0); __builtin_amdgcn_sched_group_barrier(0x8, 1, 0); __builtin_amdgcn_sched_group_barrier(0x2, 3, 0); } \
          __builtin_amdgcn_sched_barrier(0); } \
        mx_ = swap_max(mx_); \
        const bool live = mx_ > -INFINITY; \
        const float dl = first ? (live ? mx_ : 0.f) : fmaxf(mx_, 0.f); \
        if (__any(first || dl > 0.f)) { \
            m += dl; \
            _Pragma("unroll") for (int r = 0; r < 16; ++r) { S0[r] -= dl; S1[r] -= dl; N0[r] -= dl; N1[r] -= dl; } \
            if (!first) { const float alpha = __builtin_amdgcn_exp2f(-dl); lsum *= alpha; if (hi == 0) wsf[r32] = alpha; resc = true; } \
            if (live) first = false; } \
        { __builtin_amdgcn_sched_barrier(0); \
          lptr vb = lds + A_V0 + (((i) + 3) & 3) * A_VBUF + vroff; \
          bf16x8 vfa = ATT_VF(0), vfb = ATT_VF(1); \
          float ps = 0.f, pt = 0.f, one_ = 1.0f; asm volatile("" : "+v"(one_));     \
          _Pragma("unroll") for (int k = 0; k < 16; ++k) { \
              bf16x8 vfn = vfb; \
              if (k + 2 < 16) vfn = ATT_VF(k + 2); \
              const bf16x8 cc = (k & 3) == 0 ? PR0 : (k & 3) == 1 ? PR1 : (k & 3) == 2 ? PR2 : PR3; \
              if (!(ABL & 4)) o[k >> 2] = MFMA32(cc, vfa, o[k >> 2]); else { asm volatile("" :: "v"(cc), "v"(vfa)); } \
              if (k < 8) { S0[2 * k] = ATT_EXP(S0[2 * k]); S0[2 * k + 1] = ATT_EXP(S0[2 * k + 1]); ps += S0[2 * k]; pt = fmaf(S0[2 * k + 1], one_, pt); } \
              else { S1[2 * k - 16] = ATT_EXP(S1[2 * k - 16]); S1[2 * k - 15] = ATT_EXP(S1[2 * k - 15]); ps += S1[2 * k - 16]; pt = fmaf(S1[2 * k - 15], one_, pt); } \
              if (k == 3) PW0 = pack_p(S0, 0); \
              if (k == 7) PW1 = pack_p(S0, 8); \
              if (k == 11) PW2 = pack_p(S1, 0); \
              if (k == 15) PW3 = pack_p(S1, 8); \
              vfa = vfb; vfb = vfn; \
              __builtin_amdgcn_sched_barrier(0); } \
          lsum += ps + pt; \
          asm volatile("" :: "v"(PW0), "v"(PW1), "v"(PW2), "v"(PW3), "v"(lsum));     \
          } \
        if (!(ABL & 16)) __syncthreads(); } while (0)
#define ATT_MAX3(d_, a_, b_, c_) asm("v_max3_f32 %0, %1, %2, %3" : "=v"(d_) : "v"(a_), "v"(b_), "v"(c_))
#define ATT_EXP(x_) ((ABL & 2) ? (x_) * 0.001f : __builtin_amdgcn_exp2f(x_))
#define ATT_VF(k_) cat8(vtr(vb + ((k_) >> 2) * 512 + ((k_) & 3) * 4096), vtr(vb + ((k_) >> 2) * 512 + ((k_) & 3) * 4096 + 2048))
    f32x16 n0, n1;
    bf16x8 pb0 = bf16x8{}, pb1 = bf16x8{}, pb2 = bf16x8{}, pb3 = bf16x8{};
    for (int i = 0; i < NT; i += 2) {
        ATT_TRIP(i, s0, s1, n0, n1, pa0, pa1, pa2, pa3, pb0, pb1, pb2, pb3);
        ATT_TRIP(i + 1, n0, n1, s0, s1, pb0, pb1, pb2, pb3, pa0, pa1, pa2, pa3);
    }
    ATT_RESC();
#undef ATT_RESC
#undef ATT_TRIP
#undef ATT_VF
#undef ATT_EXP
    { lptr vb = lds + A_V0 + ((NT - 1) & 3) * A_VBUF + vroff;
#pragma unroll
      for (int d0 = 0; d0 < 4; ++d0) { lptr vp_ = vb + d0 * 512;
        const bf16x8 v0 = cat8(vtr(vp_), vtr(vp_ + 2048)), v1 = cat8(vtr(vp_ + 4096), vtr(vp_ + 4096 + 2048));
        const bf16x8 v2 = cat8(vtr(vp_ + 8192), vtr(vp_ + 8192 + 2048)), v3 = cat8(vtr(vp_ + 12288), vtr(vp_ + 12288 + 2048));
        o[d0] = MFMA32(pa0, v0, o[d0]); o[d0] = MFMA32(pa1, v1, o[d0]); o[d0] = MFMA32(pa2, v2, o[d0]); o[d0] = MFMA32(pa3, v3, o[d0]); } }
    __syncthreads();
#undef ATT_DMA
#undef ATT_A
#undef ATT_MASK
    lsum = swap_sum(lsum);
    if (hi == 0) wsf[32 + r32] = 1.0f / lsum;
    const float lam = ((const float*)(A.ws + WS_LAM))[l];
    LAS float* xch = (LAS float*)lds + qw * (4 * 16 * 64) + lane;
    if (mp == 1) {
#pragma unroll
        for (int r = 0; r < 16; ++r) { const float il = wsf[32 + crow(r, hi)] * lam;
#pragma unroll
            for (int d0 = 0; d0 < 4; ++d0) xch[(d0 * 16 + r) * 64] = o[d0][r] * il; }
    }
    __syncthreads();
    if (mp == 0) {
        float ss[16];
#pragma unroll
        for (int r = 0; r < 16; ++r) { const float il = wsf[32 + crow(r, hi)]; float s_ = 0.f;
#pragma unroll
            for (int d0 = 0; d0 < 4; ++d0) { const float y = o[d0][r] * il - xch[(d0 * 16 + r) * 64]; o[d0][r] = y; s_ += y * y; }
            ss[r] = s_; }
#pragma unroll
        for (int r = 0; r < 16; ++r) { float v = ss[r]; v += __shfl_xor(v, 1); v += __shfl_xor(v, 2); v += __shfl_xor(v, 4); v += __shfl_xor(v, 8); v += __shfl_xor(v, 16); ss[r] = v; }
        int l_ = l; asm volatile("" : "+s"(l_));
        const float osc = 1.0f - lam_init_of(l_);
        const float* asg = A.in[I_ASG] + l * 128;
        float gv[4];
#pragma unroll
        for (int d0 = 0; d0 < 4; ++d0) gv[d0] = asg[32 * d0 + r32] * osc;
        LAS bf16_t* stg = (LAS bf16_t*)(lds + A_STAGE) + qw * (32 * 128);
#pragma unroll
        for (int r = 0; r < 16; ++r) { const float rn = __builtin_amdgcn_rsqf(ss[r] * (1.0f / 128.0f) + RMS_EPS); const int row = crow(r, hi);
#pragma unroll
            for (int d0 = 0; d0 < 4; d0 += 2) { const unsigned pk_ = pg8::cvt_pk_bf16(o[d0][r] * rn * gv[d0], o[d0 + 1][r] * rn * gv[d0 + 1]); stg[row * 128 + 32 * d0 + r32] = (bf16_t)(pk_ & 0xffffu); stg[row * 128 + 32 * (d0 + 1) + r32] = (bf16_t)(pk_ >> 16); } }
        bf16_t* YA = ABL ? (bf16_t*)(A.ws + 254 * MiB) + (size_t)(blockIdx.x & 63) * 32 * BW : (bf16_t*)(A.ws + WS_YA) + (rowbase + q0) * BW + h * 128;
#pragma unroll
        for (int i = 0; i < 8; ++i) { const int idx = lane + 64 * i, row = idx >> 4, ch = idx & 15;
            *(u32x4*)(YA + (size_t)row * BW + ch * 8) = *(const LAS u32x4*)(stg + row * 128 + ch * 8); }
    }
}

__device__ __forceinline__ int offa(int row, int ch) { return 2048 * (row >> 3) + 512 * (ch >> 2) + 64 * (row & 7) + 16 * ((ch & 3) ^ ((row >> 2) & 3)); }
constexpr int R_K = 0, R_V = 32768, R_RT = 65536, R_ST = 98304, R_SS = 131072 + 1024;
constexpr size_t WS_RSTATE = 76 * MiB;
constexpr int CW_RFLAG = 12288;
struct RetLane { int r32, hi, tnb0, tnb1, tpb0, tpb1, rb0, rb1, w; };
__device__ __forceinline__ RetLane ret_lane(int lane) {
    int ln = lane; asm volatile("" : "+v"(ln));
    RetLane L; L.r32 = ln & 31; L.hi = ln >> 5; const int tq = (ln & 15) >> 2, tp = ln & 3, tg = (ln >> 4) & 1, z = 2 * tg + (tp >> 1); L.w = (L.r32 >> 2) & 3;
    L.tnb0 = 2048 * L.hi + 64 * tq + 8 * (tp & 1) + 16 * (z ^ (2 * L.hi));
    L.tnb1 = 2048 * L.hi + 64 * (tq + 4) + 8 * (tp & 1) + 16 * (z ^ (2 * L.hi + 1));
    L.tpb0 = 64 * (4 * L.hi + tq) + 8 * (tp & 1) + 16 * (z ^ L.hi);
    L.tpb1 = 2048 + 64 * (4 * L.hi + tq) + 8 * (tp & 1) + 16 * (z ^ (2 + L.hi));
    L.rb0 = 2048 * (L.r32 >> 3) + 64 * (L.r32 & 7) + 16 * (L.hi ^ L.w);
    L.rb1 = 2048 * (L.r32 >> 3) + 64 * (L.r32 & 7) + 16 * ((2 + L.hi) ^ L.w);
    return L;
}
__device__ __forceinline__ void ret_update(f32x16& R0, f32x16& R1, lptr lds, const RetLane& L, int qb, int vh, float g127, float g128) {
    f32x16 t0 = f32x16{}, t1 = f32x16{};
    lptr ka = lds + R_K + 512 * qb, va = lds + R_V + 512 * (2 * vh);
#pragma unroll
    for (int ks = 0; ks < 8; ++ks) {
        const bf16x8 kf = cat8(vtr(ka + L.tnb0 + 4096 * ks), vtr(ka + L.tnb1 + 4096 * ks));
        const bf16x8 v0 = cat8(vtr(va + L.tnb0 + 4096 * ks), vtr(va + L.tnb1 + 4096 * ks));
        const bf16x8 v1 = cat8(vtr(va + 512 + L.tnb0 + 4096 * ks), vtr(va + 512 + L.tnb1 + 4096 * ks));
        t0 = MFMA32(kf, v0, t0); t1 = MFMA32(kf, v1, t1);
    }
#pragma unroll
    for (int r = 0; r < 16; ++r) { R0[r] = g128 * R0[r] + g127 * t0[r]; R1[r] = g128 * R1[r] + g127 * t1[r]; }
}
#define RET_KV_LOAD(stK, stV, c_) do { const size_t r0_ = ((size_t)b * SEQ + 128 * (c_) + srow) * BW + h * 128 + sch * 8; \
    _Pragma("unroll") for (int j = 0; j < 4; ++j) { stK[j] = *(const u32x4*)(RK + r0_ + (size_t)32 * j * BW); stV[j] = *(const u32x4*)(RV + r0_ + (size_t)32 * j * BW); } } while (0)
#define RET_KV_WRITE(stK, stV) do { _Pragma("unroll") for (int j = 0; j < 4; ++j) { *(LAS u32x4*)(lds + R_K + sb + 8192 * j) = stK[j]; *(LAS u32x4*)(lds + R_V + sb + 8192 * j) = stV[j]; } } while (0)

__device__ __forceinline__ void ret_a_task(const Args& A, int l, int b, int h, int seg, lptr lds) {
    const int tid = opaque_tid(), lane = tid & 63; const int wid = __builtin_amdgcn_readfirstlane(tid >> 6), qb = wid & 3, vh = wid >> 2;
    const bf16_t* RK = (const bf16_t*)(A.ws + WS_RK); const bf16_t* RV = (const bf16_t*)(A.ws + WS_RV);
    const float l2g = log2_gamma(h); const float g127 = exp2f(127.0f * l2g), g128 = exp2f(128.0f * l2g);
    const int srow = tid >> 4, sch = tid & 15;
    const int sb = 2048 * (srow >> 3) + 512 * (sch >> 2) + 64 * (srow & 7) + 16 * ((sch & 3) ^ ((srow >> 2) & 3));
    f32x16 R0 = f32x16{}, R1 = f32x16{};
    u32x4 stK[4], stV[4];
    RET_KV_LOAD(stK, stV, 8 * seg);
    for (int cc = 0; cc < 8; ++cc) {
        const RetLane L = ret_lane(lane);
        LDS_BAR();
        RET_KV_WRITE(stK, stV);
        if (cc < 7) RET_KV_LOAD(stK, stV, 8 * seg + cc + 1);
        LDS_BAR();
        ret_update(R0, R1, lds, L, qb, vh, g127, g128);
    }
    unsigned long long* dst = (unsigned long long*)(A.ws + WS_RSTATE) + ((size_t)((b * 4 + h) * 3 + seg) * 8 + wid) * 512 + lane;
#pragma unroll
    for (int g = 0; g < 4; ++g) {
        __hip_atomic_store(dst + (2 * g) * 64, (unsigned long long)pg8::cvt_pk_bf16(R0[4 * g], R0[4 * g + 1]) | ((unsigned long long)pg8::cvt_pk_bf16(R0[4 * g + 2], R0[4 * g + 3]) << 32), RLX_AGENT);
        __hip_atomic_store(dst + (2 * g + 1) * 64, (unsigned long long)pg8::cvt_pk_bf16(R1[4 * g], R1[4 * g + 1]) | ((unsigned long long)pg8::cvt_pk_bf16(R1[4 * g + 2], R1[4 * g + 3]) << 32), RLX_AGENT);
    }
    asm volatile("s_waitcnt vmcnt(0)" ::: "memory");
    __syncthreads();
    if (threadIdx.x == 0) __hip_atomic_store((unsigned*)(A.ws + WS_CTL) + CW_RFLAG + 64 * ((l * 16 + b * 4 + h) * 4 + seg), 1u, RLX_AGENT);
}

__device__ __forceinline__ void ret_b_task(const Args& A, int l, int b, int h, int seg, lptr lds) {
    const int tid = opaque_tid(), lane = tid & 63; const int wid = __builtin_amdgcn_readfirstlane(tid >> 6), qb = wid & 3, vh = wid >> 2;
    const bf16_t* RQ = (const bf16_t*)(A.ws + WS_RQ); const bf16_t* RK = (const bf16_t*)(A.ws + WS_RK); const bf16_t* RV = (const bf16_t*)(A.ws + WS_RV);
    const bf16_t* RG = (const bf16_t*)(A.ws + WS_RG); bf16_t* YC = (bf16_t*)(A.ws + WS_YC);
    const float l2g = log2_gamma(h); const float gam = exp2f(l2g), g127 = exp2f(127.0f * l2g), g128 = exp2f(128.0f * l2g);
    const float* gn = A.in[I_RGN] + l * 128;
    LAS float* ssq = (LAS float*)(lds + R_SS);
    const int srow = tid >> 4, sch = tid & 15;
    const int sb = 2048 * (srow >> 3) + 512 * (sch >> 2) + 64 * (srow & 7) + 16 * ((sch & 3) ^ ((srow >> 2) & 3));
    u32x4 stK[4], stV[4];
    RET_KV_LOAD(stK, stV, 8 * seg);
    f32x16 R0 = f32x16{}, R1 = f32x16{};
    if (seg > 0) {
        if (threadIdx.x < 64) {
            unsigned* fl = (unsigned*)(A.ws + WS_CTL) + CW_RFLAG + 64 * ((l * 16 + b * 4 + h) * 4);
            unsigned spins = 0;
            for (;;) {
                unsigned ok = 1u;
                for (int s2 = 0; s2 < seg; ++s2) ok &= __hip_atomic_load(fl + 64 * s2, RLX_AGENT);
                if (__builtin_amdgcn_readfirstlane(ok)) break;
                __builtin_amdgcn_s_sleep(8);
                if (++spins > (1u << 22)) break;
            }
        }
        __syncthreads();
        const float g1024 = exp2f(1024.0f * l2g);
        for (int s2 = 0; s2 < seg; ++s2) {
            const unsigned long long* src = (const unsigned long long*)(A.ws + WS_RSTATE) + ((size_t)((b * 4 + h) * 3 + s2) * 8 + wid) * 512 + lane;
#pragma unroll
            for (int r = 0; r < 16; ++r) { R0[r] *= g1024; R1[r] *= g1024; }
#pragma unroll
            for (int g = 0; g < 4; ++g) {
                const unsigned long long a0 = __hip_atomic_load(src + (2 * g) * 64, RLX_AGENT), a1 = __hip_atomic_load(src + (2 * g + 1) * 64, RLX_AGENT);
                R0[4 * g] += bf2f((unsigned)a0 & 0xffffu); R0[4 * g + 1] += __uint_as_float((unsigned)a0 & 0xffff0000u); R0[4 * g + 2] += bf2f((unsigned)(a0 >> 32) & 0xffffu); R0[4 * g + 3] += __uint_as_float((unsigned)(a0 >> 32) & 0xffff0000u);
                R1[4 * g] += bf2f((unsigned)a1 & 0xffffu); R1[4 * g + 1] += __uint_as_float((unsigned)a1 & 0xffff0000u); R1[4 * g + 2] += bf2f((unsigned)(a1 >> 32) & 0xffffu); R1[4 * g + 3] += __uint_as_float((unsigned)(a1 >> 32) & 0xffff0000u);
            }
        }
    }
    bf16x8 qf[8];
    u32x4 gst[4];
#define RET_Q_LOAD(c_) do { const size_t r0_ = ((size_t)b * SEQ + 128 * (c_) + 32 * qb + (lane & 31)) * BW + h * 128 + (lane >> 5) * 8; \
    _Pragma("unroll") for (int ds = 0; ds < 8; ++ds) qf[ds] = *(const bf16x8*)(RQ + r0_ + ds * 16); } while (0)
#define RET_G_LOAD(c_) do { _Pragma("unroll") for (int i = 0; i < 4; ++i) { const int idx_ = lane + 64 * i; \
    gst[i] = *(const u32x4*)(RG + ((size_t)b * SEQ + 128 * (c_) + 32 * qb + (idx_ >> 3)) * BW + h * 128 + 64 * vh + (idx_ & 7) * 8); } } while (0)
    RET_Q_LOAD(8 * seg); RET_G_LOAD(8 * seg);
    for (int cc = 0; cc < 8; ++cc) {
        const int c = 8 * seg + cc;
        const RetLane L = ret_lane(lane);
        const int r32 = L.r32, hi = L.hi, w = L.w;
        const size_t crow0 = (size_t)b * SEQ + 128 * c;
        lptr stg = lds + R_ST + 4096 * wid;
        LDS_BAR();
        RET_KV_WRITE(stK, stV);
        if (c > 0) {
            lptr rw = lds + R_RT + 256 * (64 * vh) + 2048 * (r32 >> 3) + 64 * (r32 & 7) + 512 * qb + 8 * hi;
#pragma unroll
            for (int g = 0; g < 4; ++g) {
                *(LAS u32x2*)(rw + 16 * (g ^ w)) = (u32x2){pg8::cvt_pk_bf16(R0[4 * g], R0[4 * g + 1]), pg8::cvt_pk_bf16(R0[4 * g + 2], R0[4 * g + 3])};
                *(LAS u32x2*)(rw + 8192 + 16 * (g ^ w)) = (u32x2){pg8::cvt_pk_bf16(R1[4 * g], R1[4 * g + 1]), pg8::cvt_pk_bf16(R1[4 * g + 2], R1[4 * g + 3])};
            }
        }
#pragma unroll
        for (int i = 0; i < 4; ++i) { const int idx = lane + 64 * i; *(LAS u32x4*)(stg + (idx >> 3) * 128 + (idx & 7) * 16) = gst[i]; }
        LDS_BAR();
        f32x16 o0 = f32x16{}, o1 = f32x16{};
        for (int kb = 0; kb <= qb; ++kb) {
            f32x16 p = f32x16{};
            lptr kr = lds + R_K + 8192 * kb;
            { bf16x8 kf_[8];
#pragma unroll
              for (int ds = 0; ds < 8; ++ds) kf_[ds] = ld8(kr + ((ds & 1) ? L.rb1 : L.rb0) + 512 * (ds >> 1));
              __builtin_amdgcn_sched_barrier(0);
#pragma unroll
              for (int ds = 0; ds < 8; ++ds) p = MFMA32(kf_[ds], qf[ds], p);
              __builtin_amdgcn_sched_barrier(0); }
            if (kb == qb) {
#pragma unroll
                for (int r = 0; r < 16; ++r) if (crow(r, hi) > r32) p[r] = 0.f;
            }
            const bf16x8 pa0 = pack_p(p, 0), pa1 = pack_p(p, 8);
            lptr vr = lds + R_V + 8192 * kb + 512 * (2 * vh);
            { bf16x8 vf_[2][2];
#pragma unroll
              for (int s2 = 0; s2 < 2; ++s2) { vf_[s2][0] = cat8(vtr(vr + L.tpb0 + 4096 * s2), vtr(vr + L.tpb1 + 4096 * s2));
                                               vf_[s2][1] = cat8(vtr(vr + 512 + L.tpb0 + 4096 * s2), vtr(vr + 512 + L.tpb1 + 4096 * s2)); }
              __builtin_amdgcn_sched_barrier(0);
              o0 = MFMA32(pa0, vf_[0][0], o0); o1 = MFMA32(pa0, vf_[0][1], o1); o0 = MFMA32(pa1, vf_[1][0], o0); o1 = MFMA32(pa1, vf_[1][1], o1);
              __builtin_amdgcn_sched_barrier(0); }
        }
        if (c > 0) {
            f32x16 x0 = f32x16{}, x1 = f32x16{};
            lptr rr = lds + R_RT + 256 * (64 * vh);
#pragma unroll
            for (int ds = 0; ds < 8; ++ds) {
                const int ob = ((ds & 1) ? L.rb1 : L.rb0) + 512 * (ds >> 1);
                x0 = MFMA32(qf[ds], ld8(rr + ob), x0);
                x1 = MFMA32(qf[ds], ld8(rr + 8192 + ob), x1);
            }
#pragma unroll
            for (int r = 0; r < 16; ++r) { o0[r] += gam * x0[r]; o1[r] += gam * x1[r]; }
        }
#pragma unroll
        for (int r = 0; r < 16; ++r) { const float v = half_sum32(o0[r] * o0[r] + o1[r] * o1[r]);
            if (r32 == 16) ssq[vh * 128 + 32 * qb + crow(r, hi)] = v; }
        if (cc < 7) RET_KV_LOAD(stK, stV, c + 1);
        LDS_BAR();
        if (c < SEQ / 128 - 1) ret_update(R0, R1, lds, L, qb, vh, g127, g128);
        if (cc < 7) { RET_Q_LOAD(c + 1); RET_G_LOAD(c + 1); }
        const float gn0 = gn[64 * vh + r32], gn1 = gn[64 * vh + 32 + r32];
#pragma unroll
        for (int r = 0; r < 16; ++r) {
            const int row = crow(r, hi);
            const float rn = rsqrtf((ssq[32 * qb + row] + ssq[128 + 32 * qb + row]) * (1.0f / 128.0f) + RMS_EPS);
            LAS bf16_t* sp = (LAS bf16_t*)(stg + row * 128) + r32;
            const unsigned pk_ = pg8::cvt_pk_bf16(o0[r] * rn * gn0 * bf2f(sp[0]), o1[r] * rn * gn1 * bf2f(sp[32]));
            sp[0] = (bf16_t)(pk_ & 0xffffu); sp[32] = (bf16_t)(pk_ >> 16);
        }
#pragma unroll
        for (int i = 0; i < 4; ++i) { const int idx = lane + 64 * i;
            *(u32x4*)(YC + (crow0 + 32 * qb + (idx >> 3)) * BW + h * 128 + 64 * vh + (idx & 7) * 8) = *(const LAS u32x4*)(stg + (idx >> 3) * 128 + (idx & 7) * 16); }
    }
#undef RET_Q_LOAD
#undef RET_G_LOAD
}
#undef RET_KV_LOAD
#undef RET_KV_WRITE
#undef MFMA32

constexpr int C_Z = 65536;
__device__ __forceinline__ void conv_task(const Args& A, int l, int task, lptr lds) {
    const int tid = opaque_tid(), lane = tid & 63; const int wave = __builtin_amdgcn_readfirstlane(tid >> 6);
    const bf16_t* Z = (const bf16_t*)(A.ws + WS_Z); bf16_t* YB = (bf16_t*)(A.ws + WS_YB);
    const float* cw = A.in[I_CW] + (size_t)l * 31 * BW; const float* cb = A.in[I_CB] + l * BW;
    const float* lg = A.in[I_CLG] + l * BW; const float* lb = A.in[I_CLB] + l * BW;
    const int m0 = task * 32, t0 = m0 & (SEQ - 1);
    __syncthreads();
    for (int pc = wave; pc < 62; pc += NWAVES) {
        const int j = pc >> 1, hf = pc & 1;
        __builtin_amdgcn_global_load_lds((const unsigned*)(cw + (size_t)j * BW + 8 * lane + 4 * hf), (LAS unsigned*)(lds + pc * 1024), 16, 0, 0);
    }
    for (int r = wave; r < 62; r += NWAVES) {
        if (t0 - 30 + r >= 0) __builtin_amdgcn_global_load_lds((const unsigned*)(Z + (size_t)(m0 - 30 + r) * BW + lane * 8), (LAS unsigned*)(lds + C_Z + r * 1024), 16, 0, 0);
        else { unsigned zz = 0u; asm volatile("" : "+v"(zz)); *(LAS u32x4*)(lds + C_Z + r * 1024 + lane * 16) = (u32x4){zz, zz, zz, zz}; }
    }
    __syncthreads();
    const int c0 = lane * 8;
    float acc[4][8];
    { const f32x4 b0 = *(const f32x4*)(cb + c0), b1 = *(const f32x4*)(cb + c0 + 4);
#pragma unroll
      for (int k = 0; k < 4; ++k) { acc[k][0] = b0[0]; acc[k][1] = b0[1]; acc[k][2] = b0[2]; acc[k][3] = b0[3]; acc[k][4] = b1[0]; acc[k][5] = b1[1]; acc[k][6] = b1[2]; acc[k][7] = b1[3]; } }
    float zf[4][8];
    lptr zb = lds + C_Z + (4 * wave) * 1024 + lane * 16;
#define CONV_ZROW(slot, rr) do { const u32x4 v_ = *(const LAS u32x4*)(zb + (rr) * 1024); \
        zf[slot][0] = __uint_as_float(v_.x << 16); zf[slot][1] = __uint_as_float(v_.x & 0xffff0000u); zf[slot][2] = __uint_as_float(v_.y << 16); zf[slot][3] = __uint_as_float(v_.y & 0xffff0000u); \
        zf[slot][4] = __uint_as_float(v_.z << 16); zf[slot][5] = __uint_as_float(v_.z & 0xffff0000u); zf[slot][6] = __uint_as_float(v_.w << 16); zf[slot][7] = __uint_as_float(v_.w & 0xffff0000u); } while (0)
    CONV_ZROW(0, 0); CONV_ZROW(1, 1); CONV_ZROW(2, 2); CONV_ZROW(3, 3);
#pragma unroll
    for (int j = 0; j < 31; ++j) {
        const f32x4 w0 = *(const LAS f32x4*)(lds + ((j * 2 + 0) * 64 + lane) * 16), w1 = *(const LAS f32x4*)(lds + ((j * 2 + 1) * 64 + lane) * 16);
#pragma unroll
        for (int k = 0; k < 4; ++k) {
            const int sl = (j + k) & 3;
            acc[k][0] += w0[0] * zf[sl][0]; acc[k][1] += w0[1] * zf[sl][1]; acc[k][2] += w0[2] * zf[sl][2]; acc[k][3] += w0[3] * zf[sl][3];
            acc[k][4] += w1[0] * zf[sl][4]; acc[k][5] += w1[1] * zf[sl][5]; acc[k][6] += w1[2] * zf[sl][6]; acc[k][7] += w1[3] * zf[sl][7];
        }
        if (j < 30) CONV_ZROW(j & 3, j + 4);
    }
#undef CONV_ZROW
    const f32x4 g0 = *(const f32x4*)(lg + c0), g1 = *(const f32x4*)(lg + c0 + 4), h0 = *(const f32x4*)(lb + c0), h1 = *(const f32x4*)(lb + c0 + 4);
#pragma unroll
    for (int k = 0; k < 4; ++k) {
        float s_ = 0.f;
#pragma unroll
        for (int e = 0; e < 8; ++e) s_ += acc[k][e];
        const float mu = wave_sum(s_) * (1.0f / BW);
        float q = 0.f;
#pragma unroll
        for (int e = 0; e < 8; ++e) { acc[k][e] -= mu; q += acc[k][e] * acc[k][e]; }
        const float rstd = __builtin_amdgcn_rsqf(wave_sum(q) * (1.0f / BW) + LN_EPS);
        float o[8];
#pragma unroll
        for (int e = 0; e < 4; ++e) { const float a_ = acc[k][e] * rstd * g0[e] + h0[e], b_ = acc[k][4 + e] * rstd * g1[e] + h1[e]; o[e] = a_ * sigx(-LOG2E * a_); o[4 + e] = b_ * sigx(-LOG2E * b_); }
        *(uint4*)(YB + (size_t)(m0 + 4 * wave + k) * BW + c0) = make_uint4(pg8::cvt_pk_bf16(o[0], o[1]), pg8::cvt_pk_bf16(o[2], o[3]), pg8::cvt_pk_bf16(o[4], o[5]), pg8::cvt_pk_bf16(o[6], o[7]));
    }
}

constexpr int Q_RA = 6, Q_AT = 32, Q_RB = 8, Q_CONV = 64, Q_TASKS = Q_RA + Q_AT + Q_RB + Q_AT + Q_CONV;
constexpr int CW_QUEUE = 8192;
__device__ __forceinline__ void mixer_phase(const Args& A, int l, lptr lds, volatile LAS unsigned* slot) {
    const int x0 = (int)(xb_xcc_id() & 7u);
    int qi = 0;
    for (;;) {
        const int x = (x0 + qi) & 7;
        unsigned* ctr = (unsigned*)(A.ws + WS_CTL) + CW_QUEUE + 64 * (8 * l + x);
        __syncthreads();
        if (threadIdx.x == 0) *slot = __hip_atomic_fetch_add(ctr, 1u, __ATOMIC_RELAXED, __HIP_MEMORY_SCOPE_AGENT);
        __syncthreads();
        int id = (int)*slot;
        if (id >= Q_TASKS) { if (++qi == 8) break; continue; }
#if PROBE_PHASE >= 10
        const unsigned t0_ = (unsigned)__builtin_amdgcn_s_memrealtime(); int kind = 0;
#endif
        if (id < Q_RA) { const int bh = 2 * x + id / 3; ret_a_task(A, l, bh >> 2, bh & 3, id % 3, lds); }
        else if ((id -= Q_RA) < Q_AT) { const int bh = 2 * x + (id & 1); attn_unit<0>(A, l, bh >> 2, bh & 3, 31 - (id >> 1), lds);
#if PROBE_PHASE >= 10
            kind = 1;
#endif
        }
        else if ((id -= Q_AT) < Q_RB) { const int bh = 2 * x + (id >> 2); ret_b_task(A, l, bh >> 2, bh & 3, id & 3, lds); }
        else if ((id -= Q_RB) < Q_AT) { const int bh = 2 * x + (id & 1); attn_unit<0>(A, l, bh >> 2, bh & 3, 15 - (id >> 1), lds);
#if PROBE_PHASE >= 10
            kind = 1;
#endif
        }
        else { id -= Q_AT; conv_task(A, l, 64 * x + id, lds);
#if PROBE_PHASE >= 10
            kind = 2;
#endif
        }
#if PROBE_PHASE >= 10
        __syncthreads();
        if (threadIdx.x == 0 && kind == PROBE_PHASE - 10) atomicAdd((unsigned*)(A.ws + WS_CTL) + CW_QUEUE + 2048, (unsigned)__builtin_amdgcn_s_memrealtime() - t0_);
#endif
    }
#if ABL_ATTN > 0
    if (l == 0) {
        unsigned* ctr2 = (unsigned*)(A.ws + WS_CTL) + CW_QUEUE + 4096;
        for (;;) {
            __syncthreads();
            if (threadIdx.x == 0) *slot = __hip_atomic_fetch_add(ctr2, 1u, __ATOMIC_RELAXED, __HIP_MEMORY_SCOPE_AGENT);
            __syncthreads();
            const int id = (int)*slot;
            if (id >= 512) break;
            attn_unit<ABL_ATTN>(A, l, (id & 15) >> 2, id & 3, 31 - (id >> 4), lds);
        }
    }
#endif
}
}

constexpr int N_PHASES = 1 + 6 * DEPTH;
constexpr int RING_BYTES = 131072, MISC_OFF = RING_BYTES + 320, LDS_BYTES = 147456;
#ifndef FAST_GEMM
#define FAST_GEMM 1
#endif
#ifndef FAST_MIX
#define FAST_MIX 1
#endif
#ifndef FAST_MASK
#define FAST_MASK 0x3f
#endif
__global__ void __launch_bounds__(NTHREADS, 2) fwd_kernel(Args A) {
    extern __shared__ __attribute__((aligned(16))) unsigned char lds[];
    float* sm = (float*)lds;
    LAS unsigned char* ldsl = (LAS unsigned char*)lds;
    volatile LAS unsigned* MISC = (volatile LAS unsigned*)(ldsl + MISC_OFF);
    const int wg = blockIdx.x, nwg = gridDim.x;
    const bool multi = (A.ph_hi - A.ph_lo) > 1;
    XcdBarrier bar; bar.bar = nullptr; bar.x = 0; bar.st = nullptr;
    if (multi) {
        if (threadIdx.x < 2) MISC[threadIdx.x] = 0u;
        __syncthreads();
        bar = xcd_barrier_post((unsigned*)(A.ws + WS_CTL) + CW_BAR, MISC);
    }
    const Args& A0 = A;
#if PROBE_PHASE >= 0
    if (blockIdx.x == 0 && threadIdx.x == 0) { const unsigned now = (unsigned)__builtin_amdgcn_s_memrealtime(); MISC[8] = now; MISC[9] = 0u; MISC[10] = now; }
#endif
    for (int ph = A0.ph_lo; ph < A0.ph_hi; ++ph) {
        Args A = A0;
        asm volatile("" : "+s"(A.out), "+s"(A.ws));
        if (ph == 0) { nv_p0(A, wg, nwg); if (FAST_GEMM) fast_p0_weights(A, wg, nwg, (LAS float*)ldsl, 0, NI_W1, true); }
        else {
            const int l = (ph - 1) / 6, k = (ph - 1) % 6;
            if (k == 1) {
#if FAST_MIX
                mx::mixer_phase(A, l, ldsl, MISC + 4);
#else
                nv_attn(A, l, wg, nwg, sm); nv_conv(A, l, wg, nwg); nv_ret(A, l, wg, nwg, sm);
#endif
            }
            else if (FAST_GEMM && ((FAST_MASK >> k) & 1)) fast_gemm(A, l, k, ldsl);
            else if (k == 0) nv_p1(A, l, wg, nwg, sm);
            else if (k == 2) nv_p3(A, l, wg, nwg, sm);
            else if (k == 3) nv_resid_gemm(A, (const bf16_t*)(A.ws + WS_Y), DM, DM, A.in[I_WOUT] + (size_t)l * DM * DM, l == 0 ? A.in[I_X] : A.out,
                                           (float*)(A.ws + WS_ROWSS) + (size_t)(l == 0 ? 1 : 3) * M, wg, nwg, sm);
            else if (k == 4) nv_p5(A, l, wg, nwg, sm);
            else nv_resid_gemm(A, (const bf16_t*)(A.ws + WS_MID), DFF, DFF, A.in[I_WF2] + (size_t)l * DFF * DM, A.out,
                               l + 1 < DEPTH ? (float*)(A.ws + WS_ROWSS) + (size_t)2 * M : nullptr, wg, nwg, sm);
        }
        if (ph + 1 < A0.ph_hi) xcd_barrier(bar);
#if PROBE_PHASE >= 0
        if (blockIdx.x == 0 && threadIdx.x == 0) { const unsigned long long now = __builtin_amdgcn_s_memrealtime(); const int k = ph == 0 ? 0 : 1 + (ph - 1) % 6;
            if (k == PROBE_PHASE) MISC[9] += (unsigned)now - MISC[10]; MISC[10] = (unsigned)now; }
#endif
    }
#if PROBE_PHASE >= 0
    xcd_barrier(bar);
    if (blockIdx.x == 0 && threadIdx.x == 0) { const unsigned now = (unsigned)__builtin_amdgcn_s_memrealtime(); float frac = (float)MISC[9] / (float)(now - MISC[8]);
        if (PROBE_PHASE >= 10) frac = (float)__hip_atomic_load((unsigned*)(A0.ws + WS_CTL) + mx::CW_QUEUE + 2048, __ATOMIC_RELAXED, __HIP_MEMORY_SCOPE_AGENT) / ((float)gridDim.x * (float)(now - MISC[8]));
        A0.out[0] += 2.0f + 28.0f * frac; }
#endif
}

extern "C" void kernel_launch(void* const* d_in, const int* in_sizes, int n_in, void* d_out, int out_size, void* d_ws, size_t ws_size, hipStream_t stream) {
    static int grid = 0;
    if (grid == 0) {
        if (n_in != N_IN || out_size != M * DM || ws_size < WS_END) { fprintf(stderr, "kernel_launch: unexpected shapes (n_in %d out %d ws %zu)\n", n_in, out_size, ws_size); grid = -1; return; }
        int dev = 0, cus = 0, per_cu = 0;
        (void)hipGetDevice(&dev); (void)hipDeviceGetAttribute(&cus, hipDeviceAttributeMultiprocessorCount, dev);
        (void)hipFuncSetAttribute((const void*)fwd_kernel, hipFuncAttributeMaxDynamicSharedMemorySize, LDS_BYTES);
        (void)hipOccupancyMaxActiveBlocksPerMultiprocessor(&per_cu, (const void*)fwd_kernel, NTHREADS, LDS_BYTES);
        (void)hipGetLastError();
        if (per_cu < 1) fprintf(stderr, "kernel_launch: occupancy query says %d blocks per CU\n", per_cu);
        grid = cus;
    }
    if (grid < 0) return;
    (void)hipMemsetAsync((char*)d_ws + WS_CTL, 0, CTL_ZERO_BYTES, stream);
    Args a{};
    for (int i = 0; i < N_IN; ++i) a.in[i] = (const float*)d_in[i];
    a.out = (float*)d_out; a.ws = (unsigned char*)d_ws;
    a.ph_lo = 0; a.ph_hi = N_PHASES;
    void* args[] = {&a};
    hipError_t e = hipLaunchCooperativeKernel((const void*)fwd_kernel, dim3(grid), dim3(NTHREADS), args, LDS_BYTES, stream);
    if (e != hipSuccess) fprintf(stderr, "cooperative launch failed: %s (grid %d)\n", hipGetErrorString(e), grid);
}
```
